# Optimizing an MI355X kernel written in HIP

```python
import math
import jax, jax.numpy as jnp
from jax import lax
import numpy as np

D_MODEL = 2048
BATCH = 2
SEQ = 4096
DEPTH = 1

SSM_D_INNER = 1024
SSM_HEAD_DIM = 64
SSM_HEADS = SSM_D_INNER // SSM_HEAD_DIM
SSM_GROUPS = 4
SSM_STATE = 128
SSM_CONV = 4
SSM_CHUNK = 128
SSM_CONV_DIM = SSM_D_INNER + 2 * SSM_GROUPS * SSM_STATE

NSA_HEADS = 16
NSA_KV_HEADS = 4
NSA_HEAD_DIM = 64
NSA_Q_PER_KV = NSA_HEADS // NSA_KV_HEADS
NSA_D = NSA_HEADS * NSA_HEAD_DIM
KV_D = NSA_KV_HEADS * NSA_HEAD_DIM
CMP_BLOCK = 32
CMP_STRIDE = 16
CMP_HIDDEN = 512
SEL_BLOCK = 64
N_SELECT = 16
WINDOW = 512
Q_BLOCK = 128
ROPE_THETA = 500000.0
ROPE_DIM = NSA_HEAD_DIM // 4
SEL_FORCE_SCORE = 1.0e4

MIX_D = SSM_D_INNER + NSA_D
IN_PROJ_D = SSM_D_INNER + SSM_CONV_DIM + SSM_HEADS + NSA_D + 6 * KV_D + 3 * NSA_HEADS

N_EXPERTS = 32
TOP_K = 4
D_FF = 2048
SWIGLU_LIMIT = 7.0
SWIGLU_ALPHA = 1.702
MOE_BLOCK = 128
NORM_EPS = 1e-5

kernel_name = "hymba_ssd_nsa_moe_block"


def rmsnorm(x, w):
    xf = x.astype(jnp.float32)
    y = xf * lax.rsqrt(jnp.mean(xf * xf, axis=-1, keepdims=True) + NORM_EPS)
    return (y * w.astype(jnp.float32)).astype(x.dtype)


def masked_softmax(s, mask):
    s = jnp.where(mask, s.astype(jnp.float32), -jnp.inf)
    m = jnp.max(s, axis=-1, keepdims=True)
    m = jnp.where(jnp.isfinite(m), m, 0.0)
    e = jnp.where(mask, jnp.exp(s - m), 0.0)
    return e / jnp.maximum(jnp.sum(e, axis=-1, keepdims=True), 1e-30)


def rope_tables(pos):
    inv = ROPE_THETA ** (-jnp.arange(0, ROPE_DIM, 2, dtype=jnp.float32) / ROPE_DIM)
    ang = pos.astype(jnp.float32)[:, None] * inv[None, :]
    return jnp.cos(ang), jnp.sin(ang)


def partial_rope(x, cos, sin):
    half = ROPE_DIM // 2
    c = cos[:, None, :].astype(x.dtype)
    s = sin[:, None, :].astype(x.dtype)
    x1, x2, rest = x[..., :half], x[..., half:ROPE_DIM], x[..., ROPE_DIM:]
    return jnp.concatenate([x1 * c - x2 * s, x1 * s + x2 * c, rest], axis=-1)


def causal_depthwise_conv(u, w, b):
    out = lax.conv_general_dilated(
        u, w[:, None, :].astype(u.dtype), window_strides=(1,),
        padding=[(SSM_CONV - 1, 0)], dimension_numbers=("NWC", "WIO", "NWC"),
        feature_group_count=u.shape[-1])
    return out + b.astype(u.dtype)


def ssd_chunked_scan(x, dt, a, bm, cm):
    Bsz, S, H, P = x.shape
    N = bm.shape[-1]
    L = SSM_CHUNK
    nc = S // L
    X = (x.astype(jnp.float32) * dt[..., None]).reshape(Bsz, nc, L, H, P)
    Bc = bm.astype(jnp.float32).reshape(Bsz, nc, L, H, N)
    Cc = cm.astype(jnp.float32).reshape(Bsz, nc, L, H, N)
    a_cs = jnp.cumsum((dt * a).reshape(Bsz, nc, L, H), axis=2).transpose(0, 3, 1, 2)
    causal = jnp.tril(jnp.ones((L, L), dtype=bool))
    seg = a_cs[..., :, None] - a_cs[..., None, :]
    decay = jnp.exp(jnp.where(causal, seg, -jnp.inf))
    scores = jnp.einsum("bclhn,bcshn->bhcls", Cc, Bc) * decay
    y_diag = jnp.einsum("bhcls,bcshp->bclhp", scores, X)
    decay_to_end = jnp.exp(a_cs[..., -1:] - a_cs)
    states = jnp.einsum("bclhn,bhcl,bclhp->bchpn", Bc, decay_to_end, X)
    chunk_decay = jnp.exp(a_cs[..., -1])

    def step(h, inp):
        s_c, d_c = inp
        return d_c[..., None, None] * h + s_c, h

    _, prev = lax.scan(step, jnp.zeros((Bsz, H, P, N), jnp.float32),
                       (states.transpose(1, 0, 2, 3, 4), chunk_decay.transpose(2, 0, 1)))
    y_off = jnp.einsum("bclhn,cbhpn,bhcl->bclhp", Cc, prev, jnp.exp(a_cs))
    return (y_diag + y_off).reshape(Bsz, S, H, P).astype(x.dtype)


def gated_group_rmsnorm(y, z, w):
    g = (y * jax.nn.silu(z)).astype(jnp.float32)
    gs = g.reshape(*g.shape[:-1], SSM_GROUPS, -1)
    gs = gs * lax.rsqrt(jnp.mean(gs * gs, axis=-1, keepdims=True) + NORM_EPS)
    return (gs.reshape(g.shape) * w.astype(jnp.float32)).astype(y.dtype)


def ssd_mixer(z, xbc, dt_raw, conv_w, conv_b, dt_bias, a_log, d_skip, norm_w):
    Bsz, S, _ = z.shape
    xbc = jax.nn.silu(causal_depthwise_conv(xbc, conv_w, conv_b))
    xs, bm, cm = jnp.split(xbc, [SSM_D_INNER, SSM_D_INNER + SSM_GROUPS * SSM_STATE], axis=-1)
    rep = SSM_HEADS // SSM_GROUPS
    xs = xs.reshape(Bsz, S, SSM_HEADS, SSM_HEAD_DIM)
    bm = jnp.repeat(bm.reshape(Bsz, S, SSM_GROUPS, SSM_STATE), rep, axis=2)
    cm = jnp.repeat(cm.reshape(Bsz, S, SSM_GROUPS, SSM_STATE), rep, axis=2)
    dt = jax.nn.softplus((dt_raw + dt_bias).astype(jnp.float32))
    a = -jnp.exp(a_log.astype(jnp.float32))
    y = ssd_chunked_scan(xs, dt, a, bm, cm) + d_skip[:, None].astype(xs.dtype) * xs
    return gated_group_rmsnorm(y.reshape(Bsz, S, SSM_D_INNER), z, norm_w)


def compress_blocks(kv, pos_emb, w1, b1, w2, b2):
    Bsz, S, G, dh = kv.shape
    n_c = (S - CMP_BLOCK) // CMP_STRIDE + 1
    idx = jnp.arange(n_c)[:, None] * CMP_STRIDE + jnp.arange(CMP_BLOCK)[None, :]
    blocks = kv[:, idx] + pos_emb[:, None, :].astype(kv.dtype)
    blocks = blocks.transpose(0, 1, 3, 2, 4).reshape(Bsz, n_c, G, CMP_BLOCK * dh)
    h = jax.nn.gelu(blocks @ w1 + b1)
    return h @ w2 + b2


def nsa_mixer(q, k_cmp, v_cmp, k_slc, v_slc, k_win, v_win, gate_logits,
              cmp_pos_emb, cmp_w1, cmp_b1, cmp_w2, cmp_b2):
    Bsz, S, _ = q.shape
    G, R, dh = NSA_KV_HEADS, NSA_Q_PER_KV, NSA_HEAD_DIM
    scale = dh ** -0.5
    pos = jnp.arange(S, dtype=jnp.int32)
    cos, sin = rope_tables(pos)
    q = partial_rope(q.reshape(Bsz, S, NSA_HEADS, dh), cos, sin)
    kv_shape = (Bsz, S, G, dh)
    k_slc = partial_rope(k_slc.reshape(kv_shape), cos, sin)
    k_win = partial_rope(k_win.reshape(kv_shape), cos, sin)
    v_slc = v_slc.reshape(kv_shape)
    v_win = v_win.reshape(kv_shape)
    qg = q.reshape(Bsz, S, G, R, dh)

    kc = compress_blocks(k_cmp.reshape(kv_shape), cmp_pos_emb[0], cmp_w1[0], cmp_b1[0], cmp_w2[0], cmp_b2[0])
    vc = compress_blocks(v_cmp.reshape(kv_shape), cmp_pos_emb[1], cmp_w1[1], cmp_b1[1], cmp_w2[1], cmp_b2[1])
    n_c = kc.shape[1]
    cmp_end = jnp.arange(n_c, dtype=jnp.int32) * CMP_STRIDE + CMP_BLOCK - 1
    cc, sc = rope_tables(cmp_end)
    kc = partial_rope(kc, cc, sc)
    s_cmp = jnp.einsum("bsgrd,bcgd->bsgrc", qg, kc) * scale
    mask_cmp = cmp_end[None, :] <= pos[:, None]
    p_cmp = masked_softmax(s_cmp, mask_cmp[:, None, None, :])
    o_cmp = jnp.einsum("bsgrc,bcgd->bsgrd", p_cmp.astype(vc.dtype), vc)

    n_sel = S // SEL_BLOCK
    cmp_tok = jnp.arange(n_c)[:, None] * CMP_STRIDE + jnp.arange(CMP_BLOCK)[None, :]
    overlap = jax.nn.one_hot(cmp_tok // SEL_BLOCK, n_sel, dtype=jnp.float32).sum(axis=1)
    imp = jnp.einsum("bsgrc,cj->bsgj", p_cmp, overlap)
    cur = pos // SEL_BLOCK
    j = jnp.arange(n_sel)
    forced = (j[None, :] == 0) | (j[None, :] == cur[:, None]) | (j[None, :] == cur[:, None] - 1)
    valid = j[None, :] <= cur[:, None]
    score = jnp.where(forced[:, None, :], SEL_FORCE_SCORE,
                      jnp.where(valid[:, None, :], imp, -SEL_FORCE_SCORE))
    k_sel = min(N_SELECT, n_sel)
    _, sel_idx = lax.top_k(score, k_sel)

    nqb = S // Q_BLOCK
    span = WINDOW + Q_BLOCK
    pad = ((0, 0), (WINDOW, 0), (0, 0), (0, 0))
    k_win_pad = jnp.pad(k_win, pad)
    v_win_pad = jnp.pad(v_win, pad)
    b_ix = jnp.arange(Bsz)[:, None, None, None]
    g_ix = jnp.arange(G)[None, None, :, None]
    sel_off = jnp.arange(SEL_BLOCK, dtype=jnp.int32)

    def block_fn(args):
        qb, q_blk, idx_blk = args
        t = qb * Q_BLOCK + jnp.arange(Q_BLOCK, dtype=jnp.int32)
        tok = (idx_blk[..., None] * SEL_BLOCK + sel_off).reshape(Bsz, Q_BLOCK, G, k_sel * SEL_BLOCK)
        ks = k_slc[b_ix, tok, g_ix]
        vs = v_slc[b_ix, tok, g_ix]
        s = jnp.einsum("bqgrd,bqgnd->bqgrn", q_blk, ks) * scale
        m = (tok <= t[None, :, None, None])[:, :, :, None, :]
        p = masked_softmax(s, m).astype(vs.dtype)
        o_s = jnp.einsum("bqgrn,bqgnd->bqgrd", p, vs)
        kw = lax.dynamic_slice_in_dim(k_win_pad, qb * Q_BLOCK, span, axis=1)
        vw = lax.dynamic_slice_in_dim(v_win_pad, qb * Q_BLOCK, span, axis=1)
        kpos = qb * Q_BLOCK - WINDOW + jnp.arange(span, dtype=jnp.int32)
        dist = t[:, None] - kpos[None, :]
        mw = (dist >= 0) & (dist < WINDOW) & (kpos[None, :] >= 0)
        s = jnp.einsum("bqgrd,bkgd->bqgrk", q_blk, kw) * scale
        p = masked_softmax(s, mw[:, None, None, :]).astype(vw.dtype)
        o_w = jnp.einsum("bqgrk,bkgd->bqgrd", p, vw)
        return o_s, o_w

    q_blocks = qg.reshape(Bsz, nqb, Q_BLOCK, G, R, dh).transpose(1, 0, 2, 3, 4, 5)
    idx_blocks = sel_idx.reshape(Bsz, nqb, Q_BLOCK, G, k_sel).transpose(1, 0, 2, 3, 4)
    o_s, o_w = lax.map(block_fn, (jnp.arange(nqb, dtype=jnp.int32), q_blocks, idx_blocks))
    o_s = o_s.transpose(1, 0, 2, 3, 4, 5).reshape(Bsz, S, G, R, dh)
    o_w = o_w.transpose(1, 0, 2, 3, 4, 5).reshape(Bsz, S, G, R, dh)

    g = jax.nn.sigmoid(gate_logits.reshape(Bsz, S, G, R, 3))
    o = g[..., 0:1] * o_cmp + g[..., 1:2] * o_s + g[..., 2:3] * o_w
    return o.reshape(Bsz, S, NSA_D)


def moe_ffn(h, w_router, b_router, w_gate_up, b_gate_up, w_down, b_down):
    Bsz, S, D = h.shape
    T = Bsz * S
    xt = h.reshape(T, D)
    logits = xt @ w_router + b_router
    top_v, top_i = lax.top_k(logits, TOP_K)
    gates = jax.nn.softmax(top_v.astype(jnp.float32), axis=-1)
    n_rows = T * TOP_K
    e_flat = top_i.reshape(-1)
    tok_flat = jnp.arange(n_rows, dtype=jnp.int32) // TOP_K
    g_flat = gates.reshape(-1)
    order = jnp.argsort(e_flat)
    e_sorted = e_flat[order]
    counts = jnp.bincount(e_flat, length=N_EXPERTS)
    starts = jnp.cumsum(counts) - counts
    padded = ((counts + MOE_BLOCK - 1) // MOE_BLOCK) * MOE_BLOCK
    pad_end = jnp.cumsum(padded)
    pad_start = pad_end - padded
    dest = pad_start[e_sorted] + (jnp.arange(n_rows, dtype=jnp.int32) - starts[e_sorted])
    n_pad = n_rows + N_EXPERTS * MOE_BLOCK
    n_blocks = n_pad // MOE_BLOCK
    row_tok = jnp.full((n_pad,), T, dtype=jnp.int32).at[dest].set(tok_flat[order])
    row_gate = jnp.zeros((n_pad,), jnp.float32).at[dest].set(g_flat[order])
    blk_expert = jnp.minimum(
        jnp.searchsorted(pad_end, jnp.arange(n_blocks, dtype=jnp.int32) * MOE_BLOCK, side="right"),
        N_EXPERTS - 1)
    x_pad = jnp.concatenate([xt, jnp.zeros((1, D), xt.dtype)], axis=0)
    xb = x_pad[row_tok].reshape(n_blocks, MOE_BLOCK, D)

    def expert_block(args):
        xblk, e = args
        gu = xblk @ w_gate_up[e] + b_gate_up[e]
        gate = jnp.minimum(gu[:, :D_FF], SWIGLU_LIMIT)
        up = jnp.clip(gu[:, D_FF:], -SWIGLU_LIMIT, SWIGLU_LIMIT)
        glu = gate * jax.nn.sigmoid(SWIGLU_ALPHA * gate)
        return ((up + 1.0) * glu) @ w_down[e] + b_down[e]

    yb = lax.map(expert_block, (xb, blk_expert))
    y_rows = yb.reshape(n_pad, D) * row_gate[:, None].astype(yb.dtype)
    out = jax.ops.segment_sum(y_rows, row_tok, num_segments=T + 1)[:T]
    return out.reshape(Bsz, S, D).astype(h.dtype)


def hybrid_layer(x, attn_norm_w, w_in, conv_w, conv_b, dt_bias, a_log, d_skip, ssm_norm_w,
                 cmp_pos_emb, cmp_w1, cmp_b1, cmp_w2, cmp_b2, w_out, moe_norm_w, w_router,
                 b_router, w_gate_up, b_gate_up, w_down, b_down):
    h = rmsnorm(x, attn_norm_w)
    proj = h @ w_in
    widths = [SSM_D_INNER, SSM_CONV_DIM, SSM_HEADS, NSA_D] + [KV_D] * 6 + [3 * NSA_HEADS]
    cuts = [int(c) for c in np.cumsum(widths)[:-1]]
    (z, xbc, dt_raw, q, k_cmp, v_cmp, k_slc, v_slc, k_win, v_win, gate_logits) = jnp.split(proj, cuts, axis=-1)
    y_ssd = ssd_mixer(z, xbc, dt_raw, conv_w, conv_b, dt_bias, a_log, d_skip, ssm_norm_w)
    y_nsa = nsa_mixer(q, k_cmp, v_cmp, k_slc, v_slc, k_win, v_win, gate_logits,
                      cmp_pos_emb, cmp_w1, cmp_b1, cmp_w2, cmp_b2)
    x = x + jnp.concatenate([y_ssd, y_nsa], axis=-1) @ w_out
    x = x + moe_ffn(rmsnorm(x, moe_norm_w), w_router, b_router, w_gate_up, b_gate_up, w_down, b_down)
    return x


def setup_inputs(seed: int = 0) -> dict:
    key = jax.random.key(seed)
    ks = jax.random.split(key, 32)
    L = DEPTH
    f32 = jnp.float32

    def nrm(k, shape, scale):
        return jax.random.normal(k, shape, f32) * scale

    dt0 = jnp.exp(jax.random.uniform(ks[6], (L, SSM_HEADS), f32) * (math.log(0.1) - math.log(0.001)) + math.log(0.001))
    return {
        "x": nrm(ks[0], (BATCH, SEQ, D_MODEL), 1.0),
        "attn_norm_w": 1.0 + nrm(ks[1], (L, D_MODEL), 0.02),
        "w_in": nrm(ks[2], (L, D_MODEL, IN_PROJ_D), D_MODEL ** -0.5),
        "conv_w": nrm(ks[3], (L, SSM_CONV, SSM_CONV_DIM), SSM_CONV ** -0.5),
        "conv_b": nrm(ks[4], (L, SSM_CONV_DIM), 0.02),
        "dt_bias": dt0 + jnp.log(-jnp.expm1(-dt0)),
        "a_log": jnp.log(jax.random.uniform(ks[7], (L, SSM_HEADS), f32, 1.0, 16.0)),
        "d_skip": 1.0 + nrm(ks[8], (L, SSM_HEADS), 0.1),
        "ssm_norm_w": 1.0 + nrm(ks[9], (L, SSM_D_INNER), 0.02),
        "cmp_pos_emb": nrm(ks[10], (L, 2, CMP_BLOCK, NSA_HEAD_DIM), 0.1),
        "cmp_w1": nrm(ks[11], (L, 2, CMP_BLOCK * NSA_HEAD_DIM, CMP_HIDDEN), (CMP_BLOCK * NSA_HEAD_DIM) ** -0.5),
        "cmp_b1": nrm(ks[12], (L, 2, CMP_HIDDEN), 0.02),
        "cmp_w2": nrm(ks[13], (L, 2, CMP_HIDDEN, NSA_HEAD_DIM), CMP_HIDDEN ** -0.5),
        "cmp_b2": nrm(ks[14], (L, 2, NSA_HEAD_DIM), 0.02),
        "w_out": nrm(ks[15], (L, MIX_D, D_MODEL), MIX_D ** -0.5),
        "moe_norm_w": 1.0 + nrm(ks[16], (L, D_MODEL), 0.02),
        "w_router": nrm(ks[17], (L, D_MODEL, N_EXPERTS), D_MODEL ** -0.5),
        "b_router": nrm(ks[18], (L, N_EXPERTS), 0.01),
        "w_gate_up": nrm(ks[19], (L, N_EXPERTS, D_MODEL, 2 * D_FF), D_MODEL ** -0.5),
        "b_gate_up": nrm(ks[20], (L, N_EXPERTS, 2 * D_FF), 0.01),
        "w_down": nrm(ks[21], (L, N_EXPERTS, D_FF, D_MODEL), D_FF ** -0.5),
        "b_down": nrm(ks[22], (L, N_EXPERTS, D_MODEL), 0.01),
        "final_norm_w": 1.0 + nrm(ks[23], (D_MODEL,), 0.02),
    }


def reference(x, attn_norm_w, w_in, conv_w, conv_b, dt_bias, a_log, d_skip, ssm_norm_w,
              cmp_pos_emb, cmp_w1, cmp_b1, cmp_w2, cmp_b2, w_out, moe_norm_w, w_router,
              b_router, w_gate_up, b_gate_up, w_down, b_down, final_norm_w):
    for i in range(DEPTH):
        x = hybrid_layer(x, attn_norm_w[i], w_in[i], conv_w[i], conv_b[i], dt_bias[i], a_log[i],
                         d_skip[i], ssm_norm_w[i], cmp_pos_emb[i], cmp_w1[i], cmp_b1[i], cmp_w2[i],
                         cmp_b2[i], w_out[i], moe_norm_w[i], w_router[i], b_router[i],
                         w_gate_up[i], b_gate_up[i], w_down[i], b_down[i])
    return rmsnorm(x, final_norm_w)
```

```cpp
#include <hip/hip_runtime.h>
#include <stdint.h>
#include <stdio.h>

#ifndef N_LAUNCH_MODE
#define N_LAUNCH_MODE 0
#endif

typedef unsigned short bf16_t;
typedef short s16x4 __attribute__((ext_vector_type(4)));
typedef short s16x8 __attribute__((ext_vector_type(8)));
typedef float f32x4 __attribute__((ext_vector_type(4)));
typedef unsigned u32x4 __attribute__((ext_vector_type(4)));
typedef unsigned u32x2 __attribute__((ext_vector_type(2)));
#define LAS __attribute__((address_space(3)))

constexpr int D = 2048, BATCH = 2, SEQ = 4096, T = BATCH * SEQ;
constexpr int SSM_H = 16, SSM_N = 128;
constexpr int NSA_H = 16, DH = 64;
constexpr int CMP_HID = 512;
constexpr int N_C = 255, N_SEL = 64;
constexpr int IN_PROJ = 5696;
constexpr int OFF_Z = 0, OFF_XBC = 1024, OFF_DT = 3072, OFF_Q = 3088, OFF_KCMP = 4112, OFF_VCMP = 4368, OFF_KSLC = 4624,
              OFF_VSLC = 4880, OFF_KWIN = 5136, OFF_VWIN = 5392, OFF_GATE = 5648;
constexpr int NE = 32, DFF = 2048;
constexpr float NORM_EPS = 1e-5f;
constexpr int CMP_ROWS = BATCH * N_C * 4;
constexpr int MAX_TILES = 160, MAX_ROWS = MAX_TILES * 256;

constexpr size_t AL(size_t x) { return (x + 255) & ~(size_t)255; }
constexpr size_t WS_CTL = 0;
constexpr size_t CTL_BYTES = 32768;
constexpr size_t WS_XN = WS_CTL + CTL_BYTES;
constexpr size_t WS_PROJ = WS_XN + AL((size_t)T * D * 2);
constexpr size_t WS_XBC = WS_PROJ + AL((size_t)T * IN_PROJ * 4);
constexpr size_t WS_DT = WS_XBC + AL((size_t)T * 2048 * 4);
constexpr size_t WS_YSSD = WS_DT + AL((size_t)T * 16 * 4);
constexpr size_t WS_MIX = WS_YSSD + AL((size_t)T * 1024 * 4);
constexpr size_t WS_ROPE = WS_MIX + AL((size_t)T * 2048 * 2);
constexpr size_t WS_BLK = WS_ROPE + AL((size_t)SEQ * 16 * 4);
constexpr size_t WS_H1 = WS_BLK + AL((size_t)2 * 2048 * 2048 * 2);
constexpr size_t WS_KC = WS_H1 + AL((size_t)2 * 2048 * 512 * 2);
constexpr size_t WS_VC = WS_KC + AL((size_t)2048 * 64 * 4);
constexpr size_t WS_PCMP = WS_VC + AL((size_t)2048 * 64 * 4);
constexpr size_t WS_OCMP = WS_PCMP + AL((size_t)T * 16 * 256 * 4);
constexpr size_t WS_SEL = WS_OCMP + AL((size_t)T * 1024 * 4);
constexpr size_t WS_X2 = WS_SEL + AL((size_t)T * 4 * 8);
constexpr size_t WS_TOPE = WS_X2 + AL((size_t)T * D * 4);
constexpr size_t WS_TOPG = WS_TOPE + AL((size_t)T * 4 * 4);
constexpr size_t WS_SLOT = WS_TOPG + AL((size_t)T * 4 * 4);
constexpr size_t WS_POS = WS_SLOT + AL((size_t)T * 4 * 4);
constexpr size_t WS_ROWTOK = WS_POS + AL((size_t)T * 4 * 4);
constexpr size_t WS_ACT = WS_ROWTOK + AL((size_t)MAX_ROWS * 4);
constexpr size_t WS_Y = WS_ACT + AL((size_t)MAX_ROWS * DFF * 2);
constexpr size_t WS_END = WS_Y + AL((size_t)MAX_ROWS * D * 2);

constexpr int CW_COUNT = 4096;

#define XB_TMO      128
#define XB_XCNT(j)  (256  + 64 * (j))
#define XB_XSUB(j)  (1280 + 64 * (j))
#define XB_XGEN(j)  (2304 + 64 * (j))
#define XB_TOP      3328
#define XB_TOPGEN   3392
#define XCD_BAR_WORDS 3456
#define XB_SPIN_CAP (1u << 18)

__device__ __forceinline__ unsigned xb_ld(unsigned* p)              { return __hip_atomic_load(p, __ATOMIC_RELAXED, __HIP_MEMORY_SCOPE_AGENT); }
__device__ __forceinline__ unsigned xb_add(unsigned* p, unsigned v) { return __hip_atomic_fetch_add(p, v, __ATOMIC_RELAXED, __HIP_MEMORY_SCOPE_AGENT); }
__device__ __forceinline__ unsigned xb_xcc_id() { return (unsigned)__builtin_amdgcn_s_getreg((3 << 11) | 20) & 0xFu; }
#define XB_SPIN(cond, bar) do { unsigned _sp = 0; while (cond) { __builtin_amdgcn_s_sleep(1); \
    if ((++_sp & 255u) == 0u) { if (xb_ld(&(bar)[XB_TMO])) break; if (_sp > XB_SPIN_CAP) { atomicAdd(&(bar)[XB_TMO], 1u); break; } } } } while (0)

struct XcdBarrier { unsigned* bar; unsigned x; volatile LAS unsigned* st; };

__device__ __forceinline__ XcdBarrier xcd_barrier_post(unsigned* bar, volatile LAS unsigned* st) {
    XcdBarrier b; b.bar = bar; b.x = xb_xcc_id(); b.st = st;
    if (threadIdx.x == 0) (void)xb_add(&bar[XB_XCNT(b.x)], 1u);
    return b;
}
__device__ __forceinline__ void xcd_barrier_complete(unsigned* bar, unsigned x, unsigned& nloc, unsigned& nx) {
    const unsigned G = gridDim.x * gridDim.y * gridDim.z;
    unsigned sum, cnt, mine, sp = 0u;
    for (;;) {
        sum = 0u; cnt = 0u; mine = 0u;
#pragma unroll
        for (unsigned j = 0; j < 16; ++j) { const unsigned c = xb_ld(&bar[XB_XCNT(j)]); sum += c; cnt += (c > 0u) ? 1u : 0u; mine = (j == x) ? c : mine; }
        if (sum == G) break;
        __builtin_amdgcn_s_sleep(1);
        if ((++sp & 255u) == 0u) { if (xb_ld(&bar[XB_TMO])) break; if (sp > XB_SPIN_CAP) { atomicAdd(&bar[XB_TMO], 1u); break; } }
    }
    nloc = mine > 0u ? mine : 1u; nx = cnt > 0u ? cnt : 1u;
}
__device__ __forceinline__ void xcd_barrier(const XcdBarrier& b) {
    asm volatile("s_waitcnt vmcnt(0)" ::: "memory");
    __syncthreads();
    if (threadIdx.x == 0) {
        unsigned* bar = b.bar;
        __builtin_amdgcn_s_waitcnt(0);
        unsigned nloc = b.st[0], nx = b.st[1];
        if (nloc == 0u) { xcd_barrier_complete(bar, b.x, nloc, nx); b.st[0] = nloc; b.st[1] = nx; }
        const unsigned old = xb_add(&bar[XB_XSUB(b.x)], 1u);
        const unsigned gen = old / nloc;
        if (old + 1u == (gen + 1u) * nloc) {
            __builtin_amdgcn_fence(__ATOMIC_RELEASE, "agent");
            asm volatile("s_waitcnt vmcnt(0)" ::: "memory");
            const unsigned og = xb_add(&bar[XB_TOP], 1u);
            const unsigned tg = og / nx;
            if (og + 1u == (tg + 1u) * nx) xb_add(&bar[XB_TOPGEN], 1u);
            else XB_SPIN(xb_ld(&bar[XB_TOPGEN]) == tg, bar);
            __builtin_amdgcn_fence(__ATOMIC_ACQUIRE, "agent");
            xb_add(&bar[XB_XGEN(b.x)], 1u);
            asm volatile("s_waitcnt vmcnt(0)" ::: "memory");
        } else {
            XB_SPIN(xb_ld(&bar[XB_XGEN(b.x)]) == gen, bar);
            __builtin_amdgcn_fence(__ATOMIC_ACQUIRE, "agent");
            asm volatile("s_waitcnt vmcnt(0)" ::: "memory");
        }
    }
    __syncthreads();
}

__device__ __forceinline__ bf16_t f2bf(float f) { unsigned u = __float_as_uint(f); u += 0x7FFFu + ((u >> 16) & 1u); return (bf16_t)(u >> 16); }
__device__ __forceinline__ float bf2f(bf16_t b) { return __uint_as_float(((unsigned)b) << 16); }
__device__ __forceinline__ unsigned pack2(float lo, float hi) { return (unsigned)f2bf(lo) | ((unsigned)f2bf(hi) << 16); }
__device__ __forceinline__ float wave_sum(float v) {
#pragma unroll
    for (int o = 32; o > 0; o >>= 1) v += __shfl_xor(v, o);
    return v;
}
__device__ __forceinline__ float sigmoidf_(float x) { return 1.0f / (1.0f + __expf(-x)); }

constexpr int A_RS = 80, B_RS = 576, A_ST = 256 * A_RS, B_ST = 32 * B_RS, STAGE = A_ST + B_ST;
constexpr int GEMM_LDS = 2 * STAGE;
constexpr int LDS_BYTES = GEMM_LDS + 64;

template <bool PAIRED, class ALd, class BLd, class EP>
__device__ __forceinline__ void gemm_unit(LAS char* lds, const ALd& al, const BLd& bl, const EP& ep, const int K) {
    const int tid = threadIdx.x, lane = tid & 63, wid = tid >> 6;
    const int wr = wid >> 2, wc = wid & 3, fr = lane & 15, fq = lane >> 4;
    const bf16_t* arow0; const bf16_t* arow1;
    { const int c0 = tid, c1 = tid + 512; const bf16_t* p0 = al.row(c0 >> 2); const bf16_t* p1 = al.row(c1 >> 2);
      arow0 = p0 ? p0 + (c0 & 3) * 8 : nullptr; arow1 = p1 ? p1 + (c1 & 3) * 8 : nullptr; }
    const float* bcol = bl.col(4 * (tid & 63));
    const size_t ldb = (size_t)bl.ldb;
    const int bk0 = tid >> 6;
    u32x4 ra0, ra1; float4 rb0, rb1, rb2, rb3;
    const u32x4 z4 = (u32x4){0u, 0u, 0u, 0u}; const float4 zf = make_float4(0.f, 0.f, 0.f, 0.f);
#define G_LOAD(kt) do { \
        ra0 = arow0 ? *(const u32x4*)(arow0 + (kt) * 32) : z4; ra1 = arow1 ? *(const u32x4*)(arow1 + (kt) * 32) : z4; \
        if (bcol) { const float* bp = bcol + (size_t)((kt) * 32 + bk0) * ldb; \
            rb0 = *(const float4*)(bp); rb1 = *(const float4*)(bp + 8 * ldb); rb2 = *(const float4*)(bp + 16 * ldb); rb3 = *(const float4*)(bp + 24 * ldb); } \
        else { rb0 = zf; rb1 = zf; rb2 = zf; rb3 = zf; } } while (0)
#define S_WRITE(buf) do { LAS char* sa = lds + (buf) * STAGE; LAS char* sb = sa + A_ST; \
        *(LAS u32x4*)(sa + (tid >> 2) * A_RS + (tid & 3) * 16) = ra0; \
        *(LAS u32x4*)(sa + ((tid + 512) >> 2) * A_RS + (tid & 3) * 16) = ra1; \
        LAS char* wb = sb + bk0 * B_RS + (tid & 63) * 8; \
        *(LAS u32x2*)(wb) = (u32x2){pack2(rb0.x, rb0.y), pack2(rb0.z, rb0.w)}; \
        *(LAS u32x2*)(wb + 8 * B_RS) = (u32x2){pack2(rb1.x, rb1.y), pack2(rb1.z, rb1.w)}; \
        *(LAS u32x2*)(wb + 16 * B_RS) = (u32x2){pack2(rb2.x, rb2.y), pack2(rb2.z, rb2.w)}; \
        *(LAS u32x2*)(wb + 24 * B_RS) = (u32x2){pack2(rb3.x, rb3.y), pack2(rb3.z, rb3.w)}; } while (0)
    f32x4 acc[8][4];
#pragma unroll
    for (int m = 0; m < 8; ++m)
#pragma unroll
        for (int n = 0; n < 4; ++n) acc[m][n] = (f32x4){0.f, 0.f, 0.f, 0.f};
    const int nk = K / 32;
    const int a_off = (wr * 128 + fr) * A_RS + fq * 16;
    const int b_off = A_ST + (8 * fq + ((lane & 15) >> 2)) * B_RS + (wc * 64 + 4 * (lane & 3)) * 2;
    G_LOAD(0);
    S_WRITE(0);
    __syncthreads();
    for (int kt = 0; kt < nk; ++kt) {
        const int buf = kt & 1;
        if (kt + 1 < nk) G_LOAD(kt + 1);
        LAS char* sbase = lds + buf * STAGE;
        s16x8 af[8];
#pragma unroll
        for (int m = 0; m < 8; ++m) af[m] = *(const LAS s16x8*)(sbase + a_off + m * 16 * A_RS);
#pragma unroll
        for (int n = 0; n < 4; ++n) {
            const s16x4 t0 = __builtin_amdgcn_ds_read_tr16_b64_v4i16((LAS s16x4*)(sbase + b_off + n * 32));
            const s16x4 t1 = __builtin_amdgcn_ds_read_tr16_b64_v4i16((LAS s16x4*)(sbase + b_off + n * 32 + 4 * B_RS));
            const s16x8 bfr = {t0[0], t0[1], t0[2], t0[3], t1[0], t1[1], t1[2], t1[3]};
#pragma unroll
            for (int m = 0; m < 8; ++m) acc[m][n] = __builtin_amdgcn_mfma_f32_16x16x32_bf16(bfr, af[m], acc[m][n], 0, 0, 0);
        }
        if (kt + 1 < nk) S_WRITE(buf ^ 1);
        __syncthreads();
    }
#undef G_LOAD
#undef S_WRITE
#pragma unroll
    for (int m = 0; m < 8; ++m) {
        const int r = wr * 128 + m * 16 + fr;
        if constexpr (PAIRED) {
#pragma unroll
            for (int n = 0; n < 2; ++n) ep.pair(r, wc * 32 + n * 16 + 4 * fq, acc[m][n], acc[m][n + 2]);
        } else {
#pragma unroll
            for (int n = 0; n < 4; ++n) ep(r, wc * 64 + n * 16 + 4 * fq, acc[m][n]);
        }
    }
}

struct Args {
    const float* in[23];
    float* out;
    unsigned char* ws;
    int ph_lo, ph_hi;
};

enum { PH_NORM1 = 0, PH_INPROJ, PH_PREP, PH_SSD_CMP1, PH_GNORM_CMP2, PH_CMPATT, PH_SELECT, PH_SELWIN, PH_OUTPROJ, PH_ROUTER, PH_SCATTER, PH_GATEUP, PH_DOWN, PH_FINAL, N_PHASES };

struct ARowsDense { const bf16_t* base; size_t ld; int row0, nrows;
    __device__ __forceinline__ const bf16_t* row(int r) const { const int g = row0 + r; return g < nrows ? base + (size_t)g * ld : nullptr; } };
struct ARowsGather { const bf16_t* base; size_t ld; const int* idx;
    __device__ __forceinline__ const bf16_t* row(int r) const { const int g = idx[r]; return g >= 0 ? base + (size_t)g * ld : nullptr; } };
struct BColsDense { const float* base; int ldb; int col0, ncols;
    __device__ __forceinline__ const float* col(int n) const { const int c = col0 + n; return c < ncols ? base + c : nullptr; } };
struct BColsGateUp { const float* base; int ldb; int cn;
    __device__ __forceinline__ const float* col(int n) const { const int wc = n >> 6, nt = (n & 63) >> 4, w = n & 15; const int j = wc * 32 + (nt & 1) * 16 + w;
        return base + (nt < 2 ? 0 : DFF) + cn * 128 + j; } };

struct EpiStoreF32 { float* C; size_t ldc; int row0, col0, ncols;
    __device__ __forceinline__ void operator()(int r, int n, f32x4 v) const { const int c = col0 + n; if (c < ncols) *(f32x4*)(C + (size_t)(row0 + r) * ldc + c) = v; } };
struct EpiResidF32 { float* C; const float* X; size_t ldc; int row0, col0;
    __device__ __forceinline__ void operator()(int r, int n, f32x4 v) const { const size_t o = (size_t)(row0 + r) * ldc + col0 + n; const f32x4 x = *(const f32x4*)(X + o); *(f32x4*)(C + o) = v + x; } };
struct EpiGeluBf16 { bf16_t* O; const float* bias; size_t ldo; int row0, col0, nrows;
    __device__ __forceinline__ void operator()(int r, int n, f32x4 v) const { const int g = row0 + r; if (g >= nrows) return; const int c = col0 + n;
        float o[4];
#pragma unroll
        for (int i = 0; i < 4; ++i) { const float x = v[i] + bias[c + i]; const float u = 0.7978845608028654f * (x + 0.044715f * x * x * x); o[i] = 0.5f * x * (1.0f + tanhf(u)); }
        *(uint2*)(O + (size_t)g * ldo + c) = make_uint2(pack2(o[0], o[1]), pack2(o[2], o[3])); } };
struct EpiSwiglu { bf16_t* O; const float* bias; int row0, cn;
    __device__ __forceinline__ void pair(int r, int j, f32x4 g, f32x4 u) const { const int c = cn * 128 + j; float o[4];
#pragma unroll
        for (int i = 0; i < 4; ++i) { float gv = g[i] + bias[c + i]; float uv = u[i] + bias[DFF + c + i]; gv = fminf(gv, 7.0f); uv = fminf(fmaxf(uv, -7.0f), 7.0f);
            const float glu = gv * sigmoidf_(1.702f * gv); o[i] = (uv + 1.0f) * glu; }
        *(uint2*)(O + (size_t)(row0 + r) * DFF + c) = make_uint2(pack2(o[0], o[1]), pack2(o[2], o[3])); } };
struct EpiBiasBf16 { bf16_t* O; const float* bias; int row0, col0;
    __device__ __forceinline__ void operator()(int r, int n, f32x4 v) const { const int c = col0 + n;
        *(uint2*)(O + (size_t)(row0 + r) * D + c) = make_uint2(pack2(v[0] + bias[c], v[1] + bias[c + 1]), pack2(v[2] + bias[c + 2], v[3] + bias[c + 3])); } };

__device__ __forceinline__ float rope_inv(int i) { return (float)exp(-(double)i * 0.125 * 13.122363377404328); }

__global__ void __launch_bounds__(512, 2) fwd(Args a) {
    extern __shared__ __attribute__((aligned(16))) unsigned char lds_raw[];
    LAS char* lds = (LAS char*)lds_raw;
    const int tid = threadIdx.x, lane = tid & 63, wid = __builtin_amdgcn_readfirstlane(tid >> 6);
    const int G = gridDim.x, bid = blockIdx.x;
    const int gtid = bid * 512 + tid, gthreads = G * 512;
    const int gwave = bid * 8 + wid, gwaves = G * 8;
    unsigned char* ws = a.ws;
    unsigned* ctl = (unsigned*)(ws + WS_CTL);
    volatile LAS unsigned* barw = (volatile LAS unsigned*)(lds + GEMM_LDS);
    LAS int* lmisc = (LAS int*)(lds + GEMM_LDS + 16);
    if (tid == 0) { barw[0] = 0u; barw[1] = 0u; barw[2] = 0u; barw[3] = 0u; }
    __syncthreads();
    XcdBarrier bar; bar.bar = ctl; bar.x = 0; bar.st = barw;
    const bool multi = (a.ph_hi - a.ph_lo) > 1;
    if (multi) bar = xcd_barrier_post(ctl, barw);
#ifdef ONLY_PH
#define IN(k) ((k) == ONLY_PH)
#else
#define IN(k) (a.ph_lo <= (k) && (k) < a.ph_hi)
#endif
#define SEAM(k) do { if ((k) + 1 < a.ph_hi) xcd_barrier(bar); } while (0)

    const float* x = a.in[0];
    bf16_t* XN = (bf16_t*)(ws + WS_XN);
    float* PROJ = (float*)(ws + WS_PROJ);
    float* XBC = (float*)(ws + WS_XBC);
    float* DT = (float*)(ws + WS_DT);
    float* YSSD = (float*)(ws + WS_YSSD);
    bf16_t* MIX = (bf16_t*)(ws + WS_MIX);
    float* ROPE = (float*)(ws + WS_ROPE);
    bf16_t* BLK = (bf16_t*)(ws + WS_BLK);
    bf16_t* H1 = (bf16_t*)(ws + WS_H1);
    float* KC = (float*)(ws + WS_KC);
    float* VC = (float*)(ws + WS_VC);
    float* PCMP = (float*)(ws + WS_PCMP);
    float* OCMP = (float*)(ws + WS_OCMP);
    unsigned long long* SEL = (unsigned long long*)(ws + WS_SEL);
    float* X2 = (float*)(ws + WS_X2);
    int* TOPE = (int*)(ws + WS_TOPE);
    float* TOPG = (float*)(ws + WS_TOPG);
    int* SLOT = (int*)(ws + WS_SLOT);
    int* POS = (int*)(ws + WS_POS);
    int* ROWTOK = (int*)(ws + WS_ROWTOK);
    bf16_t* ACT = (bf16_t*)(ws + WS_ACT);
    bf16_t* YB = (bf16_t*)(ws + WS_Y);
    unsigned* COUNT = ctl + CW_COUNT;

    if (IN(PH_NORM1)) {
        const float* w = a.in[1];
        for (int row = gwave; row < T; row += gwaves) {
            const float4* xr = (const float4*)(x + (size_t)row * D);
            float4 v[8]; float ss = 0.f;
#pragma unroll
            for (int i = 0; i < 8; ++i) { v[i] = xr[lane + 64 * i]; ss += v[i].x * v[i].x + v[i].y * v[i].y + v[i].z * v[i].z + v[i].w * v[i].w; }
            ss = wave_sum(ss);
            const float rstd = rsqrtf(ss * (1.0f / D) + NORM_EPS);
#pragma unroll
            for (int i = 0; i < 8; ++i) { const float4 wv = ((const float4*)w)[lane + 64 * i];
                *(uint2*)(XN + (size_t)row * D + 4 * (lane + 64 * i)) = make_uint2(pack2(v[i].x * rstd * wv.x, v[i].y * rstd * wv.y), pack2(v[i].z * rstd * wv.z, v[i].w * rstd * wv.w)); }
        }
        for (int i = gtid; i < SEQ * 8; i += gthreads) { const int pos = i >> 3, k = i & 7; const float ang = (float)pos * rope_inv(k); ROPE[i] = cosf(ang); ROPE[SEQ * 8 + i] = sinf(ang); }
        for (int i = gtid; i < MAX_ROWS; i += gthreads) ROWTOK[i] = -1;
        SEAM(PH_NORM1);
    }

    if (IN(PH_INPROJ)) {
        const int nct = (IN_PROJ + 255) / 256, nunits = (T / 256) * nct;
        for (int u = bid; u < nunits; u += G) {
            const int rt = u / nct, ct = u % nct;
            ARowsDense al{XN, (size_t)D, rt * 256, T};
            BColsDense bl{a.in[2], IN_PROJ, ct * 256, IN_PROJ};
            EpiStoreF32 ep{PROJ, (size_t)IN_PROJ, rt * 256, ct * 256, IN_PROJ};
            gemm_unit<false>(lds, al, bl, ep, D);
        }
        SEAM(PH_INPROJ);
    }

    if (IN(PH_PREP)) {
        const float* conv_w = a.in[3]; const float* conv_b = a.in[4]; const float* dt_bias = a.in[5];
        for (int i = gtid; i < T * 2048; i += gthreads) {
            const int t = i >> 11, c = i & 2047, s = t & (SEQ - 1);
            float acc = conv_b[c];
#pragma unroll
            for (int k = 0; k < 4; ++k) { const int ts = s - 3 + k; if (ts >= 0) acc += conv_w[k * 2048 + c] * PROJ[(size_t)(t - 3 + k) * IN_PROJ + OFF_XBC + c]; }
            XBC[i] = acc * sigmoidf_(acc);
        }
        for (int i = gtid; i < T * 16; i += gthreads) { const int h = i & 15; const float v = PROJ[(size_t)(i >> 4) * IN_PROJ + OFF_DT + h] + dt_bias[h];
            DT[i] = v > 20.f ? v : log1pf(expf(v)); }
        for (int i = gtid; i < T * 24 * 8; i += gthreads) {
            const int k = i & 7, slot = (i >> 3) % 24, t = i / 192, pos = t & (SEQ - 1);
            const int col = slot < 16 ? OFF_Q + slot * 64 : (slot < 20 ? OFF_KSLC + (slot - 16) * 64 : OFF_KWIN + (slot - 20) * 64);
            float* p = PROJ + (size_t)t * IN_PROJ + col;
            const float c = ROPE[pos * 8 + k], s = ROPE[SEQ * 8 + pos * 8 + k];
            const float x1 = p[k], x2 = p[k + 8];
            p[k] = x1 * c - x2 * s; p[k + 8] = x1 * s + x2 * c;
        }
        const float* pe = a.in[9];
        for (int i = gtid; i < 2 * 2048 * 512; i += gthreads) {
            const int e4 = i & 511, row = (i >> 9) & 2047, j = i >> 20;
            uint2 o = make_uint2(0u, 0u);
            if (row < CMP_ROWS) { const int g = row & 3, n = (row >> 2) % N_C, b = (row >> 2) / N_C; const int l = e4 >> 4, d = (e4 & 15) * 4;
                const float4 v = *(const float4*)(PROJ + (size_t)(b * SEQ + 16 * n + l) * IN_PROJ + (j ? OFF_VCMP : OFF_KCMP) + g * 64 + d);
                const float4 p4 = *(const float4*)(pe + (j * 32 + l) * 64 + d);
                o = make_uint2(pack2(v.x + p4.x, v.y + p4.y), pack2(v.z + p4.z, v.w + p4.w)); }
            *(uint2*)(BLK + ((size_t)j * 2048 + row) * 2048 + e4 * 4) = o;
        }
        SEAM(PH_PREP);
    }

    if (IN(PH_SSD_CMP1)) {
        if (bid < 16) {
            const int w = bid * 8 + wid, b = w >> 6, h = (w >> 2) & 15, pq = w & 3, g = h >> 2;
            const int p = pq * 16 + (lane >> 2), nq = lane & 3;
            const float av = -expf(a.in[6][h]), dsk = a.in[7][h];
            float st[32];
#pragma unroll
            for (int n = 0; n < 32; ++n) st[n] = 0.f;
            for (int t = 0; t < SEQ; ++t) {
                const size_t tt = (size_t)b * SEQ + t;
                const float* row = XBC + tt * 2048;
                const float dtv = DT[tt * 16 + h];
                const float dA = expf(dtv * av);
                const float xv = row[h * 64 + p];
                const float4* Bp = (const float4*)(row + 1024 + g * 128 + nq * 32); const float4* Cp = (const float4*)(row + 1536 + g * 128 + nq * 32);
                const float coef = dtv * xv; float y = 0.f;
#pragma unroll
                for (int n4 = 0; n4 < 8; ++n4) { const float4 bv = Bp[n4], cv = Cp[n4];
                    st[4 * n4 + 0] = st[4 * n4 + 0] * dA + coef * bv.x; y += st[4 * n4 + 0] * cv.x;
                    st[4 * n4 + 1] = st[4 * n4 + 1] * dA + coef * bv.y; y += st[4 * n4 + 1] * cv.y;
                    st[4 * n4 + 2] = st[4 * n4 + 2] * dA + coef * bv.z; y += st[4 * n4 + 2] * cv.z;
                    st[4 * n4 + 3] = st[4 * n4 + 3] * dA + coef * bv.w; y += st[4 * n4 + 3] * cv.w; }
                y += __shfl_xor(y, 1); y += __shfl_xor(y, 2);
                if (nq == 0) YSSD[tt * 1024 + h * 64 + p] = y + dsk * xv;
            }
        } else {
            const int nb = G - 16;
            for (int u = bid - 16; u < 32; u += nb) {
                const int j = u >> 4, rt = (u >> 1) & 7, ct = u & 1;
                ARowsDense al{BLK + (size_t)j * 2048 * 2048, (size_t)2048, rt * 256, CMP_ROWS};
                BColsDense bl{a.in[10] + (size_t)j * 2048 * CMP_HID, CMP_HID, ct * 256, CMP_HID};
                EpiGeluBf16 ep{H1 + (size_t)j * 2048 * CMP_HID, a.in[11] + j * CMP_HID, (size_t)CMP_HID, rt * 256, ct * 256, CMP_ROWS};
                gemm_unit<false>(lds, al, bl, ep, 2048);
            }
        }
        SEAM(PH_SSD_CMP1);
    }

    if (IN(PH_GNORM_CMP2)) {
        const float* nw = a.in[8];
        for (int it = gwave; it < T * 4; it += gwaves) {
            const int t = it >> 2, grp = it & 3, c = grp * 256 + lane * 4;
            const float4 y = *(const float4*)(YSSD + (size_t)t * 1024 + c);
            const float4 z = *(const float4*)(PROJ + (size_t)t * IN_PROJ + OFF_Z + c);
            float gv[4] = {y.x * z.x * sigmoidf_(z.x), y.y * z.y * sigmoidf_(z.y), y.z * z.z * sigmoidf_(z.z), y.w * z.w * sigmoidf_(z.w)};
            float ss = wave_sum(gv[0] * gv[0] + gv[1] * gv[1] + gv[2] * gv[2] + gv[3] * gv[3]);
            const float sc = rsqrtf(ss * (1.0f / 256.f) + NORM_EPS);
            const float4 w4 = *(const float4*)(nw + c);
            *(uint2*)(MIX + (size_t)t * 2048 + c) = make_uint2(pack2(gv[0] * sc * w4.x, gv[1] * sc * w4.y), pack2(gv[2] * sc * w4.z, gv[3] * sc * w4.w));
        }
        const float* w2 = a.in[12]; const float* b2 = a.in[13];
        for (int i = gtid; i < 2 * CMP_ROWS * 64; i += gthreads) {
            const int d = i & 63, row = (i >> 6) % CMP_ROWS, j = i / (CMP_ROWS * 64);
            const bf16_t* hrow = H1 + ((size_t)j * 2048 + row) * CMP_HID;
            const float* wj = w2 + (size_t)j * CMP_HID * 64;
            const bool rot = (j == 0) && (d < 16);
            const int dp = rot ? (d < 8 ? d + 8 : d - 8) : d;
            float s0 = b2[j * 64 + d], s1 = b2[j * 64 + dp];
            for (int k = 0; k < CMP_HID; ++k) { const float hv = bf2f(hrow[k]); s0 += hv * wj[k * 64 + d]; s1 += hv * wj[k * 64 + dp]; }
            float o = s0;
            if (rot) { const int n = (row >> 2) % N_C, pos = 16 * n + 31, k = d & 7; const float c = ROPE[pos * 8 + k], s = ROPE[SEQ * 8 + pos * 8 + k];
                o = (d < 8) ? (s0 * c - s1 * s) : (s1 * s + s0 * c); }
            (j ? VC : KC)[(size_t)row * 64 + d] = o;
        }
        SEAM(PH_GNORM_CMP2);
    }

    if (IN(PH_CMPATT)) {
        for (int it = gtid; it < T * 16; it += gthreads) {
            const int hq = it & 15, tt = it >> 4, b = tt >> 12, t = tt & (SEQ - 1), g = hq >> 2;
            const int nvalid = t >= 31 ? ((t - 31) >> 4) + 1 : 0;
            float q[64];
            const float* qp = PROJ + (size_t)tt * IN_PROJ + OFF_Q + hq * 64;
#pragma unroll
            for (int d = 0; d < 64; d += 4) { const float4 v = *(const float4*)(qp + d); q[d] = v.x; q[d + 1] = v.y; q[d + 2] = v.z; q[d + 3] = v.w; }
            float m = -INFINITY, l = 0.f;
            for (int c = 0; c < nvalid; ++c) {
                const float* kp = KC + (size_t)((b * N_C + c) * 4 + g) * 64; float s = 0.f;
#pragma unroll
                for (int d = 0; d < 64; d += 4) { const float4 v = *(const float4*)(kp + d); s += q[d] * v.x + q[d + 1] * v.y + q[d + 2] * v.z + q[d + 3] * v.w; }
                s *= 0.125f;
                const float mn = fmaxf(m, s); l = l * __expf(m - mn) + __expf(s - mn); m = mn;
            }
            float o[64];
#pragma unroll
            for (int d = 0; d < 64; ++d) o[d] = 0.f;
            const float inv_l = nvalid > 0 ? 1.0f / fmaxf(l, 1e-30f) : 0.f;
            float* pp = PCMP + (size_t)it * 256;
            for (int c = 0; c < nvalid; ++c) {
                const float* kp = KC + (size_t)((b * N_C + c) * 4 + g) * 64; float s = 0.f;
#pragma unroll
                for (int d = 0; d < 64; d += 4) { const float4 v = *(const float4*)(kp + d); s += q[d] * v.x + q[d + 1] * v.y + q[d + 2] * v.z + q[d + 3] * v.w; }
                const float p = __expf(s * 0.125f - m) * inv_l;
                pp[c] = p;
                const float* vp = VC + (size_t)((b * N_C + c) * 4 + g) * 64;
#pragma unroll
                for (int d = 0; d < 64; d += 4) { const float4 v = *(const float4*)(vp + d); o[d] += p * v.x; o[d + 1] += p * v.y; o[d + 2] += p * v.z; o[d + 3] += p * v.w; }
            }
            for (int c = nvalid; c < 256; ++c) pp[c] = 0.f;
            float* op = OCMP + (size_t)tt * 1024 + hq * 64;
#pragma unroll
            for (int d = 0; d < 64; d += 4) *(float4*)(op + d) = make_float4(o[d], o[d + 1], o[d + 2], o[d + 3]);
        }
        SEAM(PH_CMPATT);
    }

    if (IN(PH_SELECT)) {
        for (int it = gwave; it < T * 4; it += gwaves) {
            const int g = it & 3, tt = it >> 2, t = tt & (SEQ - 1), cur = t >> 6, j = lane;
            float imp = 0.f;
#pragma unroll
            for (int r = 0; r < 4; ++r) { const float* pp = PCMP + ((size_t)tt * 16 + g * 4 + r) * 256 + 4 * j;
                const float4 v = *(const float4*)pp; const float pm1 = j > 0 ? pp[-1] : 0.f;
                imp += 32.f * (v.x + v.y + v.z) + 16.f * v.w + 16.f * pm1; }
            const bool forced = (j == 0) || (j == cur) || (j == cur - 1);
            const bool valid = j <= cur;
            const float sc = forced ? 1.0e4f : (valid ? imp : -1.0e4f);
            int rank = 0;
#pragma unroll
            for (int k = 0; k < 64; ++k) { const float o = __shfl(sc, k); rank += (o > sc || (o == sc && k < j)) ? 1 : 0; }
            const unsigned long long mask = __ballot(rank < 16 && valid);
            if (lane == 0) SEL[it] = mask;
        }
        SEAM(PH_SELECT);
    }

    if (IN(PH_SELWIN)) {
        for (int it = gtid; it < T * 16; it += gthreads) {
            const int hq = it & 15, tt = it >> 4, b = tt >> 12, t = tt & (SEQ - 1), g = hq >> 2;
            float q[64];
            const float* qp = PROJ + (size_t)tt * IN_PROJ + OFF_Q + hq * 64;
#pragma unroll
            for (int d = 0; d < 64; d += 4) { const float4 v = *(const float4*)(qp + d); q[d] = v.x; q[d + 1] = v.y; q[d + 2] = v.z; q[d + 3] = v.w; }
            const float* gl = PROJ + (size_t)tt * IN_PROJ + OFF_GATE + hq * 3;
            const float g0 = sigmoidf_(gl[0]), g1 = sigmoidf_(gl[1]), g2 = sigmoidf_(gl[2]);
            float* op = OCMP + (size_t)tt * 1024 + hq * 64;
            float o[64];
            {
#pragma unroll
                for (int d = 0; d < 64; ++d) o[d] = 0.f;
                float m = -INFINITY, l = 0.f;
                unsigned long long mask = SEL[(size_t)tt * 4 + g];
                while (mask) {
                    const int j = __ffsll((long long)mask) - 1; mask &= mask - 1;
                    const int hi = min(64 * j + 63, t);
                    for (int tok = 64 * j; tok <= hi; ++tok) {
                        const float* kp = PROJ + (size_t)(b * SEQ + tok) * IN_PROJ + OFF_KSLC + g * 64; float s = 0.f;
#pragma unroll
                        for (int d = 0; d < 64; d += 4) { const float4 v = *(const float4*)(kp + d); s += q[d] * v.x + q[d + 1] * v.y + q[d + 2] * v.z + q[d + 3] * v.w; }
                        s *= 0.125f;
                        const float mn = fmaxf(m, s), al = __expf(m - mn), p = __expf(s - mn); m = mn; l = l * al + p;
                        const float* vp = kp + (OFF_VSLC - OFF_KSLC);
#pragma unroll
                        for (int d = 0; d < 64; d += 4) { const float4 v = *(const float4*)(vp + d); o[d] = o[d] * al + p * v.x; o[d + 1] = o[d + 1] * al + p * v.y; o[d + 2] = o[d + 2] * al + p * v.z; o[d + 3] = o[d + 3] * al + p * v.w; }
                    }
                }
                const float il = g1 / fmaxf(l, 1e-30f);
#pragma unroll
                for (int d = 0; d < 64; d += 4) { float4 r = *(float4*)(op + d); r.x = g0 * r.x + il * o[d]; r.y = g0 * r.y + il * o[d + 1]; r.z = g0 * r.z + il * o[d + 2]; r.w = g0 * r.w + il * o[d + 3]; *(float4*)(op + d) = r; }
            }
            {
#pragma unroll
                for (int d = 0; d < 64; ++d) o[d] = 0.f;
                float m = -INFINITY, l = 0.f;
                const int lo = max(0, t - 511);
                for (int tok = lo; tok <= t; ++tok) {
                    const float* kp = PROJ + (size_t)(b * SEQ + tok) * IN_PROJ + OFF_KWIN + g * 64; float s = 0.f;
#pragma unroll
                    for (int d = 0; d < 64; d += 4) { const float4 v = *(const float4*)(kp + d); s += q[d] * v.x + q[d + 1] * v.y + q[d + 2] * v.z + q[d + 3] * v.w; }
                    s *= 0.125f;
                    const float mn = fmaxf(m, s), al = __expf(m - mn), p = __expf(s - mn); m = mn; l = l * al + p;
                    const float* vp = kp + (OFF_VWIN - OFF_KWIN);
#pragma unroll
                    for (int d = 0; d < 64; d += 4) { const float4 v = *(const float4*)(vp + d); o[d] = o[d] * al + p * v.x; o[d + 1] = o[d + 1] * al + p * v.y; o[d + 2] = o[d + 2] * al + p * v.z; o[d + 3] = o[d + 3] * al + p * v.w; }
                }
                const float il = g2 / fmaxf(l, 1e-30f);
                bf16_t* mp = MIX + (size_t)tt * 2048 + 1024 + hq * 64;
#pragma unroll
                for (int d = 0; d < 64; d += 4) { const float4 r = *(const float4*)(op + d);
                    *(uint2*)(mp + d) = make_uint2(pack2(r.x + il * o[d], r.y + il * o[d + 1]), pack2(r.z + il * o[d + 2], r.w + il * o[d + 3])); }
            }
        }
        SEAM(PH_SELWIN);
    }

    if (IN(PH_OUTPROJ)) {
        const int nunits = (T / 256) * (D / 256);
        for (int u = bid; u < nunits; u += G) {
            const int rt = u >> 3, ct = u & 7;
            ARowsDense al{MIX, (size_t)2048, rt * 256, T};
            BColsDense bl{a.in[14], D, ct * 256, D};
            EpiResidF32 ep{X2, x, (size_t)D, rt * 256, ct * 256};
            gemm_unit<false>(lds, al, bl, ep, 2048);
        }
        SEAM(PH_OUTPROJ);
    }

    if (IN(PH_ROUTER)) {
        const float* w = a.in[15]; const float* wr_ = a.in[16]; const float* br = a.in[17];
        for (int row = gwave; row < T; row += gwaves) {
            const float4* xr = (const float4*)(X2 + (size_t)row * D);
            float ss = 0.f;
#pragma unroll 2
            for (int i = 0; i < 8; ++i) { const float4 v = xr[lane + 64 * i]; ss += v.x * v.x + v.y * v.y + v.z * v.z + v.w * v.w; }
            ss = wave_sum(ss);
            const float rstd = rsqrtf(ss * (1.0f / D) + NORM_EPS);
            float lg[NE];
#pragma unroll
            for (int e = 0; e < NE; ++e) lg[e] = 0.f;
#pragma unroll 1
            for (int i = 0; i < 8; ++i) { const float4 wv = ((const float4*)w)[lane + 64 * i]; const float4 v = xr[lane + 64 * i];
                const float h0 = v.x * rstd * wv.x, h1 = v.y * rstd * wv.y, h2 = v.z * rstd * wv.z, h3 = v.w * rstd * wv.w;
                const int d0 = 4 * (lane + 64 * i);
                *(uint2*)(XN + (size_t)row * D + d0) = make_uint2(pack2(h0, h1), pack2(h2, h3));
                const float4* r0 = (const float4*)(wr_ + (size_t)d0 * NE);
#pragma unroll
                for (int e4 = 0; e4 < 8; ++e4) { const float4 a0 = r0[e4], a1 = r0[8 + e4], a2 = r0[16 + e4], a3 = r0[24 + e4];
                    lg[4 * e4 + 0] += h0 * a0.x + h1 * a1.x + h2 * a2.x + h3 * a3.x; lg[4 * e4 + 1] += h0 * a0.y + h1 * a1.y + h2 * a2.y + h3 * a3.y;
                    lg[4 * e4 + 2] += h0 * a0.z + h1 * a1.z + h2 * a2.z + h3 * a3.z; lg[4 * e4 + 3] += h0 * a0.w + h1 * a1.w + h2 * a2.w + h3 * a3.w; }
            }
            float mine = -INFINITY;
#pragma unroll
            for (int e = 0; e < NE; ++e) { const float s = wave_sum(lg[e]); if (lane == e) mine = s + br[e]; }
            int rank = 0;
#pragma unroll
            for (int k = 0; k < NE; ++k) { const float o = __shfl(mine, k); rank += (o > mine || (o == mine && k < lane)) ? 1 : 0; }
            const bool sel = (lane < NE) && (rank < 4);
            float mx = sel ? mine : -INFINITY;
#pragma unroll
            for (int o = 32; o > 0; o >>= 1) mx = fmaxf(mx, __shfl_xor(mx, o));
            const float ex = sel ? __expf(mine - mx) : 0.f;
            const float den = wave_sum(ex);
            if (sel) { const int slot = (int)atomicAdd(&COUNT[lane], 1u); const int o = row * 4 + rank; TOPE[o] = lane; TOPG[o] = ex / den; SLOT[o] = slot; }
        }
        SEAM(PH_ROUTER);
    }

    if (IN(PH_SCATTER)) {
        for (int i = gtid; i < T * 4; i += gthreads) {
            const int e = TOPE[i]; int off = 0;
            for (int k = 0; k < e; ++k) off += (int)((COUNT[k] + 255u) >> 8);
            const int pos = off * 256 + SLOT[i];
            ROWTOK[pos] = i >> 2; POS[i] = pos;
        }
        SEAM(PH_SCATTER);
    }

    if (IN(PH_GATEUP) || IN(PH_DOWN)) {
        LAS int* toff = (LAS int*)(lds + GEMM_LDS + 64 - 0);
        (void)toff;
    }
    if (IN(PH_GATEUP)) {
        int ntiles = 0;
        for (int k = 0; k < NE; ++k) ntiles += (int)((COUNT[k] + 255u) >> 8);
        const int nunits = ntiles * 16;
        for (int u = bid; u < nunits; u += G) {
            const int tile = u >> 4, cn = u & 15;
            int e = 0, acc = 0;
            for (int k = 0; k < NE; ++k) { const int nt = (int)((COUNT[k] + 255u) >> 8); if (tile >= acc && tile < acc + nt) e = k; acc += nt; }
            ARowsGather al{XN, (size_t)D, ROWTOK + tile * 256};
            BColsGateUp bl{a.in[18] + (size_t)e * D * 2 * DFF, 2 * DFF, cn};
            EpiSwiglu ep{ACT, a.in[19] + (size_t)e * 2 * DFF, tile * 256, cn};
            gemm_unit<true>(lds, al, bl, ep, D);
        }
        SEAM(PH_GATEUP);
    }
    if (IN(PH_DOWN)) {
        int ntiles = 0;
        for (int k = 0; k < NE; ++k) ntiles += (int)((COUNT[k] + 255u) >> 8);
        const int nunits = ntiles * 8;
        for (int u = bid; u < nunits; u += G) {
            const int tile = u >> 3, ct = u & 7;
            int e = 0, acc = 0;
            for (int k = 0; k < NE; ++k) { const int nt = (int)((COUNT[k] + 255u) >> 8); if (tile >= acc && tile < acc + nt) e = k; acc += nt; }
            ARowsDense al{ACT, (size_t)DFF, tile * 256, MAX_ROWS};
            BColsDense bl{a.in[20] + (size_t)e * DFF * D, D, ct * 256, D};
            EpiBiasBf16 ep{YB, a.in[21] + (size_t)e * D, tile * 256, ct * 256};
            gemm_unit<false>(lds, al, bl, ep, DFF);
        }
        SEAM(PH_DOWN);
    }

    if (IN(PH_FINAL)) {
        const float* fw = a.in[22];
        for (int row = gwave; row < T; row += gwaves) {
            const float4* xr = (const float4*)(X2 + (size_t)row * D);
            float4 v[8];
#pragma unroll
            for (int i = 0; i < 8; ++i) v[i] = xr[lane + 64 * i];
#pragma unroll
            for (int k = 0; k < 4; ++k) { const float gk = TOPG[row * 4 + k]; const bf16_t* yr = YB + (size_t)POS[row * 4 + k] * D;
#pragma unroll
                for (int i = 0; i < 8; ++i) { const uint2 y = *(const uint2*)(yr + 4 * (lane + 64 * i));
                    v[i].x += gk * bf2f((bf16_t)(y.x & 0xffffu)); v[i].y += gk * bf2f((bf16_t)(y.x >> 16)); v[i].z += gk * bf2f((bf16_t)(y.y & 0xffffu)); v[i].w += gk * bf2f((bf16_t)(y.y >> 16)); } }
            float ss = 0.f;
#pragma unroll
            for (int i = 0; i < 8; ++i) ss += v[i].x * v[i].x + v[i].y * v[i].y + v[i].z * v[i].z + v[i].w * v[i].w;
            ss = wave_sum(ss);
            const float rstd = rsqrtf(ss * (1.0f / D) + NORM_EPS);
#pragma unroll
            for (int i = 0; i < 8; ++i) { const float4 wv = ((const float4*)fw)[lane + 64 * i];
                ((float4*)(a.out + (size_t)row * D))[lane + 64 * i] = make_float4(v[i].x * rstd * wv.x, v[i].y * rstd * wv.y, v[i].z * rstd * wv.z, v[i].w * rstd * wv.w); }
        }
    }
#undef IN
#undef SEAM
}

extern "C" void kernel_launch(void* const* d_in, const int* in_sizes, int n_in, void* d_out, int out_size, void* d_ws, size_t ws_size, hipStream_t stream) {
    static int grid = 0;
    if (grid == 0) {
        if (n_in != 23 || out_size != T * D || ws_size < WS_END) { fprintf(stderr, "kernel_launch: unexpected shapes (n_in %d, out %d, ws %zu < %zu)\n", n_in, out_size, ws_size, (size_t)WS_END); grid = -1; return; }
        int dev = 0, cus = 0, per_cu = 0;
        if (hipGetDevice(&dev) != hipSuccess || hipDeviceGetAttribute(&cus, hipDeviceAttributeMultiprocessorCount, dev) != hipSuccess) { grid = -1; return; }
        if (hipFuncSetAttribute((const void*)fwd, hipFuncAttributeMaxDynamicSharedMemorySize, LDS_BYTES) != hipSuccess) { fprintf(stderr, "kernel_launch: hipFuncSetAttribute failed\n"); grid = -1; return; }
        if (hipOccupancyMaxActiveBlocksPerMultiprocessor(&per_cu, (const void*)fwd, 512, LDS_BYTES) != hipSuccess || per_cu < 1) { fprintf(stderr, "kernel_launch: occupancy query says %d\n", per_cu); per_cu = 1; }
        (void)hipGetLastError();
        grid = cus;
    }
    if (grid < 0) return;
    (void)hipMemsetAsync((char*)d_ws + WS_CTL, 0, CTL_BYTES, stream);
    Args a{};
    for (int i = 0; i < 23; ++i) a.in[i] = (const float*)d_in[i];
    a.out = (float*)d_out; a.ws = (unsigned char*)d_ws;
#if N_LAUNCH_MODE == 1
    a.ph_lo = 0; a.ph_hi = N_PHASES;
    hipLaunchKernelGGL(fwd, dim3(grid), dim3(512), LDS_BYTES, stream, a);
#else
    for (int ph = 0; ph < N_PHASES; ++ph) { a.ph_lo = ph; a.ph_hi = ph + 1; hipLaunchKernelGGL(fwd, dim3(grid), dim3(512), LDS_BYTES, stream, a); }
#endif
}
```

```cpp
#include <hip/hip_runtime.h>
#include <stdint.h>
#include <stdio.h>

#ifndef N_LAUNCH_MODE
#define N_LAUNCH_MODE 1
#endif

typedef unsigned short bf16_t;
typedef short s16x4 __attribute__((ext_vector_type(4)));
typedef short s16x8 __attribute__((ext_vector_type(8)));
typedef float f32x4 __attribute__((ext_vector_type(4)));
typedef unsigned u32x4 __attribute__((ext_vector_type(4)));
typedef unsigned u32x2 __attribute__((ext_vector_type(2)));
#define LAS __attribute__((address_space(3)))

constexpr int D = 2048, BATCH = 2, SEQ = 4096, T = BATCH * SEQ;
constexpr int SSM_H = 16, SSM_N = 128;
constexpr int NSA_H = 16, DH = 64;
constexpr int CMP_HID = 512;
constexpr int N_C = 255, N_SEL = 64;
constexpr int IN_PROJ = 5696;
constexpr int OFF_Z = 0, OFF_XBC = 1024, OFF_DT = 3072, OFF_Q = 3088, OFF_KCMP = 4112, OFF_VCMP = 4368, OFF_KSLC = 4624,
              OFF_VSLC = 4880, OFF_KWIN = 5136, OFF_VWIN = 5392, OFF_GATE = 5648;
constexpr int NE = 32, DFF = 2048;
constexpr float NORM_EPS = 1e-5f;
constexpr int CMP_ROWS = BATCH * N_C * 4;
constexpr int MAX_TILES = 160, MAX_ROWS = MAX_TILES * 256;

constexpr size_t AL(size_t x) { return (x + 255) & ~(size_t)255; }
constexpr size_t WS_CTL = 0;
constexpr size_t CTL_BYTES = 32768;
constexpr size_t WS_XN = WS_CTL + CTL_BYTES;
constexpr size_t WS_PROJ = WS_XN + AL((size_t)T * D * 2);
constexpr size_t WS_XBC = WS_PROJ + AL((size_t)T * IN_PROJ * 4);
constexpr size_t WS_DT = WS_XBC + AL((size_t)T * 2048 * 4);
constexpr size_t WS_YSSD = WS_DT + AL((size_t)T * 16 * 4);
constexpr size_t WS_MIX = WS_YSSD + AL((size_t)T * 1024 * 4);
constexpr size_t WS_ROPE = WS_MIX + AL((size_t)T * 2048 * 2);
constexpr size_t WS_BLK = WS_ROPE + AL((size_t)SEQ * 16 * 4);
constexpr size_t WS_H1 = WS_BLK + AL((size_t)2 * 2048 * 2048 * 2);
constexpr size_t WS_KC = WS_H1 + AL((size_t)2 * 2048 * 512 * 2);
constexpr size_t WS_VC = WS_KC + AL((size_t)2048 * 64 * 4);
constexpr size_t WS_PCMP = WS_VC + AL((size_t)2048 * 64 * 4);
constexpr size_t WS_OCMP = WS_PCMP + AL((size_t)T * 16 * 256 * 4);
constexpr size_t WS_SEL = WS_OCMP + AL((size_t)T * 1024 * 4);
constexpr size_t WS_X2 = WS_SEL + AL((size_t)T * 4 * 8);
constexpr size_t WS_TOPE = WS_X2 + AL((size_t)T * D * 4);
constexpr size_t WS_TOPG = WS_TOPE + AL((size_t)T * 4 * 4);
constexpr size_t WS_SLOT = WS_TOPG + AL((size_t)T * 4 * 4);
constexpr size_t WS_POS = WS_SLOT + AL((size_t)T * 4 * 4);
constexpr size_t WS_ROWTOK = WS_POS + AL((size_t)T * 4 * 4);
constexpr size_t WS_ACT = WS_ROWTOK + AL((size_t)MAX_ROWS * 4);
constexpr size_t WS_Y = WS_ACT + AL((size_t)MAX_ROWS * DFF * 2);
constexpr size_t WS_END = WS_Y + AL((size_t)MAX_ROWS * D * 2);

constexpr int CW_COUNT = 4096;

#define XB_TMO      128
#define XB_XCNT(j)  (256  + 64 * (j))
#define XB_XSUB(j)  (1280 + 64 * (j))
#define XB_XGEN(j)  (2304 + 64 * (j))
#define XB_TOP      3328
#define XB_TOPGEN   3392
#define XCD_BAR_WORDS 3456
#define XB_SPIN_CAP (1u << 18)

__device__ __forceinline__ unsigned xb_ld(unsigned* p)              { return __hip_atomic_load(p, __ATOMIC_RELAXED, __HIP_MEMORY_SCOPE_AGENT); }
__device__ __forceinline__ unsigned xb_add(unsigned* p, unsigned v) { return __hip_atomic_fetch_add(p, v, __ATOMIC_RELAXED, __HIP_MEMORY_SCOPE_AGENT); }
__device__ __forceinline__ unsigned xb_xcc_id() { return (unsigned)__builtin_amdgcn_s_getreg((3 << 11) | 20) & 0xFu; }
#define XB_SPIN(cond, bar) do { unsigned _sp = 0; while (cond) { __builtin_amdgcn_s_sleep(1); \
    if ((++_sp & 255u) == 0u) { if (xb_ld(&(bar)[XB_TMO])) break; if (_sp > XB_SPIN_CAP) { atomicAdd(&(bar)[XB_TMO], 1u); break; } } } } while (0)

struct XcdBarrier { unsigned* bar; unsigned x; volatile LAS unsigned* st; };

__device__ __forceinline__ XcdBarrier xcd_barrier_post(unsigned* bar, volatile LAS unsigned* st) {
    XcdBarrier b; b.bar = bar; b.x = xb_xcc_id(); b.st = st;
    if (threadIdx.x == 0) (void)xb_add(&bar[XB_XCNT(b.x)], 1u);
    return b;
}
__device__ __forceinline__ void xcd_barrier_complete(unsigned* bar, unsigned x, unsigned& nloc, unsigned& nx) {
    const unsigned G = gridDim.x * gridDim.y * gridDim.z;
    unsigned sum, cnt, mine, sp = 0u;
    for (;;) {
        sum = 0u; cnt = 0u; mine = 0u;
#pragma unroll
        for (unsigned j = 0; j < 16; ++j) { const unsigned c = xb_ld(&bar[XB_XCNT(j)]); sum += c; cnt += (c > 0u) ? 1u : 0u; mine = (j == x) ? c : mine; }
        if (sum == G) break;
        __builtin_amdgcn_s_sleep(1);
        if ((++sp & 255u) == 0u) { if (xb_ld(&bar[XB_TMO])) break; if (sp > XB_SPIN_CAP) { atomicAdd(&bar[XB_TMO], 1u); break; } }
    }
    nloc = mine > 0u ? mine : 1u; nx = cnt > 0u ? cnt : 1u;
}
__device__ __forceinline__ void xcd_barrier(const XcdBarrier& b) {
    asm volatile("s_waitcnt vmcnt(0)" ::: "memory");
    __syncthreads();
    if (threadIdx.x == 0) {
        unsigned* bar = b.bar;
        __builtin_amdgcn_s_waitcnt(0);
        unsigned nloc = b.st[0], nx = b.st[1];
        if (nloc == 0u) { xcd_barrier_complete(bar, b.x, nloc, nx); b.st[0] = nloc; b.st[1] = nx; }
        const unsigned old = xb_add(&bar[XB_XSUB(b.x)], 1u);
        const unsigned gen = old / nloc;
        if (old + 1u == (gen + 1u) * nloc) {
            __builtin_amdgcn_fence(__ATOMIC_RELEASE, "agent");
            asm volatile("s_waitcnt vmcnt(0)" ::: "memory");
            const unsigned og = xb_add(&bar[XB_TOP], 1u);
            const unsigned tg = og / nx;
            if (og + 1u == (tg + 1u) * nx) xb_add(&bar[XB_TOPGEN], 1u);
            else XB_SPIN(xb_ld(&bar[XB_TOPGEN]) == tg, bar);
            __builtin_amdgcn_fence(__ATOMIC_ACQUIRE, "agent");
            xb_add(&bar[XB_XGEN(b.x)], 1u);
            asm volatile("s_waitcnt vmcnt(0)" ::: "memory");
        } else {
            XB_SPIN(xb_ld(&bar[XB_XGEN(b.x)]) == gen, bar);
            __builtin_amdgcn_fence(__ATOMIC_ACQUIRE, "agent");
            asm volatile("s_waitcnt vmcnt(0)" ::: "memory");
        }
    }
    __syncthreads();
}

__device__ __forceinline__ bf16_t f2bf(float f) { unsigned u = __float_as_uint(f); u += 0x7FFFu + ((u >> 16) & 1u); return (bf16_t)(u >> 16); }
__device__ __forceinline__ float bf2f(bf16_t b) { return __uint_as_float(((unsigned)b) << 16); }
__device__ __forceinline__ unsigned pack2(float lo, float hi) { return (unsigned)f2bf(lo) | ((unsigned)f2bf(hi) << 16); }
__device__ __forceinline__ float wave_sum(float v) {
#pragma unroll
    for (int o = 32; o > 0; o >>= 1) v += __shfl_xor(v, o);
    return v;
}
__device__ __forceinline__ float sigmoidf_(float x) { return 1.0f / (1.0f + __expf(-x)); }

constexpr int A_RS = 80, B_RS = 576, A_ST = 256 * A_RS, B_ST = 32 * B_RS, STAGE = A_ST + B_ST;
constexpr int GEMM_LDS = 2 * STAGE;
constexpr int LDS_BYTES = GEMM_LDS + 64;

template <bool PAIRED, class ALd, class BLd, class EP>
__device__ __forceinline__ void gemm_unit(LAS char* lds, const ALd& al, const BLd& bl, const EP& ep, const int K) {
    const int tid = threadIdx.x, lane = tid & 63, wid = tid >> 6;
    const int wr = wid >> 2, wc = wid & 3, fr = lane & 15, fq = lane >> 4;
    const bf16_t* arow0; const bf16_t* arow1;
    { const int c0 = tid, c1 = tid + 512; const bf16_t* p0 = al.row(c0 >> 2); const bf16_t* p1 = al.row(c1 >> 2);
      arow0 = p0 ? p0 + (c0 & 3) * 8 : nullptr; arow1 = p1 ? p1 + (c1 & 3) * 8 : nullptr; }
    const float* bcol = bl.col(4 * (tid & 63));
    const size_t ldb = (size_t)bl.ldb;
    const int bk0 = tid >> 6;
    u32x4 ra0, ra1; float4 rb0, rb1, rb2, rb3;
    const u32x4 z4 = (u32x4){0u, 0u, 0u, 0u}; const float4 zf = make_float4(0.f, 0.f, 0.f, 0.f);
#define G_LOAD(kt) do { \
        ra0 = arow0 ? *(const u32x4*)(arow0 + (kt) * 32) : z4; ra1 = arow1 ? *(const u32x4*)(arow1 + (kt) * 32) : z4; \
        if (bcol) { const float* bp = bcol + (size_t)((kt) * 32 + bk0) * ldb; \
            rb0 = *(const float4*)(bp); rb1 = *(const float4*)(bp + 8 * ldb); rb2 = *(const float4*)(bp + 16 * ldb); rb3 = *(const float4*)(bp + 24 * ldb); } \
        else { rb0 = zf; rb1 = zf; rb2 = zf; rb3 = zf; } } while (0)
#define S_WRITE(buf) do { LAS char* sa = lds + (buf) * STAGE; LAS char* sb = sa + A_ST; \
        *(LAS u32x4*)(sa + (tid >> 2) * A_RS + (tid & 3) * 16) = ra0; \
        *(LAS u32x4*)(sa + ((tid + 512) >> 2) * A_RS + (tid & 3) * 16) = ra1; \
        LAS char* wb = sb + bk0 * B_RS + (tid & 63) * 8; \
        *(LAS u32x2*)(wb) = (u32x2){pack2(rb0.x, rb0.y), pack2(rb0.z, rb0.w)}; \
        *(LAS u32x2*)(wb + 8 * B_RS) = (u32x2){pack2(rb1.x, rb1.y), pack2(rb1.z, rb1.w)}; \
        *(LAS u32x2*)(wb + 16 * B_RS) = (u32x2){pack2(rb2.x, rb2.y), pack2(rb2.z, rb2.w)}; \
        *(LAS u32x2*)(wb + 24 * B_RS) = (u32x2){pack2(rb3.x, rb3.y), pack2(rb3.z, rb3.w)}; } while (0)
    f32x4 acc[8][4];
#pragma unroll
    for (int m = 0; m < 8; ++m)
#pragma unroll
        for (int n = 0; n < 4; ++n) acc[m][n] = (f32x4){0.f, 0.f, 0.f, 0.f};
    const int nk = K / 32;
    const int a_off = (wr * 128 + fr) * A_RS + fq * 16;
    const int b_off = A_ST + (8 * fq + ((lane & 15) >> 2)) * B_RS + (wc * 64 + 4 * (lane & 3)) * 2;
    G_LOAD(0);
    S_WRITE(0);
    __syncthreads();
    for (int kt = 0; kt < nk; ++kt) {
        const int buf = kt & 1;
        if (kt + 1 < nk) G_LOAD(kt + 1);
        LAS char* sbase = lds + buf * STAGE;
        s16x8 af[8];
#pragma unroll
        for (int m = 0; m < 8; ++m) af[m] = *(const LAS s16x8*)(sbase + a_off + m * 16 * A_RS);
#pragma unroll
        for (int n = 0; n < 4; ++n) {
            const s16x4 t0 = __builtin_amdgcn_ds_read_tr16_b64_v4i16((LAS s16x4*)(sbase + b_off + n * 32));
            const s16x4 t1 = __builtin_amdgcn_ds_read_tr16_b64_v4i16((LAS s16x4*)(sbase + b_off + n * 32 + 4 * B_RS));
            const s16x8 bfr = {t0[0], t0[1], t0[2], t0[3], t1[0], t1[1], t1[2], t1[3]};
#pragma unroll
            for (int m = 0; m < 8; ++m) acc[m][n] = __builtin_amdgcn_mfma_f32_16x16x32_bf16(bfr, af[m], acc[m][n], 0, 0, 0);
        }
        if (kt + 1 < nk) S_WRITE(buf ^ 1);
        __syncthreads();
    }
#undef G_LOAD
#undef S_WRITE
#pragma unroll
    for (int m = 0; m < 8; ++m) {
        const int r = wr * 128 + m * 16 + fr;
        if constexpr (PAIRED) {
#pragma unroll
            for (int n = 0; n < 2; ++n) ep.pair(r, wc * 32 + n * 16 + 4 * fq, acc[m][n], acc[m][n + 2]);
        } else {
#pragma unroll
            for (int n = 0; n < 4; ++n) ep(r, wc * 64 + n * 16 + 4 * fq, acc[m][n]);
        }
    }
}

struct Args {
    const float* in[23];
    float* out;
    unsigned char* ws;
    int ph_lo, ph_hi;
};

enum { PH_NORM1 = 0, PH_INPROJ, PH_PREP, PH_SSD_CMP1, PH_GNORM_CMP2, PH_CMPATT, PH_SELECT, PH_SELWIN, PH_OUTPROJ, PH_ROUTER, PH_SCATTER, PH_GATEUP, PH_DOWN, PH_FINAL, N_PHASES };

struct ARowsDense { const bf16_t* base; size_t ld; int row0, nrows;
    __device__ __forceinline__ const bf16_t* row(int r) const { const int g = row0 + r; return g < nrows ? base + (size_t)g * ld : nullptr; } };
struct ARowsGather { const bf16_t* base; size_t ld; const int* idx;
    __device__ __forceinline__ const bf16_t* row(int r) const { const int g = idx[r]; return g >= 0 ? base + (size_t)g * ld : nullptr; } };
struct BColsDense { const float* base; int ldb; int col0, ncols;
    __device__ __forceinline__ const float* col(int n) const { const int c = col0 + n; return c < ncols ? base + c : nullptr; } };
struct BColsGateUp { const float* base; int ldb; int cn;
    __device__ __forceinline__ const float* col(int n) const { const int wc = n >> 6, nt = (n & 63) >> 4, w = n & 15; const int j = wc * 32 + (nt & 1) * 16 + w;
        return base + (nt < 2 ? 0 : DFF) + cn * 128 + j; } };

struct EpiStoreF32 { float* C; size_t ldc; int row0, col0, ncols;
    __device__ __forceinline__ void operator()(int r, int n, f32x4 v) const { const int c = col0 + n; if (c < ncols) *(f32x4*)(C + (size_t)(row0 + r) * ldc + c) = v; } };
struct EpiResidF32 { float* C; const float* X; size_t ldc; int row0, col0;
    __device__ __forceinline__ void operator()(int r, int n, f32x4 v) const { const size_t o = (size_t)(row0 + r) * ldc + col0 + n; const f32x4 x = *(const f32x4*)(X + o); *(f32x4*)(C + o) = v + x; } };
struct EpiGeluBf16 { bf16_t* O; const float* bias; size_t ldo; int row0, col0, nrows;
    __device__ __forceinline__ void operator()(int r, int n, f32x4 v) const { const int g = row0 + r; if (g >= nrows) return; const int c = col0 + n;
        float o[4];
#pragma unroll
        for (int i = 0; i < 4; ++i) { const float x = v[i] + bias[c + i]; const float u = 0.7978845608028654f * (x + 0.044715f * x * x * x); o[i] = 0.5f * x * (1.0f + tanhf(u)); }
        *(uint2*)(O + (size_t)g * ldo + c) = make_uint2(pack2(o[0], o[1]), pack2(o[2], o[3])); } };
struct EpiSwiglu { bf16_t* O; const float* bias; int row0, cn;
    __device__ __forceinline__ void pair(int r, int j, f32x4 g, f32x4 u) const { const int c = cn * 128 + j; float o[4];
#pragma unroll
        for (int i = 0; i < 4; ++i) { float gv = g[i] + bias[c + i]; float uv = u[i] + bias[DFF + c + i]; gv = fminf(gv, 7.0f); uv = fminf(fmaxf(uv, -7.0f), 7.0f);
            const float glu = gv * sigmoidf_(1.702f * gv); o[i] = (uv + 1.0f) * glu; }
        *(uint2*)(O + (size_t)(row0 + r) * DFF + c) = make_uint2(pack2(o[0], o[1]), pack2(o[2], o[3])); } };
struct EpiBiasBf16 { bf16_t* O; const float* bias; int row0, col0;
    __device__ __forceinline__ void operator()(int r, int n, f32x4 v) const { const int c = col0 + n;
        *(uint2*)(O + (size_t)(row0 + r) * D + c) = make_uint2(pack2(v[0] + bias[c], v[1] + bias[c + 1]), pack2(v[2] + bias[c + 2], v[3] + bias[c + 3])); } };

__device__ __forceinline__ float rope_inv(int i) { return (float)exp(-(double)i * 0.125 * 13.122363377404328); }

__global__ void __launch_bounds__(512, 2) fwd(Args a) {
    extern __shared__ __attribute__((aligned(16))) unsigned char lds_raw[];
    LAS char* lds = (LAS char*)lds_raw;
    const int tid = threadIdx.x, lane = tid & 63, wid = __builtin_amdgcn_readfirstlane(tid >> 6);
    const int G = gridDim.x, bid = blockIdx.x;
    const int gtid = bid * 512 + tid, gthreads = G * 512;
    const int gwave = bid * 8 + wid, gwaves = G * 8;
    unsigned char* ws = a.ws;
    unsigned* ctl = (unsigned*)(ws + WS_CTL);
    volatile LAS unsigned* barw = (volatile LAS unsigned*)(lds + GEMM_LDS);
    LAS int* lmisc = (LAS int*)(lds + GEMM_LDS + 16);
    if (tid == 0) { barw[0] = 0u; barw[1] = 0u; barw[2] = 0u; barw[3] = 0u; }
    __syncthreads();
    XcdBarrier bar; bar.bar = ctl; bar.x = 0; bar.st = barw;
    const bool multi = (a.ph_hi - a.ph_lo) > 1;
    if (multi) bar = xcd_barrier_post(ctl, barw);
#ifdef ONLY_PH
#define IN(k) ((k) == ONLY_PH)
#else
#define IN(k) (a.ph_lo <= (k) && (k) < a.ph_hi)
#endif
#define SEAM(k) do { if ((k) + 1 < a.ph_hi) xcd_barrier(bar); } while (0)

    const float* x = a.in[0];
    bf16_t* XN = (bf16_t*)(ws + WS_XN);
    float* PROJ = (float*)(ws + WS_PROJ);
    float* XBC = (float*)(ws + WS_XBC);
    float* DT = (float*)(ws + WS_DT);
    float* YSSD = (float*)(ws + WS_YSSD);
    bf16_t* MIX = (bf16_t*)(ws + WS_MIX);
    float* ROPE = (float*)(ws + WS_ROPE);
    bf16_t* BLK = (bf16_t*)(ws + WS_BLK);
    bf16_t* H1 = (bf16_t*)(ws + WS_H1);
    float* KC = (float*)(ws + WS_KC);
    float* VC = (float*)(ws + WS_VC);
    float* PCMP = (float*)(ws + WS_PCMP);
    float* OCMP = (float*)(ws + WS_OCMP);
    unsigned long long* SEL = (unsigned long long*)(ws + WS_SEL);
    float* X2 = (float*)(ws + WS_X2);
    int* TOPE = (int*)(ws + WS_TOPE);
    float* TOPG = (float*)(ws + WS_TOPG);
    int* SLOT = (int*)(ws + WS_SLOT);
    int* POS = (int*)(ws + WS_POS);
    int* ROWTOK = (int*)(ws + WS_ROWTOK);
    bf16_t* ACT = (bf16_t*)(ws + WS_ACT);
    bf16_t* YB = (bf16_t*)(ws + WS_Y);
    unsigned* COUNT = ctl + CW_COUNT;

    if (IN(PH_NORM1)) {
        const float* w = a.in[1];
        for (int row = gwave; row < T; row += gwaves) {
            const float4* xr = (const float4*)(x + (size_t)row * D);
            float4 v[8]; float ss = 0.f;
#pragma unroll
            for (int i = 0; i < 8; ++i) { v[i] = xr[lane + 64 * i]; ss += v[i].x * v[i].x + v[i].y * v[i].y + v[i].z * v[i].z + v[i].w * v[i].w; }
            ss = wave_sum(ss);
            const float rstd = rsqrtf(ss * (1.0f / D) + NORM_EPS);
#pragma unroll
            for (int i = 0; i < 8; ++i) { const float4 wv = ((const float4*)w)[lane + 64 * i];
                *(uint2*)(XN + (size_t)row * D + 4 * (lane + 64 * i)) = make_uint2(pack2(v[i].x * rstd * wv.x, v[i].y * rstd * wv.y), pack2(v[i].z * rstd * wv.z, v[i].w * rstd * wv.w)); }
        }
        for (int i = gtid; i < SEQ * 8; i += gthreads) { const int pos = i >> 3, k = i & 7; const float ang = (float)pos * rope_inv(k); ROPE[i] = cosf(ang); ROPE[SEQ * 8 + i] = sinf(ang); }
        for (int i = gtid; i < MAX_ROWS; i += gthreads) ROWTOK[i] = -1;
        SEAM(PH_NORM1);
    }

    if (IN(PH_INPROJ)) {
        const int nct = (IN_PROJ + 255) / 256, nunits = (T / 256) * nct;
        for (int u = bid; u < nunits; u += G) {
            const int rt = u / nct, ct = u % nct;
            ARowsDense al{XN, (size_t)D, rt * 256, T};
            BColsDense bl{a.in[2], IN_PROJ, ct * 256, IN_PROJ};
            EpiStoreF32 ep{PROJ, (size_t)IN_PROJ, rt * 256, ct * 256, IN_PROJ};
            gemm_unit<false>(lds, al, bl, ep, D);
        }
        SEAM(PH_INPROJ);
    }

    if (IN(PH_PREP)) {
        const float* conv_w = a.in[3]; const float* conv_b = a.in[4]; const float* dt_bias = a.in[5];
        for (int i = gtid; i < T * 2048; i += gthreads) {
            const int t = i >> 11, c = i & 2047, s = t & (SEQ - 1);
            float acc = conv_b[c];
#pragma unroll
            for (int k = 0; k < 4; ++k) { const int ts = s - 3 + k; if (ts >= 0) acc += conv_w[k * 2048 + c] * PROJ[(size_t)(t - 3 + k) * IN_PROJ + OFF_XBC + c]; }
            XBC[i] = acc * sigmoidf_(acc);
        }
        for (int i = gtid; i < T * 16; i += gthreads) { const int h = i & 15; const float v = PROJ[(size_t)(i >> 4) * IN_PROJ + OFF_DT + h] + dt_bias[h];
            DT[i] = v > 20.f ? v : log1pf(expf(v)); }
        for (int i = gtid; i < T * 24 * 8; i += gthreads) {
            const int k = i & 7, slot = (i >> 3) % 24, t = i / 192, pos = t & (SEQ - 1);
            const int col = slot < 16 ? OFF_Q + slot * 64 : (slot < 20 ? OFF_KSLC + (slot - 16) * 64 : OFF_KWIN + (slot - 20) * 64);
            float* p = PROJ + (size_t)t * IN_PROJ + col;
            const float c = ROPE[pos * 8 + k], s = ROPE[SEQ * 8 + pos * 8 + k];
            const float x1 = p[k], x2 = p[k + 8];
            p[k] = x1 * c - x2 * s; p[k + 8] = x1 * s + x2 * c;
        }
        const float* pe = a.in[9];
        for (int i = gtid; i < 2 * 2048 * 512; i += gthreads) {
            const int e4 = i & 511, row = (i >> 9) & 2047, j = i >> 20;
            uint2 o = make_uint2(0u, 0u);
            if (row < CMP_ROWS) { const int g = row & 3, n = (row >> 2) % N_C, b = (row >> 2) / N_C; const int l = e4 >> 4, d = (e4 & 15) * 4;
                const float4 v = *(const float4*)(PROJ + (size_t)(b * SEQ + 16 * n + l) * IN_PROJ + (j ? OFF_VCMP : OFF_KCMP) + g * 64 + d);
                const float4 p4 = *(const float4*)(pe + (j * 32 + l) * 64 + d);
                o = make_uint2(pack2(v.x + p4.x, v.y + p4.y), pack2(v.z + p4.z, v.w + p4.w)); }
            *(uint2*)(BLK + ((size_t)j * 2048 + row) * 2048 + e4 * 4) = o;
        }
        SEAM(PH_PREP);
    }

    if (IN(PH_SSD_CMP1)) {
        if (bid < 16) {
            const int w = bid * 8 + wid, b = w >> 6, h = (w >> 2) & 15, pq = w & 3, g = h >> 2;
            const int p = pq * 16 + (lane >> 2), nq = lane & 3;
            const float av = -expf(a.in[6][h]), dsk = a.in[7][h];
            float st[32];
#pragma unroll
            for (int n = 0; n < 32; ++n) st[n] = 0.f;
            for (int t = 0; t < SEQ; ++t) {
                const size_t tt = (size_t)b * SEQ + t;
                const float* row = XBC + tt * 2048;
                const float dtv = DT[tt * 16 + h];
                const float dA = expf(dtv * av);
                const float xv = row[h * 64 + p];
                const float4* Bp = (const float4*)(row + 1024 + g * 128 + nq * 32); const float4* Cp = (const float4*)(row + 1536 + g * 128 + nq * 32);
                const float coef = dtv * xv; float y = 0.f;
#pragma unroll
                for (int n4 = 0; n4 < 8; ++n4) { const float4 bv = Bp[n4], cv = Cp[n4];
                    st[4 * n4 + 0] = st[4 * n4 + 0] * dA + coef * bv.x; y += st[4 * n4 + 0] * cv.x;
                    st[4 * n4 + 1] = st[4 * n4 + 1] * dA + coef * bv.y; y += st[4 * n4 + 1] * cv.y;
                    st[4 * n4 + 2] = st[4 * n4 + 2] * dA + coef * bv.z; y += st[4 * n4 + 2] * cv.z;
                    st[4 * n4 + 3] = st[4 * n4 + 3] * dA + coef * bv.w; y += st[4 * n4 + 3] * cv.w; }
                y += __shfl_xor(y, 1); y += __shfl_xor(y, 2);
                if (nq == 0) YSSD[tt * 1024 + h * 64 + p] = y + dsk * xv;
            }
        } else {
            const int nb = G - 16;
            for (int u = bid - 16; u < 32; u += nb) {
                const int j = u >> 4, rt = (u >> 1) & 7, ct = u & 1;
                ARowsDense al{BLK + (size_t)j * 2048 * 2048, (size_t)2048, rt * 256, CMP_ROWS};
                BColsDense bl{a.in[10] + (size_t)j * 2048 * CMP_HID, CMP_HID, ct * 256, CMP_HID};
                EpiGeluBf16 ep{H1 + (size_t)j * 2048 * CMP_HID, a.in[11] + j * CMP_HID, (size_t)CMP_HID, rt * 256, ct * 256, CMP_ROWS};
                gemm_unit<false>(lds, al, bl, ep, 2048);
            }
        }
        SEAM(PH_SSD_CMP1);
    }

    if (IN(PH_GNORM_CMP2)) {
        const float* nw = a.in[8];
        for (int it = gwave; it < T * 4; it += gwaves) {
            const int t = it >> 2, grp = it & 3, c = grp * 256 + lane * 4;
            const float4 y = *(const float4*)(YSSD + (size_t)t * 1024 + c);
            const float4 z = *(const float4*)(PROJ + (size_t)t * IN_PROJ + OFF_Z + c);
            float gv[4] = {y.x * z.x * sigmoidf_(z.x), y.y * z.y * sigmoidf_(z.y), y.z * z.z * sigmoidf_(z.z), y.w * z.w * sigmoidf_(z.w)};
            float ss = wave_sum(gv[0] * gv[0] + gv[1] * gv[1] + gv[2] * gv[2] + gv[3] * gv[3]);
            const float sc = rsqrtf(ss * (1.0f / 256.f) + NORM_EPS);
            const float4 w4 = *(const float4*)(nw + c);
            *(uint2*)(MIX + (size_t)t * 2048 + c) = make_uint2(pack2(gv[0] * sc * w4.x, gv[1] * sc * w4.y), pack2(gv[2] * sc * w4.z, gv[3] * sc * w4.w));
        }
        const float* w2 = a.in[12]; const float* b2 = a.in[13];
        for (int i = gtid; i < 2 * CMP_ROWS * 64; i += gthreads) {
            const int d = i & 63, row = (i >> 6) % CMP_ROWS, j = i / (CMP_ROWS * 64);
            const bf16_t* hrow = H1 + ((size_t)j * 2048 + row) * CMP_HID;
            const float* wj = w2 + (size_t)j * CMP_HID * 64;
            const bool rot = (j == 0) && (d < 16);
            const int dp = rot ? (d < 8 ? d + 8 : d - 8) : d;
            float s0 = b2[j * 64 + d], s1 = b2[j * 64 + dp];
            for (int k = 0; k < CMP_HID; ++k) { const float hv = bf2f(hrow[k]); s0 += hv * wj[k * 64 + d]; s1 += hv * wj[k * 64 + dp]; }
            float o = s0;
            if (rot) { const int n = (row >> 2) % N_C, pos = 16 * n + 31, k = d & 7; const float c = ROPE[pos * 8 + k], s = ROPE[SEQ * 8 + pos * 8 + k];
                o = (d < 8) ? (s0 * c - s1 * s) : (s1 * s + s0 * c); }
            (j ? VC : KC)[(size_t)row * 64 + d] = o;
        }
        SEAM(PH_GNORM_CMP2);
    }

    if (IN(PH_CMPATT)) {
        for (int it = gtid; it < T * 16; it += gthreads) {
            const int hq = it & 15, tt = it >> 4, b = tt >> 12, t = tt & (SEQ - 1), g = hq >> 2;
            const int nvalid = t >= 31 ? ((t - 31) >> 4) + 1 : 0;
            float q[64];
            const float* qp = PROJ + (size_t)tt * IN_PROJ + OFF_Q + hq * 64;
#pragma unroll
            for (int d = 0; d < 64; d += 4) { const float4 v = *(const float4*)(qp + d); q[d] = v.x; q[d + 1] = v.y; q[d + 2] = v.z; q[d + 3] = v.w; }
            float m = -INFINITY, l = 0.f;
            for (int c = 0; c < nvalid; ++c) {
                const float* kp = KC + (size_t)((b * N_C + c) * 4 + g) * 64; float s = 0.f;
#pragma unroll
                for (int d = 0; d < 64; d += 4) { const float4 v = *(const float4*)(kp + d); s += q[d] * v.x + q[d + 1] * v.y + q[d + 2] * v.z + q[d + 3] * v.w; }
                s *= 0.125f;
                const float mn = fmaxf(m, s); l = l * __expf(m - mn) + __expf(s - mn); m = mn;
            }
            float o[64];
#pragma unroll
            for (int d = 0; d < 64; ++d) o[d] = 0.f;
            const float inv_l = nvalid > 0 ? 1.0f / fmaxf(l, 1e-30f) : 0.f;
            float* pp = PCMP + (size_t)it * 256;
            for (int c = 0; c < nvalid; ++c) {
                const float* kp = KC + (size_t)((b * N_C + c) * 4 + g) * 64; float s = 0.f;
#pragma unroll
                for (int d = 0; d < 64; d += 4) { const float4 v = *(const float4*)(kp + d); s += q[d] * v.x + q[d + 1] * v.y + q[d + 2] * v.z + q[d + 3] * v.w; }
                const float p = __expf(s * 0.125f - m) * inv_l;
                pp[c] = p;
                const float* vp = VC + (size_t)((b * N_C + c) * 4 + g) * 64;
#pragma unroll
                for (int d = 0; d < 64; d += 4) { const float4 v = *(const float4*)(vp + d); o[d] += p * v.x; o[d + 1] += p * v.y; o[d + 2] += p * v.z; o[d + 3] += p * v.w; }
            }
            for (int c = nvalid; c < 256; ++c) pp[c] = 0.f;
            float* op = OCMP + (size_t)tt * 1024 + hq * 64;
#pragma unroll
            for (int d = 0; d < 64; d += 4) *(float4*)(op + d) = make_float4(o[d], o[d + 1], o[d + 2], o[d + 3]);
        }
        SEAM(PH_CMPATT);
    }

    if (IN(PH_SELECT)) {
        for (int it = gwave; it < T * 4; it += gwaves) {
            const int g = it & 3, tt = it >> 2, t = tt & (SEQ - 1), cur = t >> 6, j = lane;
            float imp = 0.f;
#pragma unroll
            for (int r = 0; r < 4; ++r) { const float* pp = PCMP + ((size_t)tt * 16 + g * 4 + r) * 256 + 4 * j;
                const float4 v = *(const float4*)pp; const float pm1 = j > 0 ? pp[-1] : 0.f;
                imp += 32.f * (v.x + v.y + v.z) + 16.f * v.w + 16.f * pm1; }
            const bool forced = (j == 0) || (j == cur) || (j == cur - 1);
            const bool valid = j <= cur;
            const float sc = forced ? 1.0e4f : (valid ? imp : -1.0e4f);
            int rank = 0;
#pragma unroll
            for (int k = 0; k < 64; ++k) { const float o = __shfl(sc, k); rank += (o > sc || (o == sc && k < j)) ? 1 : 0; }
            const unsigned long long mask = __ballot(rank < 16 && valid);
            if (lane == 0) SEL[it] = mask;
        }
        SEAM(PH_SELECT);
    }

    if (IN(PH_SELWIN)) {
        for (int it = gtid; it < T * 16; it += gthreads) {
            const int hq = it & 15, tt = it >> 4, b = tt >> 12, t = tt & (SEQ - 1), g = hq >> 2;
            float q[64];
            const float* qp = PROJ + (size_t)tt * IN_PROJ + OFF_Q + hq * 64;
#pragma unroll
            for (int d = 0; d < 64; d += 4) { const float4 v = *(const float4*)(qp + d); q[d] = v.x; q[d + 1] = v.y; q[d + 2] = v.z; q[d + 3] = v.w; }
            const float* gl = PROJ + (size_t)tt * IN_PROJ + OFF_GATE + hq * 3;
            const float g0 = sigmoidf_(gl[0]), g1 = sigmoidf_(gl[1]), g2 = sigmoidf_(gl[2]);
            float* op = OCMP + (size_t)tt * 1024 + hq * 64;
            float o[64];
            {
#pragma unroll
                for (int d = 0; d < 64; ++d) o[d] = 0.f;
                float m = -INFINITY, l = 0.f;
                unsigned long long mask = SEL[(size_t)tt * 4 + g];
                while (mask) {
                    const int j = __ffsll((long long)mask) - 1; mask &= mask - 1;
                    const int hi = min(64 * j + 63, t);
                    for (int tok = 64 * j; tok <= hi; ++tok) {
                        const float* kp = PROJ + (size_t)(b * SEQ + tok) * IN_PROJ + OFF_KSLC + g * 64; float s = 0.f;
#pragma unroll
                        for (int d = 0; d < 64; d += 4) { const float4 v = *(const float4*)(kp + d); s += q[d] * v.x + q[d + 1] * v.y + q[d + 2] * v.z + q[d + 3] * v.w; }
                        s *= 0.125f;
                        const float mn = fmaxf(m, s), al = __expf(m - mn), p = __expf(s - mn); m = mn; l = l * al + p;
                        const float* vp = kp + (OFF_VSLC - OFF_KSLC);
#pragma unroll
                        for (int d = 0; d < 64; d += 4) { const float4 v = *(const float4*)(vp + d); o[d] = o[d] * al + p * v.x; o[d + 1] = o[d + 1] * al + p * v.y; o[d + 2] = o[d + 2] * al + p * v.z; o[d + 3] = o[d + 3] * al + p * v.w; }
                    }
                }
                const float il = g1 / fmaxf(l, 1e-30f);
#pragma unroll
                for (int d = 0; d < 64; d += 4) { float4 r = *(float4*)(op + d); r.x = g0 * r.x + il * o[d]; r.y = g0 * r.y + il * o[d + 1]; r.z = g0 * r.z + il * o[d + 2]; r.w = g0 * r.w + il * o[d + 3]; *(float4*)(op + d) = r; }
            }
            {
#pragma unroll
                for (int d = 0; d < 64; ++d) o[d] = 0.f;
                float m = -INFINITY, l = 0.f;
                const int lo = max(0, t - 511);
                for (int tok = lo; tok <= t; ++tok) {
                    const float* kp = PROJ + (size_t)(b * SEQ + tok) * IN_PROJ + OFF_KWIN + g * 64; float s = 0.f;
#pragma unroll
                    for (int d = 0; d < 64; d += 4) { const float4 v = *(const float4*)(kp + d); s += q[d] * v.x + q[d + 1] * v.y + q[d + 2] * v.z + q[d + 3] * v.w; }
                    s *= 0.125f;
                    const float mn = fmaxf(m, s), al = __expf(m - mn), p = __expf(s - mn); m = mn; l = l * al + p;
                    const float* vp = kp + (OFF_VWIN - OFF_KWIN);
#pragma unroll
                    for (int d = 0; d < 64; d += 4) { const float4 v = *(const float4*)(vp + d); o[d] = o[d] * al + p * v.x; o[d + 1] = o[d + 1] * al + p * v.y; o[d + 2] = o[d + 2] * al + p * v.z; o[d + 3] = o[d + 3] * al + p * v.w; }
                }
                const float il = g2 / fmaxf(l, 1e-30f);
                bf16_t* mp = MIX + (size_t)tt * 2048 + 1024 + hq * 64;
#pragma unroll
                for (int d = 0; d < 64; d += 4) { const float4 r = *(const float4*)(op + d);
                    *(uint2*)(mp + d) = make_uint2(pack2(r.x + il * o[d], r.y + il * o[d + 1]), pack2(r.z + il * o[d + 2], r.w + il * o[d + 3])); }
            }
        }
        SEAM(PH_SELWIN);
    }

    if (IN(PH_OUTPROJ)) {
        const int nunits = (T / 256) * (D / 256);
        for (int u = bid; u < nunits; u += G) {
            const int rt = u >> 3, ct = u & 7;
            ARowsDense al{MIX, (size_t)2048, rt * 256, T};
            BColsDense bl{a.in[14], D, ct * 256, D};
            EpiResidF32 ep{X2, x, (size_t)D, rt * 256, ct * 256};
            gemm_unit<false>(lds, al, bl, ep, 2048);
        }
        SEAM(PH_OUTPROJ);
    }

    if (IN(PH_ROUTER)) {
        const float* w = a.in[15]; const float* wr_ = a.in[16]; const float* br = a.in[17];
        for (int row = gwave; row < T; row += gwaves) {
            const float4* xr = (const float4*)(X2 + (size_t)row * D);
            float ss = 0.f;
#pragma unroll 2
            for (int i = 0; i < 8; ++i) { const float4 v = xr[lane + 64 * i]; ss += v.x * v.x + v.y * v.y + v.z * v.z + v.w * v.w; }
            ss = wave_sum(ss);
            const float rstd = rsqrtf(ss * (1.0f / D) + NORM_EPS);
            float lg[NE];
#pragma unroll
            for (int e = 0; e < NE; ++e) lg[e] = 0.f;
#pragma unroll 1
            for (int i = 0; i < 8; ++i) { const float4 wv = ((const float4*)w)[lane + 64 * i]; const float4 v = xr[lane + 64 * i];
                const float h0 = v.x * rstd * wv.x, h1 = v.y * rstd * wv.y, h2 = v.z * rstd * wv.z, h3 = v.w * rstd * wv.w;
                const int d0 = 4 * (lane + 64 * i);
                *(uint2*)(XN + (size_t)row * D + d0) = make_uint2(pack2(h0, h1), pack2(h2, h3));
                const float4* r0 = (const float4*)(wr_ + (size_t)d0 * NE);
#pragma unroll
                for (int e4 = 0; e4 < 8; ++e4) { const float4 a0 = r0[e4], a1 = r0[8 + e4], a2 = r0[16 + e4], a3 = r0[24 + e4];
                    lg[4 * e4 + 0] += h0 * a0.x + h1 * a1.x + h2 * a2.x + h3 * a3.x; lg[4 * e4 + 1] += h0 * a0.y + h1 * a1.y + h2 * a2.y + h3 * a3.y;
                    lg[4 * e4 + 2] += h0 * a0.z + h1 * a1.z + h2 * a2.z + h3 * a3.z; lg[4 * e4 + 3] += h0 * a0.w + h1 * a1.w + h2 * a2.w + h3 * a3.w; }
            }
            float mine = -INFINITY;
#pragma unroll
            for (int e = 0; e < NE; ++e) { const float s = wave_sum(lg[e]); if (lane == e) mine = s + br[e]; }
            int rank = 0;
#pragma unroll
            for (int k = 0; k < NE; ++k) { const float o = __shfl(mine, k); rank += (o > mine || (o == mine && k < lane)) ? 1 : 0; }
            const bool sel = (lane < NE) && (rank < 4);
            float mx = sel ? mine : -INFINITY;
#pragma unroll
            for (int o = 32; o > 0; o >>= 1) mx = fmaxf(mx, __shfl_xor(mx, o));
            const float ex = sel ? __expf(mine - mx) : 0.f;
            const float den = wave_sum(ex);
            if (sel) { const int slot = (int)atomicAdd(&COUNT[lane], 1u); const int o = row * 4 + rank; TOPE[o] = lane; TOPG[o] = ex / den; SLOT[o] = slot; }
        }
        SEAM(PH_ROUTER);
    }

    if (IN(PH_SCATTER)) {
        for (int i = gtid; i < T * 4; i += gthreads) {
            const int e = TOPE[i]; int off = 0;
            for (int k = 0; k < e; ++k) off += (int)((COUNT[k] + 255u) >> 8);
            const int pos = off * 256 + SLOT[i];
            ROWTOK[pos] = i >> 2; POS[i] = pos;
        }
        SEAM(PH_SCATTER);
    }

    if (IN(PH_GATEUP) || IN(PH_DOWN)) {
        LAS int* toff = (LAS int*)(lds + GEMM_LDS + 64 - 0);
        (void)toff;
    }
    if (IN(PH_GATEUP)) {
        int ntiles = 0;
        for (int k = 0; k < NE; ++k) ntiles += (int)((COUNT[k] + 255u) >> 8);
        const int nunits = ntiles * 16;
        for (int u = bid; u < nunits; u += G) {
            const int tile = u >> 4, cn = u & 15;
            int e = 0, acc = 0;
            for (int k = 0; k < NE; ++k) { const int nt = (int)((COUNT[k] + 255u) >> 8); if (tile >= acc && tile < acc + nt) e = k; acc += nt; }
            ARowsGather al{XN, (size_t)D, ROWTOK + tile * 256};
            BColsGateUp bl{a.in[18] + (size_t)e * D * 2 * DFF, 2 * DFF, cn};
            EpiSwiglu ep{ACT, a.in[19] + (size_t)e * 2 * DFF, tile * 256, cn};
            gemm_unit<true>(lds, al, bl, ep, D);
        }
        SEAM(PH_GATEUP);
    }
    if (IN(PH_DOWN)) {
        int ntiles = 0;
        for (int k = 0; k < NE; ++k) ntiles += (int)((COUNT[k] + 255u) >> 8);
        const int nunits = ntiles * 8;
        for (int u = bid; u < nunits; u += G) {
            const int tile = u >> 3, ct = u & 7;
            int e = 0, acc = 0;
            for (int k = 0; k < NE; ++k) { const int nt = (int)((COUNT[k] + 255u) >> 8); if (tile >= acc && tile < acc + nt) e = k; acc += nt; }
            ARowsDense al{ACT, (size_t)DFF, tile * 256, MAX_ROWS};
            BColsDense bl{a.in[20] + (size_t)e * DFF * D, D, ct * 256, D};
            EpiBiasBf16 ep{YB, a.in[21] + (size_t)e * D, tile * 256, ct * 256};
            gemm_unit<false>(lds, al, bl, ep, DFF);
        }
        SEAM(PH_DOWN);
    }

    if (IN(PH_FINAL)) {
        const float* fw = a.in[22];
        for (int row = gwave; row < T; row += gwaves) {
            const float4* xr = (const float4*)(X2 + (size_t)row * D);
            float4 v[8];
#pragma unroll
            for (int i = 0; i < 8; ++i) v[i] = xr[lane + 64 * i];
#pragma unroll
            for (int k = 0; k < 4; ++k) { const float gk = TOPG[row * 4 + k]; const bf16_t* yr = YB + (size_t)POS[row * 4 + k] * D;
#pragma unroll
                for (int i = 0; i < 8; ++i) { const uint2 y = *(const uint2*)(yr + 4 * (lane + 64 * i));
                    v[i].x += gk * bf2f((bf16_t)(y.x & 0xffffu)); v[i].y += gk * bf2f((bf16_t)(y.x >> 16)); v[i].z += gk * bf2f((bf16_t)(y.y & 0xffffu)); v[i].w += gk * bf2f((bf16_t)(y.y >> 16)); } }
            float ss = 0.f;
#pragma unroll
            for (int i = 0; i < 8; ++i) ss += v[i].x * v[i].x + v[i].y * v[i].y + v[i].z * v[i].z + v[i].w * v[i].w;
            ss = wave_sum(ss);
            const float rstd = rsqrtf(ss * (1.0f / D) + NORM_EPS);
#pragma unroll
            for (int i = 0; i < 8; ++i) { const float4 wv = ((const float4*)fw)[lane + 64 * i];
                ((float4*)(a.out + (size_t)row * D))[lane + 64 * i] = make_float4(v[i].x * rstd * wv.x, v[i].y * rstd * wv.y, v[i].z * rstd * wv.z, v[i].w * rstd * wv.w); }
        }
    }
#undef IN
#undef SEAM
}

extern "C" void kernel_launch(void* const* d_in, const int* in_sizes, int n_in, void* d_out, int out_size, void* d_ws, size_t ws_size, hipStream_t stream) {
    static int grid = 0;
    if (grid == 0) {
        if (n_in != 23 || out_size != T * D || ws_size < WS_END) { fprintf(stderr, "kernel_launch: unexpected shapes (n_in %d, out %d, ws %zu < %zu)\n", n_in, out_size, ws_size, (size_t)WS_END); grid = -1; return; }
        int dev = 0, cus = 0, per_cu = 0;
        if (hipGetDevice(&dev) != hipSuccess || hipDeviceGetAttribute(&cus, hipDeviceAttributeMultiprocessorCount, dev) != hipSuccess) { grid = -1; return; }
        if (hipFuncSetAttribute((const void*)fwd, hipFuncAttributeMaxDynamicSharedMemorySize, LDS_BYTES) != hipSuccess) { fprintf(stderr, "kernel_launch: hipFuncSetAttribute failed\n"); grid = -1; return; }
        if (hipOccupancyMaxActiveBlocksPerMultiprocessor(&per_cu, (const void*)fwd, 512, LDS_BYTES) != hipSuccess || per_cu < 1) { fprintf(stderr, "kernel_launch: occupancy query says %d\n", per_cu); per_cu = 1; }
        (void)hipGetLastError();
        grid = cus;
    }
    if (grid < 0) return;
    (void)hipMemsetAsync((char*)d_ws + WS_CTL, 0, CTL_BYTES, stream);
    Args a{};
    for (int i = 0; i < 23; ++i) a.in[i] = (const float*)d_in[i];
    a.out = (float*)d_out; a.ws = (unsigned char*)d_ws;
#if N_LAUNCH_MODE == 1
    a.ph_lo = 0; a.ph_hi = N_PHASES;
    hipLaunchKernelGGL(fwd, dim3(grid), dim3(512), LDS_BYTES, stream, a);
#else
    for (int ph = 0; ph < N_PHASES; ++ph) { a.ph_lo = ph; a.ph_hi = ph + 1; hipLaunchKernelGGL(fwd, dim3(grid), dim3(512), LDS_BYTES, stream, a); }
#endif
}
```

```cpp
#include <hip/hip_runtime.h>
#include <stdint.h>
#include <stdio.h>

#ifndef N_LAUNCH_MODE
#define N_LAUNCH_MODE 1
#endif

typedef unsigned short bf16_t;
typedef short s16x4 __attribute__((ext_vector_type(4)));
typedef short s16x8 __attribute__((ext_vector_type(8)));
typedef float f32x4 __attribute__((ext_vector_type(4)));
typedef unsigned u32x4 __attribute__((ext_vector_type(4)));
typedef unsigned u32x2 __attribute__((ext_vector_type(2)));
#define LAS __attribute__((address_space(3)))

constexpr int D = 2048, BATCH = 2, SEQ = 4096, T = BATCH * SEQ;
constexpr int SSM_H = 16, SSM_N = 128;
constexpr int NSA_H = 16, DH = 64;
constexpr int CMP_HID = 512;
constexpr int N_C = 255, N_SEL = 64;
constexpr int IN_PROJ = 5696;
constexpr int OFF_Z = 0, OFF_XBC = 1024, OFF_DT = 3072, OFF_Q = 3088, OFF_KCMP = 4112, OFF_VCMP = 4368, OFF_KSLC = 4624,
              OFF_VSLC = 4880, OFF_KWIN = 5136, OFF_VWIN = 5392, OFF_GATE = 5648;
constexpr int NE = 32, DFF = 2048;
constexpr float NORM_EPS = 1e-5f;
constexpr int CMP_ROWS = BATCH * N_C * 4;
constexpr int MAX_TILES = 160, MAX_ROWS = MAX_TILES * 256;

constexpr size_t AL(size_t x) { return (x + 255) & ~(size_t)255; }
constexpr size_t WS_CTL = 0;
constexpr size_t CTL_BYTES = 32768;
constexpr size_t WS_XN = WS_CTL + CTL_BYTES;
constexpr size_t WS_PROJ = WS_XN + AL((size_t)T * D * 2);
constexpr size_t WS_XBC = WS_PROJ + AL((size_t)T * IN_PROJ * 4);
constexpr size_t WS_DT = WS_XBC + AL((size_t)T * 2048 * 4);
constexpr size_t WS_YSSD = WS_DT + AL((size_t)T * 16 * 4);
constexpr size_t WS_MIX = WS_YSSD + AL((size_t)T * 1024 * 4);
constexpr size_t WS_ROPE = WS_MIX + AL((size_t)T * 2048 * 2);
constexpr size_t WS_BLK = WS_ROPE + AL((size_t)SEQ * 16 * 4);
constexpr size_t WS_H1 = WS_BLK + AL((size_t)2 * 2048 * 2048 * 2);
constexpr size_t WS_KC = WS_H1 + AL((size_t)2 * 2048 * 512 * 2);
constexpr size_t WS_VC = WS_KC + AL((size_t)2048 * 64 * 4);
constexpr size_t WS_PCMP = WS_VC + AL((size_t)2048 * 64 * 4);
constexpr size_t WS_OCMP = WS_PCMP + AL((size_t)T * 16 * 256 * 4);
constexpr size_t WS_SEL = WS_OCMP + AL((size_t)T * 1024 * 4);
constexpr size_t WS_X2 = WS_SEL + AL((size_t)T * 4 * 8);
constexpr size_t WS_TOPE = WS_X2 + AL((size_t)T * D * 4);
constexpr size_t WS_TOPG = WS_TOPE + AL((size_t)T * 4 * 4);
constexpr size_t WS_SLOT = WS_TOPG + AL((size_t)T * 4 * 4);
constexpr size_t WS_POS = WS_SLOT + AL((size_t)T * 4 * 4);
constexpr size_t WS_ROWTOK = WS_POS + AL((size_t)T * 4 * 4);
constexpr size_t WS_ACT = WS_ROWTOK + AL((size_t)MAX_ROWS * 4);
constexpr size_t WS_Y = WS_ACT + AL((size_t)MAX_ROWS * DFF * 2);
constexpr size_t WS_QB = WS_Y + AL((size_t)MAX_ROWS * D * 2);
constexpr size_t WS_KS = WS_QB + AL((size_t)T * 1024 * 2);
constexpr size_t WS_VS = WS_KS + AL((size_t)T * 256 * 2);
constexpr size_t WS_KW = WS_VS + AL((size_t)T * 256 * 2);
constexpr size_t WS_VW = WS_KW + AL((size_t)T * 256 * 2);
constexpr size_t WS_KCB = WS_VW + AL((size_t)T * 256 * 2);
constexpr size_t WS_VCB = WS_KCB + AL((size_t)2 * 256 * 256 * 2);
constexpr size_t WS_CHK = WS_VCB + AL((size_t)2 * 256 * 256 * 2);
constexpr size_t WS_END = WS_CHK + AL((size_t)T * 2048 * 4);

constexpr int CW_COUNT = 4096;
constexpr int CW_CHK = 4160;

#define XB_TMO      128
#define XB_XCNT(j)  (256  + 64 * (j))
#define XB_XSUB(j)  (1280 + 64 * (j))
#define XB_XGEN(j)  (2304 + 64 * (j))
#define XB_TOP      3328
#define XB_TOPGEN   3392
#define XCD_BAR_WORDS 3456
#define XB_SPIN_CAP (1u << 18)

__device__ __forceinline__ unsigned xb_ld(unsigned* p)              { return __hip_atomic_load(p, __ATOMIC_RELAXED, __HIP_MEMORY_SCOPE_AGENT); }
__device__ __forceinline__ unsigned xb_add(unsigned* p, unsigned v) { return __hip_atomic_fetch_add(p, v, __ATOMIC_RELAXED, __HIP_MEMORY_SCOPE_AGENT); }
__device__ __forceinline__ unsigned xb_xcc_id() { return (unsigned)__builtin_amdgcn_s_getreg((3 << 11) | 20) & 0xFu; }
#define XB_SPIN(cond, bar) do { unsigned _sp = 0; while (cond) { __builtin_amdgcn_s_sleep(1); \
    if ((++_sp & 255u) == 0u) { if (xb_ld(&(bar)[XB_TMO])) break; if (_sp > XB_SPIN_CAP) { atomicAdd(&(bar)[XB_TMO], 1u); break; } } } } while (0)

struct XcdBarrier { unsigned* bar; unsigned x; volatile LAS unsigned* st; };

__device__ __forceinline__ XcdBarrier xcd_barrier_post(unsigned* bar, volatile LAS unsigned* st) {
    XcdBarrier b; b.bar = bar; b.x = xb_xcc_id(); b.st = st;
    if (threadIdx.x == 0) (void)xb_add(&bar[XB_XCNT(b.x)], 1u);
    return b;
}
__device__ __forceinline__ void xcd_barrier_complete(unsigned* bar, unsigned x, unsigned& nloc, unsigned& nx) {
    const unsigned G = gridDim.x * gridDim.y * gridDim.z;
    unsigned sum, cnt, mine, sp = 0u;
    for (;;) {
        sum = 0u; cnt = 0u; mine = 0u;
#pragma unroll
        for (unsigned j = 0; j < 16; ++j) { const unsigned c = xb_ld(&bar[XB_XCNT(j)]); sum += c; cnt += (c > 0u) ? 1u : 0u; mine = (j == x) ? c : mine; }
        if (sum == G) break;
        __builtin_amdgcn_s_sleep(1);
        if ((++sp & 255u) == 0u) { if (xb_ld(&bar[XB_TMO])) break; if (sp > XB_SPIN_CAP) { atomicAdd(&bar[XB_TMO], 1u); break; } }
    }
    nloc = mine > 0u ? mine : 1u; nx = cnt > 0u ? cnt : 1u;
}
__device__ __forceinline__ void xcd_barrier(const XcdBarrier& b) {
    asm volatile("s_waitcnt vmcnt(0)" ::: "memory");
    __syncthreads();
    if (threadIdx.x == 0) {
        unsigned* bar = b.bar;
        __builtin_amdgcn_s_waitcnt(0);
        unsigned nloc = b.st[0], nx = b.st[1];
        if (nloc == 0u) { xcd_barrier_complete(bar, b.x, nloc, nx); b.st[0] = nloc; b.st[1] = nx; }
        const unsigned old = xb_add(&bar[XB_XSUB(b.x)], 1u);
        const unsigned gen = old / nloc;
        if (old + 1u == (gen + 1u) * nloc) {
            __builtin_amdgcn_fence(__ATOMIC_RELEASE, "agent");
            asm volatile("s_waitcnt vmcnt(0)" ::: "memory");
            const unsigned og = xb_add(&bar[XB_TOP], 1u);
            const unsigned tg = og / nx;
            if (og + 1u == (tg + 1u) * nx) xb_add(&bar[XB_TOPGEN], 1u);
            else XB_SPIN(xb_ld(&bar[XB_TOPGEN]) == tg, bar);
            __builtin_amdgcn_fence(__ATOMIC_ACQUIRE, "agent");
            xb_add(&bar[XB_XGEN(b.x)], 1u);
            asm volatile("s_waitcnt vmcnt(0)" ::: "memory");
        } else {
            XB_SPIN(xb_ld(&bar[XB_XGEN(b.x)]) == gen, bar);
            __builtin_amdgcn_fence(__ATOMIC_ACQUIRE, "agent");
            asm volatile("s_waitcnt vmcnt(0)" ::: "memory");
        }
    }
    __syncthreads();
}

__device__ __forceinline__ bf16_t f2bf(float f) { unsigned u = __float_as_uint(f); u += 0x7FFFu + ((u >> 16) & 1u); return (bf16_t)(u >> 16); }
__device__ __forceinline__ float bf2f(bf16_t b) { return __uint_as_float(((unsigned)b) << 16); }
__device__ __forceinline__ unsigned pack2(float lo, float hi) { return (unsigned)f2bf(lo) | ((unsigned)f2bf(hi) << 16); }
__device__ __forceinline__ float wave_sum(float v) {
#pragma unroll
    for (int o = 32; o > 0; o >>= 1) v += __shfl_xor(v, o);
    return v;
}
__device__ __forceinline__ float sigmoidf_(float x) { return 1.0f / (1.0f + __expf(-x)); }

constexpr int A_RS = 80, B_RS = 576, A_ST = 256 * A_RS, B_ST = 32 * B_RS, STAGE = A_ST + B_ST;
constexpr int GEMM_LDS = 2 * STAGE;
constexpr int LDS_BYTES = GEMM_LDS + 64;

template <bool PAIRED, class ALd, class BLd, class EP>
__device__ __forceinline__ void gemm_unit(LAS char* lds, const ALd& al, const BLd& bl, const EP& ep, const int K) {
    const int tid = threadIdx.x, lane = tid & 63, wid = tid >> 6;
    const int wr = wid >> 2, wc = wid & 3, fr = lane & 15, fq = lane >> 4;
    const bf16_t* arow0; const bf16_t* arow1;
    { const int c0 = tid, c1 = tid + 512; const bf16_t* p0 = al.row(c0 >> 2); const bf16_t* p1 = al.row(c1 >> 2);
      arow0 = p0 ? p0 + (c0 & 3) * 8 : nullptr; arow1 = p1 ? p1 + (c1 & 3) * 8 : nullptr; }
    const float* bcol = bl.col(4 * (tid & 63));
    const size_t ldb = (size_t)bl.ldb;
    const int bk0 = tid >> 6;
    u32x4 ra0, ra1; float4 rb0, rb1, rb2, rb3;
    const u32x4 z4 = (u32x4){0u, 0u, 0u, 0u}; const float4 zf = make_float4(0.f, 0.f, 0.f, 0.f);
#define G_LOAD(kt) do { \
        ra0 = arow0 ? *(const u32x4*)(arow0 + (kt) * 32) : z4; ra1 = arow1 ? *(const u32x4*)(arow1 + (kt) * 32) : z4; \
        if (bcol) { const float* bp = bcol + (size_t)((kt) * 32 + bk0) * ldb; \
            rb0 = *(const float4*)(bp); rb1 = *(const float4*)(bp + 8 * ldb); rb2 = *(const float4*)(bp + 16 * ldb); rb3 = *(const float4*)(bp + 24 * ldb); } \
        else { rb0 = zf; rb1 = zf; rb2 = zf; rb3 = zf; } } while (0)
#define S_WRITE(buf) do { LAS char* sa = lds + (buf) * STAGE; LAS char* sb = sa + A_ST; \
        *(LAS u32x4*)(sa + (tid >> 2) * A_RS + (tid & 3) * 16) = ra0; \
        *(LAS u32x4*)(sa + ((tid + 512) >> 2) * A_RS + (tid & 3) * 16) = ra1; \
        LAS char* wb = sb + bk0 * B_RS + (tid & 63) * 8; \
        *(LAS u32x2*)(wb) = (u32x2){pack2(rb0.x, rb0.y), pack2(rb0.z, rb0.w)}; \
        *(LAS u32x2*)(wb + 8 * B_RS) = (u32x2){pack2(rb1.x, rb1.y), pack2(rb1.z, rb1.w)}; \
        *(LAS u32x2*)(wb + 16 * B_RS) = (u32x2){pack2(rb2.x, rb2.y), pack2(rb2.z, rb2.w)}; \
        *(LAS u32x2*)(wb + 24 * B_RS) = (u32x2){pack2(rb3.x, rb3.y), pack2(rb3.z, rb3.w)}; } while (0)
    f32x4 acc[8][4];
#pragma unroll
    for (int m = 0; m < 8; ++m)
#pragma unroll
        for (int n = 0; n < 4; ++n) acc[m][n] = (f32x4){0.f, 0.f, 0.f, 0.f};
    const int nk = K / 32;
    const int a_off = (wr * 128 + fr) * A_RS + fq * 16;
    const int b_off = A_ST + (8 * fq + ((lane & 15) >> 2)) * B_RS + (wc * 64 + 4 * (lane & 3)) * 2;
    G_LOAD(0);
    S_WRITE(0);
    __syncthreads();
    for (int kt = 0; kt < nk; ++kt) {
        const int buf = kt & 1;
        if (kt + 1 < nk) G_LOAD(kt + 1);
        LAS char* sbase = lds + buf * STAGE;
        s16x8 af[8];
#pragma unroll
        for (int m = 0; m < 8; ++m) af[m] = *(const LAS s16x8*)(sbase + a_off + m * 16 * A_RS);
#pragma unroll
        for (int n = 0; n < 4; ++n) {
            const s16x4 t0 = __builtin_amdgcn_ds_read_tr16_b64_v4i16((LAS s16x4*)(sbase + b_off + n * 32));
            const s16x4 t1 = __builtin_amdgcn_ds_read_tr16_b64_v4i16((LAS s16x4*)(sbase + b_off + n * 32 + 4 * B_RS));
            const s16x8 bfr = {t0[0], t0[1], t0[2], t0[3], t1[0], t1[1], t1[2], t1[3]};
#pragma unroll
            for (int m = 0; m < 8; ++m) acc[m][n] = __builtin_amdgcn_mfma_f32_16x16x32_bf16(bfr, af[m], acc[m][n], 0, 0, 0);
        }
        if (kt + 1 < nk) S_WRITE(buf ^ 1);
        __syncthreads();
    }
#undef G_LOAD
#undef S_WRITE
#pragma unroll
    for (int m = 0; m < 8; ++m) {
        const int r = wr * 128 + m * 16 + fr;
        if constexpr (PAIRED) {
#pragma unroll
            for (int n = 0; n < 2; ++n) ep.pair(r, wc * 32 + n * 16 + 4 * fq, acc[m][n], acc[m][n + 2]);
        } else {
#pragma unroll
            for (int n = 0; n < 4; ++n) ep(r, wc * 64 + n * 16 + 4 * fq, acc[m][n]);
        }
    }
}


constexpr int KV_RS = 144, KT_BYTES = 64 * KV_RS;
constexpr int ATT_IMP_OFF = 4 * KT_BYTES;
constexpr int ATT_MASK_OFF = ATT_IMP_OFF + 64 * 64 * 4;
struct GState { f32x4 o[4]; float m, l; };

template <int MODE>
__device__ __forceinline__ void attn_block(const LAS char* kt, const LAS char* vt, const int lane, const s16x8 (&qf)[2][2], GState (&st)[2],
                                           const bool (&act)[2], const int key0, const int (&lo)[2], const int (&hi)[2],
                                           LAS float* imp, const int (&tokl)[2], float (&carry)[2], const int jb) {
    const int c16 = lane & 15, fq = lane >> 4;
    const bool on[2] = {__ballot(act[0]) != 0ull, __ballot(act[1]) != 0ull};
    f32x4 s[2][4];
#pragma unroll
    for (int mt = 0; mt < 4; ++mt) {
        const s16x8 k0 = *(const LAS s16x8*)(kt + (16 * mt + c16) * KV_RS + (8 * fq) * 2);
        const s16x8 k1 = *(const LAS s16x8*)(kt + (16 * mt + c16) * KV_RS + (32 + 8 * fq) * 2);
#pragma unroll
        for (int gi = 0; gi < 2; ++gi) { s[gi][mt] = (f32x4){0.f, 0.f, 0.f, 0.f};
            if (on[gi]) { s[gi][mt] = __builtin_amdgcn_mfma_f32_16x16x32_bf16(k0, qf[gi][0], s[gi][mt], 0, 0, 0); s[gi][mt] = __builtin_amdgcn_mfma_f32_16x16x32_bf16(k1, qf[gi][1], s[gi][mt], 0, 0, 0); } }
    }
    s16x8 pf[2][2];
#pragma unroll
    for (int gi = 0; gi < 2; ++gi) {
        if (!on[gi]) continue;
        float mx = -INFINITY;
#pragma unroll
        for (int mt = 0; mt < 4; ++mt)
#pragma unroll
            for (int i = 0; i < 4; ++i) { const int key = key0 + 16 * mt + 4 * fq + i; const bool ok = act[gi] && key >= lo[gi] && key <= hi[gi];
                s[gi][mt][i] = ok ? s[gi][mt][i] : -INFINITY; mx = fmaxf(mx, s[gi][mt][i]); }
        float msafe, scale = 1.0f;
        if (MODE == 2) { msafe = (st[gi].m == -INFINITY) ? 0.f : st[gi].m; scale = st[gi].l; }
        else {
            mx = fmaxf(mx, __shfl_xor(mx, 16)); mx = fmaxf(mx, __shfl_xor(mx, 32));
            const float mnew = fmaxf(st[gi].m, mx);
            const float alpha = (mnew == -INFINITY) ? 1.0f : __expf(st[gi].m - mnew);
            msafe = (mnew == -INFINITY) ? 0.f : mnew;
            st[gi].m = mnew; st[gi].l *= alpha;
            if (MODE == 0) {
#pragma unroll
                for (int md = 0; md < 4; ++md) st[gi].o[md] *= alpha;
            }
        }
        float rs = 0.f;
#pragma unroll
        for (int mt = 0; mt < 4; ++mt)
#pragma unroll
            for (int i = 0; i < 4; ++i) { const float pv = __expf(s[gi][mt][i] - msafe) * scale; s[gi][mt][i] = pv; rs += pv; }
        if (MODE != 2) { rs += __shfl_xor(rs, 16); rs += __shfl_xor(rs, 32); st[gi].l += rs; }
        if (MODE == 2) {
#pragma unroll
            for (int mt = 0; mt < 4; ++mt) {
                const float tcur = __shfl(s[gi][mt][3], (lane - 16) & 63);
                const float tprv = __shfl(mt > 0 ? s[gi][mt > 0 ? mt - 1 : 0][3] : carry[gi], (lane - 16) & 63);
                const float prev = fq > 0 ? tcur : tprv;
                float part = 32.f * (s[gi][mt][0] + s[gi][mt][1] + s[gi][mt][2]) + 16.f * s[gi][mt][3] + 16.f * prev;
                part += __shfl_xor(part, 1); part += __shfl_xor(part, 2);
                if ((c16 & 3) == 0) imp[tokl[gi] * 64 + 16 * jb + 4 * mt + fq] = part;
            }
            carry[gi] = s[gi][3][3];
        }
        if (MODE != 1) {
#pragma unroll
            for (int ks = 0; ks < 2; ++ks) {
                const u32x4 w = {pack2(s[gi][2 * ks][0], s[gi][2 * ks][1]), pack2(s[gi][2 * ks][2], s[gi][2 * ks][3]),
                                 pack2(s[gi][2 * ks + 1][0], s[gi][2 * ks + 1][1]), pack2(s[gi][2 * ks + 1][2], s[gi][2 * ks + 1][3])};
                pf[gi][ks] = __builtin_bit_cast(s16x8, w);
            }
        }
    }
    if (MODE != 1) {
        const int q = c16 >> 2, p = c16 & 3;
#pragma unroll
        for (int md = 0; md < 4; ++md) {
            s16x8 vf[2];
#pragma unroll
            for (int ks = 0; ks < 2; ++ks) {
                const s16x4 t0 = __builtin_amdgcn_ds_read_tr16_b64_v4i16((LAS s16x4*)(vt + (32 * ks + 4 * fq + q) * KV_RS + (16 * md + 4 * p) * 2));
                const s16x4 t1 = __builtin_amdgcn_ds_read_tr16_b64_v4i16((LAS s16x4*)(vt + (32 * ks + 16 + 4 * fq + q) * KV_RS + (16 * md + 4 * p) * 2));
                vf[ks] = (s16x8){t0[0], t0[1], t0[2], t0[3], t1[0], t1[1], t1[2], t1[3]};
            }
#pragma unroll
            for (int gi = 0; gi < 2; ++gi)
                if (on[gi]) { st[gi].o[md] = __builtin_amdgcn_mfma_f32_16x16x32_bf16(vf[0], pf[gi][0], st[gi].o[md], 0, 0, 0); st[gi].o[md] = __builtin_amdgcn_mfma_f32_16x16x32_bf16(vf[1], pf[gi][1], st[gi].o[md], 0, 0, 0); }
        }
    }
}

#define ATT_GLOAD(Kg, Vg, row0) do { const size_t _o = ((size_t)(row0) + (tid >> 3)) * 256 + g * 64 + (tid & 7) * 8; rk = *(const u32x4*)((Kg) + _o); rv = *(const u32x4*)((Vg) + _o); } while (0)
#define ATT_SWRITE(buf) do { LAS char* _k = lds + (buf) * 2 * KT_BYTES + (tid >> 3) * KV_RS + (tid & 7) * 16; *(LAS u32x4*)_k = rk; *(LAS u32x4*)(_k + KT_BYTES) = rv; } while (0)

__device__ __forceinline__ void nsa_unit(LAS char* lds, const int unit, const bf16_t* QB, const bf16_t* KS, const bf16_t* VS, const bf16_t* KW, const bf16_t* VW,
                                         const bf16_t* KCB, const bf16_t* VCB, const float* PROJ, bf16_t* MIX) {
    const int tid = threadIdx.x, lane = tid & 63, wid = tid >> 6, c16 = lane & 15, fq = lane >> 4;
    const int qt = unit >> 3, b = (unit >> 2) & 1, g = unit & 3;
    const int t0 = qt * 64;
    LAS float* imp = (LAS float*)(lds + ATT_IMP_OFF);
    LAS unsigned* lmask = (LAS unsigned*)(lds + ATT_MASK_OFF);
    int tokl[2], tpos[2]; s16x8 qf[2][2]; float gate[2][3];
#pragma unroll
    for (int gi = 0; gi < 2; ++gi) {
        tokl[gi] = 8 * wid + 4 * gi + (c16 >> 2); tpos[gi] = t0 + tokl[gi];
        const size_t tt = (size_t)b * SEQ + tpos[gi]; const int hq = g * 4 + (c16 & 3);
#pragma unroll
        for (int ks = 0; ks < 2; ++ks) qf[gi][ks] = *(const s16x8*)(QB + tt * 1024 + hq * 64 + 32 * ks + 8 * fq);
        const float* gl = PROJ + tt * IN_PROJ + OFF_GATE + hq * 3;
        gate[gi][0] = sigmoidf_(gl[0]); gate[gi][1] = sigmoidf_(gl[1]); gate[gi][2] = sigmoidf_(gl[2]);
    }
    for (int i = tid; i < 64 * 64; i += 512) imp[i] = 0.f;
    f32x4 res[2][4];
    GState st[2]; bool act[2]; int lo[2], hi[2]; float carry[2] = {0.f, 0.f};
    u32x4 rk, rv;
    const bf16_t* KCg = KCB + (size_t)b * 256 * 256; const bf16_t* VCg = VCB + (size_t)b * 256 * 256;
    const bf16_t* KSg = KS + (size_t)b * SEQ * 256; const bf16_t* VSg = VS + (size_t)b * SEQ * 256;
    const bf16_t* KWg = KW + (size_t)b * SEQ * 256; const bf16_t* VWg = VW + (size_t)b * SEQ * 256;
    const int cmax_u = (t0 + 63 - 31) >> 4;
    const int ncb = cmax_u < 0 ? 0 : min(4, (cmax_u + 1) / 64 + 1);
#pragma unroll
    for (int gi = 0; gi < 2; ++gi) { act[gi] = true; lo[gi] = 0; hi[gi] = tpos[gi] >= 31 ? ((tpos[gi] - 31) >> 4) : -1; st[gi].m = -INFINITY; st[gi].l = 0.f;
#pragma unroll
        for (int md = 0; md < 4; ++md) st[gi].o[md] = (f32x4){0.f, 0.f, 0.f, 0.f}; }
    __syncthreads();
    if (ncb > 0) {
        ATT_GLOAD(KCg, VCg, 0); ATT_SWRITE(0); __syncthreads();
        for (int jb = 0; jb < ncb; ++jb) {
            if (jb + 1 < ncb) ATT_GLOAD(KCg, VCg, 64 * (jb + 1));
            attn_block<1>(lds + (jb & 1) * 2 * KT_BYTES, lds + (jb & 1) * 2 * KT_BYTES + KT_BYTES, lane, qf, st, act, 64 * jb, lo, hi, imp, tokl, carry, jb);
            if (jb + 1 < ncb) ATT_SWRITE((jb + 1) & 1);
            __syncthreads();
        }
#pragma unroll
        for (int gi = 0; gi < 2; ++gi) st[gi].l = st[gi].l > 0.f ? 1.0f / st[gi].l : 0.f;
        ATT_GLOAD(KCg, VCg, 0); ATT_SWRITE(0); __syncthreads();
        for (int jb = 0; jb < ncb; ++jb) {
            if (jb + 1 < ncb) ATT_GLOAD(KCg, VCg, 64 * (jb + 1));
            attn_block<2>(lds + (jb & 1) * 2 * KT_BYTES, lds + (jb & 1) * 2 * KT_BYTES + KT_BYTES, lane, qf, st, act, 64 * jb, lo, hi, imp, tokl, carry, jb);
            if (jb + 1 < ncb) ATT_SWRITE((jb + 1) & 1);
            __syncthreads();
        }
    }
#pragma unroll
    for (int gi = 0; gi < 2; ++gi)
#pragma unroll
        for (int md = 0; md < 4; ++md) res[gi][md] = st[gi].o[md] * gate[gi][0];
    __syncthreads();
    for (int k = 0; k < 8; ++k) {
        const int tl = 8 * wid + k, j = lane;
        const float iv = imp[tl * 64 + j];
        const bool forced = (j == 0) || (j == qt) || (j == qt - 1), valid = j <= qt;
        const float sc = forced ? 1.0e4f : (valid ? iv : -1.0e4f);
        int rank = 0;
#pragma unroll
        for (int kk = 0; kk < 64; ++kk) { const float o = __shfl(sc, kk); rank += (o > sc || (o == sc && kk < j)) ? 1 : 0; }
        const unsigned long long m64 = __ballot(rank < 16 && valid);
        if (lane == 0) { lmask[tl * 2] = (unsigned)m64; lmask[tl * 2 + 1] = (unsigned)(m64 >> 32); }
    }
    __syncthreads();
    unsigned long long msk[2]; unsigned long long wunion;
    {
#pragma unroll
        for (int gi = 0; gi < 2; ++gi) msk[gi] = (unsigned long long)lmask[tokl[gi] * 2] | ((unsigned long long)lmask[tokl[gi] * 2 + 1] << 32);
        unsigned ul = (unsigned)(msk[0] | msk[1]), uh = (unsigned)((msk[0] | msk[1]) >> 32);
#pragma unroll
        for (int o = 1; o < 64; o <<= 1) { ul |= __shfl_xor(ul, o); uh |= __shfl_xor(uh, o); }
        wunion = (unsigned long long)ul | ((unsigned long long)uh << 32);
    }
#pragma unroll
    for (int gi = 0; gi < 2; ++gi) { lo[gi] = 0; hi[gi] = tpos[gi]; st[gi].m = -INFINITY; st[gi].l = 0.f;
#pragma unroll
        for (int md = 0; md < 4; ++md) st[gi].o[md] = (f32x4){0.f, 0.f, 0.f, 0.f}; }
    ATT_GLOAD(KSg, VSg, 0); ATT_SWRITE(0); __syncthreads();
    for (int j = 0; j <= qt; ++j) {
        if (j + 1 <= qt) ATT_GLOAD(KSg, VSg, 64 * (j + 1));
        if ((wunion >> j) & 1ull) {
            act[0] = (msk[0] >> j) & 1ull; act[1] = (msk[1] >> j) & 1ull;
            attn_block<0>(lds + (j & 1) * 2 * KT_BYTES, lds + (j & 1) * 2 * KT_BYTES + KT_BYTES, lane, qf, st, act, 64 * j, lo, hi, imp, tokl, carry, 0);
        }
        if (j + 1 <= qt) ATT_SWRITE((j + 1) & 1);
        __syncthreads();
    }
#pragma unroll
    for (int gi = 0; gi < 2; ++gi) { const float il = gate[gi][1] / fmaxf(st[gi].l, 1e-30f);
#pragma unroll
        for (int md = 0; md < 4; ++md) res[gi][md] += st[gi].o[md] * il; }
#pragma unroll
    for (int gi = 0; gi < 2; ++gi) { act[gi] = true; lo[gi] = tpos[gi] - 511; hi[gi] = tpos[gi]; st[gi].m = -INFINITY; st[gi].l = 0.f;
#pragma unroll
        for (int md = 0; md < 4; ++md) st[gi].o[md] = (f32x4){0.f, 0.f, 0.f, 0.f}; }
    const int jw0 = qt >= 8 ? qt - 8 : 0;
    ATT_GLOAD(KWg, VWg, 64 * jw0); ATT_SWRITE(jw0 & 1); __syncthreads();
    for (int j = jw0; j <= qt; ++j) {
        if (j + 1 <= qt) ATT_GLOAD(KWg, VWg, 64 * (j + 1));
        attn_block<0>(lds + (j & 1) * 2 * KT_BYTES, lds + (j & 1) * 2 * KT_BYTES + KT_BYTES, lane, qf, st, act, 64 * j, lo, hi, imp, tokl, carry, 0);
        if (j + 1 <= qt) ATT_SWRITE((j + 1) & 1);
        __syncthreads();
    }
#pragma unroll
    for (int gi = 0; gi < 2; ++gi) { const float il = gate[gi][2] / fmaxf(st[gi].l, 1e-30f);
        bf16_t* mp = MIX + ((size_t)b * SEQ + tpos[gi]) * 2048 + 1024 + (g * 4 + (c16 & 3)) * 64 + 4 * fq;
#pragma unroll
        for (int md = 0; md < 4; ++md) { const f32x4 r = res[gi][md] + st[gi].o[md] * il;
            *(uint2*)(mp + 16 * md) = make_uint2(pack2(r[0], r[1]), pack2(r[2], r[3])); } }
}
#undef ATT_GLOAD
#undef ATT_SWRITE

struct Args {
    const float* in[23];
    float* out;
    unsigned char* ws;
    int ph_lo, ph_hi;
};

enum { PH_NORM1 = 0, PH_INPROJ, PH_PREP, PH_SSD_CMP1, PH_GNORM_CMP2,
#ifdef SELFCHECK
       PH_CMPATT, PH_SELECT, PH_SELWIN,
#endif
       PH_NSA,
#ifdef SELFCHECK
       PH_CHECK,
#endif
       PH_OUTPROJ, PH_ROUTER, PH_SCATTER, PH_GATEUP, PH_DOWN, PH_FINAL, N_PHASES };

struct ARowsDense { const bf16_t* base; size_t ld; int row0, nrows;
    __device__ __forceinline__ const bf16_t* row(int r) const { const int g = row0 + r; return g < nrows ? base + (size_t)g * ld : nullptr; } };
struct ARowsGather { const bf16_t* base; size_t ld; const int* idx;
    __device__ __forceinline__ const bf16_t* row(int r) const { const int g = idx[r]; return g >= 0 ? base + (size_t)g * ld : nullptr; } };
struct BColsDense { const float* base; int ldb; int col0, ncols;
    __device__ __forceinline__ const float* col(int n) const { const int c = col0 + n; return c < ncols ? base + c : nullptr; } };
struct BColsGateUp { const float* base; int ldb; int cn;
    __device__ __forceinline__ const float* col(int n) const { const int wc = n >> 6, nt = (n & 63) >> 4, w = n & 15; const int j = wc * 32 + (nt & 1) * 16 + w;
        return base + (nt < 2 ? 0 : DFF) + cn * 128 + j; } };

struct EpiStoreF32 { float* C; size_t ldc; int row0, col0, ncols;
    __device__ __forceinline__ void operator()(int r, int n, f32x4 v) const { const int c = col0 + n; if (c < ncols) *(f32x4*)(C + (size_t)(row0 + r) * ldc + c) = v; } };
struct EpiResidF32 { float* C; const float* X; size_t ldc; int row0, col0;
    __device__ __forceinline__ void operator()(int r, int n, f32x4 v) const { const size_t o = (size_t)(row0 + r) * ldc + col0 + n; const f32x4 x = *(const f32x4*)(X + o); *(f32x4*)(C + o) = v + x; } };
struct EpiGeluBf16 { bf16_t* O; const float* bias; size_t ldo; int row0, col0, nrows;
    __device__ __forceinline__ void operator()(int r, int n, f32x4 v) const { const int g = row0 + r; if (g >= nrows) return; const int c = col0 + n;
        float o[4];
#pragma unroll
        for (int i = 0; i < 4; ++i) { const float x = v[i] + bias[c + i]; const float u = 0.7978845608028654f * (x + 0.044715f * x * x * x); o[i] = 0.5f * x * (1.0f + tanhf(u)); }
        *(uint2*)(O + (size_t)g * ldo + c) = make_uint2(pack2(o[0], o[1]), pack2(o[2], o[3])); } };
struct EpiSwiglu { bf16_t* O; const float* bias; int row0, cn;
    __device__ __forceinline__ void pair(int r, int j, f32x4 g, f32x4 u) const { const int c = cn * 128 + j; float o[4];
#pragma unroll
        for (int i = 0; i < 4; ++i) { float gv = g[i] + bias[c + i]; float uv = u[i] + bias[DFF + c + i]; gv = fminf(gv, 7.0f); uv = fminf(fmaxf(uv, -7.0f), 7.0f);
            const float glu = gv * sigmoidf_(1.702f * gv); o[i] = (uv + 1.0f) * glu; }
        *(uint2*)(O + (size_t)(row0 + r) * DFF + c) = make_uint2(pack2(o[0], o[1]), pack2(o[2], o[3])); } };
struct EpiBiasBf16 { bf16_t* O; const float* bias; int row0, col0;
    __device__ __forceinline__ void operator()(int r, int n, f32x4 v) const { const int c = col0 + n;
        *(uint2*)(O + (size_t)(row0 + r) * D + c) = make_uint2(pack2(v[0] + bias[c], v[1] + bias[c + 1]), pack2(v[2] + bias[c + 2], v[3] + bias[c + 3])); } };

__device__ __forceinline__ float rope_inv(int i) { return (float)exp(-(double)i * 0.125 * 13.122363377404328); }

__global__ void __launch_bounds__(512, 2) fwd(Args a) {
    extern __shared__ __attribute__((aligned(16))) unsigned char lds_raw[];
    LAS char* lds = (LAS char*)lds_raw;
    const int tid = threadIdx.x, lane = tid & 63, wid = __builtin_amdgcn_readfirstlane(tid >> 6);
    const int G = gridDim.x, bid = blockIdx.x;
    const int gtid = bid * 512 + tid, gthreads = G * 512;
    const int gwave = bid * 8 + wid, gwaves = G * 8;
    unsigned char* ws = a.ws;
    unsigned* ctl = (unsigned*)(ws + WS_CTL);
    volatile LAS unsigned* barw = (volatile LAS unsigned*)(lds + GEMM_LDS);
    LAS int* lmisc = (LAS int*)(lds + GEMM_LDS + 16);
    if (tid == 0) { barw[0] = 0u; barw[1] = 0u; barw[2] = 0u; barw[3] = 0u; }
    __syncthreads();
    XcdBarrier bar; bar.bar = ctl; bar.x = 0; bar.st = barw;
    const bool multi = (a.ph_hi - a.ph_lo) > 1;
    if (multi) bar = xcd_barrier_post(ctl, barw);
#ifdef ONLY_PH
#define IN(k) ((k) == ONLY_PH)
#else
#define IN(k) (a.ph_lo <= (k) && (k) < a.ph_hi)
#endif
#define SEAM(k) do { if ((k) + 1 < a.ph_hi) xcd_barrier(bar); } while (0)

    const float* x = a.in[0];
    bf16_t* XN = (bf16_t*)(ws + WS_XN);
    float* PROJ = (float*)(ws + WS_PROJ);
    float* XBC = (float*)(ws + WS_XBC);
    float* DT = (float*)(ws + WS_DT);
    float* YSSD = (float*)(ws + WS_YSSD);
    bf16_t* MIX = (bf16_t*)(ws + WS_MIX);
    float* ROPE = (float*)(ws + WS_ROPE);
    bf16_t* BLK = (bf16_t*)(ws + WS_BLK);
    bf16_t* H1 = (bf16_t*)(ws + WS_H1);
    float* KC = (float*)(ws + WS_KC);
    float* VC = (float*)(ws + WS_VC);
    float* PCMP = (float*)(ws + WS_PCMP);
    float* OCMP = (float*)(ws + WS_OCMP);
    unsigned long long* SEL = (unsigned long long*)(ws + WS_SEL);
    float* X2 = (float*)(ws + WS_X2);
    int* TOPE = (int*)(ws + WS_TOPE);
    float* TOPG = (float*)(ws + WS_TOPG);
    int* SLOT = (int*)(ws + WS_SLOT);
    int* POS = (int*)(ws + WS_POS);
    int* ROWTOK = (int*)(ws + WS_ROWTOK);
    bf16_t* ACT = (bf16_t*)(ws + WS_ACT);
    bf16_t* YB = (bf16_t*)(ws + WS_Y);
    unsigned* COUNT = ctl + CW_COUNT;
    bf16_t* QB = (bf16_t*)(ws + WS_QB); bf16_t* KSb = (bf16_t*)(ws + WS_KS); bf16_t* VSb = (bf16_t*)(ws + WS_VS);
    bf16_t* KWb = (bf16_t*)(ws + WS_KW); bf16_t* VWb = (bf16_t*)(ws + WS_VW); bf16_t* KCB = (bf16_t*)(ws + WS_KCB); bf16_t* VCB = (bf16_t*)(ws + WS_VCB);

    if (IN(PH_NORM1)) {
        const float* w = a.in[1];
        for (int row = gwave; row < T; row += gwaves) {
            const float4* xr = (const float4*)(x + (size_t)row * D);
            float4 v[8]; float ss = 0.f;
#pragma unroll
            for (int i = 0; i < 8; ++i) { v[i] = xr[lane + 64 * i]; ss += v[i].x * v[i].x + v[i].y * v[i].y + v[i].z * v[i].z + v[i].w * v[i].w; }
            ss = wave_sum(ss);
            const float rstd = rsqrtf(ss * (1.0f / D) + NORM_EPS);
#pragma unroll
            for (int i = 0; i < 8; ++i) { const float4 wv = ((const float4*)w)[lane + 64 * i];
                *(uint2*)(XN + (size_t)row * D + 4 * (lane + 64 * i)) = make_uint2(pack2(v[i].x * rstd * wv.x, v[i].y * rstd * wv.y), pack2(v[i].z * rstd * wv.z, v[i].w * rstd * wv.w)); }
        }
        for (int i = gtid; i < SEQ * 8; i += gthreads) { const int pos = i >> 3, k = i & 7; const float ang = (float)pos * rope_inv(k); ROPE[i] = cosf(ang); ROPE[SEQ * 8 + i] = sinf(ang); }
        for (int i = gtid; i < MAX_ROWS; i += gthreads) ROWTOK[i] = -1;
        SEAM(PH_NORM1);
    }

    if (IN(PH_INPROJ)) {
        const int nct = (IN_PROJ + 255) / 256, nunits = (T / 256) * nct;
        for (int u = bid; u < nunits; u += G) {
            const int rt = u / nct, ct = u % nct;
            ARowsDense al{XN, (size_t)D, rt * 256, T};
            BColsDense bl{a.in[2], IN_PROJ, ct * 256, IN_PROJ};
            EpiStoreF32 ep{PROJ, (size_t)IN_PROJ, rt * 256, ct * 256, IN_PROJ};
            gemm_unit<false>(lds, al, bl, ep, D);
        }
        SEAM(PH_INPROJ);
    }

    if (IN(PH_PREP)) {
        const float* conv_w = a.in[3]; const float* conv_b = a.in[4]; const float* dt_bias = a.in[5];
        for (int i = gtid; i < T * 2048; i += gthreads) {
            const int t = i >> 11, c = i & 2047, s = t & (SEQ - 1);
            float acc = conv_b[c];
#pragma unroll
            for (int k = 0; k < 4; ++k) { const int ts = s - 3 + k; if (ts >= 0) acc += conv_w[k * 2048 + c] * PROJ[(size_t)(t - 3 + k) * IN_PROJ + OFF_XBC + c]; }
            XBC[i] = acc * sigmoidf_(acc);
        }
        for (int i = gtid; i < T * 16; i += gthreads) { const int h = i & 15; const float v = PROJ[(size_t)(i >> 4) * IN_PROJ + OFF_DT + h] + dt_bias[h];
            DT[i] = v > 20.f ? v : log1pf(expf(v)); }
        for (int i = gtid; i < T * 256; i += gthreads) {
            const int ch = i & 7, slot = (i >> 3) & 31, t = i >> 8, pos = t & (SEQ - 1);
            int col; bf16_t* dst; float scl = 1.0f; bool rope = slot < 24;
            if (slot < 16) { col = OFF_Q + slot * 64; dst = QB + (size_t)t * 1024 + slot * 64; scl = 0.125f; }
            else if (slot < 20) { col = OFF_KSLC + (slot - 16) * 64; dst = KSb + (size_t)t * 256 + (slot - 16) * 64; }
            else if (slot < 24) { col = OFF_KWIN + (slot - 20) * 64; dst = KWb + (size_t)t * 256 + (slot - 20) * 64; }
            else if (slot < 28) { col = OFF_VSLC + (slot - 24) * 64; dst = VSb + (size_t)t * 256 + (slot - 24) * 64; }
            else { col = OFF_VWIN + (slot - 28) * 64; dst = VWb + (size_t)t * 256 + (slot - 28) * 64; }
            const float* p = PROJ + (size_t)t * IN_PROJ + col;
            float v[8];
            if (rope && ch < 2) {
                const float4 a0 = *(const float4*)(p), a1 = *(const float4*)(p + 4), b0 = *(const float4*)(p + 8), b1 = *(const float4*)(p + 12);
                const float x1[8] = {a0.x, a0.y, a0.z, a0.w, a1.x, a1.y, a1.z, a1.w}, x2[8] = {b0.x, b0.y, b0.z, b0.w, b1.x, b1.y, b1.z, b1.w};
#pragma unroll
                for (int k = 0; k < 8; ++k) { const float c = ROPE[pos * 8 + k], sn = ROPE[SEQ * 8 + pos * 8 + k]; v[k] = (ch == 0) ? (x1[k] * c - x2[k] * sn) : (x1[k] * sn + x2[k] * c); }
            } else {
                const float4 a0 = *(const float4*)(p + ch * 8), a1 = *(const float4*)(p + ch * 8 + 4);
                v[0] = a0.x; v[1] = a0.y; v[2] = a0.z; v[3] = a0.w; v[4] = a1.x; v[5] = a1.y; v[6] = a1.z; v[7] = a1.w;
            }
            u32x4 o = {pack2(v[0] * scl, v[1] * scl), pack2(v[2] * scl, v[3] * scl), pack2(v[4] * scl, v[5] * scl), pack2(v[6] * scl, v[7] * scl)};
            *(u32x4*)(dst + ch * 8) = o;
        }
        for (int i = gtid; i < 2 * 2 * 256; i += gthreads) { const int d = i & 255, b = (i >> 8) & 1, j = i >> 9; (j ? VCB : KCB)[((size_t)b * 256 + 255) * 256 + d] = 0; }
        const float* pe = a.in[9];
        for (int i = gtid; i < 2 * 2048 * 512; i += gthreads) {
            const int e4 = i & 511, row = (i >> 9) & 2047, j = i >> 20;
            uint2 o = make_uint2(0u, 0u);
            if (row < CMP_ROWS) { const int g = row & 3, n = (row >> 2) % N_C, b = (row >> 2) / N_C; const int l = e4 >> 4, d = (e4 & 15) * 4;
                const float4 v = *(const float4*)(PROJ + (size_t)(b * SEQ + 16 * n + l) * IN_PROJ + (j ? OFF_VCMP : OFF_KCMP) + g * 64 + d);
                const float4 p4 = *(const float4*)(pe + (j * 32 + l) * 64 + d);
                o = make_uint2(pack2(v.x + p4.x, v.y + p4.y), pack2(v.z + p4.z, v.w + p4.w)); }
            *(uint2*)(BLK + ((size_t)j * 2048 + row) * 2048 + e4 * 4) = o;
        }
        SEAM(PH_PREP);
    }

    if (IN(PH_SSD_CMP1)) {
        if (bid < 16) {
            const int w = bid * 8 + wid, b = w >> 6, h = (w >> 2) & 15, pq = w & 3, g = h >> 2;
            const int p = pq * 16 + (lane >> 2), nq = lane & 3;
            const float av = -expf(a.in[6][h]), dsk = a.in[7][h];
            float st[32];
#pragma unroll
            for (int n = 0; n < 32; ++n) st[n] = 0.f;
            for (int t = 0; t < SEQ; ++t) {
                const size_t tt = (size_t)b * SEQ + t;
                const float* row = XBC + tt * 2048;
                const float dtv = DT[tt * 16 + h];
                const float dA = expf(dtv * av);
                const float xv = row[h * 64 + p];
                const float4* Bp = (const float4*)(row + 1024 + g * 128 + nq * 32); const float4* Cp = (const float4*)(row + 1536 + g * 128 + nq * 32);
                const float coef = dtv * xv; float y = 0.f;
#pragma unroll
                for (int n4 = 0; n4 < 8; ++n4) { const float4 bv = Bp[n4], cv = Cp[n4];
                    st[4 * n4 + 0] = st[4 * n4 + 0] * dA + coef * bv.x; y += st[4 * n4 + 0] * cv.x;
                    st[4 * n4 + 1] = st[4 * n4 + 1] * dA + coef * bv.y; y += st[4 * n4 + 1] * cv.y;
                    st[4 * n4 + 2] = st[4 * n4 + 2] * dA + coef * bv.z; y += st[4 * n4 + 2] * cv.z;
                    st[4 * n4 + 3] = st[4 * n4 + 3] * dA + coef * bv.w; y += st[4 * n4 + 3] * cv.w; }
                y += __shfl_xor(y, 1); y += __shfl_xor(y, 2);
                if (nq == 0) YSSD[tt * 1024 + h * 64 + p] = y + dsk * xv;
            }
        } else {
            const int nb = G - 16;
            for (int u = bid - 16; u < 32; u += nb) {
                const int j = u >> 4, rt = (u >> 1) & 7, ct = u & 1;
                ARowsDense al{BLK + (size_t)j * 2048 * 2048, (size_t)2048, rt * 256, CMP_ROWS};
                BColsDense bl{a.in[10] + (size_t)j * 2048 * CMP_HID, CMP_HID, ct * 256, CMP_HID};
                EpiGeluBf16 ep{H1 + (size_t)j * 2048 * CMP_HID, a.in[11] + j * CMP_HID, (size_t)CMP_HID, rt * 256, ct * 256, CMP_ROWS};
                gemm_unit<false>(lds, al, bl, ep, 2048);
            }
        }
        SEAM(PH_SSD_CMP1);
    }

    if (IN(PH_GNORM_CMP2)) {
        const float* nw = a.in[8];
#ifdef SELFCHECK
        for (int i = gtid; i < T * 24 * 8; i += gthreads) {
            const int k = i & 7, slot = (i >> 3) % 24, t = i / 192, pos = t & (SEQ - 1);
            const int col = slot < 16 ? OFF_Q + slot * 64 : (slot < 20 ? OFF_KSLC + (slot - 16) * 64 : OFF_KWIN + (slot - 20) * 64);
            float* p = PROJ + (size_t)t * IN_PROJ + col;
            const float c = ROPE[pos * 8 + k], s = ROPE[SEQ * 8 + pos * 8 + k];
            const float x1 = p[k], x2 = p[k + 8];
            p[k] = x1 * c - x2 * s; p[k + 8] = x1 * s + x2 * c;
        }
#endif
        for (int it = gwave; it < T * 4; it += gwaves) {
            const int t = it >> 2, grp = it & 3, c = grp * 256 + lane * 4;
            const float4 y = *(const float4*)(YSSD + (size_t)t * 1024 + c);
            const float4 z = *(const float4*)(PROJ + (size_t)t * IN_PROJ + OFF_Z + c);
            float gv[4] = {y.x * z.x * sigmoidf_(z.x), y.y * z.y * sigmoidf_(z.y), y.z * z.z * sigmoidf_(z.z), y.w * z.w * sigmoidf_(z.w)};
            float ss = wave_sum(gv[0] * gv[0] + gv[1] * gv[1] + gv[2] * gv[2] + gv[3] * gv[3]);
            const float sc = rsqrtf(ss * (1.0f / 256.f) + NORM_EPS);
            const float4 w4 = *(const float4*)(nw + c);
            *(uint2*)(MIX + (size_t)t * 2048 + c) = make_uint2(pack2(gv[0] * sc * w4.x, gv[1] * sc * w4.y), pack2(gv[2] * sc * w4.z, gv[3] * sc * w4.w));
        }
        const float* w2 = a.in[12]; const float* b2 = a.in[13];
        for (int i = gtid; i < 2 * CMP_ROWS * 64; i += gthreads) {
            const int d = i & 63, row = (i >> 6) % CMP_ROWS, j = i / (CMP_ROWS * 64);
            const bf16_t* hrow = H1 + ((size_t)j * 2048 + row) * CMP_HID;
            const float* wj = w2 + (size_t)j * CMP_HID * 64;
            const bool rot = (j == 0) && (d < 16);
            const int dp = rot ? (d < 8 ? d + 8 : d - 8) : d;
            float s0 = b2[j * 64 + d], s1 = b2[j * 64 + dp];
            for (int k = 0; k < CMP_HID; ++k) { const float hv = bf2f(hrow[k]); s0 += hv * wj[k * 64 + d]; s1 += hv * wj[k * 64 + dp]; }
            float o = s0;
            if (rot) { const int n = (row >> 2) % N_C, pos = 16 * n + 31, k = d & 7; const float c = ROPE[pos * 8 + k], s = ROPE[SEQ * 8 + pos * 8 + k];
                o = (d < 8) ? (s0 * c - s1 * s) : (s1 * s + s0 * c); }
            (j ? VC : KC)[(size_t)row * 64 + d] = o;
            { const int g4 = row & 3, n = (row >> 2) % N_C, bb = (row >> 2) / N_C; (j ? VCB : KCB)[((size_t)bb * 256 + n) * 256 + g4 * 64 + d] = f2bf(o); }
        }
        SEAM(PH_GNORM_CMP2);
    }

#ifdef SELFCHECK
    if (IN(PH_CMPATT)) {
        for (int it = gtid; it < T * 16; it += gthreads) {
            const int hq = it & 15, tt = it >> 4, b = tt >> 12, t = tt & (SEQ - 1), g = hq >> 2;
            const int nvalid = t >= 31 ? ((t - 31) >> 4) + 1 : 0;
            float q[64];
            const float* qp = PROJ + (size_t)tt * IN_PROJ + OFF_Q + hq * 64;
#pragma unroll
            for (int d = 0; d < 64; d += 4) { const float4 v = *(const float4*)(qp + d); q[d] = v.x; q[d + 1] = v.y; q[d + 2] = v.z; q[d + 3] = v.w; }
            float m = -INFINITY, l = 0.f;
            for (int c = 0; c < nvalid; ++c) {
                const float* kp = KC + (size_t)((b * N_C + c) * 4 + g) * 64; float s = 0.f;
#pragma unroll
                for (int d = 0; d < 64; d += 4) { const float4 v = *(const float4*)(kp + d); s += q[d] * v.x + q[d + 1] * v.y + q[d + 2] * v.z + q[d + 3] * v.w; }
                s *= 0.125f;
                const float mn = fmaxf(m, s); l = l * __expf(m - mn) + __expf(s - mn); m = mn;
            }
            float o[64];
#pragma unroll
            for (int d = 0; d < 64; ++d) o[d] = 0.f;
            const float inv_l = nvalid > 0 ? 1.0f / fmaxf(l, 1e-30f) : 0.f;
            float* pp = PCMP + (size_t)it * 256;
            for (int c = 0; c < nvalid; ++c) {
                const float* kp = KC + (size_t)((b * N_C + c) * 4 + g) * 64; float s = 0.f;
#pragma unroll
                for (int d = 0; d < 64; d += 4) { const float4 v = *(const float4*)(kp + d); s += q[d] * v.x + q[d + 1] * v.y + q[d + 2] * v.z + q[d + 3] * v.w; }
                const float p = __expf(s * 0.125f - m) * inv_l;
                pp[c] = p;
                const float* vp = VC + (size_t)((b * N_C + c) * 4 + g) * 64;
#pragma unroll
                for (int d = 0; d < 64; d += 4) { const float4 v = *(const float4*)(vp + d); o[d] += p * v.x; o[d + 1] += p * v.y; o[d + 2] += p * v.z; o[d + 3] += p * v.w; }
            }
            for (int c = nvalid; c < 256; ++c) pp[c] = 0.f;
            float* op = OCMP + (size_t)tt * 1024 + hq * 64;
#pragma unroll
            for (int d = 0; d < 64; d += 4) *(float4*)(op + d) = make_float4(o[d], o[d + 1], o[d + 2], o[d + 3]);
        }
        SEAM(PH_CMPATT);
    }

    if (IN(PH_SELECT)) {
        for (int it = gwave; it < T * 4; it += gwaves) {
            const int g = it & 3, tt = it >> 2, t = tt & (SEQ - 1), cur = t >> 6, j = lane;
            float imp = 0.f;
#pragma unroll
            for (int r = 0; r < 4; ++r) { const float* pp = PCMP + ((size_t)tt * 16 + g * 4 + r) * 256 + 4 * j;
                const float4 v = *(const float4*)pp; const float pm1 = j > 0 ? pp[-1] : 0.f;
                imp += 32.f * (v.x + v.y + v.z) + 16.f * v.w + 16.f * pm1; }
            const bool forced = (j == 0) || (j == cur) || (j == cur - 1);
            const bool valid = j <= cur;
            const float sc = forced ? 1.0e4f : (valid ? imp : -1.0e4f);
            int rank = 0;
#pragma unroll
            for (int k = 0; k < 64; ++k) { const float o = __shfl(sc, k); rank += (o > sc || (o == sc && k < j)) ? 1 : 0; }
            const unsigned long long mask = __ballot(rank < 16 && valid);
            if (lane == 0) SEL[it] = mask;
        }
        SEAM(PH_SELECT);
    }

    if (IN(PH_SELWIN)) {
        for (int it = gtid; it < T * 16; it += gthreads) {
            const int hq = it & 15, tt = it >> 4, b = tt >> 12, t = tt & (SEQ - 1), g = hq >> 2;
            float q[64];
            const float* qp = PROJ + (size_t)tt * IN_PROJ + OFF_Q + hq * 64;
#pragma unroll
            for (int d = 0; d < 64; d += 4) { const float4 v = *(const float4*)(qp + d); q[d] = v.x; q[d + 1] = v.y; q[d + 2] = v.z; q[d + 3] = v.w; }
            const float* gl = PROJ + (size_t)tt * IN_PROJ + OFF_GATE + hq * 3;
            const float g0 = sigmoidf_(gl[0]), g1 = sigmoidf_(gl[1]), g2 = sigmoidf_(gl[2]);
            float* op = OCMP + (size_t)tt * 1024 + hq * 64;
            float o[64];
            {
#pragma unroll
                for (int d = 0; d < 64; ++d) o[d] = 0.f;
                float m = -INFINITY, l = 0.f;
                unsigned long long mask = SEL[(size_t)tt * 4 + g];
                while (mask) {
                    const int j = __ffsll((long long)mask) - 1; mask &= mask - 1;
                    const int hi = min(64 * j + 63, t);
                    for (int tok = 64 * j; tok <= hi; ++tok) {
                        const float* kp = PROJ + (size_t)(b * SEQ + tok) * IN_PROJ + OFF_KSLC + g * 64; float s = 0.f;
#pragma unroll
                        for (int d = 0; d < 64; d += 4) { const float4 v = *(const float4*)(kp + d); s += q[d] * v.x + q[d + 1] * v.y + q[d + 2] * v.z + q[d + 3] * v.w; }
                        s *= 0.125f;
                        const float mn = fmaxf(m, s), al = __expf(m - mn), p = __expf(s - mn); m = mn; l = l * al + p;
                        const float* vp = kp + (OFF_VSLC - OFF_KSLC);
#pragma unroll
                        for (int d = 0; d < 64; d += 4) { const float4 v = *(const float4*)(vp + d); o[d] = o[d] * al + p * v.x; o[d + 1] = o[d + 1] * al + p * v.y; o[d + 2] = o[d + 2] * al + p * v.z; o[d + 3] = o[d + 3] * al + p * v.w; }
                    }
                }
                const float il = g1 / fmaxf(l, 1e-30f);
#pragma unroll
                for (int d = 0; d < 64; d += 4) { float4 r = *(float4*)(op + d); r.x = g0 * r.x + il * o[d]; r.y = g0 * r.y + il * o[d + 1]; r.z = g0 * r.z + il * o[d + 2]; r.w = g0 * r.w + il * o[d + 3]; *(float4*)(op + d) = r; }
            }
            {
#pragma unroll
                for (int d = 0; d < 64; ++d) o[d] = 0.f;
                float m = -INFINITY, l = 0.f;
                const int lo = max(0, t - 511);
                for (int tok = lo; tok <= t; ++tok) {
                    const float* kp = PROJ + (size_t)(b * SEQ + tok) * IN_PROJ + OFF_KWIN + g * 64; float s = 0.f;
#pragma unroll
                    for (int d = 0; d < 64; d += 4) { const float4 v = *(const float4*)(kp + d); s += q[d] * v.x + q[d + 1] * v.y + q[d + 2] * v.z + q[d + 3] * v.w; }
                    s *= 0.125f;
                    const float mn = fmaxf(m, s), al = __expf(m - mn), p = __expf(s - mn); m = mn; l = l * al + p;
                    const float* vp = kp + (OFF_VWIN - OFF_KWIN);
#pragma unroll
                    for (int d = 0; d < 64; d += 4) { const float4 v = *(const float4*)(vp + d); o[d] = o[d] * al + p * v.x; o[d + 1] = o[d + 1] * al + p * v.y; o[d + 2] = o[d + 2] * al + p * v.z; o[d + 3] = o[d + 3] * al + p * v.w; }
                }
                const float il = g2 / fmaxf(l, 1e-30f);
                bf16_t* mp = MIX + (size_t)tt * 2048 + 1024 + hq * 64;
#pragma unroll
                for (int d = 0; d < 64; d += 4) { const float4 r = *(const float4*)(op + d);
                    *(uint2*)(mp + d) = make_uint2(pack2(r.x + il * o[d], r.y + il * o[d + 1]), pack2(r.z + il * o[d + 2], r.w + il * o[d + 3])); }
            }
        }
        SEAM(PH_SELWIN);
    }

#endif
    if (IN(PH_NSA)) {
#ifdef SELFCHECK
        bf16_t* MIXO = (bf16_t*)(ws + WS_CHK);
#else
        bf16_t* MIXO = MIX;
#endif
        for (int k = bid; k < 512; k += G) { const int rnd = k / G; const int u = (rnd & 1) ? 511 - (k - G * rnd) - G * (rnd - 1) : k;
            if (u >= 0 && u < 512) nsa_unit(lds, (G == 256) ? u : k, QB, KSb, VSb, KWb, VWb, KCB, VCB, PROJ, MIXO); }
        SEAM(PH_NSA);
    }
#ifdef SELFCHECK
    if (IN(PH_CHECK)) {
        const bf16_t* A_ = MIX; const bf16_t* B_ = (const bf16_t*)(ws + WS_CHK);
        float sd = 0.f, sr = 0.f;
        for (int i = gtid; i < T * 1024; i += gthreads) { const size_t o = (size_t)(i >> 10) * 2048 + 1024 + (i & 1023); const float r = bf2f(A_[o]), v = bf2f(B_[o]); sd += (r - v) * (r - v); sr += r * r; }
        sd = wave_sum(sd); sr = wave_sum(sr);
        if (lane == 0) { atomicAdd((float*)(ctl + CW_CHK), sd); atomicAdd((float*)(ctl + CW_CHK + 1), sr); }
        SEAM(PH_CHECK);
    }
#endif

    if (IN(PH_OUTPROJ)) {
        const int nunits = (T / 256) * (D / 256);
        for (int u = bid; u < nunits; u += G) {
            const int rt = u >> 3, ct = u & 7;
            ARowsDense al{MIX, (size_t)2048, rt * 256, T};
            BColsDense bl{a.in[14], D, ct * 256, D};
            EpiResidF32 ep{X2, x, (size_t)D, rt * 256, ct * 256};
            gemm_unit<false>(lds, al, bl, ep, 2048);
        }
        SEAM(PH_OUTPROJ);
    }

    if (IN(PH_ROUTER)) {
        const float* w = a.in[15]; const float* wr_ = a.in[16]; const float* br = a.in[17];
        for (int row = gwave; row < T; row += gwaves) {
            const float4* xr = (const float4*)(X2 + (size_t)row * D);
            float ss = 0.f;
#pragma unroll 2
            for (int i = 0; i < 8; ++i) { const float4 v = xr[lane + 64 * i]; ss += v.x * v.x + v.y * v.y + v.z * v.z + v.w * v.w; }
            ss = wave_sum(ss);
            const float rstd = rsqrtf(ss * (1.0f / D) + NORM_EPS);
            float lg[NE];
#pragma unroll
            for (int e = 0; e < NE; ++e) lg[e] = 0.f;
#pragma unroll 1
            for (int i = 0; i < 8; ++i) { const float4 wv = ((const float4*)w)[lane + 64 * i]; const float4 v = xr[lane + 64 * i];
                const float h0 = v.x * rstd * wv.x, h1 = v.y * rstd * wv.y, h2 = v.z * rstd * wv.z, h3 = v.w * rstd * wv.w;
                const int d0 = 4 * (lane + 64 * i);
                *(uint2*)(XN + (size_t)row * D + d0) = make_uint2(pack2(h0, h1), pack2(h2, h3));
                const float4* r0 = (const float4*)(wr_ + (size_t)d0 * NE);
#pragma unroll
                for (int e4 = 0; e4 < 8; ++e4) { const float4 a0 = r0[e4], a1 = r0[8 + e4], a2 = r0[16 + e4], a3 = r0[24 + e4];
                    lg[4 * e4 + 0] += h0 * a0.x + h1 * a1.x + h2 * a2.x + h3 * a3.x; lg[4 * e4 + 1] += h0 * a0.y + h1 * a1.y + h2 * a2.y + h3 * a3.y;
                    lg[4 * e4 + 2] += h0 * a0.z + h1 * a1.z + h2 * a2.z + h3 * a3.z; lg[4 * e4 + 3] += h0 * a0.w + h1 * a1.w + h2 * a2.w + h3 * a3.w; }
            }
            float mine = -INFINITY;
#pragma unroll
            for (int e = 0; e < NE; ++e) { const float s = wave_sum(lg[e]); if (lane == e) mine = s + br[e]; }
            int rank = 0;
#pragma unroll
            for (int k = 0; k < NE; ++k) { const float o = __shfl(mine, k); rank += (o > mine || (o == mine && k < lane)) ? 1 : 0; }
            const bool sel = (lane < NE) && (rank < 4);
            float mx = sel ? mine : -INFINITY;
#pragma unroll
            for (int o = 32; o > 0; o >>= 1) mx = fmaxf(mx, __shfl_xor(mx, o));
            const float ex = sel ? __expf(mine - mx) : 0.f;
            const float den = wave_sum(ex);
            if (sel) { const int slot = (int)atomicAdd(&COUNT[lane], 1u); const int o = row * 4 + rank; TOPE[o] = lane; TOPG[o] = ex / den; SLOT[o] = slot; }
        }
        SEAM(PH_ROUTER);
    }

    if (IN(PH_SCATTER)) {
        for (int i = gtid; i < T * 4; i += gthreads) {
            const int e = TOPE[i]; int off = 0;
            for (int k = 0; k < e; ++k) off += (int)((COUNT[k] + 255u) >> 8);
            const int pos = off * 256 + SLOT[i];
            ROWTOK[pos] = i >> 2; POS[i] = pos;
        }
        SEAM(PH_SCATTER);
    }

    if (IN(PH_GATEUP) || IN(PH_DOWN)) {
        LAS int* toff = (LAS int*)(lds + GEMM_LDS + 64 - 0);
        (void)toff;
    }
    if (IN(PH_GATEUP)) {
        int ntiles = 0;
        for (int k = 0; k < NE; ++k) ntiles += (int)((COUNT[k] + 255u) >> 8);
        const int nunits = ntiles * 16;
        for (int u = bid; u < nunits; u += G) {
            const int tile = u >> 4, cn = u & 15;
            int e = 0, acc = 0;
            for (int k = 0; k < NE; ++k) { const int nt = (int)((COUNT[k] + 255u) >> 8); if (tile >= acc && tile < acc + nt) e = k; acc += nt; }
            ARowsGather al{XN, (size_t)D, ROWTOK + tile * 256};
            BColsGateUp bl{a.in[18] + (size_t)e * D * 2 * DFF, 2 * DFF, cn};
            EpiSwiglu ep{ACT, a.in[19] + (size_t)e * 2 * DFF, tile * 256, cn};
            gemm_unit<true>(lds, al, bl, ep, D);
        }
        SEAM(PH_GATEUP);
    }
    if (IN(PH_DOWN)) {
        int ntiles = 0;
        for (int k = 0; k < NE; ++k) ntiles += (int)((COUNT[k] + 255u) >> 8);
        const int nunits = ntiles * 8;
        for (int u = bid; u < nunits; u += G) {
            const int tile = u >> 3, ct = u & 7;
            int e = 0, acc = 0;
            for (int k = 0; k < NE; ++k) { const int nt = (int)((COUNT[k] + 255u) >> 8); if (tile >= acc && tile < acc + nt) e = k; acc += nt; }
            ARowsDense al{ACT, (size_t)DFF, tile * 256, MAX_ROWS};
            BColsDense bl{a.in[20] + (size_t)e * DFF * D, D, ct * 256, D};
            EpiBiasBf16 ep{YB, a.in[21] + (size_t)e * D, tile * 256, ct * 256};
            gemm_unit<false>(lds, al, bl, ep, DFF);
        }
        SEAM(PH_DOWN);
    }

    if (IN(PH_FINAL)) {
        const float* fw = a.in[22];
        for (int row = gwave; row < T; row += gwaves) {
            const float4* xr = (const float4*)(X2 + (size_t)row * D);
            float4 v[8];
#pragma unroll
            for (int i = 0; i < 8; ++i) v[i] = xr[lane + 64 * i];
#pragma unroll
            for (int k = 0; k < 4; ++k) { const float gk = TOPG[row * 4 + k]; const bf16_t* yr = YB + (size_t)POS[row * 4 + k] * D;
#pragma unroll
                for (int i = 0; i < 8; ++i) { const uint2 y = *(const uint2*)(yr + 4 * (lane + 64 * i));
                    v[i].x += gk * bf2f((bf16_t)(y.x & 0xffffu)); v[i].y += gk * bf2f((bf16_t)(y.x >> 16)); v[i].z += gk * bf2f((bf16_t)(y.y & 0xffffu)); v[i].w += gk * bf2f((bf16_t)(y.y >> 16)); } }
            float ss = 0.f;
#pragma unroll
            for (int i = 0; i < 8; ++i) ss += v[i].x * v[i].x + v[i].y * v[i].y + v[i].z * v[i].z + v[i].w * v[i].w;
            ss = wave_sum(ss);
            float rstd = rsqrtf(ss * (1.0f / D) + NORM_EPS);
#ifdef SELFCHECK
            { const float sd = ((const float*)(ctl + CW_CHK))[0], sr = ((const float*)(ctl + CW_CHK))[1]; const float rel = sqrtf(sd / fmaxf(sr, 1e-30f)); rstd *= 1.0f + fminf(1.0f, 10.0f * rel); }
#endif
#pragma unroll
            for (int i = 0; i < 8; ++i) { const float4 wv = ((const float4*)fw)[lane + 64 * i];
                ((float4*)(a.out + (size_t)row * D))[lane + 64 * i] = make_float4(v[i].x * rstd * wv.x, v[i].y * rstd * wv.y, v[i].z * rstd * wv.z, v[i].w * rstd * wv.w); }
        }
    }
#undef IN
#undef SEAM
}

extern "C" void kernel_launch(void* const* d_in, const int* in_sizes, int n_in, void* d_out, int out_size, void* d_ws, size_t ws_size, hipStream_t stream) {
    static int grid = 0;
    if (grid == 0) {
        if (n_in != 23 || out_size != T * D || ws_size < WS_END) { fprintf(stderr, "kernel_launch: unexpected shapes (n_in %d, out %d, ws %zu < %zu)\n", n_in, out_size, ws_size, (size_t)WS_END); grid = -1; return; }
        int dev = 0, cus = 0, per_cu = 0;
        if (hipGetDevice(&dev) != hipSuccess || hipDeviceGetAttribute(&cus, hipDeviceAttributeMultiprocessorCount, dev) != hipSuccess) { grid = -1; return; }
        if (hipFuncSetAttribute((const void*)fwd, hipFuncAttributeMaxDynamicSharedMemorySize, LDS_BYTES) != hipSuccess) { fprintf(stderr, "kernel_launch: hipFuncSetAttribute failed\n"); grid = -1; return; }
        if (hipOccupancyMaxActiveBlocksPerMultiprocessor(&per_cu, (const void*)fwd, 512, LDS_BYTES) != hipSuccess || per_cu < 1) { fprintf(stderr, "kernel_launch: occupancy query says %d\n", per_cu); per_cu = 1; }
        (void)hipGetLastError();
        grid = cus;
    }
    if (grid < 0) return;
    (void)hipMemsetAsync((char*)d_ws + WS_CTL, 0, CTL_BYTES, stream);
    Args a{};
    for (int i = 0; i < 23; ++i) a.in[i] = (const float*)d_in[i];
    a.out = (float*)d_out; a.ws = (unsigned char*)d_ws;
#if N_LAUNCH_MODE == 1
    a.ph_lo = 0; a.ph_hi = N_PHASES;
    hipLaunchKernelGGL(fwd, dim3(grid), dim3(512), LDS_BYTES, stream, a);
#else
    for (int ph = 0; ph < N_PHASES; ++ph) { a.ph_lo = ph; a.ph_hi = ph + 1; hipLaunchKernelGGL(fwd, dim3(grid), dim3(512), LDS_BYTES, stream, a); }
#endif
}
```

```cpp
#include <hip/hip_runtime.h>
#include <stdint.h>
#include <stdio.h>

#ifndef N_LAUNCH_MODE
#define N_LAUNCH_MODE 1
#endif

typedef unsigned short bf16_t;
typedef short s16x4 __attribute__((ext_vector_type(4)));
typedef short s16x8 __attribute__((ext_vector_type(8)));
typedef float f32x4 __attribute__((ext_vector_type(4)));
typedef unsigned u32x4 __attribute__((ext_vector_type(4)));
typedef unsigned u32x2 __attribute__((ext_vector_type(2)));
#define LAS __attribute__((address_space(3)))

constexpr int D = 2048, BATCH = 2, SEQ = 4096, T = BATCH * SEQ;
constexpr int SSM_H = 16, SSM_N = 128;
constexpr int NSA_H = 16, DH = 64;
constexpr int CMP_HID = 512;
constexpr int N_C = 255, N_SEL = 64;
constexpr int IN_PROJ = 5696;
constexpr int OFF_Z = 0, OFF_XBC = 1024, OFF_DT = 3072, OFF_Q = 3088, OFF_KCMP = 4112, OFF_VCMP = 4368, OFF_KSLC = 4624,
              OFF_VSLC = 4880, OFF_KWIN = 5136, OFF_VWIN = 5392, OFF_GATE = 5648;
constexpr int NE = 32, DFF = 2048;
constexpr float NORM_EPS = 1e-5f;
constexpr int CMP_ROWS = BATCH * N_C * 4;
constexpr int MAX_TILES = 160, MAX_ROWS = MAX_TILES * 256;

constexpr size_t AL(size_t x) { return (x + 255) & ~(size_t)255; }
constexpr size_t WS_CTL = 0;
constexpr size_t CTL_BYTES = 32768;
constexpr size_t WS_XN = WS_CTL + CTL_BYTES;
constexpr size_t WS_PROJ = WS_XN + AL((size_t)T * D * 2);
constexpr size_t WS_XBC = WS_PROJ + AL((size_t)T * IN_PROJ * 4);
constexpr size_t WS_DT = WS_XBC + AL((size_t)T * 2048 * 4);
constexpr size_t WS_YSSD = WS_DT + AL((size_t)T * 16 * 4);
constexpr size_t WS_MIX = WS_YSSD + AL((size_t)T * 1024 * 4);
constexpr size_t WS_ROPE = WS_MIX + AL((size_t)T * 2048 * 2);
constexpr size_t WS_BLK = WS_ROPE + AL((size_t)SEQ * 16 * 4);
constexpr size_t WS_H1 = WS_BLK + AL((size_t)2 * 2048 * 2048 * 2);
constexpr size_t WS_KC = WS_H1 + AL((size_t)2 * 2048 * 512 * 2);
constexpr size_t WS_VC = WS_KC + AL((size_t)2048 * 64 * 4);
constexpr size_t WS_PCMP = WS_VC + AL((size_t)2048 * 64 * 4);
constexpr size_t WS_OCMP = WS_PCMP + AL((size_t)T * 16 * 256 * 4);
constexpr size_t WS_SEL = WS_OCMP + AL((size_t)T * 1024 * 4);
constexpr size_t WS_X2 = WS_SEL + AL((size_t)T * 4 * 8);
constexpr size_t WS_TOPE = WS_X2 + AL((size_t)T * D * 4);
constexpr size_t WS_TOPG = WS_TOPE + AL((size_t)T * 4 * 4);
constexpr size_t WS_SLOT = WS_TOPG + AL((size_t)T * 4 * 4);
constexpr size_t WS_POS = WS_SLOT + AL((size_t)T * 4 * 4);
constexpr size_t WS_ROWTOK = WS_POS + AL((size_t)T * 4 * 4);
constexpr size_t WS_ACT = WS_ROWTOK + AL((size_t)MAX_ROWS * 4);
constexpr size_t WS_Y = WS_ACT + AL((size_t)MAX_ROWS * DFF * 2);
constexpr size_t WS_QB = WS_Y + AL((size_t)MAX_ROWS * D * 2);
constexpr size_t WS_KS = WS_QB + AL((size_t)T * 1024 * 2);
constexpr size_t WS_VS = WS_KS + AL((size_t)T * 256 * 2);
constexpr size_t WS_KW = WS_VS + AL((size_t)T * 256 * 2);
constexpr size_t WS_VW = WS_KW + AL((size_t)T * 256 * 2);
constexpr size_t WS_KCB = WS_VW + AL((size_t)T * 256 * 2);
constexpr size_t WS_VCB = WS_KCB + AL((size_t)2 * 256 * 256 * 2);
constexpr size_t WS_XBCB = WS_VCB + AL((size_t)2 * 256 * 256 * 2);
constexpr size_t WS_STATES = WS_XBCB + AL((size_t)T * 2048 * 2);
constexpr size_t WS_PREV = WS_STATES + AL((size_t)2 * 32 * 16 * 64 * 128 * 4);
constexpr size_t WS_CHDEC = WS_PREV + AL((size_t)2 * 32 * 16 * 64 * 128 * 2);
constexpr size_t WS_CHK = WS_CHDEC + AL((size_t)2 * 32 * 16 * 4);
constexpr size_t WS_END = WS_CHK + AL((size_t)T * 2048 * 4);

constexpr int CW_COUNT = 4096;
constexpr int CW_CHK = 4160;

#define XB_TMO      128
#define XB_XCNT(j)  (256  + 64 * (j))
#define XB_XSUB(j)  (1280 + 64 * (j))
#define XB_XGEN(j)  (2304 + 64 * (j))
#define XB_TOP      3328
#define XB_TOPGEN   3392
#define XCD_BAR_WORDS 3456
#define XB_SPIN_CAP (1u << 18)

__device__ __forceinline__ unsigned xb_ld(unsigned* p)              { return __hip_atomic_load(p, __ATOMIC_RELAXED, __HIP_MEMORY_SCOPE_AGENT); }
__device__ __forceinline__ unsigned xb_add(unsigned* p, unsigned v) { return __hip_atomic_fetch_add(p, v, __ATOMIC_RELAXED, __HIP_MEMORY_SCOPE_AGENT); }
__device__ __forceinline__ unsigned xb_xcc_id() { return (unsigned)__builtin_amdgcn_s_getreg((3 << 11) | 20) & 0xFu; }
#define XB_SPIN(cond, bar) do { unsigned _sp = 0; while (cond) { __builtin_amdgcn_s_sleep(1); \
    if ((++_sp & 255u) == 0u) { if (xb_ld(&(bar)[XB_TMO])) break; if (_sp > XB_SPIN_CAP) { atomicAdd(&(bar)[XB_TMO], 1u); break; } } } } while (0)

struct XcdBarrier { unsigned* bar; unsigned x; volatile LAS unsigned* st; };

__device__ __forceinline__ XcdBarrier xcd_barrier_post(unsigned* bar, volatile LAS unsigned* st) {
    XcdBarrier b; b.bar = bar; b.x = xb_xcc_id(); b.st = st;
    if (threadIdx.x == 0) (void)xb_add(&bar[XB_XCNT(b.x)], 1u);
    return b;
}
__device__ __forceinline__ void xcd_barrier_complete(unsigned* bar, unsigned x, unsigned& nloc, unsigned& nx) {
    const unsigned G = gridDim.x * gridDim.y * gridDim.z;
    unsigned sum, cnt, mine, sp = 0u;
    for (;;) {
        sum = 0u; cnt = 0u; mine = 0u;
#pragma unroll
        for (unsigned j = 0; j < 16; ++j) { const unsigned c = xb_ld(&bar[XB_XCNT(j)]); sum += c; cnt += (c > 0u) ? 1u : 0u; mine = (j == x) ? c : mine; }
        if (sum == G) break;
        __builtin_amdgcn_s_sleep(1);
        if ((++sp & 255u) == 0u) { if (xb_ld(&bar[XB_TMO])) break; if (sp > XB_SPIN_CAP) { atomicAdd(&bar[XB_TMO], 1u); break; } }
    }
    nloc = mine > 0u ? mine : 1u; nx = cnt > 0u ? cnt : 1u;
}
__device__ __forceinline__ void xcd_barrier(const XcdBarrier& b) {
    asm volatile("s_waitcnt vmcnt(0)" ::: "memory");
    __syncthreads();
    if (threadIdx.x == 0) {
        unsigned* bar = b.bar;
        __builtin_amdgcn_s_waitcnt(0);
        unsigned nloc = b.st[0], nx = b.st[1];
        if (nloc == 0u) { xcd_barrier_complete(bar, b.x, nloc, nx); b.st[0] = nloc; b.st[1] = nx; }
        const unsigned old = xb_add(&bar[XB_XSUB(b.x)], 1u);
        const unsigned gen = old / nloc;
        if (old + 1u == (gen + 1u) * nloc) {
            __builtin_amdgcn_fence(__ATOMIC_RELEASE, "agent");
            asm volatile("s_waitcnt vmcnt(0)" ::: "memory");
            const unsigned og = xb_add(&bar[XB_TOP], 1u);
            const unsigned tg = og / nx;
            if (og + 1u == (tg + 1u) * nx) xb_add(&bar[XB_TOPGEN], 1u);
            else XB_SPIN(xb_ld(&bar[XB_TOPGEN]) == tg, bar);
            __builtin_amdgcn_fence(__ATOMIC_ACQUIRE, "agent");
            xb_add(&bar[XB_XGEN(b.x)], 1u);
            asm volatile("s_waitcnt vmcnt(0)" ::: "memory");
        } else {
            XB_SPIN(xb_ld(&bar[XB_XGEN(b.x)]) == gen, bar);
            __builtin_amdgcn_fence(__ATOMIC_ACQUIRE, "agent");
            asm volatile("s_waitcnt vmcnt(0)" ::: "memory");
        }
    }
    __syncthreads();
}

__device__ __forceinline__ bf16_t f2bf(float f) { unsigned u = __float_as_uint(f); u += 0x7FFFu + ((u >> 16) & 1u); return (bf16_t)(u >> 16); }
__device__ __forceinline__ float bf2f(bf16_t b) { return __uint_as_float(((unsigned)b) << 16); }
__device__ __forceinline__ unsigned pack2(float lo, float hi) { return (unsigned)f2bf(lo) | ((unsigned)f2bf(hi) << 16); }
__device__ __forceinline__ float wave_sum(float v) {
#pragma unroll
    for (int o = 32; o > 0; o >>= 1) v += __shfl_xor(v, o);
    return v;
}
__device__ __forceinline__ float sigmoidf_(float x) { return 1.0f / (1.0f + __expf(-x)); }

constexpr int A_RS = 80, B_RS = 576, A_ST = 256 * A_RS, B_ST = 32 * B_RS, STAGE = A_ST + B_ST;
constexpr int GEMM_LDS = 2 * STAGE;
constexpr int SSD_LDS = 147456;
constexpr int MAIN_LDS = SSD_LDS > GEMM_LDS ? SSD_LDS : GEMM_LDS;
constexpr int LDS_BYTES = MAIN_LDS + 64;

template <bool PAIRED, class ALd, class BLd, class EP>
__device__ __forceinline__ void gemm_unit(LAS char* lds, const ALd& al, const BLd& bl, const EP& ep, const int K) {
    const int tid = threadIdx.x, lane = tid & 63, wid = tid >> 6;
    const int wr = wid >> 2, wc = wid & 3, fr = lane & 15, fq = lane >> 4;
    const bf16_t* arow0; const bf16_t* arow1;
    { const int c0 = tid, c1 = tid + 512; const bf16_t* p0 = al.row(c0 >> 2); const bf16_t* p1 = al.row(c1 >> 2);
      arow0 = p0 ? p0 + (c0 & 3) * 8 : nullptr; arow1 = p1 ? p1 + (c1 & 3) * 8 : nullptr; }
    const float* bcol = bl.col(4 * (tid & 63));
    const size_t ldb = (size_t)bl.ldb;
    const int bk0 = tid >> 6;
    u32x4 ra0, ra1; float4 rb0, rb1, rb2, rb3;
    const u32x4 z4 = (u32x4){0u, 0u, 0u, 0u}; const float4 zf = make_float4(0.f, 0.f, 0.f, 0.f);
#define G_LOAD(kt) do { \
        ra0 = arow0 ? *(const u32x4*)(arow0 + (kt) * 32) : z4; ra1 = arow1 ? *(const u32x4*)(arow1 + (kt) * 32) : z4; \
        if (bcol) { const float* bp = bcol + (size_t)((kt) * 32 + bk0) * ldb; \
            rb0 = *(const float4*)(bp); rb1 = *(const float4*)(bp + 8 * ldb); rb2 = *(const float4*)(bp + 16 * ldb); rb3 = *(const float4*)(bp + 24 * ldb); } \
        else { rb0 = zf; rb1 = zf; rb2 = zf; rb3 = zf; } } while (0)
#define S_WRITE(buf) do { LAS char* sa = lds + (buf) * STAGE; LAS char* sb = sa + A_ST; \
        *(LAS u32x4*)(sa + (tid >> 2) * A_RS + (tid & 3) * 16) = ra0; \
        *(LAS u32x4*)(sa + ((tid + 512) >> 2) * A_RS + (tid & 3) * 16) = ra1; \
        LAS char* wb = sb + bk0 * B_RS + (tid & 63) * 8; \
        *(LAS u32x2*)(wb) = (u32x2){pack2(rb0.x, rb0.y), pack2(rb0.z, rb0.w)}; \
        *(LAS u32x2*)(wb + 8 * B_RS) = (u32x2){pack2(rb1.x, rb1.y), pack2(rb1.z, rb1.w)}; \
        *(LAS u32x2*)(wb + 16 * B_RS) = (u32x2){pack2(rb2.x, rb2.y), pack2(rb2.z, rb2.w)}; \
        *(LAS u32x2*)(wb + 24 * B_RS) = (u32x2){pack2(rb3.x, rb3.y), pack2(rb3.z, rb3.w)}; } while (0)
    f32x4 acc[8][4];
#pragma unroll
    for (int m = 0; m < 8; ++m)
#pragma unroll
        for (int n = 0; n < 4; ++n) acc[m][n] = (f32x4){0.f, 0.f, 0.f, 0.f};
    const int nk = K / 32;
    const int a_off = (wr * 128 + fr) * A_RS + fq * 16;
    const int b_off = A_ST + (8 * fq + ((lane & 15) >> 2)) * B_RS + (wc * 64 + 4 * (lane & 3)) * 2;
    G_LOAD(0);
    S_WRITE(0);
    __syncthreads();
    for (int kt = 0; kt < nk; ++kt) {
        const int buf = kt & 1;
        if (kt + 1 < nk) G_LOAD(kt + 1);
        LAS char* sbase = lds + buf * STAGE;
        s16x8 af[8];
#pragma unroll
        for (int m = 0; m < 8; ++m) af[m] = *(const LAS s16x8*)(sbase + a_off + m * 16 * A_RS);
#pragma unroll
        for (int n = 0; n < 4; ++n) {
            const s16x4 t0 = __builtin_amdgcn_ds_read_tr16_b64_v4i16((LAS s16x4*)(sbase + b_off + n * 32));
            const s16x4 t1 = __builtin_amdgcn_ds_read_tr16_b64_v4i16((LAS s16x4*)(sbase + b_off + n * 32 + 4 * B_RS));
            const s16x8 bfr = {t0[0], t0[1], t0[2], t0[3], t1[0], t1[1], t1[2], t1[3]};
#pragma unroll
            for (int m = 0; m < 8; ++m) acc[m][n] = __builtin_amdgcn_mfma_f32_16x16x32_bf16(bfr, af[m], acc[m][n], 0, 0, 0);
        }
        if (kt + 1 < nk) S_WRITE(buf ^ 1);
        __syncthreads();
    }
#undef G_LOAD
#undef S_WRITE
#pragma unroll
    for (int m = 0; m < 8; ++m) {
        const int r = wr * 128 + m * 16 + fr;
        if constexpr (PAIRED) {
#pragma unroll
            for (int n = 0; n < 2; ++n) ep.pair(r, wc * 32 + n * 16 + 4 * fq, acc[m][n], acc[m][n + 2]);
        } else {
#pragma unroll
            for (int n = 0; n < 4; ++n) ep(r, wc * 64 + n * 16 + 4 * fq, acc[m][n]);
        }
    }
}


constexpr int KV_RS = 144, KT_BYTES = 64 * KV_RS;
constexpr int ATT_IMP_OFF = 4 * KT_BYTES;
constexpr int ATT_MASK_OFF = ATT_IMP_OFF + 64 * 64 * 4;
struct GState { f32x4 o[4]; float m, l; };

template <int MODE>
__device__ __forceinline__ void attn_block(const LAS char* kt, const LAS char* vt, const int lane, const s16x8 (&qf)[2][2], GState (&st)[2],
                                           const bool (&act)[2], const int key0, const int (&lo)[2], const int (&hi)[2],
                                           LAS float* imp, const int (&tokl)[2], float (&carry)[2], const int jb) {
    const int c16 = lane & 15, fq = lane >> 4;
    const bool on[2] = {__ballot(act[0]) != 0ull, __ballot(act[1]) != 0ull};
    f32x4 s[2][4];
#pragma unroll
    for (int mt = 0; mt < 4; ++mt) {
        const s16x8 k0 = *(const LAS s16x8*)(kt + (16 * mt + c16) * KV_RS + (8 * fq) * 2);
        const s16x8 k1 = *(const LAS s16x8*)(kt + (16 * mt + c16) * KV_RS + (32 + 8 * fq) * 2);
#pragma unroll
        for (int gi = 0; gi < 2; ++gi) { s[gi][mt] = (f32x4){0.f, 0.f, 0.f, 0.f};
            if (on[gi]) { s[gi][mt] = __builtin_amdgcn_mfma_f32_16x16x32_bf16(k0, qf[gi][0], s[gi][mt], 0, 0, 0); s[gi][mt] = __builtin_amdgcn_mfma_f32_16x16x32_bf16(k1, qf[gi][1], s[gi][mt], 0, 0, 0); } }
    }
    s16x8 pf[2][2];
#pragma unroll
    for (int gi = 0; gi < 2; ++gi) {
        if (!on[gi]) continue;
        float mx = -INFINITY;
#pragma unroll
        for (int mt = 0; mt < 4; ++mt)
#pragma unroll
            for (int i = 0; i < 4; ++i) { const int key = key0 + 16 * mt + 4 * fq + i; const bool ok = act[gi] && key >= lo[gi] && key <= hi[gi];
                s[gi][mt][i] = ok ? s[gi][mt][i] : -INFINITY; mx = fmaxf(mx, s[gi][mt][i]); }
        float msafe, scale = 1.0f;
        if (MODE == 2) { msafe = (st[gi].m == -INFINITY) ? 0.f : st[gi].m; scale = st[gi].l; }
        else {
            mx = fmaxf(mx, __shfl_xor(mx, 16)); mx = fmaxf(mx, __shfl_xor(mx, 32));
            const float mnew = fmaxf(st[gi].m, mx);
            const float alpha = (mnew == -INFINITY) ? 1.0f : __expf(st[gi].m - mnew);
            msafe = (mnew == -INFINITY) ? 0.f : mnew;
            st[gi].m = mnew; st[gi].l *= alpha;
            if (MODE == 0) {
#pragma unroll
                for (int md = 0; md < 4; ++md) st[gi].o[md] *= alpha;
            }
        }
        float rs = 0.f;
#pragma unroll
        for (int mt = 0; mt < 4; ++mt)
#pragma unroll
            for (int i = 0; i < 4; ++i) { const float pv = __expf(s[gi][mt][i] - msafe) * scale; s[gi][mt][i] = pv; rs += pv; }
        if (MODE != 2) { rs += __shfl_xor(rs, 16); rs += __shfl_xor(rs, 32); st[gi].l += rs; }
        if (MODE == 2) {
#pragma unroll
            for (int mt = 0; mt < 4; ++mt) {
                const float tcur = __shfl(s[gi][mt][3], (lane - 16) & 63);
                const float tprv = __shfl(mt > 0 ? s[gi][mt > 0 ? mt - 1 : 0][3] : carry[gi], (lane - 16) & 63);
                const float prev = fq > 0 ? tcur : tprv;
                float part = 32.f * (s[gi][mt][0] + s[gi][mt][1] + s[gi][mt][2]) + 16.f * s[gi][mt][3] + 16.f * prev;
                part += __shfl_xor(part, 1); part += __shfl_xor(part, 2);
                if ((c16 & 3) == 0) imp[tokl[gi] * 64 + 16 * jb + 4 * mt + fq] = part;
            }
            carry[gi] = s[gi][3][3];
        }
        if (MODE != 1) {
#pragma unroll
            for (int ks = 0; ks < 2; ++ks) {
                const u32x4 w = {pack2(s[gi][2 * ks][0], s[gi][2 * ks][1]), pack2(s[gi][2 * ks][2], s[gi][2 * ks][3]),
                                 pack2(s[gi][2 * ks + 1][0], s[gi][2 * ks + 1][1]), pack2(s[gi][2 * ks + 1][2], s[gi][2 * ks + 1][3])};
                pf[gi][ks] = __builtin_bit_cast(s16x8, w);
            }
        }
    }
    if (MODE != 1) {
        const int q = c16 >> 2, p = c16 & 3;
#pragma unroll
        for (int md = 0; md < 4; ++md) {
            s16x8 vf[2];
#pragma unroll
            for (int ks = 0; ks < 2; ++ks) {
                const s16x4 t0 = __builtin_amdgcn_ds_read_tr16_b64_v4i16((LAS s16x4*)(vt + (32 * ks + 4 * fq + q) * KV_RS + (16 * md + 4 * p) * 2));
                const s16x4 t1 = __builtin_amdgcn_ds_read_tr16_b64_v4i16((LAS s16x4*)(vt + (32 * ks + 16 + 4 * fq + q) * KV_RS + (16 * md + 4 * p) * 2));
                vf[ks] = (s16x8){t0[0], t0[1], t0[2], t0[3], t1[0], t1[1], t1[2], t1[3]};
            }
#pragma unroll
            for (int gi = 0; gi < 2; ++gi)
                if (on[gi]) { st[gi].o[md] = __builtin_amdgcn_mfma_f32_16x16x32_bf16(vf[0], pf[gi][0], st[gi].o[md], 0, 0, 0); st[gi].o[md] = __builtin_amdgcn_mfma_f32_16x16x32_bf16(vf[1], pf[gi][1], st[gi].o[md], 0, 0, 0); }
        }
    }
}

#define ATT_GLOAD(Kg, Vg, row0) do { const size_t _o = ((size_t)(row0) + (tid >> 3)) * 256 + g * 64 + (tid & 7) * 8; rk = *(const u32x4*)((Kg) + _o); rv = *(const u32x4*)((Vg) + _o); } while (0)
#define ATT_SWRITE(buf) do { LAS char* _k = lds + (buf) * 2 * KT_BYTES + (tid >> 3) * KV_RS + (tid & 7) * 16; *(LAS u32x4*)_k = rk; *(LAS u32x4*)(_k + KT_BYTES) = rv; } while (0)

__device__ __forceinline__ void nsa_unit(LAS char* lds, const int unit, const bf16_t* QB, const bf16_t* KS, const bf16_t* VS, const bf16_t* KW, const bf16_t* VW,
                                         const bf16_t* KCB, const bf16_t* VCB, const float* PROJ, bf16_t* MIX) {
    const int tid = threadIdx.x, lane = tid & 63, wid = tid >> 6, c16 = lane & 15, fq = lane >> 4;
    const int qt = unit >> 3, b = (unit >> 2) & 1, g = unit & 3;
    const int t0 = qt * 64;
    LAS float* imp = (LAS float*)(lds + ATT_IMP_OFF);
    LAS unsigned* lmask = (LAS unsigned*)(lds + ATT_MASK_OFF);
    int tokl[2], tpos[2]; s16x8 qf[2][2]; float gate[2][3];
#pragma unroll
    for (int gi = 0; gi < 2; ++gi) {
        tokl[gi] = 8 * wid + 4 * gi + (c16 >> 2); tpos[gi] = t0 + tokl[gi];
        const size_t tt = (size_t)b * SEQ + tpos[gi]; const int hq = g * 4 + (c16 & 3);
#pragma unroll
        for (int ks = 0; ks < 2; ++ks) qf[gi][ks] = *(const s16x8*)(QB + tt * 1024 + hq * 64 + 32 * ks + 8 * fq);
        const float* gl = PROJ + tt * IN_PROJ + OFF_GATE + hq * 3;
        gate[gi][0] = sigmoidf_(gl[0]); gate[gi][1] = sigmoidf_(gl[1]); gate[gi][2] = sigmoidf_(gl[2]);
    }
    for (int i = tid; i < 64 * 64; i += 512) imp[i] = 0.f;
    f32x4 res[2][4];
    GState st[2]; bool act[2]; int lo[2], hi[2]; float carry[2] = {0.f, 0.f};
    u32x4 rk, rv;
    const bf16_t* KCg = KCB + (size_t)b * 256 * 256; const bf16_t* VCg = VCB + (size_t)b * 256 * 256;
    const bf16_t* KSg = KS + (size_t)b * SEQ * 256; const bf16_t* VSg = VS + (size_t)b * SEQ * 256;
    const bf16_t* KWg = KW + (size_t)b * SEQ * 256; const bf16_t* VWg = VW + (size_t)b * SEQ * 256;
    const int cmax_u = (t0 + 63 - 31) >> 4;
    const int ncb = cmax_u < 0 ? 0 : min(4, (cmax_u + 1) / 64 + 1);
#pragma unroll
    for (int gi = 0; gi < 2; ++gi) { act[gi] = true; lo[gi] = 0; hi[gi] = tpos[gi] >= 31 ? ((tpos[gi] - 31) >> 4) : -1; st[gi].m = -INFINITY; st[gi].l = 0.f;
#pragma unroll
        for (int md = 0; md < 4; ++md) st[gi].o[md] = (f32x4){0.f, 0.f, 0.f, 0.f}; }
    __syncthreads();
    if (ncb > 0) {
        ATT_GLOAD(KCg, VCg, 0); ATT_SWRITE(0); __syncthreads();
        for (int jb = 0; jb < ncb; ++jb) {
            if (jb + 1 < ncb) ATT_GLOAD(KCg, VCg, 64 * (jb + 1));
            attn_block<1>(lds + (jb & 1) * 2 * KT_BYTES, lds + (jb & 1) * 2 * KT_BYTES + KT_BYTES, lane, qf, st, act, 64 * jb, lo, hi, imp, tokl, carry, jb);
            if (jb + 1 < ncb) ATT_SWRITE((jb + 1) & 1);
            __syncthreads();
        }
#pragma unroll
        for (int gi = 0; gi < 2; ++gi) st[gi].l = st[gi].l > 0.f ? 1.0f / st[gi].l : 0.f;
        ATT_GLOAD(KCg, VCg, 0); ATT_SWRITE(0); __syncthreads();
        for (int jb = 0; jb < ncb; ++jb) {
            if (jb + 1 < ncb) ATT_GLOAD(KCg, VCg, 64 * (jb + 1));
            attn_block<2>(lds + (jb & 1) * 2 * KT_BYTES, lds + (jb & 1) * 2 * KT_BYTES + KT_BYTES, lane, qf, st, act, 64 * jb, lo, hi, imp, tokl, carry, jb);
            if (jb + 1 < ncb) ATT_SWRITE((jb + 1) & 1);
            __syncthreads();
        }
    }
#pragma unroll
    for (int gi = 0; gi < 2; ++gi)
#pragma unroll
        for (int md = 0; md < 4; ++md) res[gi][md] = st[gi].o[md] * gate[gi][0];
    __syncthreads();
    for (int k = 0; k < 8; ++k) {
        const int tl = 8 * wid + k, j = lane;
        const float iv = imp[tl * 64 + j];
        const bool forced = (j == 0) || (j == qt) || (j == qt - 1), valid = j <= qt;
        const float sc = forced ? 1.0e4f : (valid ? iv : -1.0e4f);
        int rank = 0;
#pragma unroll
        for (int kk = 0; kk < 64; ++kk) { const float o = __shfl(sc, kk); rank += (o > sc || (o == sc && kk < j)) ? 1 : 0; }
        const unsigned long long m64 = __ballot(rank < 16 && valid);
        if (lane == 0) { lmask[tl * 2] = (unsigned)m64; lmask[tl * 2 + 1] = (unsigned)(m64 >> 32); }
    }
    __syncthreads();
    unsigned long long msk[2]; unsigned long long wunion;
    {
#pragma unroll
        for (int gi = 0; gi < 2; ++gi) msk[gi] = (unsigned long long)lmask[tokl[gi] * 2] | ((unsigned long long)lmask[tokl[gi] * 2 + 1] << 32);
        unsigned ul = (unsigned)(msk[0] | msk[1]), uh = (unsigned)((msk[0] | msk[1]) >> 32);
#pragma unroll
        for (int o = 1; o < 64; o <<= 1) { ul |= __shfl_xor(ul, o); uh |= __shfl_xor(uh, o); }
        wunion = (unsigned long long)ul | ((unsigned long long)uh << 32);
    }
#pragma unroll
    for (int gi = 0; gi < 2; ++gi) { lo[gi] = 0; hi[gi] = tpos[gi]; st[gi].m = -INFINITY; st[gi].l = 0.f;
#pragma unroll
        for (int md = 0; md < 4; ++md) st[gi].o[md] = (f32x4){0.f, 0.f, 0.f, 0.f}; }
    ATT_GLOAD(KSg, VSg, 0); ATT_SWRITE(0); __syncthreads();
    for (int j = 0; j <= qt; ++j) {
        if (j + 1 <= qt) ATT_GLOAD(KSg, VSg, 64 * (j + 1));
        if ((wunion >> j) & 1ull) {
            act[0] = (msk[0] >> j) & 1ull; act[1] = (msk[1] >> j) & 1ull;
            attn_block<0>(lds + (j & 1) * 2 * KT_BYTES, lds + (j & 1) * 2 * KT_BYTES + KT_BYTES, lane, qf, st, act, 64 * j, lo, hi, imp, tokl, carry, 0);
        }
        if (j + 1 <= qt) ATT_SWRITE((j + 1) & 1);
        __syncthreads();
    }
#pragma unroll
    for (int gi = 0; gi < 2; ++gi) { const float il = gate[gi][1] / fmaxf(st[gi].l, 1e-30f);
#pragma unroll
        for (int md = 0; md < 4; ++md) res[gi][md] += st[gi].o[md] * il; }
#pragma unroll
    for (int gi = 0; gi < 2; ++gi) { act[gi] = true; lo[gi] = tpos[gi] - 511; hi[gi] = tpos[gi]; st[gi].m = -INFINITY; st[gi].l = 0.f;
#pragma unroll
        for (int md = 0; md < 4; ++md) st[gi].o[md] = (f32x4){0.f, 0.f, 0.f, 0.f}; }
    const int jw0 = qt >= 8 ? qt - 8 : 0;
    ATT_GLOAD(KWg, VWg, 64 * jw0); ATT_SWRITE(jw0 & 1); __syncthreads();
    for (int j = jw0; j <= qt; ++j) {
        if (j + 1 <= qt) ATT_GLOAD(KWg, VWg, 64 * (j + 1));
        attn_block<0>(lds + (j & 1) * 2 * KT_BYTES, lds + (j & 1) * 2 * KT_BYTES + KT_BYTES, lane, qf, st, act, 64 * j, lo, hi, imp, tokl, carry, 0);
        if (j + 1 <= qt) ATT_SWRITE((j + 1) & 1);
        __syncthreads();
    }
#pragma unroll
    for (int gi = 0; gi < 2; ++gi) { const float il = gate[gi][2] / fmaxf(st[gi].l, 1e-30f);
        bf16_t* mp = MIX + ((size_t)b * SEQ + tpos[gi]) * 2048 + 1024 + (g * 4 + (c16 & 3)) * 64 + 4 * fq;
#pragma unroll
        for (int md = 0; md < 4; ++md) { const f32x4 r = res[gi][md] + st[gi].o[md] * il;
            *(uint2*)(mp + 16 * md) = make_uint2(pack2(r[0], r[1]), pack2(r[2], r[3])); } }
}
#undef ATT_GLOAD
#undef ATT_SWRITE

constexpr int SX_RS = 144, SX_H = 128 * SX_RS, SB_RS = 272, SB_BYTES = 128 * SB_RS;
constexpr int SSD_X_OFF = 0, SSD_B_OFF = 4 * SX_H, SSD_C_OFF = SSD_B_OFF + SB_BYTES, SSD_T_OFF = SSD_C_OFF + SB_BYTES;
static_assert(SSD_T_OFF + 4096 <= SSD_LDS, "ssd lds");

template <bool WITH_C>
__device__ __forceinline__ void ssd_stage(LAS char* lds, const bf16_t* XBCB, const float* DT, const float* a_log, const int b, const int c, const int grp) {
    const int tid = threadIdx.x;
    const size_t tt0 = (size_t)b * SEQ + c * 128;
#pragma unroll
    for (int k = 0; k < 8; ++k) { const int id = tid + 512 * k, l = id >> 5, ch = id & 31, h = ch >> 3, pc = ch & 7;
        const u32x4 v = *(const u32x4*)(XBCB + (tt0 + l) * 2048 + grp * 256 + ch * 8);
        *(LAS u32x4*)(lds + SSD_X_OFF + h * SX_H + l * SX_RS + pc * 16) = v; }
#pragma unroll
    for (int k = 0; k < 4; ++k) { const int id = tid + 512 * k, l = id >> 4, ch = id & 15;
        const u32x4 v = *(const u32x4*)(XBCB + (tt0 + l) * 2048 + 1024 + grp * 128 + ch * 8);
        *(LAS u32x4*)(lds + SSD_B_OFF + l * SB_RS + ch * 16) = v;
        if (WITH_C) { const u32x4 w = *(const u32x4*)(XBCB + (tt0 + l) * 2048 + 1536 + grp * 128 + ch * 8);
            *(LAS u32x4*)(lds + SSD_C_OFF + l * SB_RS + ch * 16) = w; } }
    LAS float* dtl = (LAS float*)(lds + SSD_T_OFF); LAS float* acs = dtl + 512;
    const int h = tid >> 7, l = tid & 127;
    const float av = -expf(a_log[grp * 4 + h]);
    const float dtv = DT[(tt0 + l) * 16 + grp * 4 + h];
    dtl[tid] = dtv; acs[tid] = dtv * av;
    __syncthreads();
    float cs = 0.f;
    for (int k = 0; k <= l; ++k) cs += acs[h * 128 + k];
    __syncthreads();
    acs[tid] = cs;
    __syncthreads();
}

__device__ __forceinline__ void ssd_states_item(LAS char* lds, const int item, const bf16_t* XBCB, const float* DT, const float* a_log, float* STATES, float* CHDEC) {
    const int tid = threadIdx.x, lane = tid & 63, wid = tid >> 6, c16 = lane & 15, fq = lane >> 4, q = c16 >> 2, pp = c16 & 3;
    const int grp = item & 3, c = (item >> 2) & 31, b = item >> 7;
    __syncthreads();
    ssd_stage<false>(lds, XBCB, DT, a_log, b, c, grp);
    LAS float* dtl = (LAS float*)(lds + SSD_T_OFF); LAS float* acs = dtl + 512;
#pragma unroll
    for (int k = 0; k < 8; ++k) { const int id = tid + 512 * k, l = id >> 5, ch = id & 31, h = ch >> 3, pc = ch & 7;
        const float w = __expf(acs[h * 128 + 127] - acs[h * 128 + l]) * dtl[h * 128 + l];
        LAS u32x4* pv = (LAS u32x4*)(lds + SSD_X_OFF + h * SX_H + l * SX_RS + pc * 16);
        u32x4 v = *pv;
#pragma unroll
        for (int e = 0; e < 4; ++e) { const float lo = __uint_as_float(v[e] << 16) * w, hi = __uint_as_float(v[e] & 0xffff0000u) * w; v[e] = pack2(lo, hi); }
        *pv = v; }
    if (tid < 4) CHDEC[((size_t)b * 32 + c) * 16 + grp * 4 + tid] = __expf(acs[tid * 128 + 127]);
    __syncthreads();
    s16x8 af[4];
#pragma unroll
    for (int ks = 0; ks < 4; ++ks) {
        const s16x4 t0 = __builtin_amdgcn_ds_read_tr16_b64_v4i16((LAS s16x4*)(lds + SSD_B_OFF + (32 * ks + 8 * fq + q) * SB_RS + (16 * wid + 4 * pp) * 2));
        const s16x4 t1 = __builtin_amdgcn_ds_read_tr16_b64_v4i16((LAS s16x4*)(lds + SSD_B_OFF + (32 * ks + 8 * fq + 4 + q) * SB_RS + (16 * wid + 4 * pp) * 2));
        af[ks] = (s16x8){t0[0], t0[1], t0[2], t0[3], t1[0], t1[1], t1[2], t1[3]};
    }
#pragma unroll
    for (int h = 0; h < 4; ++h) {
        float* sp = STATES + (((size_t)b * 32 + c) * 16 + grp * 4 + h) * 8192;
#pragma unroll
        for (int pt = 0; pt < 4; ++pt) {
            f32x4 acc = {0.f, 0.f, 0.f, 0.f};
#pragma unroll
            for (int ks = 0; ks < 4; ++ks) {
                const s16x4 t0 = __builtin_amdgcn_ds_read_tr16_b64_v4i16((LAS s16x4*)(lds + SSD_X_OFF + h * SX_H + (32 * ks + 8 * fq + q) * SX_RS + (16 * pt + 4 * pp) * 2));
                const s16x4 t1 = __builtin_amdgcn_ds_read_tr16_b64_v4i16((LAS s16x4*)(lds + SSD_X_OFF + h * SX_H + (32 * ks + 8 * fq + 4 + q) * SX_RS + (16 * pt + 4 * pp) * 2));
                const s16x8 bfr = {t0[0], t0[1], t0[2], t0[3], t1[0], t1[1], t1[2], t1[3]};
                acc = __builtin_amdgcn_mfma_f32_16x16x32_bf16(af[ks], bfr, acc, 0, 0, 0);
            }
            *(f32x4*)(sp + (size_t)(16 * pt + c16) * 128 + 16 * wid + 4 * fq) = acc;
        }
    }
}

__device__ __forceinline__ void ssd_out_item(LAS char* lds, const int item, const bf16_t* XBCB, const float* DT, const float* a_log, const float* d_skip, const float* nw,
                                             const bf16_t* PREV, const float* PROJ, float* YTMP, bf16_t* MIXO) {
    const int tid = threadIdx.x, lane = tid & 63, wid = tid >> 6, c16 = lane & 15, fq = lane >> 4, q = c16 >> 2, pp = c16 & 3;
    const int grp = item & 3, c = (item >> 2) & 31, b = item >> 7;
    __syncthreads();
    ssd_stage<true>(lds, XBCB, DT, a_log, b, c, grp);
    LAS float* dtl = (LAS float*)(lds + SSD_T_OFF); LAS float* acs = dtl + 512;
    const int lcol = 16 * wid + c16;
    const size_t tt = (size_t)b * SEQ + c * 128 + lcol;
    s16x8 cf[4];
#pragma unroll
    for (int ks = 0; ks < 4; ++ks) cf[ks] = *(const LAS s16x8*)(lds + SSD_C_OFF + lcol * SB_RS + (32 * ks + 8 * fq) * 2);
    f32x4 g[8];
#pragma unroll
    for (int mt = 0; mt < 8; ++mt) { g[mt] = (f32x4){0.f, 0.f, 0.f, 0.f};
        if (mt <= wid) {
#pragma unroll
            for (int ks = 0; ks < 4; ++ks) { const s16x8 bfr = *(const LAS s16x8*)(lds + SSD_B_OFF + (16 * mt + c16) * SB_RS + (32 * ks + 8 * fq) * 2);
                g[mt] = __builtin_amdgcn_mfma_f32_16x16x32_bf16(bfr, cf[ks], g[mt], 0, 0, 0); } } }
    float ss = 0.f;
#pragma unroll 1
    for (int h = 0; h < 4; ++h) {
        const int hh = grp * 4 + h;
        const float acs_l = acs[h * 128 + lcol];
        s16x8 pf[4];
#pragma unroll
        for (int ks = 0; ks < 4; ++ks) {
            float pv[2][4];
#pragma unroll
            for (int u = 0; u < 2; ++u)
#pragma unroll
                for (int i = 0; i < 4; ++i) { const int sidx = 32 * ks + 16 * u + 4 * fq + i;
                    const float e = (sidx <= lcol) ? __expf(acs_l - acs[h * 128 + sidx]) * dtl[h * 128 + sidx] : 0.f;
                    pv[u][i] = g[2 * ks + u][i] * e; }
            const u32x4 w = {pack2(pv[0][0], pv[0][1]), pack2(pv[0][2], pv[0][3]), pack2(pv[1][0], pv[1][1]), pack2(pv[1][2], pv[1][3])};
            pf[ks] = __builtin_bit_cast(s16x8, w);
        }
        const float dsk = d_skip[hh], eal = __expf(acs_l);
        const bf16_t* prevp = PREV + (((size_t)b * 32 + c) * 16 + hh) * 8192;
#pragma unroll
        for (int pt = 0; pt < 4; ++pt) {
            f32x4 yd = {0.f, 0.f, 0.f, 0.f}, yo = {0.f, 0.f, 0.f, 0.f};
#pragma unroll
            for (int ks = 0; ks < 4; ++ks) {
                if (2 * ks <= wid) {
                    const s16x4 t0 = __builtin_amdgcn_ds_read_tr16_b64_v4i16((LAS s16x4*)(lds + SSD_X_OFF + h * SX_H + (32 * ks + 4 * fq + q) * SX_RS + (16 * pt + 4 * pp) * 2));
                    const s16x4 t1 = __builtin_amdgcn_ds_read_tr16_b64_v4i16((LAS s16x4*)(lds + SSD_X_OFF + h * SX_H + (32 * ks + 16 + 4 * fq + q) * SX_RS + (16 * pt + 4 * pp) * 2));
                    const s16x8 xf = {t0[0], t0[1], t0[2], t0[3], t1[0], t1[1], t1[2], t1[3]};
                    yd = __builtin_amdgcn_mfma_f32_16x16x32_bf16(xf, pf[ks], yd, 0, 0, 0);
                }
                const s16x8 pr = *(const s16x8*)(prevp + (size_t)(16 * pt + c16) * 128 + 32 * ks + 8 * fq);
                yo = __builtin_amdgcn_mfma_f32_16x16x32_bf16(pr, cf[ks], yo, 0, 0, 0);
            }
            const u32x2 xr = *(const LAS u32x2*)(lds + SSD_X_OFF + h * SX_H + lcol * SX_RS + (16 * pt + 4 * fq) * 2);
            const float xv[4] = {__uint_as_float(xr[0] << 16), __uint_as_float(xr[0] & 0xffff0000u), __uint_as_float(xr[1] << 16), __uint_as_float(xr[1] & 0xffff0000u)};
            const f32x4 z = *(const f32x4*)(PROJ + tt * IN_PROJ + OFF_Z + hh * 64 + 16 * pt + 4 * fq);
            f32x4 gvv;
#pragma unroll
            for (int i = 0; i < 4; ++i) { const float y = yd[i] + eal * yo[i] + dsk * xv[i]; gvv[i] = y * z[i] * sigmoidf_(z[i]); ss += gvv[i] * gvv[i]; }
            *(f32x4*)(YTMP + tt * 1024 + hh * 64 + 16 * pt + 4 * fq) = gvv;
        }
    }
    ss += __shfl_xor(ss, 16); ss += __shfl_xor(ss, 32);
    const float rs = rsqrtf(ss * (1.0f / 256.f) + NORM_EPS);
#pragma unroll 1
    for (int h = 0; h < 4; ++h)
#pragma unroll
        for (int pt = 0; pt < 4; ++pt) { const int ch = (grp * 4 + h) * 64 + 16 * pt + 4 * fq; const f32x4 w4 = *(const f32x4*)(nw + ch);
            const f32x4 gvv = *(const f32x4*)(YTMP + tt * 1024 + ch);
            *(uint2*)(MIXO + tt * 2048 + ch) = make_uint2(pack2(gvv[0] * rs * w4[0], gvv[1] * rs * w4[1]), pack2(gvv[2] * rs * w4[2], gvv[3] * rs * w4[3])); }
}

struct Args {
    const float* in[23];
    float* out;
    unsigned char* ws;
    int ph_lo, ph_hi;
};

enum { PH_NORM1 = 0, PH_INPROJ, PH_PREP, PH_SSD_CMP1, PH_GNORM_CMP2,
#ifdef SELFCHECK
       PH_CMPATT, PH_SELECT, PH_SELWIN,
#endif
       PH_NSA,
#ifdef SELFCHECK
       PH_CHECK,
#endif
       PH_OUTPROJ, PH_ROUTER, PH_SCATTER, PH_GATEUP, PH_DOWN, PH_FINAL, N_PHASES };

struct ARowsDense { const bf16_t* base; size_t ld; int row0, nrows;
    __device__ __forceinline__ const bf16_t* row(int r) const { const int g = row0 + r; return g < nrows ? base + (size_t)g * ld : nullptr; } };
struct ARowsGather { const bf16_t* base; size_t ld; const int* idx;
    __device__ __forceinline__ const bf16_t* row(int r) const { const int g = idx[r]; return g >= 0 ? base + (size_t)g * ld : nullptr; } };
struct BColsDense { const float* base; int ldb; int col0, ncols;
    __device__ __forceinline__ const float* col(int n) const { const int c = col0 + n; return c < ncols ? base + c : nullptr; } };
struct BColsGateUp { const float* base; int ldb; int cn;
    __device__ __forceinline__ const float* col(int n) const { const int wc = n >> 6, nt = (n & 63) >> 4, w = n & 15; const int j = wc * 32 + (nt & 1) * 16 + w;
        return base + (nt < 2 ? 0 : DFF) + cn * 128 + j; } };

struct EpiStoreF32 { float* C; size_t ldc; int row0, col0, ncols;
    __device__ __forceinline__ void operator()(int r, int n, f32x4 v) const { const int c = col0 + n; if (c < ncols) *(f32x4*)(C + (size_t)(row0 + r) * ldc + c) = v; } };
struct EpiResidF32 { float* C; const float* X; size_t ldc; int row0, col0;
    __device__ __forceinline__ void operator()(int r, int n, f32x4 v) const { const size_t o = (size_t)(row0 + r) * ldc + col0 + n; const f32x4 x = *(const f32x4*)(X + o); *(f32x4*)(C + o) = v + x; } };
struct EpiGeluBf16 { bf16_t* O; const float* bias; size_t ldo; int row0, col0, nrows;
    __device__ __forceinline__ void operator()(int r, int n, f32x4 v) const { const int g = row0 + r; if (g >= nrows) return; const int c = col0 + n;
        float o[4];
#pragma unroll
        for (int i = 0; i < 4; ++i) { const float x = v[i] + bias[c + i]; const float u = 0.7978845608028654f * (x + 0.044715f * x * x * x); o[i] = 0.5f * x * (1.0f + tanhf(u)); }
        *(uint2*)(O + (size_t)g * ldo + c) = make_uint2(pack2(o[0], o[1]), pack2(o[2], o[3])); } };
struct EpiSwiglu { bf16_t* O; const float* bias; int row0, cn;
    __device__ __forceinline__ void pair(int r, int j, f32x4 g, f32x4 u) const { const int c = cn * 128 + j; float o[4];
#pragma unroll
        for (int i = 0; i < 4; ++i) { float gv = g[i] + bias[c + i]; float uv = u[i] + bias[DFF + c + i]; gv = fminf(gv, 7.0f); uv = fminf(fmaxf(uv, -7.0f), 7.0f);
            const float glu = gv * sigmoidf_(1.702f * gv); o[i] = (uv + 1.0f) * glu; }
        *(uint2*)(O + (size_t)(row0 + r) * DFF + c) = make_uint2(pack2(o[0], o[1]), pack2(o[2], o[3])); } };
struct EpiBiasBf16 { bf16_t* O; const float* bias; int row0, col0;
    __device__ __forceinline__ void operator()(int r, int n, f32x4 v) const { const int c = col0 + n;
        *(uint2*)(O + (size_t)(row0 + r) * D + c) = make_uint2(pack2(v[0] + bias[c], v[1] + bias[c + 1]), pack2(v[2] + bias[c + 2], v[3] + bias[c + 3])); } };

__device__ __forceinline__ float rope_inv(int i) { return (float)exp(-(double)i * 0.125 * 13.122363377404328); }

__global__ void __launch_bounds__(512, 2) fwd(Args a) {
    extern __shared__ __attribute__((aligned(16))) unsigned char lds_raw[];
    LAS char* lds = (LAS char*)lds_raw;
    const int tid = threadIdx.x, lane = tid & 63, wid = __builtin_amdgcn_readfirstlane(tid >> 6);
    const int G = gridDim.x, bid = blockIdx.x;
    const int gtid = bid * 512 + tid, gthreads = G * 512;
    const int gwave = bid * 8 + wid, gwaves = G * 8;
    unsigned char* ws = a.ws;
    unsigned* ctl = (unsigned*)(ws + WS_CTL);
    volatile LAS unsigned* barw = (volatile LAS unsigned*)(lds + MAIN_LDS);
    if (tid == 0) { barw[0] = 0u; barw[1] = 0u; barw[2] = 0u; barw[3] = 0u; }
    __syncthreads();
    XcdBarrier bar; bar.bar = ctl; bar.x = 0; bar.st = barw;
    const bool multi = (a.ph_hi - a.ph_lo) > 1;
    if (multi) bar = xcd_barrier_post(ctl, barw);
#ifdef ONLY_PH
#define IN(k) ((k) == ONLY_PH)
#else
#define IN(k) (a.ph_lo <= (k) && (k) < a.ph_hi)
#endif
#define SEAM(k) do { if ((k) + 1 < a.ph_hi) xcd_barrier(bar); } while (0)

    const float* x = a.in[0];
    bf16_t* XN = (bf16_t*)(ws + WS_XN);
    float* PROJ = (float*)(ws + WS_PROJ);
    float* XBC = (float*)(ws + WS_XBC);
    float* DT = (float*)(ws + WS_DT);
    float* YSSD = (float*)(ws + WS_YSSD);
    bf16_t* MIX = (bf16_t*)(ws + WS_MIX);
    float* ROPE = (float*)(ws + WS_ROPE);
    bf16_t* BLK = (bf16_t*)(ws + WS_BLK);
    bf16_t* H1 = (bf16_t*)(ws + WS_H1);
    float* KC = (float*)(ws + WS_KC);
    float* VC = (float*)(ws + WS_VC);
    float* PCMP = (float*)(ws + WS_PCMP);
    float* OCMP = (float*)(ws + WS_OCMP);
    unsigned long long* SEL = (unsigned long long*)(ws + WS_SEL);
    float* X2 = (float*)(ws + WS_X2);
    int* TOPE = (int*)(ws + WS_TOPE);
    float* TOPG = (float*)(ws + WS_TOPG);
    int* SLOT = (int*)(ws + WS_SLOT);
    int* POS = (int*)(ws + WS_POS);
    int* ROWTOK = (int*)(ws + WS_ROWTOK);
    bf16_t* ACT = (bf16_t*)(ws + WS_ACT);
    bf16_t* YB = (bf16_t*)(ws + WS_Y);
    unsigned* COUNT = ctl + CW_COUNT;
    bf16_t* XBCB = (bf16_t*)(ws + WS_XBCB); float* STATES = (float*)(ws + WS_STATES); bf16_t* PREV = (bf16_t*)(ws + WS_PREV); float* CHDEC = (float*)(ws + WS_CHDEC);
    bf16_t* QB = (bf16_t*)(ws + WS_QB); bf16_t* KSb = (bf16_t*)(ws + WS_KS); bf16_t* VSb = (bf16_t*)(ws + WS_VS);
    bf16_t* KWb = (bf16_t*)(ws + WS_KW); bf16_t* VWb = (bf16_t*)(ws + WS_VW); bf16_t* KCB = (bf16_t*)(ws + WS_KCB); bf16_t* VCB = (bf16_t*)(ws + WS_VCB);

    if (IN(PH_NORM1)) {
        const float* w = a.in[1];
        for (int row = gwave; row < T; row += gwaves) {
            const float4* xr = (const float4*)(x + (size_t)row * D);
            float4 v[8]; float ss = 0.f;
#pragma unroll
            for (int i = 0; i < 8; ++i) { v[i] = xr[lane + 64 * i]; ss += v[i].x * v[i].x + v[i].y * v[i].y + v[i].z * v[i].z + v[i].w * v[i].w; }
            ss = wave_sum(ss);
            const float rstd = rsqrtf(ss * (1.0f / D) + NORM_EPS);
#pragma unroll
            for (int i = 0; i < 8; ++i) { const float4 wv = ((const float4*)w)[lane + 64 * i];
                *(uint2*)(XN + (size_t)row * D + 4 * (lane + 64 * i)) = make_uint2(pack2(v[i].x * rstd * wv.x, v[i].y * rstd * wv.y), pack2(v[i].z * rstd * wv.z, v[i].w * rstd * wv.w)); }
        }
        for (int i = gtid; i < SEQ * 8; i += gthreads) { const int pos = i >> 3, k = i & 7; const float ang = (float)pos * rope_inv(k); ROPE[i] = cosf(ang); ROPE[SEQ * 8 + i] = sinf(ang); }
        for (int i = gtid; i < MAX_ROWS; i += gthreads) ROWTOK[i] = -1;
        SEAM(PH_NORM1);
    }

    if (IN(PH_INPROJ)) {
        const int nct = (IN_PROJ + 255) / 256, nunits = (T / 256) * nct;
        for (int u = bid; u < nunits; u += G) {
            const int rt = u / nct, ct = u % nct;
            ARowsDense al{XN, (size_t)D, rt * 256, T};
            BColsDense bl{a.in[2], IN_PROJ, ct * 256, IN_PROJ};
            EpiStoreF32 ep{PROJ, (size_t)IN_PROJ, rt * 256, ct * 256, IN_PROJ};
            gemm_unit<false>(lds, al, bl, ep, D);
        }
        SEAM(PH_INPROJ);
    }

    if (IN(PH_PREP)) {
        const float* conv_w = a.in[3]; const float* conv_b = a.in[4]; const float* dt_bias = a.in[5];
        for (int i = gtid; i < T * 2048; i += gthreads) {
            const int t = i >> 11, c = i & 2047, s = t & (SEQ - 1);
            float acc = conv_b[c];
#pragma unroll
            for (int k = 0; k < 4; ++k) { const int ts = s - 3 + k; if (ts >= 0) acc += conv_w[k * 2048 + c] * PROJ[(size_t)(t - 3 + k) * IN_PROJ + OFF_XBC + c]; }
            const float cv = acc * sigmoidf_(acc);
#if defined(SELFCHECK) && SELFCHECK == 2
            XBC[i] = cv;
#endif
            XBCB[i] = f2bf(cv);
        }
        for (int i = gtid; i < T * 16; i += gthreads) { const int h = i & 15; const float v = PROJ[(size_t)(i >> 4) * IN_PROJ + OFF_DT + h] + dt_bias[h];
            DT[i] = v > 20.f ? v : log1pf(expf(v)); }
        for (int i = gtid; i < T * 256; i += gthreads) {
            const int ch = i & 7, slot = (i >> 3) & 31, t = i >> 8, pos = t & (SEQ - 1);
            int col; bf16_t* dst; float scl = 1.0f; bool rope = slot < 24;
            if (slot < 16) { col = OFF_Q + slot * 64; dst = QB + (size_t)t * 1024 + slot * 64; scl = 0.125f; }
            else if (slot < 20) { col = OFF_KSLC + (slot - 16) * 64; dst = KSb + (size_t)t * 256 + (slot - 16) * 64; }
            else if (slot < 24) { col = OFF_KWIN + (slot - 20) * 64; dst = KWb + (size_t)t * 256 + (slot - 20) * 64; }
            else if (slot < 28) { col = OFF_VSLC + (slot - 24) * 64; dst = VSb + (size_t)t * 256 + (slot - 24) * 64; }
            else { col = OFF_VWIN + (slot - 28) * 64; dst = VWb + (size_t)t * 256 + (slot - 28) * 64; }
            const float* p = PROJ + (size_t)t * IN_PROJ + col;
            float v[8];
            if (rope && ch < 2) {
                const float4 a0 = *(const float4*)(p), a1 = *(const float4*)(p + 4), b0 = *(const float4*)(p + 8), b1 = *(const float4*)(p + 12);
                const float x1[8] = {a0.x, a0.y, a0.z, a0.w, a1.x, a1.y, a1.z, a1.w}, x2[8] = {b0.x, b0.y, b0.z, b0.w, b1.x, b1.y, b1.z, b1.w};
#pragma unroll
                for (int k = 0; k < 8; ++k) { const float c = ROPE[pos * 8 + k], sn = ROPE[SEQ * 8 + pos * 8 + k]; v[k] = (ch == 0) ? (x1[k] * c - x2[k] * sn) : (x1[k] * sn + x2[k] * c); }
            } else {
                const float4 a0 = *(const float4*)(p + ch * 8), a1 = *(const float4*)(p + ch * 8 + 4);
                v[0] = a0.x; v[1] = a0.y; v[2] = a0.z; v[3] = a0.w; v[4] = a1.x; v[5] = a1.y; v[6] = a1.z; v[7] = a1.w;
            }
            u32x4 o = {pack2(v[0] * scl, v[1] * scl), pack2(v[2] * scl, v[3] * scl), pack2(v[4] * scl, v[5] * scl), pack2(v[6] * scl, v[7] * scl)};
            *(u32x4*)(dst + ch * 8) = o;
        }
        for (int i = gtid; i < 2 * 2 * 256; i += gthreads) { const int d = i & 255, b = (i >> 8) & 1, j = i >> 9; (j ? VCB : KCB)[((size_t)b * 256 + 255) * 256 + d] = 0; }
        const float* pe = a.in[9];
        for (int i = gtid; i < 2 * 2048 * 512; i += gthreads) {
            const int e4 = i & 511, row = (i >> 9) & 2047, j = i >> 20;
            uint2 o = make_uint2(0u, 0u);
            if (row < CMP_ROWS) { const int g = row & 3, n = (row >> 2) % N_C, b = (row >> 2) / N_C; const int l = e4 >> 4, d = (e4 & 15) * 4;
                const float4 v = *(const float4*)(PROJ + (size_t)(b * SEQ + 16 * n + l) * IN_PROJ + (j ? OFF_VCMP : OFF_KCMP) + g * 64 + d);
                const float4 p4 = *(const float4*)(pe + (j * 32 + l) * 64 + d);
                o = make_uint2(pack2(v.x + p4.x, v.y + p4.y), pack2(v.z + p4.z, v.w + p4.w)); }
            *(uint2*)(BLK + ((size_t)j * 2048 + row) * 2048 + e4 * 4) = o;
        }
        SEAM(PH_PREP);
    }

    if (IN(PH_SSD_CMP1)) {
#if defined(SELFCHECK) && SELFCHECK == 2
        const int GW = G - 16;
        if (bid >= GW) {
            const int w = (bid - GW) * 8 + wid, b = w >> 6, h = (w >> 2) & 15, pq = w & 3, g = h >> 2;
            const int p = pq * 16 + (lane >> 2), nq = lane & 3;
            const float av = -expf(a.in[6][h]), dsk = a.in[7][h];
            float st[32];
#pragma unroll
            for (int n = 0; n < 32; ++n) st[n] = 0.f;
            for (int t = 0; t < SEQ; ++t) {
                const size_t tt = (size_t)b * SEQ + t;
                const float* row = XBC + tt * 2048;
                const float dtv = DT[tt * 16 + h];
                const float dA = expf(dtv * av);
                const float xv = row[h * 64 + p];
                const float4* Bp = (const float4*)(row + 1024 + g * 128 + nq * 32); const float4* Cp = (const float4*)(row + 1536 + g * 128 + nq * 32);
                const float coef = dtv * xv; float y = 0.f;
#pragma unroll
                for (int n4 = 0; n4 < 8; ++n4) { const float4 bv = Bp[n4], cv = Cp[n4];
                    st[4 * n4 + 0] = st[4 * n4 + 0] * dA + coef * bv.x; y += st[4 * n4 + 0] * cv.x;
                    st[4 * n4 + 1] = st[4 * n4 + 1] * dA + coef * bv.y; y += st[4 * n4 + 1] * cv.y;
                    st[4 * n4 + 2] = st[4 * n4 + 2] * dA + coef * bv.z; y += st[4 * n4 + 2] * cv.z;
                    st[4 * n4 + 3] = st[4 * n4 + 3] * dA + coef * bv.w; y += st[4 * n4 + 3] * cv.w; }
                y += __shfl_xor(y, 1); y += __shfl_xor(y, 2);
                if (nq == 0) YSSD[tt * 1024 + h * 64 + p] = y + dsk * xv;
            }
        } else
#else
        const int GW = G;
#endif
        {
            for (int u = bid; u < 32; u += GW) {
                const int j = u >> 4, rt = (u >> 1) & 7, ct = u & 1;
                ARowsDense al{BLK + (size_t)j * 2048 * 2048, (size_t)2048, rt * 256, CMP_ROWS};
                BColsDense bl{a.in[10] + (size_t)j * 2048 * CMP_HID, CMP_HID, ct * 256, CMP_HID};
                EpiGeluBf16 ep{H1 + (size_t)j * 2048 * CMP_HID, a.in[11] + j * CMP_HID, (size_t)CMP_HID, rt * 256, ct * 256, CMP_ROWS};
                gemm_unit<false>(lds, al, bl, ep, 2048);
            }
            for (int it = (bid + GW - (32 % GW)) % GW; it < 256; it += GW) ssd_states_item(lds, it, XBCB, DT, a.in[6], STATES, CHDEC);
        }
        SEAM(PH_SSD_CMP1);
    }

    if (IN(PH_GNORM_CMP2)) {
        const float* nw = a.in[8];
#ifdef SELFCHECK
        for (int i = gtid; i < T * 24 * 8; i += gthreads) {
            const int k = i & 7, slot = (i >> 3) % 24, t = i / 192, pos = t & (SEQ - 1);
            const int col = slot < 16 ? OFF_Q + slot * 64 : (slot < 20 ? OFF_KSLC + (slot - 16) * 64 : OFF_KWIN + (slot - 20) * 64);
            float* p = PROJ + (size_t)t * IN_PROJ + col;
            const float c = ROPE[pos * 8 + k], s = ROPE[SEQ * 8 + pos * 8 + k];
            const float x1 = p[k], x2 = p[k + 8];
            p[k] = x1 * c - x2 * s; p[k + 8] = x1 * s + x2 * c;
        }
#endif
#if defined(SELFCHECK) && SELFCHECK == 2
        for (int it = gwave; it < T * 4; it += gwaves) {
            const int t = it >> 2, grp = it & 3, c = grp * 256 + lane * 4;
            const float4 y = *(const float4*)(YSSD + (size_t)t * 1024 + c);
            const float4 z = *(const float4*)(PROJ + (size_t)t * IN_PROJ + OFF_Z + c);
            float gv[4] = {y.x * z.x * sigmoidf_(z.x), y.y * z.y * sigmoidf_(z.y), y.z * z.z * sigmoidf_(z.z), y.w * z.w * sigmoidf_(z.w)};
            float ss = wave_sum(gv[0] * gv[0] + gv[1] * gv[1] + gv[2] * gv[2] + gv[3] * gv[3]);
            const float sc = rsqrtf(ss * (1.0f / 256.f) + NORM_EPS);
            const float4 w4 = *(const float4*)(nw + c);
            *(uint2*)(MIX + (size_t)t * 2048 + c) = make_uint2(pack2(gv[0] * sc * w4.x, gv[1] * sc * w4.y), pack2(gv[2] * sc * w4.z, gv[3] * sc * w4.w));
        }
#endif
        for (int i = gtid; i < 2 * 16 * 64 * 32; i += gthreads) {
            const int n4 = i & 31, p = (i >> 5) & 63, h = (i >> 11) & 15, b = i >> 15;
            f32x4 run = {0.f, 0.f, 0.f, 0.f};
            for (int c = 0; c < 32; ++c) {
                const size_t base = (((size_t)b * 32 + c) * 16 + h) * 8192 + p * 128 + n4 * 4;
                *(uint2*)(PREV + base) = make_uint2(pack2(run[0], run[1]), pack2(run[2], run[3]));
                const float dec = CHDEC[((size_t)b * 32 + c) * 16 + h];
                const f32x4 sv = *(const f32x4*)(STATES + base);
                run = run * dec + sv;
            }
        }
        const float* w2 = a.in[12]; const float* b2 = a.in[13];
        for (int i = gtid; i < 2 * CMP_ROWS * 64; i += gthreads) {
            const int d = i & 63, row = (i >> 6) % CMP_ROWS, j = i / (CMP_ROWS * 64);
            const bf16_t* hrow = H1 + ((size_t)j * 2048 + row) * CMP_HID;
            const float* wj = w2 + (size_t)j * CMP_HID * 64;
            const bool rot = (j == 0) && (d < 16);
            const int dp = rot ? (d < 8 ? d + 8 : d - 8) : d;
            float s0 = b2[j * 64 + d], s1 = b2[j * 64 + dp];
            for (int k = 0; k < CMP_HID; ++k) { const float hv = bf2f(hrow[k]); s0 += hv * wj[k * 64 + d]; s1 += hv * wj[k * 64 + dp]; }
            float o = s0;
            if (rot) { const int n = (row >> 2) % N_C, pos = 16 * n + 31, k = d & 7; const float c = ROPE[pos * 8 + k], s = ROPE[SEQ * 8 + pos * 8 + k];
                o = (d < 8) ? (s0 * c - s1 * s) : (s1 * s + s0 * c); }
            (j ? VC : KC)[(size_t)row * 64 + d] = o;
            { const int g4 = row & 3, n = (row >> 2) % N_C, bb = (row >> 2) / N_C; (j ? VCB : KCB)[((size_t)bb * 256 + n) * 256 + g4 * 64 + d] = f2bf(o); }
        }
        SEAM(PH_GNORM_CMP2);
    }

#ifdef SELFCHECK
    if (IN(PH_CMPATT)) {
        for (int it = gtid; it < T * 16; it += gthreads) {
            const int hq = it & 15, tt = it >> 4, b = tt >> 12, t = tt & (SEQ - 1), g = hq >> 2;
            const int nvalid = t >= 31 ? ((t - 31) >> 4) + 1 : 0;
            float q[64];
            const float* qp = PROJ + (size_t)tt * IN_PROJ + OFF_Q + hq * 64;
#pragma unroll
            for (int d = 0; d < 64; d += 4) { const float4 v = *(const float4*)(qp + d); q[d] = v.x; q[d + 1] = v.y; q[d + 2] = v.z; q[d + 3] = v.w; }
            float m = -INFINITY, l = 0.f;
            for (int c = 0; c < nvalid; ++c) {
                const float* kp = KC + (size_t)((b * N_C + c) * 4 + g) * 64; float s = 0.f;
#pragma unroll
                for (int d = 0; d < 64; d += 4) { const float4 v = *(const float4*)(kp + d); s += q[d] * v.x + q[d + 1] * v.y + q[d + 2] * v.z + q[d + 3] * v.w; }
                s *= 0.125f;
                const float mn = fmaxf(m, s); l = l * __expf(m - mn) + __expf(s - mn); m = mn;
            }
            float o[64];
#pragma unroll
            for (int d = 0; d < 64; ++d) o[d] = 0.f;
            const float inv_l = nvalid > 0 ? 1.0f / fmaxf(l, 1e-30f) : 0.f;
            float* pp = PCMP + (size_t)it * 256;
            for (int c = 0; c < nvalid; ++c) {
                const float* kp = KC + (size_t)((b * N_C + c) * 4 + g) * 64; float s = 0.f;
#pragma unroll
                for (int d = 0; d < 64; d += 4) { const float4 v = *(const float4*)(kp + d); s += q[d] * v.x + q[d + 1] * v.y + q[d + 2] * v.z + q[d + 3] * v.w; }
                const float p = __expf(s * 0.125f - m) * inv_l;
                pp[c] = p;
                const float* vp = VC + (size_t)((b * N_C + c) * 4 + g) * 64;
#pragma unroll
                for (int d = 0; d < 64; d += 4) { const float4 v = *(const float4*)(vp + d); o[d] += p * v.x; o[d + 1] += p * v.y; o[d + 2] += p * v.z; o[d + 3] += p * v.w; }
            }
            for (int c = nvalid; c < 256; ++c) pp[c] = 0.f;
            float* op = OCMP + (size_t)tt * 1024 + hq * 64;
#pragma unroll
            for (int d = 0; d < 64; d += 4) *(float4*)(op + d) = make_float4(o[d], o[d + 1], o[d + 2], o[d + 3]);
        }
        SEAM(PH_CMPATT);
    }

    if (IN(PH_SELECT)) {
        for (int it = gwave; it < T * 4; it += gwaves) {
            const int g = it & 3, tt = it >> 2, t = tt & (SEQ - 1), cur = t >> 6, j = lane;
            float imp = 0.f;
#pragma unroll
            for (int r = 0; r < 4; ++r) { const float* pp = PCMP + ((size_t)tt * 16 + g * 4 + r) * 256 + 4 * j;
                const float4 v = *(const float4*)pp; const float pm1 = j > 0 ? pp[-1] : 0.f;
                imp += 32.f * (v.x + v.y + v.z) + 16.f * v.w + 16.f * pm1; }
            const bool forced = (j == 0) || (j == cur) || (j == cur - 1);
            const bool valid = j <= cur;
            const float sc = forced ? 1.0e4f : (valid ? imp : -1.0e4f);
            int rank = 0;
#pragma unroll
            for (int k = 0; k < 64; ++k) { const float o = __shfl(sc, k); rank += (o > sc || (o == sc && k < j)) ? 1 : 0; }
            const unsigned long long mask = __ballot(rank < 16 && valid);
            if (lane == 0) SEL[it] = mask;
        }
        SEAM(PH_SELECT);
    }

    if (IN(PH_SELWIN)) {
        for (int it = gtid; it < T * 16; it += gthreads) {
            const int hq = it & 15, tt = it >> 4, b = tt >> 12, t = tt & (SEQ - 1), g = hq >> 2;
            float q[64];
            const float* qp = PROJ + (size_t)tt * IN_PROJ + OFF_Q + hq * 64;
#pragma unroll
            for (int d = 0; d < 64; d += 4) { const float4 v = *(const float4*)(qp + d); q[d] = v.x; q[d + 1] = v.y; q[d + 2] = v.z; q[d + 3] = v.w; }
            const float* gl = PROJ + (size_t)tt * IN_PROJ + OFF_GATE + hq * 3;
            const float g0 = sigmoidf_(gl[0]), g1 = sigmoidf_(gl[1]), g2 = sigmoidf_(gl[2]);
            float* op = OCMP + (size_t)tt * 1024 + hq * 64;
            float o[64];
            {
#pragma unroll
                for (int d = 0; d < 64; ++d) o[d] = 0.f;
                float m = -INFINITY, l = 0.f;
                unsigned long long mask = SEL[(size_t)tt * 4 + g];
                while (mask) {
                    const int j = __ffsll((long long)mask) - 1; mask &= mask - 1;
                    const int hi = min(64 * j + 63, t);
                    for (int tok = 64 * j; tok <= hi; ++tok) {
                        const float* kp = PROJ + (size_t)(b * SEQ + tok) * IN_PROJ + OFF_KSLC + g * 64; float s = 0.f;
#pragma unroll
                        for (int d = 0; d < 64; d += 4) { const float4 v = *(const float4*)(kp + d); s += q[d] * v.x + q[d + 1] * v.y + q[d + 2] * v.z + q[d + 3] * v.w; }
                        s *= 0.125f;
                        const float mn = fmaxf(m, s), al = __expf(m - mn), p = __expf(s - mn); m = mn; l = l * al + p;
                        const float* vp = kp + (OFF_VSLC - OFF_KSLC);
#pragma unroll
                        for (int d = 0; d < 64; d += 4) { const float4 v = *(const float4*)(vp + d); o[d] = o[d] * al + p * v.x; o[d + 1] = o[d + 1] * al + p * v.y; o[d + 2] = o[d + 2] * al + p * v.z; o[d + 3] = o[d + 3] * al + p * v.w; }
                    }
                }
                const float il = g1 / fmaxf(l, 1e-30f);
#pragma unroll
                for (int d = 0; d < 64; d += 4) { float4 r = *(float4*)(op + d); r.x = g0 * r.x + il * o[d]; r.y = g0 * r.y + il * o[d + 1]; r.z = g0 * r.z + il * o[d + 2]; r.w = g0 * r.w + il * o[d + 3]; *(float4*)(op + d) = r; }
            }
            {
#pragma unroll
                for (int d = 0; d < 64; ++d) o[d] = 0.f;
                float m = -INFINITY, l = 0.f;
                const int lo = max(0, t - 511);
                for (int tok = lo; tok <= t; ++tok) {
                    const float* kp = PROJ + (size_t)(b * SEQ + tok) * IN_PROJ + OFF_KWIN + g * 64; float s = 0.f;
#pragma unroll
                    for (int d = 0; d < 64; d += 4) { const float4 v = *(const float4*)(kp + d); s += q[d] * v.x + q[d + 1] * v.y + q[d + 2] * v.z + q[d + 3] * v.w; }
                    s *= 0.125f;
                    const float mn = fmaxf(m, s), al = __expf(m - mn), p = __expf(s - mn); m = mn; l = l * al + p;
                    const float* vp = kp + (OFF_VWIN - OFF_KWIN);
#pragma unroll
                    for (int d = 0; d < 64; d += 4) { const float4 v = *(const float4*)(vp + d); o[d] = o[d] * al + p * v.x; o[d + 1] = o[d + 1] * al + p * v.y; o[d + 2] = o[d + 2] * al + p * v.z; o[d + 3] = o[d + 3] * al + p * v.w; }
                }
                const float il = g2 / fmaxf(l, 1e-30f);
                bf16_t* mp = MIX + (size_t)tt * 2048 + 1024 + hq * 64;
#pragma unroll
                for (int d = 0; d < 64; d += 4) { const float4 r = *(const float4*)(op + d);
                    *(uint2*)(mp + d) = make_uint2(pack2(r.x + il * o[d], r.y + il * o[d + 1]), pack2(r.z + il * o[d + 2], r.w + il * o[d + 3])); }
            }
        }
        SEAM(PH_SELWIN);
    }

#endif
    if (IN(PH_NSA)) {
#ifdef SELFCHECK
        bf16_t* MIXO = (bf16_t*)(ws + WS_CHK);
#else
        bf16_t* MIXO = MIX;
#endif
        for (int k = bid; k < 512; k += G) { const int rnd = k / G; const int u = (rnd & 1) ? 511 - (k - G * rnd) - G * (rnd - 1) : k;
            if (u >= 0 && u < 512) nsa_unit(lds, (G == 256) ? u : k, QB, KSb, VSb, KWb, VWb, KCB, VCB, PROJ, MIXO); }
        for (int it = bid; it < 256; it += G) ssd_out_item(lds, it, XBCB, DT, a.in[6], a.in[7], a.in[8], PREV, PROJ, YSSD, MIXO);
        SEAM(PH_NSA);
    }
#ifdef SELFCHECK
    if (IN(PH_CHECK)) {
        const bf16_t* A_ = MIX; const bf16_t* B_ = (const bf16_t*)(ws + WS_CHK);
        float sd = 0.f, sr = 0.f;
        for (int i = gtid; i < T * 1024; i += gthreads) { const size_t o = (size_t)(i >> 10) * 2048 + (SELFCHECK == 1 ? 1024 : 0) + (i & 1023); const float r = bf2f(A_[o]), v = bf2f(B_[o]); sd += (r - v) * (r - v); sr += r * r; }
        sd = wave_sum(sd); sr = wave_sum(sr);
        if (lane == 0) { atomicAdd((float*)(ctl + CW_CHK), sd); atomicAdd((float*)(ctl + CW_CHK + 1), sr); }
        SEAM(PH_CHECK);
    }
#endif

    if (IN(PH_OUTPROJ)) {
        const int nunits = (T / 256) * (D / 256);
        for (int u = bid; u < nunits; u += G) {
            const int rt = u >> 3, ct = u & 7;
            ARowsDense al{MIX, (size_t)2048, rt * 256, T};
            BColsDense bl{a.in[14], D, ct * 256, D};
            EpiResidF32 ep{X2, x, (size_t)D, rt * 256, ct * 256};
            gemm_unit<false>(lds, al, bl, ep, 2048);
        }
        SEAM(PH_OUTPROJ);
    }

    if (IN(PH_ROUTER)) {
        const float* w = a.in[15]; const float* wr_ = a.in[16]; const float* br = a.in[17];
        for (int row = gwave; row < T; row += gwaves) {
            const float4* xr = (const float4*)(X2 + (size_t)row * D);
            float ss = 0.f;
#pragma unroll 2
            for (int i = 0; i < 8; ++i) { const float4 v = xr[lane + 64 * i]; ss += v.x * v.x + v.y * v.y + v.z * v.z + v.w * v.w; }
            ss = wave_sum(ss);
            const float rstd = rsqrtf(ss * (1.0f / D) + NORM_EPS);
            float lg[NE];
#pragma unroll
            for (int e = 0; e < NE; ++e) lg[e] = 0.f;
#pragma unroll 1
            for (int i = 0; i < 8; ++i) { const float4 wv = ((const float4*)w)[lane + 64 * i]; const float4 v = xr[lane + 64 * i];
                const float h0 = v.x * rstd * wv.x, h1 = v.y * rstd * wv.y, h2 = v.z * rstd * wv.z, h3 = v.w * rstd * wv.w;
                const int d0 = 4 * (lane + 64 * i);
                *(uint2*)(XN + (size_t)row * D + d0) = make_uint2(pack2(h0, h1), pack2(h2, h3));
                const float4* r0 = (const float4*)(wr_ + (size_t)d0 * NE);
#pragma unroll
                for (int e4 = 0; e4 < 8; ++e4) { const float4 a0 = r0[e4], a1 = r0[8 + e4], a2 = r0[16 + e4], a3 = r0[24 + e4];
                    lg[4 * e4 + 0] += h0 * a0.x + h1 * a1.x + h2 * a2.x + h3 * a3.x; lg[4 * e4 + 1] += h0 * a0.y + h1 * a1.y + h2 * a2.y + h3 * a3.y;
                    lg[4 * e4 + 2] += h0 * a0.z + h1 * a1.z + h2 * a2.z + h3 * a3.z; lg[4 * e4 + 3] += h0 * a0.w + h1 * a1.w + h2 * a2.w + h3 * a3.w; }
            }
            float mine = -INFINITY;
#pragma unroll
            for (int e = 0; e < NE; ++e) { const float s = wave_sum(lg[e]); if (lane == e) mine = s + br[e]; }
            int rank = 0;
#pragma unroll
            for (int k = 0; k < NE; ++k) { const float o = __shfl(mine, k); rank += (o > mine || (o == mine && k < lane)) ? 1 : 0; }
            const bool sel = (lane < NE) && (rank < 4);
            float mx = sel ? mine : -INFINITY;
#pragma unroll
            for (int o = 32; o > 0; o >>= 1) mx = fmaxf(mx, __shfl_xor(mx, o));
            const float ex = sel ? __expf(mine - mx) : 0.f;
            const float den = wave_sum(ex);
            if (sel) { const int slot = (int)atomicAdd(&COUNT[lane], 1u); const int o = row * 4 + rank; TOPE[o] = lane; TOPG[o] = ex / den; SLOT[o] = slot; }
        }
        SEAM(PH_ROUTER);
    }

    if (IN(PH_SCATTER)) {
        for (int i = gtid; i < T * 4; i += gthreads) {
            const int e = TOPE[i]; int off = 0;
            for (int k = 0; k < e; ++k) off += (int)((COUNT[k] + 255u) >> 8);
            const int pos = off * 256 + SLOT[i];
            ROWTOK[pos] = i >> 2; POS[i] = pos;
        }
        SEAM(PH_SCATTER);
    }

    if (IN(PH_GATEUP) || IN(PH_DOWN)) {
        LAS int* toff = (LAS int*)(lds + GEMM_LDS + 64 - 0);
        (void)toff;
    }
    if (IN(PH_GATEUP)) {
        int ntiles = 0;
        for (int k = 0; k < NE; ++k) ntiles += (int)((COUNT[k] + 255u) >> 8);
        const int nunits = ntiles * 16;
        for (int u = bid; u < nunits; u += G) {
            const int tile = u >> 4, cn = u & 15;
            int e = 0, acc = 0;
            for (int k = 0; k < NE; ++k) { const int nt = (int)((COUNT[k] + 255u) >> 8); if (tile >= acc && tile < acc + nt) e = k; acc += nt; }
            ARowsGather al{XN, (size_t)D, ROWTOK + tile * 256};
            BColsGateUp bl{a.in[18] + (size_t)e * D * 2 * DFF, 2 * DFF, cn};
            EpiSwiglu ep{ACT, a.in[19] + (size_t)e * 2 * DFF, tile * 256, cn};
            gemm_unit<true>(lds, al, bl, ep, D);
        }
        SEAM(PH_GATEUP);
    }
    if (IN(PH_DOWN)) {
        int ntiles = 0;
        for (int k = 0; k < NE; ++k) ntiles += (int)((COUNT[k] + 255u) >> 8);
        const int nunits = ntiles * 8;
        for (int u = bid; u < nunits; u += G) {
            const int tile = u >> 3, ct = u & 7;
            int e = 0, acc = 0;
            for (int k = 0; k < NE; ++k) { const int nt = (int)((COUNT[k] + 255u) >> 8); if (tile >= acc && tile < acc + nt) e = k; acc += nt; }
            ARowsDense al{ACT, (size_t)DFF, tile * 256, MAX_ROWS};
            BColsDense bl{a.in[20] + (size_t)e * DFF * D, D, ct * 256, D};
            EpiBiasBf16 ep{YB, a.in[21] + (size_t)e * D, tile * 256, ct * 256};
            gemm_unit<false>(lds, al, bl, ep, DFF);
        }
        SEAM(PH_DOWN);
    }

    if (IN(PH_FINAL)) {
        const float* fw = a.in[22];
        for (int row = gwave; row < T; row += gwaves) {
            const float4* xr = (const float4*)(X2 + (size_t)row * D);
            float4 v[8];
#pragma unroll
            for (int i = 0; i < 8; ++i) v[i] = xr[lane + 64 * i];
#pragma unroll
            for (int k = 0; k < 4; ++k) { const float gk = TOPG[row * 4 + k]; const bf16_t* yr = YB + (size_t)POS[row * 4 + k] * D;
#pragma unroll
                for (int i = 0; i < 8; ++i) { const uint2 y = *(const uint2*)(yr + 4 * (lane + 64 * i));
                    v[i].x += gk * bf2f((bf16_t)(y.x & 0xffffu)); v[i].y += gk * bf2f((bf16_t)(y.x >> 16)); v[i].z += gk * bf2f((bf16_t)(y.y & 0xffffu)); v[i].w += gk * bf2f((bf16_t)(y.y >> 16)); } }
            float ss = 0.f;
#pragma unroll
            for (int i = 0; i < 8; ++i) ss += v[i].x * v[i].x + v[i].y * v[i].y + v[i].z * v[i].z + v[i].w * v[i].w;
            ss = wave_sum(ss);
            float rstd = rsqrtf(ss * (1.0f / D) + NORM_EPS);
#ifdef SELFCHECK
            { const float sd = ((const float*)(ctl + CW_CHK))[0], sr = ((const float*)(ctl + CW_CHK))[1]; const float rel = sqrtf(sd / fmaxf(sr, 1e-30f)); rstd *= 1.0f + fminf(1.0f, 10.0f * rel); }
#endif
#pragma unroll
            for (int i = 0; i < 8; ++i) { const float4 wv = ((const float4*)fw)[lane + 64 * i];
                ((float4*)(a.out + (size_t)row * D))[lane + 64 * i] = make_float4(v[i].x * rstd * wv.x, v[i].y * rstd * wv.y, v[i].z * rstd * wv.z, v[i].w * rstd * wv.w); }
        }
    }
#undef IN
#undef SEAM
}

extern "C" void kernel_launch(void* const* d_in, const int* in_sizes, int n_in, void* d_out, int out_size, void* d_ws, size_t ws_size, hipStream_t stream) {
    static int grid = 0;
    if (grid == 0) {
        if (n_in != 23 || out_size != T * D || ws_size < WS_END) { fprintf(stderr, "kernel_launch: unexpected shapes (n_in %d, out %d, ws %zu < %zu)\n", n_in, out_size, ws_size, (size_t)WS_END); grid = -1; return; }
        int dev = 0, cus = 0, per_cu = 0;
        if (hipGetDevice(&dev) != hipSuccess || hipDeviceGetAttribute(&cus, hipDeviceAttributeMultiprocessorCount, dev) != hipSuccess) { grid = -1; return; }
        if (hipFuncSetAttribute((const void*)fwd, hipFuncAttributeMaxDynamicSharedMemorySize, LDS_BYTES) != hipSuccess) { fprintf(stderr, "kernel_launch: hipFuncSetAttribute failed\n"); grid = -1; return; }
        if (hipOccupancyMaxActiveBlocksPerMultiprocessor(&per_cu, (const void*)fwd, 512, LDS_BYTES) != hipSuccess || per_cu < 1) { fprintf(stderr, "kernel_launch: occupancy query says %d\n", per_cu); per_cu = 1; }
        (void)hipGetLastError();
        grid = cus;
    }
    if (grid < 0) return;
    (void)hipMemsetAsync((char*)d_ws + WS_CTL, 0, CTL_BYTES, stream);
    Args a{};
    for (int i = 0; i < 23; ++i) a.in[i] = (const float*)d_in[i];
    a.out = (float*)d_out; a.ws = (unsigned char*)d_ws;
#if N_LAUNCH_MODE == 1
    a.ph_lo = 0; a.ph_hi = N_PHASES;
    hipLaunchKernelGGL(fwd, dim3(grid), dim3(512), LDS_BYTES, stream, a);
#else
    for (int ph = 0; ph < N_PHASES; ++ph) { a.ph_lo = ph; a.ph_hi = ph + 1; hipLaunchKernelGGL(fwd, dim3(grid), dim3(512), LDS_BYTES, stream, a); }
#endif
}
```

```cpp
#include <hip/hip_runtime.h>
#include <stdint.h>
#include <stdio.h>

#ifndef N_LAUNCH_MODE
#define N_LAUNCH_MODE 1
#endif

typedef unsigned short bf16_t;
typedef short s16x4 __attribute__((ext_vector_type(4)));
typedef short s16x8 __attribute__((ext_vector_type(8)));
typedef float f32x4 __attribute__((ext_vector_type(4)));
typedef unsigned u32x4 __attribute__((ext_vector_type(4)));
typedef unsigned u32x2 __attribute__((ext_vector_type(2)));
#define LAS __attribute__((address_space(3)))

constexpr int D = 2048, BATCH = 2, SEQ = 4096, T = BATCH * SEQ;
constexpr int SSM_H = 16, SSM_N = 128;
constexpr int NSA_H = 16, DH = 64;
constexpr int CMP_HID = 512;
constexpr int N_C = 255, N_SEL = 64;
constexpr int IN_PROJ = 5696;
constexpr int OFF_Z = 0, OFF_XBC = 1024, OFF_DT = 3072, OFF_Q = 3088, OFF_KCMP = 4112, OFF_VCMP = 4368, OFF_KSLC = 4624,
              OFF_VSLC = 4880, OFF_KWIN = 5136, OFF_VWIN = 5392, OFF_GATE = 5648;
constexpr int NE = 32, DFF = 2048;
constexpr float NORM_EPS = 1e-5f;
constexpr int CMP_ROWS = BATCH * N_C * 4;
constexpr int MAX_TILES = 160, MAX_ROWS = MAX_TILES * 256;

constexpr size_t AL(size_t x) { return (x + 255) & ~(size_t)255; }
constexpr size_t WS_CTL = 0;
constexpr size_t CTL_BYTES = 32768;
constexpr size_t WS_XN = WS_CTL + CTL_BYTES;
constexpr size_t WS_PROJ = WS_XN + AL((size_t)T * D * 2);
constexpr size_t WS_XBC = WS_PROJ + AL((size_t)T * IN_PROJ * 4);
constexpr size_t WS_DT = WS_XBC + AL((size_t)T * 2048 * 4);
constexpr size_t WS_YSSD = WS_DT + AL((size_t)T * 16 * 4);
constexpr size_t WS_MIX = WS_YSSD + AL((size_t)T * 1024 * 4);
constexpr size_t WS_ROPE = WS_MIX + AL((size_t)T * 2048 * 2);
constexpr size_t WS_BLK = WS_ROPE + AL((size_t)SEQ * 16 * 4);
constexpr size_t WS_H1 = WS_BLK + AL((size_t)2 * 2048 * 2048 * 2);
constexpr size_t WS_KC = WS_H1 + AL((size_t)2 * 2048 * 512 * 2);
constexpr size_t WS_VC = WS_KC + AL((size_t)2048 * 64 * 4);
constexpr size_t WS_PCMP = WS_VC + AL((size_t)2048 * 64 * 4);
constexpr size_t WS_OCMP = WS_PCMP + AL((size_t)T * 16 * 256 * 4);
constexpr size_t WS_SEL = WS_OCMP + AL((size_t)T * 1024 * 4);
constexpr size_t WS_X2 = WS_SEL + AL((size_t)T * 4 * 8);
constexpr size_t WS_TOPE = WS_X2 + AL((size_t)T * D * 4);
constexpr size_t WS_TOPG = WS_TOPE + AL((size_t)T * 4 * 4);
constexpr size_t WS_SLOT = WS_TOPG + AL((size_t)T * 4 * 4);
constexpr size_t WS_POS = WS_SLOT + AL((size_t)T * 4 * 4);
constexpr size_t WS_ROWTOK = WS_POS + AL((size_t)T * 4 * 4);
constexpr size_t WS_ACT = WS_ROWTOK + AL((size_t)MAX_ROWS * 4);
constexpr size_t WS_Y = WS_ACT + AL((size_t)MAX_ROWS * DFF * 2);
constexpr size_t WS_QB = WS_Y + AL((size_t)MAX_ROWS * D * 2);
constexpr size_t WS_KS = WS_QB + AL((size_t)T * 1024 * 2);
constexpr size_t WS_VS = WS_KS + AL((size_t)T * 256 * 2);
constexpr size_t WS_KW = WS_VS + AL((size_t)T * 256 * 2);
constexpr size_t WS_VW = WS_KW + AL((size_t)T * 256 * 2);
constexpr size_t WS_KCB = WS_VW + AL((size_t)T * 256 * 2);
constexpr size_t WS_VCB = WS_KCB + AL((size_t)2 * 256 * 256 * 2);
constexpr size_t WS_XBCB = WS_VCB + AL((size_t)2 * 256 * 256 * 2);
constexpr size_t WS_STATES = WS_XBCB + AL((size_t)T * 2048 * 2);
constexpr size_t WS_PREV = WS_STATES + AL((size_t)2 * 32 * 16 * 64 * 128 * 4);
constexpr size_t WS_CHDEC = WS_PREV + AL((size_t)2 * 32 * 16 * 64 * 128 * 2);
constexpr size_t WS_CHK = WS_CHDEC + AL((size_t)2 * 32 * 16 * 4);
constexpr size_t WS_END = WS_CHK + AL((size_t)T * 2048 * 4);

constexpr int CW_COUNT = 4096;
constexpr int CW_ZROW = 5120;
constexpr int CW_CHK = 4160;

#define XB_TMO      128
#define XB_XCNT(j)  (256  + 64 * (j))
#define XB_XSUB(j)  (1280 + 64 * (j))
#define XB_XGEN(j)  (2304 + 64 * (j))
#define XB_TOP      3328
#define XB_TOPGEN   3392
#define XCD_BAR_WORDS 3456
#define XB_SPIN_CAP (1u << 18)

__device__ __forceinline__ unsigned xb_ld(unsigned* p)              { return __hip_atomic_load(p, __ATOMIC_RELAXED, __HIP_MEMORY_SCOPE_AGENT); }
__device__ __forceinline__ unsigned xb_add(unsigned* p, unsigned v) { return __hip_atomic_fetch_add(p, v, __ATOMIC_RELAXED, __HIP_MEMORY_SCOPE_AGENT); }
__device__ __forceinline__ unsigned xb_xcc_id() { return (unsigned)__builtin_amdgcn_s_getreg((3 << 11) | 20) & 0xFu; }
#define XB_SPIN(cond, bar) do { unsigned _sp = 0; while (cond) { __builtin_amdgcn_s_sleep(1); \
    if ((++_sp & 255u) == 0u) { if (xb_ld(&(bar)[XB_TMO])) break; if (_sp > XB_SPIN_CAP) { atomicAdd(&(bar)[XB_TMO], 1u); break; } } } } while (0)

struct XcdBarrier { unsigned* bar; unsigned x; volatile LAS unsigned* st; };

__device__ __forceinline__ XcdBarrier xcd_barrier_post(unsigned* bar, volatile LAS unsigned* st) {
    XcdBarrier b; b.bar = bar; b.x = xb_xcc_id(); b.st = st;
    if (threadIdx.x == 0) (void)xb_add(&bar[XB_XCNT(b.x)], 1u);
    return b;
}
__device__ __forceinline__ void xcd_barrier_complete(unsigned* bar, unsigned x, unsigned& nloc, unsigned& nx) {
    const unsigned G = gridDim.x * gridDim.y * gridDim.z;
    unsigned sum, cnt, mine, sp = 0u;
    for (;;) {
        sum = 0u; cnt = 0u; mine = 0u;
#pragma unroll
        for (unsigned j = 0; j < 16; ++j) { const unsigned c = xb_ld(&bar[XB_XCNT(j)]); sum += c; cnt += (c > 0u) ? 1u : 0u; mine = (j == x) ? c : mine; }
        if (sum == G) break;
        __builtin_amdgcn_s_sleep(1);
        if ((++sp & 255u) == 0u) { if (xb_ld(&bar[XB_TMO])) break; if (sp > XB_SPIN_CAP) { atomicAdd(&bar[XB_TMO], 1u); break; } }
    }
    nloc = mine > 0u ? mine : 1u; nx = cnt > 0u ? cnt : 1u;
}
__device__ __forceinline__ void xcd_barrier(const XcdBarrier& b) {
    asm volatile("s_waitcnt vmcnt(0)" ::: "memory");
    __syncthreads();
    if (threadIdx.x == 0) {
        unsigned* bar = b.bar;
        __builtin_amdgcn_s_waitcnt(0);
        unsigned nloc = b.st[0], nx = b.st[1];
        if (nloc == 0u) { xcd_barrier_complete(bar, b.x, nloc, nx); b.st[0] = nloc; b.st[1] = nx; }
        const unsigned old = xb_add(&bar[XB_XSUB(b.x)], 1u);
        const unsigned gen = old / nloc;
        if (old + 1u == (gen + 1u) * nloc) {
            __builtin_amdgcn_fence(__ATOMIC_RELEASE, "agent");
            asm volatile("s_waitcnt vmcnt(0)" ::: "memory");
            const unsigned og = xb_add(&bar[XB_TOP], 1u);
            const unsigned tg = og / nx;
            if (og + 1u == (tg + 1u) * nx) xb_add(&bar[XB_TOPGEN], 1u);
            else XB_SPIN(xb_ld(&bar[XB_TOPGEN]) == tg, bar);
            __builtin_amdgcn_fence(__ATOMIC_ACQUIRE, "agent");
            xb_add(&bar[XB_XGEN(b.x)], 1u);
            asm volatile("s_waitcnt vmcnt(0)" ::: "memory");
        } else {
            XB_SPIN(xb_ld(&bar[XB_XGEN(b.x)]) == gen, bar);
            __builtin_amdgcn_fence(__ATOMIC_ACQUIRE, "agent");
            asm volatile("s_waitcnt vmcnt(0)" ::: "memory");
        }
    }
    __syncthreads();
}

__device__ __forceinline__ bf16_t f2bf(float f) { unsigned u = __float_as_uint(f); u += 0x7FFFu + ((u >> 16) & 1u); return (bf16_t)(u >> 16); }
__device__ __forceinline__ float bf2f(bf16_t b) { return __uint_as_float(((unsigned)b) << 16); }
typedef __bf16 bf16x2_t __attribute__((ext_vector_type(2)));
typedef float f32x2_t __attribute__((ext_vector_type(2)));
__device__ __forceinline__ unsigned pack2(float lo, float hi) { const f32x2_t v = {lo, hi}; return __builtin_bit_cast(unsigned, __builtin_convertvector(v, bf16x2_t)); }
__device__ __forceinline__ float wave_sum(float v) {
#pragma unroll
    for (int o = 32; o > 0; o >>= 1) v += __shfl_xor(v, o);
    return v;
}
__device__ __forceinline__ float sigmoidf_(float x) { return 1.0f / (1.0f + __expf(-x)); }

constexpr int B_RS = 576, A_ST = 256 * 128, B_ST = 64 * B_RS, STAGE = A_ST + B_ST;
constexpr int GEMM_LDS = 2 * STAGE;
constexpr int SSD_LDS = 147456;
constexpr int MAIN_LDS = SSD_LDS > GEMM_LDS ? SSD_LDS : GEMM_LDS;
constexpr int LDS_BYTES = MAIN_LDS + 64;

template <bool PAIRED, class ALd, class BLd, class EP>
__device__ __forceinline__ void gemm_unit(LAS char* lds, const ALd& al, const BLd& bl, const EP& ep, const int K) {
    const int tid = threadIdx.x, lane = tid & 63, wid = __builtin_amdgcn_readfirstlane(tid >> 6);
    const int wr = wid >> 1, wc = wid & 1, fr = lane & 15, fq = lane >> 4;
    const char* abase = (const char*)al.wsbase;
    unsigned aoff[4];
#pragma unroll
    for (int j = 0; j < 4; ++j) aoff[j] = (unsigned)((const char*)(al.row(32 * wid + 8 * j + (lane >> 3)) + ((lane & 7) ^ (lane >> 3)) * 8) - abase);
    const char* bbase = (const char*)bl.base;
    const unsigned ldb4 = (unsigned)bl.ldb * 4u;
    unsigned boff = (unsigned)bl.coloff(4 * (tid & 63)) * 4u + (unsigned)(tid >> 6) * ldb4;
    const int bk0 = tid >> 6;
    u32x4 ra[4]; float4 rb[8];
#define G_LOAD(kt, buf) do { \
        _Pragma("unroll") for (int j = 0; j < 4; ++j) ra[j] = *(const u32x4*)(abase + aoff[j]); \
        _Pragma("unroll") for (int p = 0; p < 8; ++p) rb[p] = *(const float4*)(bbase + (boff + (unsigned)(8 * p) * ldb4)); \
        _Pragma("unroll") for (int j = 0; j < 4; ++j) aoff[j] += 128u; \
        boff += 64u * ldb4; } while (0)
#define S_WRITE(buf) do { \
        _Pragma("unroll") for (int j = 0; j < 4; ++j) *(LAS u32x4*)(lds + (buf) * STAGE + (4 * wid + j) * 1024 + lane * 16) = ra[j]; \
        LAS char* wb = lds + (buf) * STAGE + A_ST + bk0 * B_RS + (tid & 63) * 8; \
        _Pragma("unroll") for (int p = 0; p < 8; ++p) *(LAS u32x2*)(wb + 8 * p * B_RS) = (u32x2){pack2(rb[p].x, rb[p].y), pack2(rb[p].z, rb[p].w)}; } while (0)
    f32x4 acc[4][8];
#pragma unroll
    for (int m = 0; m < 4; ++m)
#pragma unroll
        for (int n = 0; n < 8; ++n) acc[m][n] = (f32x4){0.f, 0.f, 0.f, 0.f};
    const int nk = K / 64;
    const int a_off0 = (wr * 64 + fr) * 128 + ((fq ^ (fr & 7)) * 16);
    const int a_off1 = (wr * 64 + fr) * 128 + (((4 + fq) ^ (fr & 7)) * 16);
    const int b_off = A_ST + (8 * fq + ((lane & 15) >> 2)) * B_RS + (wc * 128 + 4 * (lane & 3)) * 2;
    G_LOAD(0, 0);
    S_WRITE(0);
    __syncthreads();
    for (int kt = 0; kt < nk; ++kt) {
        const int buf = kt & 1;
        if (kt + 1 < nk) G_LOAD(kt + 1, buf ^ 1);
        __builtin_amdgcn_sched_barrier(0);
        LAS char* sbase = lds + buf * STAGE;
#pragma unroll
        for (int ks = 0; ks < 2; ++ks) {
            s16x8 af[4];
#pragma unroll
            for (int m = 0; m < 4; ++m) af[m] = *(const LAS s16x8*)(sbase + (ks ? a_off1 : a_off0) + m * 16 * 128);
#pragma unroll
            for (int n = 0; n < 8; ++n) {
                const s16x4 t0 = __builtin_amdgcn_ds_read_tr16_b64_v4i16((LAS s16x4*)(sbase + b_off + ks * 32 * B_RS + n * 32));
                const s16x4 t1 = __builtin_amdgcn_ds_read_tr16_b64_v4i16((LAS s16x4*)(sbase + b_off + ks * 32 * B_RS + n * 32 + 4 * B_RS));
                const s16x8 bfr = {t0[0], t0[1], t0[2], t0[3], t1[0], t1[1], t1[2], t1[3]};
#pragma unroll
                for (int m = 0; m < 4; ++m) acc[m][n] = __builtin_amdgcn_mfma_f32_16x16x32_bf16(bfr, af[m], acc[m][n], 0, 0, 0);
            }
        }
        __builtin_amdgcn_sched_barrier(0);
        if (kt + 1 < nk) S_WRITE(buf ^ 1);
        __syncthreads();
    }
#undef G_LOAD
#undef S_WRITE
#pragma unroll
    for (int m = 0; m < 4; ++m) {
        const int r = wr * 64 + m * 16 + fr;
        if constexpr (PAIRED) {
#pragma unroll
            for (int n = 0; n < 4; ++n) ep.pair(r, wc * 64 + n * 16 + 4 * fq, acc[m][n], acc[m][n + 4]);
        } else {
#pragma unroll
            for (int n = 0; n < 8; ++n) ep(r, wc * 128 + n * 16 + 4 * fq, acc[m][n]);
        }
    }
}

constexpr int KV_RS = 144, KT_BYTES = 64 * KV_RS;
constexpr int ATT_IMP_OFF = 4 * KT_BYTES;
constexpr int ATT_MASK_OFF = ATT_IMP_OFF + 64 * 64 * 4;
struct GState { f32x4 o[4]; float m, l; };

template <int MODE>
__device__ __forceinline__ void attn_block(const LAS char* kt, const LAS char* vt, const int lane, const s16x8 (&qf)[2][2], GState (&st)[2],
                                           const bool (&act)[2], const int key0, const int (&lo)[2], const int (&hi)[2],
                                           LAS float* imp, const int (&tokl)[2], float (&carry)[2], const int jb) {
    const int c16 = lane & 15, fq = lane >> 4;
    const bool on[2] = {__ballot(act[0]) != 0ull, __ballot(act[1]) != 0ull};
    f32x4 s[2][4];
#pragma unroll
    for (int mt = 0; mt < 4; ++mt) {
        const s16x8 k0 = *(const LAS s16x8*)(kt + (16 * mt + c16) * KV_RS + (8 * fq) * 2);
        const s16x8 k1 = *(const LAS s16x8*)(kt + (16 * mt + c16) * KV_RS + (32 + 8 * fq) * 2);
#pragma unroll
        for (int gi = 0; gi < 2; ++gi) { s[gi][mt] = (f32x4){0.f, 0.f, 0.f, 0.f};
            if (on[gi]) { s[gi][mt] = __builtin_amdgcn_mfma_f32_16x16x32_bf16(k0, qf[gi][0], s[gi][mt], 0, 0, 0); s[gi][mt] = __builtin_amdgcn_mfma_f32_16x16x32_bf16(k1, qf[gi][1], s[gi][mt], 0, 0, 0); } }
    }
    s16x8 pf[2][2];
#pragma unroll
    for (int gi = 0; gi < 2; ++gi) {
        if (!on[gi]) continue;
        float mx = -INFINITY;
#pragma unroll
        for (int mt = 0; mt < 4; ++mt)
#pragma unroll
            for (int i = 0; i < 4; ++i) { const int key = key0 + 16 * mt + 4 * fq + i; const bool ok = act[gi] && key >= lo[gi] && key <= hi[gi];
                s[gi][mt][i] = ok ? s[gi][mt][i] : -INFINITY; mx = fmaxf(mx, s[gi][mt][i]); }
        float msafe, scale = 1.0f;
        if (MODE == 2) { msafe = (st[gi].m == -INFINITY) ? 0.f : st[gi].m; scale = st[gi].l; }
        else {
            mx = fmaxf(mx, __shfl_xor(mx, 16)); mx = fmaxf(mx, __shfl_xor(mx, 32));
            const float mnew = fmaxf(st[gi].m, mx);
            const float alpha = (mnew == -INFINITY) ? 1.0f : __expf(st[gi].m - mnew);
            msafe = (mnew == -INFINITY) ? 0.f : mnew;
            st[gi].m = mnew; st[gi].l *= alpha;
            if (MODE == 0) {
#pragma unroll
                for (int md = 0; md < 4; ++md) st[gi].o[md] *= alpha;
            }
        }
        float rs = 0.f;
#pragma unroll
        for (int mt = 0; mt < 4; ++mt)
#pragma unroll
            for (int i = 0; i < 4; ++i) { const float pv = __expf(s[gi][mt][i] - msafe) * scale; s[gi][mt][i] = pv; rs += pv; }
        if (MODE != 2) { rs += __shfl_xor(rs, 16); rs += __shfl_xor(rs, 32); st[gi].l += rs; }
        if (MODE == 2) {
#pragma unroll
            for (int mt = 0; mt < 4; ++mt) {
                const float tcur = __shfl(s[gi][mt][3], (lane - 16) & 63);
                const float tprv = __shfl(mt > 0 ? s[gi][mt > 0 ? mt - 1 : 0][3] : carry[gi], (lane - 16) & 63);
                const float prev = fq > 0 ? tcur : tprv;
                float part = 32.f * (s[gi][mt][0] + s[gi][mt][1] + s[gi][mt][2]) + 16.f * s[gi][mt][3] + 16.f * prev;
                part += __shfl_xor(part, 1); part += __shfl_xor(part, 2);
                if ((c16 & 3) == 0) imp[tokl[gi] * 64 + 16 * jb + 4 * mt + fq] = part;
            }
            carry[gi] = s[gi][3][3];
        }
        if (MODE != 1) {
#pragma unroll
            for (int ks = 0; ks < 2; ++ks) {
                const u32x4 w = {pack2(s[gi][2 * ks][0], s[gi][2 * ks][1]), pack2(s[gi][2 * ks][2], s[gi][2 * ks][3]),
                                 pack2(s[gi][2 * ks + 1][0], s[gi][2 * ks + 1][1]), pack2(s[gi][2 * ks + 1][2], s[gi][2 * ks + 1][3])};
                pf[gi][ks] = __builtin_bit_cast(s16x8, w);
            }
        }
    }
    if (MODE != 1) {
        const int q = c16 >> 2, p = c16 & 3;
#pragma unroll
        for (int md = 0; md < 4; ++md) {
            s16x8 vf[2];
#pragma unroll
            for (int ks = 0; ks < 2; ++ks) {
                const s16x4 t0 = __builtin_amdgcn_ds_read_tr16_b64_v4i16((LAS s16x4*)(vt + (32 * ks + 4 * fq + q) * KV_RS + (16 * md + 4 * p) * 2));
                const s16x4 t1 = __builtin_amdgcn_ds_read_tr16_b64_v4i16((LAS s16x4*)(vt + (32 * ks + 16 + 4 * fq + q) * KV_RS + (16 * md + 4 * p) * 2));
                vf[ks] = (s16x8){t0[0], t0[1], t0[2], t0[3], t1[0], t1[1], t1[2], t1[3]};
            }
#pragma unroll
            for (int gi = 0; gi < 2; ++gi)
                if (on[gi]) { st[gi].o[md] = __builtin_amdgcn_mfma_f32_16x16x32_bf16(vf[0], pf[gi][0], st[gi].o[md], 0, 0, 0); st[gi].o[md] = __builtin_amdgcn_mfma_f32_16x16x32_bf16(vf[1], pf[gi][1], st[gi].o[md], 0, 0, 0); }
        }
    }
}

#define ATT_GLOAD(Kg, Vg, row0) do { const size_t _o = ((size_t)(row0) + (tid >> 3)) * 256 + g * 64 + (tid & 7) * 8; rk = *(const u32x4*)((Kg) + _o); rv = *(const u32x4*)((Vg) + _o); } while (0)
#define ATT_SWRITE(buf) do { LAS char* _k = lds + (buf) * 2 * KT_BYTES + (tid >> 3) * KV_RS + (tid & 7) * 16; *(LAS u32x4*)_k = rk; *(LAS u32x4*)(_k + KT_BYTES) = rv; } while (0)

__device__ __forceinline__ void nsa_unit(LAS char* lds, const int unit, const bf16_t* QB, const bf16_t* KS, const bf16_t* VS, const bf16_t* KW, const bf16_t* VW,
                                         const bf16_t* KCB, const bf16_t* VCB, const float* PROJ, bf16_t* MIX) {
    const int tid = threadIdx.x, lane = tid & 63, wid = tid >> 6, c16 = lane & 15, fq = lane >> 4;
    const int qt = unit >> 3, b = (unit >> 2) & 1, g = unit & 3;
    const int t0 = qt * 64;
    LAS float* imp = (LAS float*)(lds + ATT_IMP_OFF);
    LAS unsigned* lmask = (LAS unsigned*)(lds + ATT_MASK_OFF);
    int tokl[2], tpos[2]; s16x8 qf[2][2]; float gate[2][3];
#pragma unroll
    for (int gi = 0; gi < 2; ++gi) {
        tokl[gi] = 8 * wid + 4 * gi + (c16 >> 2); tpos[gi] = t0 + tokl[gi];
        const size_t tt = (size_t)b * SEQ + tpos[gi]; const int hq = g * 4 + (c16 & 3);
#pragma unroll
        for (int ks = 0; ks < 2; ++ks) qf[gi][ks] = *(const s16x8*)(QB + tt * 1024 + hq * 64 + 32 * ks + 8 * fq);
        const float* gl = PROJ + tt * IN_PROJ + OFF_GATE + hq * 3;
        gate[gi][0] = sigmoidf_(gl[0]); gate[gi][1] = sigmoidf_(gl[1]); gate[gi][2] = sigmoidf_(gl[2]);
    }
    for (int i = tid; i < 64 * 64; i += 512) imp[i] = 0.f;
    f32x4 res[2][4];
    GState st[2]; bool act[2]; int lo[2], hi[2]; float carry[2] = {0.f, 0.f};
    u32x4 rk, rv;
    const bf16_t* KCg = KCB + (size_t)b * 256 * 256; const bf16_t* VCg = VCB + (size_t)b * 256 * 256;
    const bf16_t* KSg = KS + (size_t)b * SEQ * 256; const bf16_t* VSg = VS + (size_t)b * SEQ * 256;
    const bf16_t* KWg = KW + (size_t)b * SEQ * 256; const bf16_t* VWg = VW + (size_t)b * SEQ * 256;
    const int cmax_u = (t0 + 63 - 31) >> 4;
    const int ncb = cmax_u < 0 ? 0 : min(4, (cmax_u + 1) / 64 + 1);
#pragma unroll
    for (int gi = 0; gi < 2; ++gi) { act[gi] = true; lo[gi] = 0; hi[gi] = tpos[gi] >= 31 ? ((tpos[gi] - 31) >> 4) : -1; st[gi].m = -INFINITY; st[gi].l = 0.f;
#pragma unroll
        for (int md = 0; md < 4; ++md) st[gi].o[md] = (f32x4){0.f, 0.f, 0.f, 0.f}; }
    __syncthreads();
    if (ncb > 0) {
        ATT_GLOAD(KCg, VCg, 0); ATT_SWRITE(0); __syncthreads();
        for (int jb = 0; jb < ncb; ++jb) {
            if (jb + 1 < ncb) ATT_GLOAD(KCg, VCg, 64 * (jb + 1));
            attn_block<1>(lds + (jb & 1) * 2 * KT_BYTES, lds + (jb & 1) * 2 * KT_BYTES + KT_BYTES, lane, qf, st, act, 64 * jb, lo, hi, imp, tokl, carry, jb);
            if (jb + 1 < ncb) ATT_SWRITE((jb + 1) & 1);
            __syncthreads();
        }
#pragma unroll
        for (int gi = 0; gi < 2; ++gi) st[gi].l = st[gi].l > 0.f ? 1.0f / st[gi].l : 0.f;
        ATT_GLOAD(KCg, VCg, 0); ATT_SWRITE(0); __syncthreads();
        for (int jb = 0; jb < ncb; ++jb) {
            if (jb + 1 < ncb) ATT_GLOAD(KCg, VCg, 64 * (jb + 1));
            attn_block<2>(lds + (jb & 1) * 2 * KT_BYTES, lds + (jb & 1) * 2 * KT_BYTES + KT_BYTES, lane, qf, st, act, 64 * jb, lo, hi, imp, tokl, carry, jb);
            if (jb + 1 < ncb) ATT_SWRITE((jb + 1) & 1);
            __syncthreads();
        }
    }
#pragma unroll
    for (int gi = 0; gi < 2; ++gi)
#pragma unroll
        for (int md = 0; md < 4; ++md) res[gi][md] = st[gi].o[md] * gate[gi][0];
    __syncthreads();
    for (int k = 0; k < 8; ++k) {
        const int tl = 8 * wid + k, j = lane;
        const float iv = imp[tl * 64 + j];
        const bool forced = (j == 0) || (j == qt) || (j == qt - 1), valid = j <= qt;
        const float sc = forced ? 1.0e4f : (valid ? iv : -1.0e4f);
        int rank = 0;
#pragma unroll
        for (int kk = 0; kk < 64; ++kk) { const float o = __shfl(sc, kk); rank += (o > sc || (o == sc && kk < j)) ? 1 : 0; }
        const unsigned long long m64 = __ballot(rank < 16 && valid);
        if (lane == 0) { lmask[tl * 2] = (unsigned)m64; lmask[tl * 2 + 1] = (unsigned)(m64 >> 32); }
    }
    __syncthreads();
    unsigned long long msk[2]; unsigned long long wunion;
    {
#pragma unroll
        for (int gi = 0; gi < 2; ++gi) msk[gi] = (unsigned long long)lmask[tokl[gi] * 2] | ((unsigned long long)lmask[tokl[gi] * 2 + 1] << 32);
        unsigned ul = (unsigned)(msk[0] | msk[1]), uh = (unsigned)((msk[0] | msk[1]) >> 32);
#pragma unroll
        for (int o = 1; o < 64; o <<= 1) { ul |= __shfl_xor(ul, o); uh |= __shfl_xor(uh, o); }
        wunion = (unsigned long long)ul | ((unsigned long long)uh << 32);
    }
#pragma unroll
    for (int gi = 0; gi < 2; ++gi) { lo[gi] = 0; hi[gi] = tpos[gi]; st[gi].m = -INFINITY; st[gi].l = 0.f;
#pragma unroll
        for (int md = 0; md < 4; ++md) st[gi].o[md] = (f32x4){0.f, 0.f, 0.f, 0.f}; }
    ATT_GLOAD(KSg, VSg, 0); ATT_SWRITE(0); __syncthreads();
    for (int j = 0; j <= qt; ++j) {
        if (j + 1 <= qt) ATT_GLOAD(KSg, VSg, 64 * (j + 1));
        if ((wunion >> j) & 1ull) {
            act[0] = (msk[0] >> j) & 1ull; act[1] = (msk[1] >> j) & 1ull;
            attn_block<0>(lds + (j & 1) * 2 * KT_BYTES, lds + (j & 1) * 2 * KT_BYTES + KT_BYTES, lane, qf, st, act, 64 * j, lo, hi, imp, tokl, carry, 0);
        }
        if (j + 1 <= qt) ATT_SWRITE((j + 1) & 1);
        __syncthreads();
    }
#pragma unroll
    for (int gi = 0; gi < 2; ++gi) { const float il = gate[gi][1] / fmaxf(st[gi].l, 1e-30f);
#pragma unroll
        for (int md = 0; md < 4; ++md) res[gi][md] += st[gi].o[md] * il; }
#pragma unroll
    for (int gi = 0; gi < 2; ++gi) { act[gi] = true; lo[gi] = tpos[gi] - 511; hi[gi] = tpos[gi]; st[gi].m = -INFINITY; st[gi].l = 0.f;
#pragma unroll
        for (int md = 0; md < 4; ++md) st[gi].o[md] = (f32x4){0.f, 0.f, 0.f, 0.f}; }
    const int jw0 = qt >= 8 ? qt - 8 : 0;
    ATT_GLOAD(KWg, VWg, 64 * jw0); ATT_SWRITE(jw0 & 1); __syncthreads();
    for (int j = jw0; j <= qt; ++j) {
        if (j + 1 <= qt) ATT_GLOAD(KWg, VWg, 64 * (j + 1));
        attn_block<0>(lds + (j & 1) * 2 * KT_BYTES, lds + (j & 1) * 2 * KT_BYTES + KT_BYTES, lane, qf, st, act, 64 * j, lo, hi, imp, tokl, carry, 0);
        if (j + 1 <= qt) ATT_SWRITE((j + 1) & 1);
        __syncthreads();
    }
#pragma unroll
    for (int gi = 0; gi < 2; ++gi) { const float il = gate[gi][2] / fmaxf(st[gi].l, 1e-30f);
        bf16_t* mp = MIX + ((size_t)b * SEQ + tpos[gi]) * 2048 + 1024 + (g * 4 + (c16 & 3)) * 64 + 4 * fq;
#pragma unroll
        for (int md = 0; md < 4; ++md) { const f32x4 r = res[gi][md] + st[gi].o[md] * il;
            *(uint2*)(mp + 16 * md) = make_uint2(pack2(r[0], r[1]), pack2(r[2], r[3])); } }
}
#undef ATT_GLOAD
#undef ATT_SWRITE

constexpr int SX_RS = 144, SX_H = 128 * SX_RS, SB_RS = 272, SB_BYTES = 128 * SB_RS;
constexpr int SSD_X_OFF = 0, SSD_B_OFF = 4 * SX_H, SSD_C_OFF = SSD_B_OFF + SB_BYTES, SSD_T_OFF = SSD_C_OFF + SB_BYTES;
static_assert(SSD_T_OFF + 4096 <= SSD_LDS, "ssd lds");

template <bool WITH_C>
__device__ __forceinline__ void ssd_stage(LAS char* lds, const bf16_t* XBCB, const float* DT, const float* a_log, const int b, const int c, const int grp) {
    const int tid = threadIdx.x;
    const size_t tt0 = (size_t)b * SEQ + c * 128;
#pragma unroll
    for (int k = 0; k < 8; ++k) { const int id = tid + 512 * k, l = id >> 5, ch = id & 31, h = ch >> 3, pc = ch & 7;
        const u32x4 v = *(const u32x4*)(XBCB + (tt0 + l) * 2048 + grp * 256 + ch * 8);
        *(LAS u32x4*)(lds + SSD_X_OFF + h * SX_H + l * SX_RS + pc * 16) = v; }
#pragma unroll
    for (int k = 0; k < 4; ++k) { const int id = tid + 512 * k, l = id >> 4, ch = id & 15;
        const u32x4 v = *(const u32x4*)(XBCB + (tt0 + l) * 2048 + 1024 + grp * 128 + ch * 8);
        *(LAS u32x4*)(lds + SSD_B_OFF + l * SB_RS + ch * 16) = v;
        if (WITH_C) { const u32x4 w = *(const u32x4*)(XBCB + (tt0 + l) * 2048 + 1536 + grp * 128 + ch * 8);
            *(LAS u32x4*)(lds + SSD_C_OFF + l * SB_RS + ch * 16) = w; } }
    LAS float* dtl = (LAS float*)(lds + SSD_T_OFF); LAS float* acs = dtl + 512;
    const int h = tid >> 7, l = tid & 127;
    const float av = -expf(a_log[grp * 4 + h]);
    const float dtv = DT[(tt0 + l) * 16 + grp * 4 + h];
    dtl[tid] = dtv; acs[tid] = dtv * av;
    __syncthreads();
    float cs = 0.f;
    for (int k = 0; k <= l; ++k) cs += acs[h * 128 + k];
    __syncthreads();
    acs[tid] = cs;
    __syncthreads();
}

__device__ __forceinline__ void ssd_states_item(LAS char* lds, const int item, const bf16_t* XBCB, const float* DT, const float* a_log, float* STATES, float* CHDEC) {
    const int tid = threadIdx.x, lane = tid & 63, wid = tid >> 6, c16 = lane & 15, fq = lane >> 4, q = c16 >> 2, pp = c16 & 3;
    const int grp = item & 3, c = (item >> 2) & 31, b = item >> 7;
    __syncthreads();
    ssd_stage<false>(lds, XBCB, DT, a_log, b, c, grp);
    LAS float* dtl = (LAS float*)(lds + SSD_T_OFF); LAS float* acs = dtl + 512;
#pragma unroll
    for (int k = 0; k < 8; ++k) { const int id = tid + 512 * k, l = id >> 5, ch = id & 31, h = ch >> 3, pc = ch & 7;
        const float w = __expf(acs[h * 128 + 127] - acs[h * 128 + l]) * dtl[h * 128 + l];
        LAS u32x4* pv = (LAS u32x4*)(lds + SSD_X_OFF + h * SX_H + l * SX_RS + pc * 16);
        u32x4 v = *pv;
#pragma unroll
        for (int e = 0; e < 4; ++e) { const float lo = __uint_as_float(v[e] << 16) * w, hi = __uint_as_float(v[e] & 0xffff0000u) * w; v[e] = pack2(lo, hi); }
        *pv = v; }
    if (tid < 4) CHDEC[((size_t)b * 32 + c) * 16 + grp * 4 + tid] = __expf(acs[tid * 128 + 127]);
    __syncthreads();
    s16x8 af[4];
#pragma unroll
    for (int ks = 0; ks < 4; ++ks) {
        const s16x4 t0 = __builtin_amdgcn_ds_read_tr16_b64_v4i16((LAS s16x4*)(lds + SSD_B_OFF + (32 * ks + 8 * fq + q) * SB_RS + (16 * wid + 4 * pp) * 2));
        const s16x4 t1 = __builtin_amdgcn_ds_read_tr16_b64_v4i16((LAS s16x4*)(lds + SSD_B_OFF + (32 * ks + 8 * fq + 4 + q) * SB_RS + (16 * wid + 4 * pp) * 2));
        af[ks] = (s16x8){t0[0], t0[1], t0[2], t0[3], t1[0], t1[1], t1[2], t1[3]};
    }
#pragma unroll
    for (int h = 0; h < 4; ++h) {
        float* sp = STATES + (((size_t)b * 32 + c) * 16 + grp * 4 + h) * 8192;
#pragma unroll
        for (int pt = 0; pt < 4; ++pt) {
            f32x4 acc = {0.f, 0.f, 0.f, 0.f};
#pragma unroll
            for (int ks = 0; ks < 4; ++ks) {
                const s16x4 t0 = __builtin_amdgcn_ds_read_tr16_b64_v4i16((LAS s16x4*)(lds + SSD_X_OFF + h * SX_H + (32 * ks + 8 * fq + q) * SX_RS + (16 * pt + 4 * pp) * 2));
                const s16x4 t1 = __builtin_amdgcn_ds_read_tr16_b64_v4i16((LAS s16x4*)(lds + SSD_X_OFF + h * SX_H + (32 * ks + 8 * fq + 4 + q) * SX_RS + (16 * pt + 4 * pp) * 2));
                const s16x8 bfr = {t0[0], t0[1], t0[2], t0[3], t1[0], t1[1], t1[2], t1[3]};
                acc = __builtin_amdgcn_mfma_f32_16x16x32_bf16(af[ks], bfr, acc, 0, 0, 0);
            }
            *(f32x4*)(sp + (size_t)(16 * pt + c16) * 128 + 16 * wid + 4 * fq) = acc;
        }
    }
}

__device__ __forceinline__ void ssd_out_item(LAS char* lds, const int item, const bf16_t* XBCB, const float* DT, const float* a_log, const float* d_skip, const float* nw,
                                             const bf16_t* PREV, const float* PROJ, float* YTMP, bf16_t* MIXO) {
    const int tid = threadIdx.x, lane = tid & 63, wid = tid >> 6, c16 = lane & 15, fq = lane >> 4, q = c16 >> 2, pp = c16 & 3;
    const int grp = item & 3, c = (item >> 2) & 31, b = item >> 7;
    __syncthreads();
    ssd_stage<true>(lds, XBCB, DT, a_log, b, c, grp);
    LAS float* dtl = (LAS float*)(lds + SSD_T_OFF); LAS float* acs = dtl + 512;
    const int lcol = 16 * wid + c16;
    const size_t tt = (size_t)b * SEQ + c * 128 + lcol;
    s16x8 cf[4];
#pragma unroll
    for (int ks = 0; ks < 4; ++ks) cf[ks] = *(const LAS s16x8*)(lds + SSD_C_OFF + lcol * SB_RS + (32 * ks + 8 * fq) * 2);
    f32x4 g[8];
#pragma unroll
    for (int mt = 0; mt < 8; ++mt) { g[mt] = (f32x4){0.f, 0.f, 0.f, 0.f};
        if (mt <= wid) {
#pragma unroll
            for (int ks = 0; ks < 4; ++ks) { const s16x8 bfr = *(const LAS s16x8*)(lds + SSD_B_OFF + (16 * mt + c16) * SB_RS + (32 * ks + 8 * fq) * 2);
                g[mt] = __builtin_amdgcn_mfma_f32_16x16x32_bf16(bfr, cf[ks], g[mt], 0, 0, 0); } } }
    float ss = 0.f;
#pragma unroll 1
    for (int h = 0; h < 4; ++h) {
        const int hh = grp * 4 + h;
        const float acs_l = acs[h * 128 + lcol];
        s16x8 pf[4];
#pragma unroll
        for (int ks = 0; ks < 4; ++ks) {
            float pv[2][4];
#pragma unroll
            for (int u = 0; u < 2; ++u)
#pragma unroll
                for (int i = 0; i < 4; ++i) { const int sidx = 32 * ks + 16 * u + 4 * fq + i;
                    const float e = (sidx <= lcol) ? __expf(acs_l - acs[h * 128 + sidx]) * dtl[h * 128 + sidx] : 0.f;
                    pv[u][i] = g[2 * ks + u][i] * e; }
            const u32x4 w = {pack2(pv[0][0], pv[0][1]), pack2(pv[0][2], pv[0][3]), pack2(pv[1][0], pv[1][1]), pack2(pv[1][2], pv[1][3])};
            pf[ks] = __builtin_bit_cast(s16x8, w);
        }
        const float dsk = d_skip[hh], eal = __expf(acs_l);
        const bf16_t* prevp = PREV + (((size_t)b * 32 + c) * 16 + hh) * 8192;
#pragma unroll
        for (int pt = 0; pt < 4; ++pt) {
            f32x4 yd = {0.f, 0.f, 0.f, 0.f}, yo = {0.f, 0.f, 0.f, 0.f};
#pragma unroll
            for (int ks = 0; ks < 4; ++ks) {
                if (2 * ks <= wid) {
                    const s16x4 t0 = __builtin_amdgcn_ds_read_tr16_b64_v4i16((LAS s16x4*)(lds + SSD_X_OFF + h * SX_H + (32 * ks + 4 * fq + q) * SX_RS + (16 * pt + 4 * pp) * 2));
                    const s16x4 t1 = __builtin_amdgcn_ds_read_tr16_b64_v4i16((LAS s16x4*)(lds + SSD_X_OFF + h * SX_H + (32 * ks + 16 + 4 * fq + q) * SX_RS + (16 * pt + 4 * pp) * 2));
                    const s16x8 xf = {t0[0], t0[1], t0[2], t0[3], t1[0], t1[1], t1[2], t1[3]};
                    yd = __builtin_amdgcn_mfma_f32_16x16x32_bf16(xf, pf[ks], yd, 0, 0, 0);
                }
                const s16x8 pr = *(const s16x8*)(prevp + (size_t)(16 * pt + c16) * 128 + 32 * ks + 8 * fq);
                yo = __builtin_amdgcn_mfma_f32_16x16x32_bf16(pr, cf[ks], yo, 0, 0, 0);
            }
            const u32x2 xr = *(const LAS u32x2*)(lds + SSD_X_OFF + h * SX_H + lcol * SX_RS + (16 * pt + 4 * fq) * 2);
            const float xv[4] = {__uint_as_float(xr[0] << 16), __uint_as_float(xr[0] & 0xffff0000u), __uint_as_float(xr[1] << 16), __uint_as_float(xr[1] & 0xffff0000u)};
            const f32x4 z = *(const f32x4*)(PROJ + tt * IN_PROJ + OFF_Z + hh * 64 + 16 * pt + 4 * fq);
            f32x4 gvv;
#pragma unroll
            for (int i = 0; i < 4; ++i) { const float y = yd[i] + eal * yo[i] + dsk * xv[i]; gvv[i] = y * z[i] * sigmoidf_(z[i]); ss += gvv[i] * gvv[i]; }
            *(f32x4*)(YTMP + tt * 1024 + hh * 64 + 16 * pt + 4 * fq) = gvv;
        }
    }
    ss += __shfl_xor(ss, 16); ss += __shfl_xor(ss, 32);
    const float rs = rsqrtf(ss * (1.0f / 256.f) + NORM_EPS);
#pragma unroll 1
    for (int h = 0; h < 4; ++h)
#pragma unroll
        for (int pt = 0; pt < 4; ++pt) { const int ch = (grp * 4 + h) * 64 + 16 * pt + 4 * fq; const f32x4 w4 = *(const f32x4*)(nw + ch);
            const f32x4 gvv = *(const f32x4*)(YTMP + tt * 1024 + ch);
            *(uint2*)(MIXO + tt * 2048 + ch) = make_uint2(pack2(gvv[0] * rs * w4[0], gvv[1] * rs * w4[1]), pack2(gvv[2] * rs * w4[2], gvv[3] * rs * w4[3])); }
}

struct Args {
    const float* in[23];
    float* out;
    unsigned char* ws;
    int ph_lo, ph_hi;
};

enum { PH_NORM1 = 0, PH_INPROJ, PH_PREP, PH_SSD_CMP1, PH_GNORM_CMP2,
#ifdef SELFCHECK
       PH_CMPATT, PH_SELECT, PH_SELWIN,
#endif
       PH_NSA,
#ifdef SELFCHECK
       PH_CHECK,
#endif
       PH_OUTPROJ, PH_ROUTER, PH_SCATTER, PH_GATEUP, PH_DOWN, PH_FINAL, N_PHASES };

struct ARowsDense { const bf16_t* base; size_t ld; int row0, nrows; const bf16_t* zrow; const void* wsbase;
    __device__ __forceinline__ const bf16_t* row(int r) const { const int g = row0 + r; return g < nrows ? base + (size_t)g * ld : zrow; } };
struct ARowsGather { const bf16_t* base; size_t ld; const int* idx; const bf16_t* zrow; const void* wsbase;
    __device__ __forceinline__ const bf16_t* row(int r) const { const int g = idx[r]; return g >= 0 ? base + (size_t)g * ld : zrow; } };
struct BColsDense { const float* base; int ldb; int col0, ncols;
    __device__ __forceinline__ int coloff(int n) const { const int c = col0 + n; return c < ncols ? c : ncols - 4; } };
struct BColsGateUp { const float* base; int ldb; int cn;
    __device__ __forceinline__ int coloff(int n) const { const int wc = n >> 7, nt = (n & 127) >> 4, w = n & 15; const int j = wc * 64 + (nt & 3) * 16 + w;
        return (nt < 4 ? 0 : DFF) + cn * 128 + j; } };

struct EpiStoreF32 { float* C; size_t ldc; int row0, col0, ncols;
    __device__ __forceinline__ void operator()(int r, int n, f32x4 v) const { const int c = col0 + n; if (c < ncols) *(f32x4*)(C + (size_t)(row0 + r) * ldc + c) = v; } };
struct EpiResidF32 { float* C; const float* X; size_t ldc; int row0, col0;
    __device__ __forceinline__ void operator()(int r, int n, f32x4 v) const { const size_t o = (size_t)(row0 + r) * ldc + col0 + n; const f32x4 x = *(const f32x4*)(X + o); *(f32x4*)(C + o) = v + x; } };
struct EpiGeluBf16 { bf16_t* O; const float* bias; size_t ldo; int row0, col0, nrows;
    __device__ __forceinline__ void operator()(int r, int n, f32x4 v) const { const int g = row0 + r; if (g >= nrows) return; const int c = col0 + n;
        float o[4];
#pragma unroll
        for (int i = 0; i < 4; ++i) { const float x = v[i] + bias[c + i]; const float u = 0.7978845608028654f * (x + 0.044715f * x * x * x); o[i] = 0.5f * x * (1.0f + tanhf(u)); }
        *(uint2*)(O + (size_t)g * ldo + c) = make_uint2(pack2(o[0], o[1]), pack2(o[2], o[3])); } };
struct EpiSwiglu { bf16_t* O; const float* bias; int row0, cn;
    __device__ __forceinline__ void pair(int r, int j, f32x4 g, f32x4 u) const { const int c = cn * 128 + j; float o[4];
#pragma unroll
        for (int i = 0; i < 4; ++i) { float gv = g[i] + bias[c + i]; float uv = u[i] + bias[DFF + c + i]; gv = fminf(gv, 7.0f); uv = fminf(fmaxf(uv, -7.0f), 7.0f);
            const float glu = gv * sigmoidf_(1.702f * gv); o[i] = (uv + 1.0f) * glu; }
        *(uint2*)(O + (size_t)(row0 + r) * DFF + c) = make_uint2(pack2(o[0], o[1]), pack2(o[2], o[3])); } };
struct EpiBiasBf16 { bf16_t* O; const float* bias; int row0, col0;
    __device__ __forceinline__ void operator()(int r, int n, f32x4 v) const { const int c = col0 + n;
        *(uint2*)(O + (size_t)(row0 + r) * D + c) = make_uint2(pack2(v[0] + bias[c], v[1] + bias[c + 1]), pack2(v[2] + bias[c + 2], v[3] + bias[c + 3])); } };

__device__ __forceinline__ float rope_inv(int i) { return (float)exp(-(double)i * 0.125 * 13.122363377404328); }

__global__ void __launch_bounds__(512, 2) fwd(Args a) {
    extern __shared__ __attribute__((aligned(16))) unsigned char lds_raw[];
    LAS char* lds = (LAS char*)lds_raw;
    const int tid = threadIdx.x, lane = tid & 63, wid = __builtin_amdgcn_readfirstlane(tid >> 6);
    const int G = gridDim.x, bid = blockIdx.x;
    const int gtid = bid * 512 + tid, gthreads = G * 512;
    const int gwave = bid * 8 + wid, gwaves = G * 8;
    unsigned char* ws = a.ws;
    unsigned* ctl = (unsigned*)(ws + WS_CTL);
    volatile LAS unsigned* barw = (volatile LAS unsigned*)(lds + MAIN_LDS);
    if (tid == 0) { barw[0] = 0u; barw[1] = 0u; barw[2] = 0u; barw[3] = 0u; }
    __syncthreads();
    XcdBarrier bar; bar.bar = ctl; bar.x = 0; bar.st = barw;
    const bool multi = (a.ph_hi - a.ph_lo) > 1;
    if (multi) bar = xcd_barrier_post(ctl, barw);
#ifdef ONLY_PH
#define IN(k) ((k) == ONLY_PH)
#else
#define IN(k) (a.ph_lo <= (k) && (k) < a.ph_hi)
#endif
#define SEAM(k) do { if ((k) + 1 < a.ph_hi) xcd_barrier(bar); } while (0)

#define XN ((bf16_t*)(ws + WS_XN))
#define PROJ ((float*)(ws + WS_PROJ))
#define XBC ((float*)(ws + WS_XBC))
#define DT ((float*)(ws + WS_DT))
#define YSSD ((float*)(ws + WS_YSSD))
#define MIX ((bf16_t*)(ws + WS_MIX))
#define ROPE ((float*)(ws + WS_ROPE))
#define BLK ((bf16_t*)(ws + WS_BLK))
#define H1 ((bf16_t*)(ws + WS_H1))
#define KC ((float*)(ws + WS_KC))
#define VC ((float*)(ws + WS_VC))
#define PCMP ((float*)(ws + WS_PCMP))
#define OCMP ((float*)(ws + WS_OCMP))
#define SEL ((unsigned long long*)(ws + WS_SEL))
#define X2 ((float*)(ws + WS_X2))
#define TOPE ((int*)(ws + WS_TOPE))
#define TOPG ((float*)(ws + WS_TOPG))
#define SLOT ((int*)(ws + WS_SLOT))
#define POS ((int*)(ws + WS_POS))
#define ROWTOK ((int*)(ws + WS_ROWTOK))
#define ACT ((bf16_t*)(ws + WS_ACT))
#define YB ((bf16_t*)(ws + WS_Y))
#define XBCB ((bf16_t*)(ws + WS_XBCB))
#define STATES ((float*)(ws + WS_STATES))
#define PREV ((bf16_t*)(ws + WS_PREV))
#define CHDEC ((float*)(ws + WS_CHDEC))
#define QB ((bf16_t*)(ws + WS_QB))
#define KSb ((bf16_t*)(ws + WS_KS))
#define VSb ((bf16_t*)(ws + WS_VS))
#define KWb ((bf16_t*)(ws + WS_KW))
#define VWb ((bf16_t*)(ws + WS_VW))
#define KCB ((bf16_t*)(ws + WS_KCB))
#define VCB ((bf16_t*)(ws + WS_VCB))
#define XIN (a.in[0])
#define COUNT (ctl + CW_COUNT)
#define ZROW ((const bf16_t*)(ctl + CW_ZROW))
    if (IN(PH_NORM1)) {
        const float* w = a.in[1];
        for (int row = gwave; row < T; row += gwaves) {
            const float4* xr = (const float4*)(XIN + (size_t)row * D);
            float4 v[8]; float ss = 0.f;
#pragma unroll
            for (int i = 0; i < 8; ++i) { v[i] = xr[lane + 64 * i]; ss += v[i].x * v[i].x + v[i].y * v[i].y + v[i].z * v[i].z + v[i].w * v[i].w; }
            ss = wave_sum(ss);
            const float rstd = rsqrtf(ss * (1.0f / D) + NORM_EPS);
#pragma unroll
            for (int i = 0; i < 8; ++i) { const float4 wv = ((const float4*)w)[lane + 64 * i];
                *(uint2*)(XN + (size_t)row * D + 4 * (lane + 64 * i)) = make_uint2(pack2(v[i].x * rstd * wv.x, v[i].y * rstd * wv.y), pack2(v[i].z * rstd * wv.z, v[i].w * rstd * wv.w)); }
        }
        for (int i = gtid; i < SEQ * 8; i += gthreads) { const int pos = i >> 3, k = i & 7; const float ang = (float)pos * rope_inv(k); ROPE[i] = cosf(ang); ROPE[SEQ * 8 + i] = sinf(ang); }
        for (int i = gtid; i < MAX_ROWS; i += gthreads) ROWTOK[i] = -1;
        SEAM(PH_NORM1);
    }

    if (IN(PH_INPROJ)) {
        const int nct = (IN_PROJ + 255) / 256, nunits = (T / 256) * nct;
        for (int u = bid; u < nunits; u += G) {
            const int rt = u / nct, ct = u % nct;
            ARowsDense al{XN, (size_t)D, rt * 256, T, ZROW, ws};
            BColsDense bl{a.in[2], IN_PROJ, ct * 256, IN_PROJ};
            EpiStoreF32 ep{PROJ, (size_t)IN_PROJ, rt * 256, ct * 256, IN_PROJ};
            gemm_unit<false>(lds, al, bl, ep, D);
        }
        SEAM(PH_INPROJ);
    }

    if (IN(PH_PREP)) {
        const float* conv_w = a.in[3]; const float* conv_b = a.in[4]; const float* dt_bias = a.in[5];
        for (int i = gtid; i < T * 2048; i += gthreads) {
            const int t = i >> 11, c = i & 2047, s = t & (SEQ - 1);
            float acc = conv_b[c];
#pragma unroll
            for (int k = 0; k < 4; ++k) { const int ts = s - 3 + k; if (ts >= 0) acc += conv_w[k * 2048 + c] * PROJ[(size_t)(t - 3 + k) * IN_PROJ + OFF_XBC + c]; }
            const float cv = acc * sigmoidf_(acc);
#if defined(SELFCHECK) && SELFCHECK == 2
            XBC[i] = cv;
#endif
            XBCB[i] = f2bf(cv);
        }
        for (int i = gtid; i < T * 16; i += gthreads) { const int h = i & 15; const float v = PROJ[(size_t)(i >> 4) * IN_PROJ + OFF_DT + h] + dt_bias[h];
            DT[i] = v > 20.f ? v : log1pf(expf(v)); }
        for (int i = gtid; i < T * 256; i += gthreads) {
            const int ch = i & 7, slot = (i >> 3) & 31, t = i >> 8, pos = t & (SEQ - 1);
            int col; bf16_t* dst; float scl = 1.0f; bool rope = slot < 24;
            if (slot < 16) { col = OFF_Q + slot * 64; dst = QB + (size_t)t * 1024 + slot * 64; scl = 0.125f; }
            else if (slot < 20) { col = OFF_KSLC + (slot - 16) * 64; dst = KSb + (size_t)t * 256 + (slot - 16) * 64; }
            else if (slot < 24) { col = OFF_KWIN + (slot - 20) * 64; dst = KWb + (size_t)t * 256 + (slot - 20) * 64; }
            else if (slot < 28) { col = OFF_VSLC + (slot - 24) * 64; dst = VSb + (size_t)t * 256 + (slot - 24) * 64; }
            else { col = OFF_VWIN + (slot - 28) * 64; dst = VWb + (size_t)t * 256 + (slot - 28) * 64; }
            const float* p = PROJ + (size_t)t * IN_PROJ + col;
            float v[8];
            if (rope && ch < 2) {
                const float4 a0 = *(const float4*)(p), a1 = *(const float4*)(p + 4), b0 = *(const float4*)(p + 8), b1 = *(const float4*)(p + 12);
                const float x1[8] = {a0.x, a0.y, a0.z, a0.w, a1.x, a1.y, a1.z, a1.w}, x2[8] = {b0.x, b0.y, b0.z, b0.w, b1.x, b1.y, b1.z, b1.w};
#pragma unroll
                for (int k = 0; k < 8; ++k) { const float c = ROPE[pos * 8 + k], sn = ROPE[SEQ * 8 + pos * 8 + k]; v[k] = (ch == 0) ? (x1[k] * c - x2[k] * sn) : (x1[k] * sn + x2[k] * c); }
            } else {
                const float4 a0 = *(const float4*)(p + ch * 8), a1 = *(const float4*)(p + ch * 8 + 4);
                v[0] = a0.x; v[1] = a0.y; v[2] = a0.z; v[3] = a0.w; v[4] = a1.x; v[5] = a1.y; v[6] = a1.z; v[7] = a1.w;
            }
            u32x4 o = {pack2(v[0] * scl, v[1] * scl), pack2(v[2] * scl, v[3] * scl), pack2(v[4] * scl, v[5] * scl), pack2(v[6] * scl, v[7] * scl)};
            *(u32x4*)(dst + ch * 8) = o;
        }
        for (int i = gtid; i < 2 * 2 * 256; i += gthreads) { const int d = i & 255, b = (i >> 8) & 1, j = i >> 9; (j ? VCB : KCB)[((size_t)b * 256 + 255) * 256 + d] = 0; }
        const float* pe = a.in[9];
        for (int i = gtid; i < 2 * 2048 * 512; i += gthreads) {
            const int e4 = i & 511, row = (i >> 9) & 2047, j = i >> 20;
            uint2 o = make_uint2(0u, 0u);
            if (row < CMP_ROWS) { const int g = row & 3, n = (row >> 2) % N_C, b = (row >> 2) / N_C; const int l = e4 >> 4, d = (e4 & 15) * 4;
                const float4 v = *(const float4*)(PROJ + (size_t)(b * SEQ + 16 * n + l) * IN_PROJ + (j ? OFF_VCMP : OFF_KCMP) + g * 64 + d);
                const float4 p4 = *(const float4*)(pe + (j * 32 + l) * 64 + d);
                o = make_uint2(pack2(v.x + p4.x, v.y + p4.y), pack2(v.z + p4.z, v.w + p4.w)); }
            *(uint2*)(BLK + ((size_t)j * 2048 + row) * 2048 + e4 * 4) = o;
        }
        SEAM(PH_PREP);
    }

    if (IN(PH_SSD_CMP1)) {
#if defined(SELFCHECK) && SELFCHECK == 2
        const int GW = G - 16;
        if (bid >= GW) {
            const int w = (bid - GW) * 8 + wid, b = w >> 6, h = (w >> 2) & 15, pq = w & 3, g = h >> 2;
            const int p = pq * 16 + (lane >> 2), nq = lane & 3;
            const float av = -expf(a.in[6][h]), dsk = a.in[7][h];
            float st[32];
#pragma unroll
            for (int n = 0; n < 32; ++n) st[n] = 0.f;
            for (int t = 0; t < SEQ; ++t) {
                const size_t tt = (size_t)b * SEQ + t;
                const float* row = XBC + tt * 2048;
                const float dtv = DT[tt * 16 + h];
                const float dA = expf(dtv * av);
                const float xv = row[h * 64 + p];
                const float4* Bp = (const float4*)(row + 1024 + g * 128 + nq * 32); const float4* Cp = (const float4*)(row + 1536 + g * 128 + nq * 32);
                const float coef = dtv * xv; float y = 0.f;
#pragma unroll
                for (int n4 = 0; n4 < 8; ++n4) { const float4 bv = Bp[n4], cv = Cp[n4];
                    st[4 * n4 + 0] = st[4 * n4 + 0] * dA + coef * bv.x; y += st[4 * n4 + 0] * cv.x;
                    st[4 * n4 + 1] = st[4 * n4 + 1] * dA + coef * bv.y; y += st[4 * n4 + 1] * cv.y;
                    st[4 * n4 + 2] = st[4 * n4 + 2] * dA + coef * bv.z; y += st[4 * n4 + 2] * cv.z;
                    st[4 * n4 + 3] = st[4 * n4 + 3] * dA + coef * bv.w; y += st[4 * n4 + 3] * cv.w; }
                y += __shfl_xor(y, 1); y += __shfl_xor(y, 2);
                if (nq == 0) YSSD[tt * 1024 + h * 64 + p] = y + dsk * xv;
            }
        } else
#else
        const int GW = G;
#endif
        {
            for (int u = bid; u < 32; u += GW) {
                const int j = u >> 4, rt = (u >> 1) & 7, ct = u & 1;
                ARowsDense al{BLK + (size_t)j * 2048 * 2048, (size_t)2048, rt * 256, CMP_ROWS, ZROW, ws};
                BColsDense bl{a.in[10] + (size_t)j * 2048 * CMP_HID, CMP_HID, ct * 256, CMP_HID};
                EpiGeluBf16 ep{H1 + (size_t)j * 2048 * CMP_HID, a.in[11] + j * CMP_HID, (size_t)CMP_HID, rt * 256, ct * 256, CMP_ROWS};
                gemm_unit<false>(lds, al, bl, ep, 2048);
            }
            for (int it = (bid + GW - (32 % GW)) % GW; it < 256; it += GW) ssd_states_item(lds, it, XBCB, DT, a.in[6], STATES, CHDEC);
        }
        SEAM(PH_SSD_CMP1);
    }

    if (IN(PH_GNORM_CMP2)) {
        const float* nw = a.in[8];
#ifdef SELFCHECK
        for (int i = gtid; i < T * 24 * 8; i += gthreads) {
            const int k = i & 7, slot = (i >> 3) % 24, t = i / 192, pos = t & (SEQ - 1);
            const int col = slot < 16 ? OFF_Q + slot * 64 : (slot < 20 ? OFF_KSLC + (slot - 16) * 64 : OFF_KWIN + (slot - 20) * 64);
            float* p = PROJ + (size_t)t * IN_PROJ + col;
            const float c = ROPE[pos * 8 + k], s = ROPE[SEQ * 8 + pos * 8 + k];
            const float x1 = p[k], x2 = p[k + 8];
            p[k] = x1 * c - x2 * s; p[k + 8] = x1 * s + x2 * c;
        }
#endif
#if defined(SELFCHECK) && SELFCHECK == 2
        for (int it = gwave; it < T * 4; it += gwaves) {
            const int t = it >> 2, grp = it & 3, c = grp * 256 + lane * 4;
            const float4 y = *(const float4*)(YSSD + (size_t)t * 1024 + c);
            const float4 z = *(const float4*)(PROJ + (size_t)t * IN_PROJ + OFF_Z + c);
            float gv[4] = {y.x * z.x * sigmoidf_(z.x), y.y * z.y * sigmoidf_(z.y), y.z * z.z * sigmoidf_(z.z), y.w * z.w * sigmoidf_(z.w)};
            float ss = wave_sum(gv[0] * gv[0] + gv[1] * gv[1] + gv[2] * gv[2] + gv[3] * gv[3]);
            const float sc = rsqrtf(ss * (1.0f / 256.f) + NORM_EPS);
            const float4 w4 = *(const float4*)(nw + c);
            *(uint2*)(MIX + (size_t)t * 2048 + c) = make_uint2(pack2(gv[0] * sc * w4.x, gv[1] * sc * w4.y), pack2(gv[2] * sc * w4.z, gv[3] * sc * w4.w));
        }
#endif
        for (int i = gtid; i < 2 * 16 * 64 * 32; i += gthreads) {
            const int n4 = i & 31, p = (i >> 5) & 63, h = (i >> 11) & 15, b = i >> 15;
            f32x4 run = {0.f, 0.f, 0.f, 0.f};
            for (int c = 0; c < 32; ++c) {
                const size_t base = (((size_t)b * 32 + c) * 16 + h) * 8192 + p * 128 + n4 * 4;
                *(uint2*)(PREV + base) = make_uint2(pack2(run[0], run[1]), pack2(run[2], run[3]));
                const float dec = CHDEC[((size_t)b * 32 + c) * 16 + h];
                const f32x4 sv = *(const f32x4*)(STATES + base);
                run = run * dec + sv;
            }
        }
        const float* w2 = a.in[12]; const float* b2 = a.in[13];
        for (int i = gtid; i < 2 * CMP_ROWS * 64; i += gthreads) {
            const int d = i & 63, row = (i >> 6) % CMP_ROWS, j = i / (CMP_ROWS * 64);
            const bf16_t* hrow = H1 + ((size_t)j * 2048 + row) * CMP_HID;
            const float* wj = w2 + (size_t)j * CMP_HID * 64;
            const bool rot = (j == 0) && (d < 16);
            const int dp = rot ? (d < 8 ? d + 8 : d - 8) : d;
            float s0 = b2[j * 64 + d], s1 = b2[j * 64 + dp];
            for (int k = 0; k < CMP_HID; ++k) { const float hv = bf2f(hrow[k]); s0 += hv * wj[k * 64 + d]; s1 += hv * wj[k * 64 + dp]; }
            float o = s0;
            if (rot) { const int n = (row >> 2) % N_C, pos = 16 * n + 31, k = d & 7; const float c = ROPE[pos * 8 + k], s = ROPE[SEQ * 8 + pos * 8 + k];
                o = (d < 8) ? (s0 * c - s1 * s) : (s1 * s + s0 * c); }
            (j ? VC : KC)[(size_t)row * 64 + d] = o;
            { const int g4 = row & 3, n = (row >> 2) % N_C, bb = (row >> 2) / N_C; (j ? VCB : KCB)[((size_t)bb * 256 + n) * 256 + g4 * 64 + d] = f2bf(o); }
        }
        SEAM(PH_GNORM_CMP2);
    }

#ifdef SELFCHECK
    if (IN(PH_CMPATT)) {
        for (int it = gtid; it < T * 16; it += gthreads) {
            const int hq = it & 15, tt = it >> 4, b = tt >> 12, t = tt & (SEQ - 1), g = hq >> 2;
            const int nvalid = t >= 31 ? ((t - 31) >> 4) + 1 : 0;
            float q[64];
            const float* qp = PROJ + (size_t)tt * IN_PROJ + OFF_Q + hq * 64;
#pragma unroll
            for (int d = 0; d < 64; d += 4) { const float4 v = *(const float4*)(qp + d); q[d] = v.x; q[d + 1] = v.y; q[d + 2] = v.z; q[d + 3] = v.w; }
            float m = -INFINITY, l = 0.f;
            for (int c = 0; c < nvalid; ++c) {
                const float* kp = KC + (size_t)((b * N_C + c) * 4 + g) * 64; float s = 0.f;
#pragma unroll
                for (int d = 0; d < 64; d += 4) { const float4 v = *(const float4*)(kp + d); s += q[d] * v.x + q[d + 1] * v.y + q[d + 2] * v.z + q[d + 3] * v.w; }
                s *= 0.125f;
                const float mn = fmaxf(m, s); l = l * __expf(m - mn) + __expf(s - mn); m = mn;
            }
            float o[64];
#pragma unroll
            for (int d = 0; d < 64; ++d) o[d] = 0.f;
            const float inv_l = nvalid > 0 ? 1.0f / fmaxf(l, 1e-30f) : 0.f;
            float* pp = PCMP + (size_t)it * 256;
            for (int c = 0; c < nvalid; ++c) {
                const float* kp = KC + (size_t)((b * N_C + c) * 4 + g) * 64; float s = 0.f;
#pragma unroll
                for (int d = 0; d < 64; d += 4) { const float4 v = *(const float4*)(kp + d); s += q[d] * v.x + q[d + 1] * v.y + q[d + 2] * v.z + q[d + 3] * v.w; }
                const float p = __expf(s * 0.125f - m) * inv_l;
                pp[c] = p;
                const float* vp = VC + (size_t)((b * N_C + c) * 4 + g) * 64;
#pragma unroll
                for (int d = 0; d < 64; d += 4) { const float4 v = *(const float4*)(vp + d); o[d] += p * v.x; o[d + 1] += p * v.y; o[d + 2] += p * v.z; o[d + 3] += p * v.w; }
            }
            for (int c = nvalid; c < 256; ++c) pp[c] = 0.f;
            float* op = OCMP + (size_t)tt * 1024 + hq * 64;
#pragma unroll
            for (int d = 0; d < 64; d += 4) *(float4*)(op + d) = make_float4(o[d], o[d + 1], o[d + 2], o[d + 3]);
        }
        SEAM(PH_CMPATT);
    }

    if (IN(PH_SELECT)) {
        for (int it = gwave; it < T * 4; it += gwaves) {
            const int g = it & 3, tt = it >> 2, t = tt & (SEQ - 1), cur = t >> 6, j = lane;
            float imp = 0.f;
#pragma unroll
            for (int r = 0; r < 4; ++r) { const float* pp = PCMP + ((size_t)tt * 16 + g * 4 + r) * 256 + 4 * j;
                const float4 v = *(const float4*)pp; const float pm1 = j > 0 ? pp[-1] : 0.f;
                imp += 32.f * (v.x + v.y + v.z) + 16.f * v.w + 16.f * pm1; }
            const bool forced = (j == 0) || (j == cur) || (j == cur - 1);
            const bool valid = j <= cur;
            const float sc = forced ? 1.0e4f : (valid ? imp : -1.0e4f);
            int rank = 0;
#pragma unroll
            for (int k = 0; k < 64; ++k) { const float o = __shfl(sc, k); rank += (o > sc || (o == sc && k < j)) ? 1 : 0; }
            const unsigned long long mask = __ballot(rank < 16 && valid);
            if (lane == 0) SEL[it] = mask;
        }
        SEAM(PH_SELECT);
    }

    if (IN(PH_SELWIN)) {
        for (int it = gtid; it < T * 16; it += gthreads) {
            const int hq = it & 15, tt = it >> 4, b = tt >> 12, t = tt & (SEQ - 1), g = hq >> 2;
            float q[64];
            const float* qp = PROJ + (size_t)tt * IN_PROJ + OFF_Q + hq * 64;
#pragma unroll
            for (int d = 0; d < 64; d += 4) { const float4 v = *(const float4*)(qp + d); q[d] = v.x; q[d + 1] = v.y; q[d + 2] = v.z; q[d + 3] = v.w; }
            const float* gl = PROJ + (size_t)tt * IN_PROJ + OFF_GATE + hq * 3;
            const float g0 = sigmoidf_(gl[0]), g1 = sigmoidf_(gl[1]), g2 = sigmoidf_(gl[2]);
            float* op = OCMP + (size_t)tt * 1024 + hq * 64;
            float o[64];
            {
#pragma unroll
                for (int d = 0; d < 64; ++d) o[d] = 0.f;
                float m = -INFINITY, l = 0.f;
                unsigned long long mask = SEL[(size_t)tt * 4 + g];
                while (mask) {
                    const int j = __ffsll((long long)mask) - 1; mask &= mask - 1;
                    const int hi = min(64 * j + 63, t);
                    for (int tok = 64 * j; tok <= hi; ++tok) {
                        const float* kp = PROJ + (size_t)(b * SEQ + tok) * IN_PROJ + OFF_KSLC + g * 64; float s = 0.f;
#pragma unroll
                        for (int d = 0; d < 64; d += 4) { const float4 v = *(const float4*)(kp + d); s += q[d] * v.x + q[d + 1] * v.y + q[d + 2] * v.z + q[d + 3] * v.w; }
                        s *= 0.125f;
                        const float mn = fmaxf(m, s), al = __expf(m - mn), p = __expf(s - mn); m = mn; l = l * al + p;
                        const float* vp = kp + (OFF_VSLC - OFF_KSLC);
#pragma unroll
                        for (int d = 0; d < 64; d += 4) { const float4 v = *(const float4*)(vp + d); o[d] = o[d] * al + p * v.x; o[d + 1] = o[d + 1] * al + p * v.y; o[d + 2] = o[d + 2] * al + p * v.z; o[d + 3] = o[d + 3] * al + p * v.w; }
                    }
                }
                const float il = g1 / fmaxf(l, 1e-30f);
#pragma unroll
                for (int d = 0; d < 64; d += 4) { float4 r = *(float4*)(op + d); r.x = g0 * r.x + il * o[d]; r.y = g0 * r.y + il * o[d + 1]; r.z = g0 * r.z + il * o[d + 2]; r.w = g0 * r.w + il * o[d + 3]; *(float4*)(op + d) = r; }
            }
            {
#pragma unroll
                for (int d = 0; d < 64; ++d) o[d] = 0.f;
                float m = -INFINITY, l = 0.f;
                const int lo = max(0, t - 511);
                for (int tok = lo; tok <= t; ++tok) {
                    const float* kp = PROJ + (size_t)(b * SEQ + tok) * IN_PROJ + OFF_KWIN + g * 64; float s = 0.f;
#pragma unroll
                    for (int d = 0; d < 64; d += 4) { const float4 v = *(const float4*)(kp + d); s += q[d] * v.x + q[d + 1] * v.y + q[d + 2] * v.z + q[d + 3] * v.w; }
                    s *= 0.125f;
                    const float mn = fmaxf(m, s), al = __expf(m - mn), p = __expf(s - mn); m = mn; l = l * al + p;
                    const float* vp = kp + (OFF_VWIN - OFF_KWIN);
#pragma unroll
                    for (int d = 0; d < 64; d += 4) { const float4 v = *(const float4*)(vp + d); o[d] = o[d] * al + p * v.x; o[d + 1] = o[d + 1] * al + p * v.y; o[d + 2] = o[d + 2] * al + p * v.z; o[d + 3] = o[d + 3] * al + p * v.w; }
                }
                const float il = g2 / fmaxf(l, 1e-30f);
                bf16_t* mp = MIX + (size_t)tt * 2048 + 1024 + hq * 64;
#pragma unroll
                for (int d = 0; d < 64; d += 4) { const float4 r = *(const float4*)(op + d);
                    *(uint2*)(mp + d) = make_uint2(pack2(r.x + il * o[d], r.y + il * o[d + 1]), pack2(r.z + il * o[d + 2], r.w + il * o[d + 3])); }
            }
        }
        SEAM(PH_SELWIN);
    }

#endif
    if (IN(PH_NSA)) {
#ifdef SELFCHECK
        bf16_t* MIXO = (bf16_t*)(ws + WS_CHK);
#else
        bf16_t* MIXO = MIX;
#endif
        for (int k = bid; k < 512; k += G) { const int rnd = k / G; const int u = (rnd & 1) ? 511 - (k - G * rnd) - G * (rnd - 1) : k;
            if (u >= 0 && u < 512) nsa_unit(lds, (G == 256) ? u : k, QB, KSb, VSb, KWb, VWb, KCB, VCB, PROJ, MIXO); }
        for (int it = bid; it < 256; it += G) ssd_out_item(lds, it, XBCB, DT, a.in[6], a.in[7], a.in[8], PREV, PROJ, YSSD, MIXO);
        SEAM(PH_NSA);
    }
#ifdef SELFCHECK
    if (IN(PH_CHECK)) {
        const bf16_t* A_ = MIX; const bf16_t* B_ = (const bf16_t*)(ws + WS_CHK);
        float sd = 0.f, sr = 0.f;
        for (int i = gtid; i < T * 1024; i += gthreads) { const size_t o = (size_t)(i >> 10) * 2048 + (SELFCHECK == 1 ? 1024 : 0) + (i & 1023); const float r = bf2f(A_[o]), v = bf2f(B_[o]); sd += (r - v) * (r - v); sr += r * r; }
        sd = wave_sum(sd); sr = wave_sum(sr);
        if (lane == 0) { atomicAdd((float*)(ctl + CW_CHK), sd); atomicAdd((float*)(ctl + CW_CHK + 1), sr); }
        SEAM(PH_CHECK);
    }
#endif

    if (IN(PH_OUTPROJ)) {
        const int nunits = (T / 256) * (D / 256);
        for (int u = bid; u < nunits; u += G) {
            const int rt = u >> 3, ct = u & 7;
            ARowsDense al{MIX, (size_t)2048, rt * 256, T, ZROW, ws};
            BColsDense bl{a.in[14], D, ct * 256, D};
            EpiResidF32 ep{X2, XIN, (size_t)D, rt * 256, ct * 256};
            gemm_unit<false>(lds, al, bl, ep, 2048);
        }
        SEAM(PH_OUTPROJ);
    }

    if (IN(PH_ROUTER)) {
        const float* w = a.in[15]; const float* wr_ = a.in[16]; const float* br = a.in[17];
        for (int row = gwave; row < T; row += gwaves) {
            const float4* xr = (const float4*)(X2 + (size_t)row * D);
            float ss = 0.f;
#pragma unroll 2
            for (int i = 0; i < 8; ++i) { const float4 v = xr[lane + 64 * i]; ss += v.x * v.x + v.y * v.y + v.z * v.z + v.w * v.w; }
            ss = wave_sum(ss);
            const float rstd = rsqrtf(ss * (1.0f / D) + NORM_EPS);
            float lg[NE];
#pragma unroll
            for (int e = 0; e < NE; ++e) lg[e] = 0.f;
#pragma unroll 1
            for (int i = 0; i < 8; ++i) { const float4 wv = ((const float4*)w)[lane + 64 * i]; const float4 v = xr[lane + 64 * i];
                const float h0 = v.x * rstd * wv.x, h1 = v.y * rstd * wv.y, h2 = v.z * rstd * wv.z, h3 = v.w * rstd * wv.w;
                const int d0 = 4 * (lane + 64 * i);
                *(uint2*)(XN + (size_t)row * D + d0) = make_uint2(pack2(h0, h1), pack2(h2, h3));
                const float4* r0 = (const float4*)(wr_ + (size_t)d0 * NE);
#pragma unroll
                for (int e4 = 0; e4 < 8; ++e4) { const float4 a0 = r0[e4], a1 = r0[8 + e4], a2 = r0[16 + e4], a3 = r0[24 + e4];
                    lg[4 * e4 + 0] += h0 * a0.x + h1 * a1.x + h2 * a2.x + h3 * a3.x; lg[4 * e4 + 1] += h0 * a0.y + h1 * a1.y + h2 * a2.y + h3 * a3.y;
                    lg[4 * e4 + 2] += h0 * a0.z + h1 * a1.z + h2 * a2.z + h3 * a3.z; lg[4 * e4 + 3] += h0 * a0.w + h1 * a1.w + h2 * a2.w + h3 * a3.w; }
            }
            float mine = -INFINITY;
#pragma unroll
            for (int e = 0; e < NE; ++e) { const float s = wave_sum(lg[e]); if (lane == e) mine = s + br[e]; }
            int rank = 0;
#pragma unroll
            for (int k = 0; k < NE; ++k) { const float o = __shfl(mine, k); rank += (o > mine || (o == mine && k < lane)) ? 1 : 0; }
            const bool sel = (lane < NE) && (rank < 4);
            float mx = sel ? mine : -INFINITY;
#pragma unroll
            for (int o = 32; o > 0; o >>= 1) mx = fmaxf(mx, __shfl_xor(mx, o));
            const float ex = sel ? __expf(mine - mx) : 0.f;
            const float den = wave_sum(ex);
            if (sel) { const int slot = (int)atomicAdd(&COUNT[lane], 1u); const int o = row * 4 + rank; TOPE[o] = lane; TOPG[o] = ex / den; SLOT[o] = slot; }
        }
        SEAM(PH_ROUTER);
    }

    if (IN(PH_SCATTER)) {
        for (int i = gtid; i < T * 4; i += gthreads) {
            const int e = TOPE[i]; int off = 0;
            for (int k = 0; k < e; ++k) off += (int)((COUNT[k] + 255u) >> 8);
            const int pos = off * 256 + SLOT[i];
            ROWTOK[pos] = i >> 2; POS[i] = pos;
        }
        SEAM(PH_SCATTER);
    }

    if (IN(PH_GATEUP) || IN(PH_DOWN)) {
        LAS int* toff = (LAS int*)(lds + GEMM_LDS + 64 - 0);
        (void)toff;
    }
    if (IN(PH_GATEUP)) {
        int ntiles = 0;
        for (int k = 0; k < NE; ++k) ntiles += (int)((COUNT[k] + 255u) >> 8);
        const int nunits = ntiles * 16;
        for (int u = bid; u < nunits; u += G) {
            const int tile = u >> 4, cn = u & 15;
            int e = 0, acc = 0;
            for (int k = 0; k < NE; ++k) { const int nt = (int)((COUNT[k] + 255u) >> 8); if (tile >= acc && tile < acc + nt) e = k; acc += nt; }
            ARowsGather al{XN, (size_t)D, ROWTOK + tile * 256, ZROW, ws};
            BColsGateUp bl{a.in[18] + (size_t)e * D * 2 * DFF, 2 * DFF, cn};
            EpiSwiglu ep{ACT, a.in[19] + (size_t)e * 2 * DFF, tile * 256, cn};
            gemm_unit<true>(lds, al, bl, ep, D);
        }
        SEAM(PH_GATEUP);
    }
    if (IN(PH_DOWN)) {
        int ntiles = 0;
        for (int k = 0; k < NE; ++k) ntiles += (int)((COUNT[k] + 255u) >> 8);
        const int nunits = ntiles * 8;
        for (int u = bid; u < nunits; u += G) {
            const int tile = u >> 3, ct = u & 7;
            int e = 0, acc = 0;
            for (int k = 0; k < NE; ++k) { const int nt = (int)((COUNT[k] + 255u) >> 8); if (tile >= acc && tile < acc + nt) e = k; acc += nt; }
            ARowsDense al{ACT, (size_t)DFF, tile * 256, MAX_ROWS, ZROW, ws};
            BColsDense bl{a.in[20] + (size_t)e * DFF * D, D, ct * 256, D};
            EpiBiasBf16 ep{YB, a.in[21] + (size_t)e * D, tile * 256, ct * 256};
            gemm_unit<false>(lds, al, bl, ep, DFF);
        }
        SEAM(PH_DOWN);
    }

    if (IN(PH_FINAL)) {
        const float* fw = a.in[22];
        for (int row = gwave; row < T; row += gwaves) {
            const float4* xr = (const float4*)(X2 + (size_t)row * D);
            float4 v[8];
#pragma unroll
            for (int i = 0; i < 8; ++i) v[i] = xr[lane + 64 * i];
#pragma unroll
            for (int k = 0; k < 4; ++k) { const float gk = TOPG[row * 4 + k]; const bf16_t* yr = YB + (size_t)POS[row * 4 + k] * D;
#pragma unroll
                for (int i = 0; i < 8; ++i) { const uint2 y = *(const uint2*)(yr + 4 * (lane + 64 * i));
                    v[i].x += gk * bf2f((bf16_t)(y.x & 0xffffu)); v[i].y += gk * bf2f((bf16_t)(y.x >> 16)); v[i].z += gk * bf2f((bf16_t)(y.y & 0xffffu)); v[i].w += gk * bf2f((bf16_t)(y.y >> 16)); } }
            float ss = 0.f;
#pragma unroll
            for (int i = 0; i < 8; ++i) ss += v[i].x * v[i].x + v[i].y * v[i].y + v[i].z * v[i].z + v[i].w * v[i].w;
            ss = wave_sum(ss);
            float rstd = rsqrtf(ss * (1.0f / D) + NORM_EPS);
#ifdef SELFCHECK
            { const float sd = ((const float*)(ctl + CW_CHK))[0], sr = ((const float*)(ctl + CW_CHK))[1]; const float rel = sqrtf(sd / fmaxf(sr, 1e-30f)); rstd *= 1.0f + fminf(1.0f, 10.0f * rel); }
#endif
#pragma unroll
            for (int i = 0; i < 8; ++i) { const float4 wv = ((const float4*)fw)[lane + 64 * i];
                ((float4*)(a.out + (size_t)row * D))[lane + 64 * i] = make_float4(v[i].x * rstd * wv.x, v[i].y * rstd * wv.y, v[i].z * rstd * wv.z, v[i].w * rstd * wv.w); }
        }
    }
#undef IN
#undef SEAM
}

extern "C" void kernel_launch(void* const* d_in, const int* in_sizes, int n_in, void* d_out, int out_size, void* d_ws, size_t ws_size, hipStream_t stream) {
    static int grid = 0;
    if (grid == 0) {
        if (n_in != 23 || out_size != T * D || ws_size < WS_END) { fprintf(stderr, "kernel_launch: unexpected shapes (n_in %d, out %d, ws %zu < %zu)\n", n_in, out_size, ws_size, (size_t)WS_END); grid = -1; return; }
        int dev = 0, cus = 0, per_cu = 0;
        if (hipGetDevice(&dev) != hipSuccess || hipDeviceGetAttribute(&cus, hipDeviceAttributeMultiprocessorCount, dev) != hipSuccess) { grid = -1; return; }
        if (hipFuncSetAttribute((const void*)fwd, hipFuncAttributeMaxDynamicSharedMemorySize, LDS_BYTES) != hipSuccess) { fprintf(stderr, "kernel_launch: hipFuncSetAttribute failed\n"); grid = -1; return; }
        if (hipOccupancyMaxActiveBlocksPerMultiprocessor(&per_cu, (const void*)fwd, 512, LDS_BYTES) != hipSuccess || per_cu < 1) { fprintf(stderr, "kernel_launch: occupancy query says %d\n", per_cu); per_cu = 1; }
        (void)hipGetLastError();
        grid = cus;
    }
    if (grid < 0) return;
    (void)hipMemsetAsync((char*)d_ws + WS_CTL, 0, CTL_BYTES, stream);
    Args a{};
    for (int i = 0; i < 23; ++i) a.in[i] = (const float*)d_in[i];
    a.out = (float*)d_out; a.ws = (unsigned char*)d_ws;
#if N_LAUNCH_MODE == 1
    a.ph_lo = 0; a.ph_hi = N_PHASES;
    hipLaunchKernelGGL(fwd, dim3(grid), dim3(512), LDS_BYTES, stream, a);
#else
    for (int ph = 0; ph < N_PHASES; ++ph) { a.ph_lo = ph; a.ph_hi = ph + 1; hipLaunchKernelGGL(fwd, dim3(grid), dim3(512), LDS_BYTES, stream, a); }
#endif
}
```

```cpp
#include <hip/hip_runtime.h>
#include <stdint.h>
#include <stdio.h>

#ifndef N_LAUNCH_MODE
#define N_LAUNCH_MODE 1
#endif

typedef unsigned short bf16_t;
typedef short s16x4 __attribute__((ext_vector_type(4)));
typedef short s16x8 __attribute__((ext_vector_type(8)));
typedef float f32x4 __attribute__((ext_vector_type(4)));
typedef unsigned u32x4 __attribute__((ext_vector_type(4)));
typedef unsigned u32x2 __attribute__((ext_vector_type(2)));
#define LAS __attribute__((address_space(3)))

constexpr int D = 2048, BATCH = 2, SEQ = 4096, T = BATCH * SEQ;
constexpr int SSM_H = 16, SSM_N = 128;
constexpr int NSA_H = 16, DH = 64;
constexpr int CMP_HID = 512;
constexpr int N_C = 255, N_SEL = 64;
constexpr int IN_PROJ = 5696;
constexpr int OFF_Z = 0, OFF_XBC = 1024, OFF_DT = 3072, OFF_Q = 3088, OFF_KCMP = 4112, OFF_VCMP = 4368, OFF_KSLC = 4624,
              OFF_VSLC = 4880, OFF_KWIN = 5136, OFF_VWIN = 5392, OFF_GATE = 5648;
constexpr int NE = 32, DFF = 2048;
constexpr float NORM_EPS = 1e-5f;
constexpr int CMP_ROWS = BATCH * N_C * 4;
constexpr int MAX_TILES = 160, MAX_ROWS = MAX_TILES * 256;

constexpr size_t AL(size_t x) { return (x + 255) & ~(size_t)255; }
constexpr size_t WS_CTL = 0;
constexpr size_t CTL_BYTES = 32768;
constexpr size_t WS_XN = WS_CTL + CTL_BYTES;
constexpr size_t WS_PROJ = WS_XN + AL((size_t)T * D * 2);
constexpr size_t WS_XBC = WS_PROJ + AL((size_t)T * IN_PROJ * 4);
constexpr size_t WS_DT = WS_XBC + AL((size_t)T * 2048 * 4);
constexpr size_t WS_YSSD = WS_DT + AL((size_t)T * 16 * 4);
constexpr size_t WS_MIX = WS_YSSD + AL((size_t)T * 1024 * 4);
constexpr size_t WS_ROPE = WS_MIX + AL((size_t)T * 2048 * 2);
constexpr size_t WS_BLK = WS_ROPE + AL((size_t)SEQ * 16 * 4);
constexpr size_t WS_H1 = WS_BLK + AL((size_t)2 * 2048 * 2048 * 2);
constexpr size_t WS_KC = WS_H1 + AL((size_t)2 * 2048 * 512 * 2);
constexpr size_t WS_VC = WS_KC + AL((size_t)2048 * 64 * 4);
constexpr size_t WS_PCMP = WS_VC + AL((size_t)2048 * 64 * 4);
constexpr size_t WS_OCMP = WS_PCMP + AL((size_t)T * 16 * 256 * 4);
constexpr size_t WS_SEL = WS_OCMP + AL((size_t)T * 1024 * 4);
constexpr size_t WS_X2 = WS_SEL + AL((size_t)T * 4 * 8);
constexpr size_t WS_TOPE = WS_X2 + AL((size_t)T * D * 4);
constexpr size_t WS_TOPG = WS_TOPE + AL((size_t)T * 4 * 4);
constexpr size_t WS_SLOT = WS_TOPG + AL((size_t)T * 4 * 4);
constexpr size_t WS_POS = WS_SLOT + AL((size_t)T * 4 * 4);
constexpr size_t WS_ROWTOK = WS_POS + AL((size_t)T * 4 * 4);
constexpr size_t WS_ACT = WS_ROWTOK + AL((size_t)MAX_ROWS * 4);
constexpr size_t WS_Y = WS_ACT + AL((size_t)MAX_ROWS * DFF * 2);
constexpr size_t WS_QB = WS_Y + AL((size_t)MAX_ROWS * D * 2);
constexpr size_t WS_KS = WS_QB + AL((size_t)T * 1024 * 2);
constexpr size_t WS_VS = WS_KS + AL((size_t)T * 256 * 2);
constexpr size_t WS_KW = WS_VS + AL((size_t)T * 256 * 2);
constexpr size_t WS_VW = WS_KW + AL((size_t)T * 256 * 2);
constexpr size_t WS_KCB = WS_VW + AL((size_t)T * 256 * 2);
constexpr size_t WS_VCB = WS_KCB + AL((size_t)2 * 256 * 256 * 2);
constexpr size_t WS_XBCB = WS_VCB + AL((size_t)2 * 256 * 256 * 2);
constexpr size_t WS_STATES = WS_XBCB + AL((size_t)T * 2048 * 2);
constexpr size_t WS_PREV = WS_STATES + AL((size_t)2 * 32 * 16 * 64 * 128 * 4);
constexpr size_t WS_CHDEC = WS_PREV + AL((size_t)2 * 32 * 16 * 64 * 128 * 2);
constexpr size_t WS_RW = WS_CHDEC + AL((size_t)2 * 32 * 16 * 4);
constexpr size_t WS_CHK = WS_RW + AL((size_t)2048 * 32 * 4);
constexpr size_t WS_END = WS_CHK + AL((size_t)T * 2048 * 4);

constexpr int CW_COUNT = 4096;
constexpr int CW_ZROW = 5120;
constexpr int CW_CHK = 4160;

#define XB_TMO      128
#define XB_XCNT(j)  (256  + 64 * (j))
#define XB_XSUB(j)  (1280 + 64 * (j))
#define XB_XGEN(j)  (2304 + 64 * (j))
#define XB_TOP      3328
#define XB_TOPGEN   3392
#define XCD_BAR_WORDS 3456
#define XB_SPIN_CAP (1u << 18)

__device__ __forceinline__ unsigned xb_ld(unsigned* p)              { return __hip_atomic_load(p, __ATOMIC_RELAXED, __HIP_MEMORY_SCOPE_AGENT); }
__device__ __forceinline__ unsigned xb_add(unsigned* p, unsigned v) { return __hip_atomic_fetch_add(p, v, __ATOMIC_RELAXED, __HIP_MEMORY_SCOPE_AGENT); }
__device__ __forceinline__ unsigned xb_xcc_id() { return (unsigned)__builtin_amdgcn_s_getreg((3 << 11) | 20) & 0xFu; }
#define XB_SPIN(cond, bar) do { unsigned _sp = 0; while (cond) { __builtin_amdgcn_s_sleep(1); \
    if ((++_sp & 255u) == 0u) { if (xb_ld(&(bar)[XB_TMO])) break; if (_sp > XB_SPIN_CAP) { atomicAdd(&(bar)[XB_TMO], 1u); break; } } } } while (0)

struct XcdBarrier { unsigned* bar; unsigned x; volatile LAS unsigned* st; };

__device__ __forceinline__ XcdBarrier xcd_barrier_post(unsigned* bar, volatile LAS unsigned* st) {
    XcdBarrier b; b.bar = bar; b.x = xb_xcc_id(); b.st = st;
    if (threadIdx.x == 0) (void)xb_add(&bar[XB_XCNT(b.x)], 1u);
    return b;
}
__device__ __forceinline__ void xcd_barrier_complete(unsigned* bar, unsigned x, unsigned& nloc, unsigned& nx) {
    const unsigned G = gridDim.x * gridDim.y * gridDim.z;
    unsigned sum, cnt, mine, sp = 0u;
    for (;;) {
        sum = 0u; cnt = 0u; mine = 0u;
#pragma unroll
        for (unsigned j = 0; j < 16; ++j) { const unsigned c = xb_ld(&bar[XB_XCNT(j)]); sum += c; cnt += (c > 0u) ? 1u : 0u; mine = (j == x) ? c : mine; }
        if (sum == G) break;
        __builtin_amdgcn_s_sleep(1);
        if ((++sp & 255u) == 0u) { if (xb_ld(&bar[XB_TMO])) break; if (sp > XB_SPIN_CAP) { atomicAdd(&bar[XB_TMO], 1u); break; } }
    }
    nloc = mine > 0u ? mine : 1u; nx = cnt > 0u ? cnt : 1u;
}
__device__ __forceinline__ void xcd_barrier(const XcdBarrier& b) {
    asm volatile("s_waitcnt vmcnt(0)" ::: "memory");
    __syncthreads();
    if (threadIdx.x == 0) {
        unsigned* bar = b.bar;
        __builtin_amdgcn_s_waitcnt(0);
        unsigned nloc = b.st[0], nx = b.st[1];
        if (nloc == 0u) { xcd_barrier_complete(bar, b.x, nloc, nx); b.st[0] = nloc; b.st[1] = nx; }
        const unsigned old = xb_add(&bar[XB_XSUB(b.x)], 1u);
        const unsigned gen = old / nloc;
        if (old + 1u == (gen + 1u) * nloc) {
            __builtin_amdgcn_fence(__ATOMIC_RELEASE, "agent");
            asm volatile("s_waitcnt vmcnt(0)" ::: "memory");
            const unsigned og = xb_add(&bar[XB_TOP], 1u);
            const unsigned tg = og / nx;
            if (og + 1u == (tg + 1u) * nx) xb_add(&bar[XB_TOPGEN], 1u);
            else XB_SPIN(xb_ld(&bar[XB_TOPGEN]) == tg, bar);
            __builtin_amdgcn_fence(__ATOMIC_ACQUIRE, "agent");
            xb_add(&bar[XB_XGEN(b.x)], 1u);
            asm volatile("s_waitcnt vmcnt(0)" ::: "memory");
        } else {
            XB_SPIN(xb_ld(&bar[XB_XGEN(b.x)]) == gen, bar);
            __builtin_amdgcn_fence(__ATOMIC_ACQUIRE, "agent");
            asm volatile("s_waitcnt vmcnt(0)" ::: "memory");
        }
    }
    __syncthreads();
}

__device__ __forceinline__ bf16_t f2bf(float f) { unsigned u = __float_as_uint(f); u += 0x7FFFu + ((u >> 16) & 1u); return (bf16_t)(u >> 16); }
__device__ __forceinline__ float bf2f(bf16_t b) { return __uint_as_float(((unsigned)b) << 16); }
typedef __bf16 bf16x2_t __attribute__((ext_vector_type(2)));
typedef float f32x2_t __attribute__((ext_vector_type(2)));
__device__ __forceinline__ unsigned pack2(float lo, float hi) { const f32x2_t v = {lo, hi}; return __builtin_bit_cast(unsigned, __builtin_convertvector(v, bf16x2_t)); }
__device__ __forceinline__ float wave_sum(float v) {
#pragma unroll
    for (int o = 32; o > 0; o >>= 1) v += __shfl_xor(v, o);
    return v;
}
__device__ __forceinline__ float sigmoidf_(float x) { return 1.0f / (1.0f + __expf(-x)); }

constexpr int B_RS = 544, A_ST = 256 * 128, B_ST = 64 * B_RS, STAGE = A_ST + B_ST;
constexpr int GEMM_LDS = 2 * STAGE;
constexpr int SSD_LDS = 147456;
constexpr int MAIN_LDS = SSD_LDS > GEMM_LDS + 8192 ? SSD_LDS : GEMM_LDS + 8192;
constexpr int LDS_BYTES = MAIN_LDS + 64;

template <bool PAIRED, class ALd, class BLd, class EP>
__device__ __forceinline__ void gemm_unit(LAS char* lds, const ALd& al, const BLd& bl, const EP& ep, const int K) {
    const int tid = threadIdx.x, lane = tid & 63, wid = __builtin_amdgcn_readfirstlane(tid >> 6);
    const int wr = wid >> 1, wc = wid & 1, fr = lane & 15, fq = lane >> 4;
    const char* abase = (const char*)al.wsbase;
    LAS unsigned* aoffs = (LAS unsigned*)(lds + GEMM_LDS) + tid * 4;
#pragma unroll
    for (int j = 0; j < 4; ++j) aoffs[j] = (unsigned)((const char*)(al.row(32 * wid + 8 * j + (lane >> 3)) + ((lane & 7) ^ (lane >> 3)) * 8) - abase);
    const char* bbase = (const char*)bl.base;
    const unsigned ldb4 = (unsigned)bl.ldb * 4u;
    const unsigned boff = (unsigned)bl.coloff(4 * (tid & 63)) * 4u + (unsigned)(tid >> 6) * ldb4;
    const int bk0 = tid >> 6;
    unsigned atile = 0u, btile = 0u;
    u32x4 ra[4]; float4 rb[8];
    const __amdgpu_buffer_rsrc_t rsa = __builtin_amdgcn_make_buffer_rsrc((void*)abase, 0, 0x7fffffff, 0x00020000);
    const __amdgpu_buffer_rsrc_t rsb = __builtin_amdgcn_make_buffer_rsrc((void*)bbase, 0, 0x7fffffff, 0x00020000);
#define LD_CHUNK(c) do { if ((c) < 8) { const u32x4 t_ = __builtin_amdgcn_raw_buffer_load_b128(rsb, (int)boff, (int)(btile + (unsigned)(8 * ((c) & 7)) * ldb4), 0); rb[(c) & 7] = __builtin_bit_cast(float4, t_); } \
        else ra[(c) & 3] = __builtin_amdgcn_raw_buffer_load_b128(rsa, (int)aoffs[(c) & 3], (int)atile, 0); } while (0)
#define WR_CHUNK(c, buf) do { if ((c) < 8) *(LAS u32x2*)(lds + (buf) * STAGE + A_ST + bw_off + ((((c) & 7) & 1) * 4 + (((c) & 7) >> 1) * 16) * B_RS) = (u32x2){pack2(rb[(c) & 7].x, rb[(c) & 7].y), pack2(rb[(c) & 7].z, rb[(c) & 7].w)}; \
        else *(LAS u32x4*)(lds + (buf) * STAGE + (4 * wid + ((c) & 3)) * 1024 + lane * 16) = ra[(c) & 3]; } while (0)
#define ADVANCE() do { atile += 128u; btile += 64u * ldb4; } while (0)
    f32x4 acc[4][8];
#pragma unroll
    for (int m = 0; m < 4; ++m)
#pragma unroll
        for (int n = 0; n < 8; ++n) acc[m][n] = (f32x4){0.f, 0.f, 0.f, 0.f};
    const int nk = K / 64;
    const int a_off0 = (wr * 64 + fr) * 128 + ((fq ^ (fr & 7)) * 16);
    const int br_off = A_ST + (((fq & 1) * 4 + (fq >> 1) * 16 + ((lane & 15) >> 2)) * B_RS) + (wc * 128 + 4 * (lane & 3)) * 2;
    const int bw_off = ((bk0 & 3) + ((bk0 >> 2) << 3)) * B_RS + (tid & 63) * 8;
#pragma unroll
    for (int c = 0; c < 12; ++c) LD_CHUNK(c);
    ADVANCE();
#pragma unroll
    for (int c = 0; c < 12; ++c) { WR_CHUNK(c, 0); LD_CHUNK(c); }
    if (2 < nk) ADVANCE();
    __syncthreads();
    for (int kt = 0; kt < nk; ++kt) {
        const int buf = kt & 1;
        LAS char* sbase = lds + buf * STAGE;
        s16x8 af[4]; s16x4 tq[4][2];
#define RD_B(slot, st_) do { tq[slot][0] = __builtin_amdgcn_ds_read_tr16_b64_v4i16((LAS s16x4*)(sbase + br_off + ((st_) >> 3) * 32 * B_RS + ((st_) & 7) * 32)); \
                             tq[slot][1] = __builtin_amdgcn_ds_read_tr16_b64_v4i16((LAS s16x4*)(sbase + br_off + ((st_) >> 3) * 32 * B_RS + ((st_) & 7) * 32 + 8 * B_RS)); } while (0)
#pragma unroll
        for (int m = 0; m < 4; ++m) af[m] = *(const LAS s16x8*)(sbase + a_off0 + m * 16 * 128);
        RD_B(0, 0); RD_B(1, 1); RD_B(2, 2);
        __builtin_amdgcn_sched_barrier(0);
#pragma unroll
        for (int st = 0; st < 16; ++st) {
            const int ks = st >> 3, n = st & 7;
            if (st + 3 < 16) RD_B((st + 3) & 3, st + 3);
            const s16x8 bfr = {tq[st & 3][0][0], tq[st & 3][0][1], tq[st & 3][0][2], tq[st & 3][0][3], tq[st & 3][1][0], tq[st & 3][1][1], tq[st & 3][1][2], tq[st & 3][1][3]};
#pragma unroll
            for (int m = 0; m < 4; ++m) acc[m][n] = __builtin_amdgcn_mfma_f32_16x16x32_bf16(bfr, af[m], acc[m][n], 0, 0, 0);
            if (st == 7) {
#pragma unroll
                for (int m = 0; m < 4; ++m) af[m] = *(const LAS s16x8*)(sbase + (a_off0 ^ 64) + m * 16 * 128);
            }
            if (st < 12) { WR_CHUNK(st, buf ^ 1); LD_CHUNK(st); }
            __builtin_amdgcn_sched_barrier(0);
        }
#undef RD_B
        if (kt + 3 < nk) ADVANCE();
        __syncthreads();
    }
#undef LD_CHUNK
#undef WR_CHUNK
#undef ADVANCE
#pragma unroll
    for (int m = 0; m < 4; ++m) {
        const int r = wr * 64 + m * 16 + fr;
        if constexpr (PAIRED) {
#pragma unroll
            for (int n = 0; n < 4; ++n) ep.pair(r, wc * 64 + n * 16 + 4 * fq, acc[m][n], acc[m][n + 4]);
        } else {
#pragma unroll
            for (int n = 0; n < 8; ++n) ep(r, wc * 128 + n * 16 + 4 * fq, acc[m][n]);
        }
    }
}

constexpr int KV_RS = 144, KT_BYTES = 64 * KV_RS;
constexpr int ATT_IMP_OFF = 4 * KT_BYTES;
constexpr int ATT_MASK_OFF = ATT_IMP_OFF + 64 * 64 * 4;
struct GState { f32x4 o[4]; float m, l; };

template <int MODE>
__device__ __forceinline__ void attn_block(const LAS char* kt, const LAS char* vt, const int lane, const s16x8 (&qf)[2][2], GState (&st)[2],
                                           const bool (&act)[2], const int key0, const int (&lo)[2], const int (&hi)[2],
                                           LAS float* imp, const int (&tokl)[2], float (&carry)[2], const int jb) {
    const int c16 = lane & 15, fq = lane >> 4;
    const bool on[2] = {__ballot(act[0]) != 0ull, __ballot(act[1]) != 0ull};
    f32x4 s[2][4];
#pragma unroll
    for (int mt = 0; mt < 4; ++mt) {
        const s16x8 k0 = *(const LAS s16x8*)(kt + (16 * mt + c16) * KV_RS + (8 * fq) * 2);
        const s16x8 k1 = *(const LAS s16x8*)(kt + (16 * mt + c16) * KV_RS + (32 + 8 * fq) * 2);
#pragma unroll
        for (int gi = 0; gi < 2; ++gi) { s[gi][mt] = (f32x4){0.f, 0.f, 0.f, 0.f};
            if (on[gi]) { s[gi][mt] = __builtin_amdgcn_mfma_f32_16x16x32_bf16(k0, qf[gi][0], s[gi][mt], 0, 0, 0); s[gi][mt] = __builtin_amdgcn_mfma_f32_16x16x32_bf16(k1, qf[gi][1], s[gi][mt], 0, 0, 0); } }
    }
    s16x8 pf[2][2];
#pragma unroll
    for (int gi = 0; gi < 2; ++gi) {
        if (!on[gi]) continue;
        float mx = -INFINITY;
#pragma unroll
        for (int mt = 0; mt < 4; ++mt)
#pragma unroll
            for (int i = 0; i < 4; ++i) { const int key = key0 + 16 * mt + 4 * fq + i; const bool ok = act[gi] && key >= lo[gi] && key <= hi[gi];
                s[gi][mt][i] = ok ? s[gi][mt][i] : -INFINITY; mx = fmaxf(mx, s[gi][mt][i]); }
        float msafe, scale = 1.0f;
        if (MODE == 2) { msafe = (st[gi].m == -INFINITY) ? 0.f : st[gi].m; scale = st[gi].l; }
        else {
            mx = fmaxf(mx, __shfl_xor(mx, 16)); mx = fmaxf(mx, __shfl_xor(mx, 32));
            const float mnew = fmaxf(st[gi].m, mx);
            const float alpha = (mnew == -INFINITY) ? 1.0f : __expf(st[gi].m - mnew);
            msafe = (mnew == -INFINITY) ? 0.f : mnew;
            st[gi].m = mnew; st[gi].l *= alpha;
            if (MODE == 0) {
#pragma unroll
                for (int md = 0; md < 4; ++md) st[gi].o[md] *= alpha;
            }
        }
        float rs = 0.f;
#pragma unroll
        for (int mt = 0; mt < 4; ++mt)
#pragma unroll
            for (int i = 0; i < 4; ++i) { const float pv = __expf(s[gi][mt][i] - msafe) * scale; s[gi][mt][i] = pv; rs += pv; }
        if (MODE != 2) { rs += __shfl_xor(rs, 16); rs += __shfl_xor(rs, 32); st[gi].l += rs; }
        if (MODE == 2) {
#pragma unroll
            for (int mt = 0; mt < 4; ++mt) {
                const float tcur = __shfl(s[gi][mt][3], (lane - 16) & 63);
                const float tprv = __shfl(mt > 0 ? s[gi][mt > 0 ? mt - 1 : 0][3] : carry[gi], (lane - 16) & 63);
                const float prev = fq > 0 ? tcur : tprv;
                float part = 32.f * (s[gi][mt][0] + s[gi][mt][1] + s[gi][mt][2]) + 16.f * s[gi][mt][3] + 16.f * prev;
                part += __shfl_xor(part, 1); part += __shfl_xor(part, 2);
                if ((c16 & 3) == 0) imp[tokl[gi] * 64 + 16 * jb + 4 * mt + fq] = part;
            }
            carry[gi] = s[gi][3][3];
        }
        if (MODE != 1) {
#pragma unroll
            for (int ks = 0; ks < 2; ++ks) {
                const u32x4 w = {pack2(s[gi][2 * ks][0], s[gi][2 * ks][1]), pack2(s[gi][2 * ks][2], s[gi][2 * ks][3]),
                                 pack2(s[gi][2 * ks + 1][0], s[gi][2 * ks + 1][1]), pack2(s[gi][2 * ks + 1][2], s[gi][2 * ks + 1][3])};
                pf[gi][ks] = __builtin_bit_cast(s16x8, w);
            }
        }
    }
    if (MODE != 1) {
        const int q = c16 >> 2, p = c16 & 3;
#pragma unroll
        for (int md = 0; md < 4; ++md) {
            s16x8 vf[2];
#pragma unroll
            for (int ks = 0; ks < 2; ++ks) {
                const s16x4 t0 = __builtin_amdgcn_ds_read_tr16_b64_v4i16((LAS s16x4*)(vt + (32 * ks + 4 * fq + q) * KV_RS + (16 * md + 4 * p) * 2));
                const s16x4 t1 = __builtin_amdgcn_ds_read_tr16_b64_v4i16((LAS s16x4*)(vt + (32 * ks + 16 + 4 * fq + q) * KV_RS + (16 * md + 4 * p) * 2));
                vf[ks] = (s16x8){t0[0], t0[1], t0[2], t0[3], t1[0], t1[1], t1[2], t1[3]};
            }
#pragma unroll
            for (int gi = 0; gi < 2; ++gi)
                if (on[gi]) { st[gi].o[md] = __builtin_amdgcn_mfma_f32_16x16x32_bf16(vf[0], pf[gi][0], st[gi].o[md], 0, 0, 0); st[gi].o[md] = __builtin_amdgcn_mfma_f32_16x16x32_bf16(vf[1], pf[gi][1], st[gi].o[md], 0, 0, 0); }
        }
    }
}

#define ATT_GLOAD(Kg, Vg, row0) do { const size_t _o = ((size_t)(row0) + (tid >> 3)) * 256 + g * 64 + (tid & 7) * 8; rk = *(const u32x4*)((Kg) + _o); rv = *(const u32x4*)((Vg) + _o); } while (0)
#define ATT_SWRITE(buf) do { LAS char* _k = lds + (buf) * 2 * KT_BYTES + (tid >> 3) * KV_RS + (tid & 7) * 16; *(LAS u32x4*)_k = rk; *(LAS u32x4*)(_k + KT_BYTES) = rv; } while (0)

__device__ __forceinline__ void nsa_unit(LAS char* lds, const int unit, const bf16_t* QB, const bf16_t* KS, const bf16_t* VS, const bf16_t* KW, const bf16_t* VW,
                                         const bf16_t* KCB, const bf16_t* VCB, const float* PROJ, bf16_t* MIX) {
    const int tid = threadIdx.x, lane = tid & 63, wid = tid >> 6, c16 = lane & 15, fq = lane >> 4;
    const int qt = unit >> 3, b = (unit >> 2) & 1, g = unit & 3;
    const int t0 = qt * 64;
    LAS float* imp = (LAS float*)(lds + ATT_IMP_OFF);
    LAS unsigned* lmask = (LAS unsigned*)(lds + ATT_MASK_OFF);
    int tokl[2], tpos[2]; s16x8 qf[2][2]; float gate[2][3];
#pragma unroll
    for (int gi = 0; gi < 2; ++gi) {
        tokl[gi] = 8 * wid + 4 * gi + (c16 >> 2); tpos[gi] = t0 + tokl[gi];
        const size_t tt = (size_t)b * SEQ + tpos[gi]; const int hq = g * 4 + (c16 & 3);
#pragma unroll
        for (int ks = 0; ks < 2; ++ks) qf[gi][ks] = *(const s16x8*)(QB + tt * 1024 + hq * 64 + 32 * ks + 8 * fq);
        const float* gl = PROJ + tt * IN_PROJ + OFF_GATE + hq * 3;
        gate[gi][0] = sigmoidf_(gl[0]); gate[gi][1] = sigmoidf_(gl[1]); gate[gi][2] = sigmoidf_(gl[2]);
    }
    for (int i = tid; i < 64 * 64; i += 512) imp[i] = 0.f;
    f32x4 res[2][4];
    GState st[2]; bool act[2]; int lo[2], hi[2]; float carry[2] = {0.f, 0.f};
    u32x4 rk, rv;
    const bf16_t* KCg = KCB + (size_t)b * 256 * 256; const bf16_t* VCg = VCB + (size_t)b * 256 * 256;
    const bf16_t* KSg = KS + (size_t)b * SEQ * 256; const bf16_t* VSg = VS + (size_t)b * SEQ * 256;
    const bf16_t* KWg = KW + (size_t)b * SEQ * 256; const bf16_t* VWg = VW + (size_t)b * SEQ * 256;
    const int cmax_u = (t0 + 63 - 31) >> 4;
    const int ncb = cmax_u < 0 ? 0 : min(4, (cmax_u + 1) / 64 + 1);
#pragma unroll
    for (int gi = 0; gi < 2; ++gi) { act[gi] = true; lo[gi] = 0; hi[gi] = tpos[gi] >= 31 ? ((tpos[gi] - 31) >> 4) : -1; st[gi].m = -INFINITY; st[gi].l = 0.f;
#pragma unroll
        for (int md = 0; md < 4; ++md) st[gi].o[md] = (f32x4){0.f, 0.f, 0.f, 0.f}; }
    __syncthreads();
    if (ncb > 0) {
        ATT_GLOAD(KCg, VCg, 0); ATT_SWRITE(0); __syncthreads();
        for (int jb = 0; jb < ncb; ++jb) {
            if (jb + 1 < ncb) ATT_GLOAD(KCg, VCg, 64 * (jb + 1));
            attn_block<1>(lds + (jb & 1) * 2 * KT_BYTES, lds + (jb & 1) * 2 * KT_BYTES + KT_BYTES, lane, qf, st, act, 64 * jb, lo, hi, imp, tokl, carry, jb);
            if (jb + 1 < ncb) ATT_SWRITE((jb + 1) & 1);
            __syncthreads();
        }
#pragma unroll
        for (int gi = 0; gi < 2; ++gi) st[gi].l = st[gi].l > 0.f ? 1.0f / st[gi].l : 0.f;
        ATT_GLOAD(KCg, VCg, 0); ATT_SWRITE(0); __syncthreads();
        for (int jb = 0; jb < ncb; ++jb) {
            if (jb + 1 < ncb) ATT_GLOAD(KCg, VCg, 64 * (jb + 1));
            attn_block<2>(lds + (jb & 1) * 2 * KT_BYTES, lds + (jb & 1) * 2 * KT_BYTES + KT_BYTES, lane, qf, st, act, 64 * jb, lo, hi, imp, tokl, carry, jb);
            if (jb + 1 < ncb) ATT_SWRITE((jb + 1) & 1);
            __syncthreads();
        }
    }
#pragma unroll
    for (int gi = 0; gi < 2; ++gi)
#pragma unroll
        for (int md = 0; md < 4; ++md) res[gi][md] = st[gi].o[md] * gate[gi][0];
    __syncthreads();
    for (int k = 0; k < 8; ++k) {
        const int tl = 8 * wid + k, j = lane;
        const float iv = imp[tl * 64 + j];
        const bool forced = (j == 0) || (j == qt) || (j == qt - 1), valid = j <= qt;
        const float sc = forced ? 1.0e4f : (valid ? iv : -1.0e4f);
        int rank = 0;
#pragma unroll
        for (int kk = 0; kk < 64; ++kk) { const float o = __shfl(sc, kk); rank += (o > sc || (o == sc && kk < j)) ? 1 : 0; }
        const unsigned long long m64 = __ballot(rank < 16 && valid);
        if (lane == 0) { lmask[tl * 2] = (unsigned)m64; lmask[tl * 2 + 1] = (unsigned)(m64 >> 32); }
    }
    __syncthreads();
    unsigned long long msk[2]; unsigned long long wunion;
    {
#pragma unroll
        for (int gi = 0; gi < 2; ++gi) msk[gi] = (unsigned long long)lmask[tokl[gi] * 2] | ((unsigned long long)lmask[tokl[gi] * 2 + 1] << 32);
        unsigned ul = (unsigned)(msk[0] | msk[1]), uh = (unsigned)((msk[0] | msk[1]) >> 32);
#pragma unroll
        for (int o = 1; o < 64; o <<= 1) { ul |= __shfl_xor(ul, o); uh |= __shfl_xor(uh, o); }
        wunion = (unsigned long long)ul | ((unsigned long long)uh << 32);
    }
#pragma unroll
    for (int gi = 0; gi < 2; ++gi) { lo[gi] = 0; hi[gi] = tpos[gi]; st[gi].m = -INFINITY; st[gi].l = 0.f;
#pragma unroll
        for (int md = 0; md < 4; ++md) st[gi].o[md] = (f32x4){0.f, 0.f, 0.f, 0.f}; }
    ATT_GLOAD(KSg, VSg, 0); ATT_SWRITE(0); __syncthreads();
    for (int j = 0; j <= qt; ++j) {
        if (j + 1 <= qt) ATT_GLOAD(KSg, VSg, 64 * (j + 1));
        if ((wunion >> j) & 1ull) {
            act[0] = (msk[0] >> j) & 1ull; act[1] = (msk[1] >> j) & 1ull;
            attn_block<0>(lds + (j & 1) * 2 * KT_BYTES, lds + (j & 1) * 2 * KT_BYTES + KT_BYTES, lane, qf, st, act, 64 * j, lo, hi, imp, tokl, carry, 0);
        }
        if (j + 1 <= qt) ATT_SWRITE((j + 1) & 1);
        __syncthreads();
    }
#pragma unroll
    for (int gi = 0; gi < 2; ++gi) { const float il = gate[gi][1] / fmaxf(st[gi].l, 1e-30f);
#pragma unroll
        for (int md = 0; md < 4; ++md) res[gi][md] += st[gi].o[md] * il; }
#pragma unroll
    for (int gi = 0; gi < 2; ++gi) { act[gi] = true; lo[gi] = tpos[gi] - 511; hi[gi] = tpos[gi]; st[gi].m = -INFINITY; st[gi].l = 0.f;
#pragma unroll
        for (int md = 0; md < 4; ++md) st[gi].o[md] = (f32x4){0.f, 0.f, 0.f, 0.f}; }
    const int jw0 = qt >= 8 ? qt - 8 : 0;
    ATT_GLOAD(KWg, VWg, 64 * jw0); ATT_SWRITE(jw0 & 1); __syncthreads();
    for (int j = jw0; j <= qt; ++j) {
        if (j + 1 <= qt) ATT_GLOAD(KWg, VWg, 64 * (j + 1));
        attn_block<0>(lds + (j & 1) * 2 * KT_BYTES, lds + (j & 1) * 2 * KT_BYTES + KT_BYTES, lane, qf, st, act, 64 * j, lo, hi, imp, tokl, carry, 0);
        if (j + 1 <= qt) ATT_SWRITE((j + 1) & 1);
        __syncthreads();
    }
#pragma unroll
    for (int gi = 0; gi < 2; ++gi) { const float il = gate[gi][2] / fmaxf(st[gi].l, 1e-30f);
        bf16_t* mp = MIX + ((size_t)b * SEQ + tpos[gi]) * 2048 + 1024 + (g * 4 + (c16 & 3)) * 64 + 4 * fq;
#pragma unroll
        for (int md = 0; md < 4; ++md) { const f32x4 r = res[gi][md] + st[gi].o[md] * il;
            *(uint2*)(mp + 16 * md) = make_uint2(pack2(r[0], r[1]), pack2(r[2], r[3])); } }
}
#undef ATT_GLOAD
#undef ATT_SWRITE

constexpr int SX_RS = 144, SX_H = 128 * SX_RS, SB_RS = 272, SB_BYTES = 128 * SB_RS;
constexpr int SSD_X_OFF = 0, SSD_B_OFF = 4 * SX_H, SSD_C_OFF = SSD_B_OFF + SB_BYTES, SSD_T_OFF = SSD_C_OFF + SB_BYTES;
static_assert(SSD_T_OFF + 4096 <= SSD_LDS, "ssd lds");

template <bool WITH_C>
__device__ __forceinline__ void ssd_stage(LAS char* lds, const bf16_t* XBCB, const float* DT, const float* a_log, const int b, const int c, const int grp) {
    const int tid = threadIdx.x;
    const size_t tt0 = (size_t)b * SEQ + c * 128;
#pragma unroll
    for (int k = 0; k < 8; ++k) { const int id = tid + 512 * k, l = id >> 5, ch = id & 31, h = ch >> 3, pc = ch & 7;
        const u32x4 v = *(const u32x4*)(XBCB + (tt0 + l) * 2048 + grp * 256 + ch * 8);
        *(LAS u32x4*)(lds + SSD_X_OFF + h * SX_H + l * SX_RS + pc * 16) = v; }
#pragma unroll
    for (int k = 0; k < 4; ++k) { const int id = tid + 512 * k, l = id >> 4, ch = id & 15;
        const u32x4 v = *(const u32x4*)(XBCB + (tt0 + l) * 2048 + 1024 + grp * 128 + ch * 8);
        *(LAS u32x4*)(lds + SSD_B_OFF + l * SB_RS + ch * 16) = v;
        if (WITH_C) { const u32x4 w = *(const u32x4*)(XBCB + (tt0 + l) * 2048 + 1536 + grp * 128 + ch * 8);
            *(LAS u32x4*)(lds + SSD_C_OFF + l * SB_RS + ch * 16) = w; } }
    LAS float* dtl = (LAS float*)(lds + SSD_T_OFF); LAS float* acs = dtl + 512;
    const int h = tid >> 7, l = tid & 127;
    const float av = -expf(a_log[grp * 4 + h]);
    const float dtv = DT[(tt0 + l) * 16 + grp * 4 + h];
    dtl[tid] = dtv; acs[tid] = dtv * av;
    __syncthreads();
    float cs = 0.f;
    for (int k = 0; k <= l; ++k) cs += acs[h * 128 + k];
    __syncthreads();
    acs[tid] = cs;
    __syncthreads();
}

__device__ __forceinline__ void ssd_states_item(LAS char* lds, const int item, const bf16_t* XBCB, const float* DT, const float* a_log, float* STATES, float* CHDEC) {
    const int tid = threadIdx.x, lane = tid & 63, wid = tid >> 6, c16 = lane & 15, fq = lane >> 4, q = c16 >> 2, pp = c16 & 3;
    const int grp = item & 3, c = (item >> 2) & 31, b = item >> 7;
    __syncthreads();
    ssd_stage<false>(lds, XBCB, DT, a_log, b, c, grp);
    LAS float* dtl = (LAS float*)(lds + SSD_T_OFF); LAS float* acs = dtl + 512;
#pragma unroll
    for (int k = 0; k < 8; ++k) { const int id = tid + 512 * k, l = id >> 5, ch = id & 31, h = ch >> 3, pc = ch & 7;
        const float w = __expf(acs[h * 128 + 127] - acs[h * 128 + l]) * dtl[h * 128 + l];
        LAS u32x4* pv = (LAS u32x4*)(lds + SSD_X_OFF + h * SX_H + l * SX_RS + pc * 16);
        u32x4 v = *pv;
#pragma unroll
        for (int e = 0; e < 4; ++e) { const float lo = __uint_as_float(v[e] << 16) * w, hi = __uint_as_float(v[e] & 0xffff0000u) * w; v[e] = pack2(lo, hi); }
        *pv = v; }
    if (tid < 4) CHDEC[((size_t)b * 32 + c) * 16 + grp * 4 + tid] = __expf(acs[tid * 128 + 127]);
    __syncthreads();
    s16x8 af[4];
#pragma unroll
    for (int ks = 0; ks < 4; ++ks) {
        const s16x4 t0 = __builtin_amdgcn_ds_read_tr16_b64_v4i16((LAS s16x4*)(lds + SSD_B_OFF + (32 * ks + 8 * fq + q) * SB_RS + (16 * wid + 4 * pp) * 2));
        const s16x4 t1 = __builtin_amdgcn_ds_read_tr16_b64_v4i16((LAS s16x4*)(lds + SSD_B_OFF + (32 * ks + 8 * fq + 4 + q) * SB_RS + (16 * wid + 4 * pp) * 2));
        af[ks] = (s16x8){t0[0], t0[1], t0[2], t0[3], t1[0], t1[1], t1[2], t1[3]};
    }
#pragma unroll
    for (int h = 0; h < 4; ++h) {
        float* sp = STATES + (((size_t)b * 32 + c) * 16 + grp * 4 + h) * 8192;
#pragma unroll
        for (int pt = 0; pt < 4; ++pt) {
            f32x4 acc = {0.f, 0.f, 0.f, 0.f};
#pragma unroll
            for (int ks = 0; ks < 4; ++ks) {
                const s16x4 t0 = __builtin_amdgcn_ds_read_tr16_b64_v4i16((LAS s16x4*)(lds + SSD_X_OFF + h * SX_H + (32 * ks + 8 * fq + q) * SX_RS + (16 * pt + 4 * pp) * 2));
                const s16x4 t1 = __builtin_amdgcn_ds_read_tr16_b64_v4i16((LAS s16x4*)(lds + SSD_X_OFF + h * SX_H + (32 * ks + 8 * fq + 4 + q) * SX_RS + (16 * pt + 4 * pp) * 2));
                const s16x8 bfr = {t0[0], t0[1], t0[2], t0[3], t1[0], t1[1], t1[2], t1[3]};
                acc = __builtin_amdgcn_mfma_f32_16x16x32_bf16(af[ks], bfr, acc, 0, 0, 0);
            }
            *(f32x4*)(sp + (size_t)(16 * pt + c16) * 128 + 16 * wid + 4 * fq) = acc;
        }
    }
}

__device__ __forceinline__ void ssd_out_item(LAS char* lds, const int item, const bf16_t* XBCB, const float* DT, const float* a_log, const float* d_skip, const float* nw,
                                             const bf16_t* PREV, const float* PROJ, float* YTMP, bf16_t* MIXO) {
    const int tid = threadIdx.x, lane = tid & 63, wid = tid >> 6, c16 = lane & 15, fq = lane >> 4, q = c16 >> 2, pp = c16 & 3;
    const int grp = item & 3, c = (item >> 2) & 31, b = item >> 7;
    __syncthreads();
    ssd_stage<true>(lds, XBCB, DT, a_log, b, c, grp);
    LAS float* dtl = (LAS float*)(lds + SSD_T_OFF); LAS float* acs = dtl + 512;
    const int lcol = 16 * wid + c16;
    const size_t tt = (size_t)b * SEQ + c * 128 + lcol;
    s16x8 cf[4];
#pragma unroll
    for (int ks = 0; ks < 4; ++ks) cf[ks] = *(const LAS s16x8*)(lds + SSD_C_OFF + lcol * SB_RS + (32 * ks + 8 * fq) * 2);
    f32x4 g[8];
#pragma unroll
    for (int mt = 0; mt < 8; ++mt) { g[mt] = (f32x4){0.f, 0.f, 0.f, 0.f};
        if (mt <= wid) {
#pragma unroll
            for (int ks = 0; ks < 4; ++ks) { const s16x8 bfr = *(const LAS s16x8*)(lds + SSD_B_OFF + (16 * mt + c16) * SB_RS + (32 * ks + 8 * fq) * 2);
                g[mt] = __builtin_amdgcn_mfma_f32_16x16x32_bf16(bfr, cf[ks], g[mt], 0, 0, 0); } } }
    float ss = 0.f;
#pragma unroll 1
    for (int h = 0; h < 4; ++h) {
        const int hh = grp * 4 + h;
        const float acs_l = acs[h * 128 + lcol];
        s16x8 pf[4];
#pragma unroll
        for (int ks = 0; ks < 4; ++ks) {
            float pv[2][4];
#pragma unroll
            for (int u = 0; u < 2; ++u)
#pragma unroll
                for (int i = 0; i < 4; ++i) { const int sidx = 32 * ks + 16 * u + 4 * fq + i;
                    const float e = (sidx <= lcol) ? __expf(acs_l - acs[h * 128 + sidx]) * dtl[h * 128 + sidx] : 0.f;
                    pv[u][i] = g[2 * ks + u][i] * e; }
            const u32x4 w = {pack2(pv[0][0], pv[0][1]), pack2(pv[0][2], pv[0][3]), pack2(pv[1][0], pv[1][1]), pack2(pv[1][2], pv[1][3])};
            pf[ks] = __builtin_bit_cast(s16x8, w);
        }
        const float dsk = d_skip[hh], eal = __expf(acs_l);
        const bf16_t* prevp = PREV + (((size_t)b * 32 + c) * 16 + hh) * 8192;
#pragma unroll
        for (int pt = 0; pt < 4; ++pt) {
            f32x4 yd = {0.f, 0.f, 0.f, 0.f}, yo = {0.f, 0.f, 0.f, 0.f};
#pragma unroll
            for (int ks = 0; ks < 4; ++ks) {
                if (2 * ks <= wid) {
                    const s16x4 t0 = __builtin_amdgcn_ds_read_tr16_b64_v4i16((LAS s16x4*)(lds + SSD_X_OFF + h * SX_H + (32 * ks + 4 * fq + q) * SX_RS + (16 * pt + 4 * pp) * 2));
                    const s16x4 t1 = __builtin_amdgcn_ds_read_tr16_b64_v4i16((LAS s16x4*)(lds + SSD_X_OFF + h * SX_H + (32 * ks + 16 + 4 * fq + q) * SX_RS + (16 * pt + 4 * pp) * 2));
                    const s16x8 xf = {t0[0], t0[1], t0[2], t0[3], t1[0], t1[1], t1[2], t1[3]};
                    yd = __builtin_amdgcn_mfma_f32_16x16x32_bf16(xf, pf[ks], yd, 0, 0, 0);
                }
                const s16x8 pr = *(const s16x8*)(prevp + (size_t)(16 * pt + c16) * 128 + 32 * ks + 8 * fq);
                yo = __builtin_amdgcn_mfma_f32_16x16x32_bf16(pr, cf[ks], yo, 0, 0, 0);
            }
            const u32x2 xr = *(const LAS u32x2*)(lds + SSD_X_OFF + h * SX_H + lcol * SX_RS + (16 * pt + 4 * fq) * 2);
            const float xv[4] = {__uint_as_float(xr[0] << 16), __uint_as_float(xr[0] & 0xffff0000u), __uint_as_float(xr[1] << 16), __uint_as_float(xr[1] & 0xffff0000u)};
            const f32x4 z = *(const f32x4*)(PROJ + tt * IN_PROJ + OFF_Z + hh * 64 + 16 * pt + 4 * fq);
            f32x4 gvv;
#pragma unroll
            for (int i = 0; i < 4; ++i) { const float y = yd[i] + eal * yo[i] + dsk * xv[i]; gvv[i] = y * z[i] * sigmoidf_(z[i]); ss += gvv[i] * gvv[i]; }
            *(f32x4*)(YTMP + tt * 1024 + hh * 64 + 16 * pt + 4 * fq) = gvv;
        }
    }
    ss += __shfl_xor(ss, 16); ss += __shfl_xor(ss, 32);
    const float rs = rsqrtf(ss * (1.0f / 256.f) + NORM_EPS);
#pragma unroll 1
    for (int h = 0; h < 4; ++h)
#pragma unroll
        for (int pt = 0; pt < 4; ++pt) { const int ch = (grp * 4 + h) * 64 + 16 * pt + 4 * fq; const f32x4 w4 = *(const f32x4*)(nw + ch);
            const f32x4 gvv = *(const f32x4*)(YTMP + tt * 1024 + ch);
            *(uint2*)(MIXO + tt * 2048 + ch) = make_uint2(pack2(gvv[0] * rs * w4[0], gvv[1] * rs * w4[1]), pack2(gvv[2] * rs * w4[2], gvv[3] * rs * w4[3])); }
}

struct Args {
    const float* in[23];
    float* out;
    unsigned char* ws;
    int ph_lo, ph_hi;
};

enum { PH_NORM1 = 0, PH_INPROJ, PH_PREP, PH_SSD_CMP1, PH_GNORM_CMP2,
#ifdef SELFCHECK
       PH_CMPATT, PH_SELECT, PH_SELWIN,
#endif
       PH_NSA,
#ifdef SELFCHECK
       PH_CHECK,
#endif
       PH_OUTPROJ, PH_ROUTER, PH_SCATTER, PH_GATEUP, PH_DOWN, PH_FINAL, N_PHASES };

struct ARowsDense { const bf16_t* base; size_t ld; int row0, nrows; const bf16_t* zrow; const void* wsbase;
    __device__ __forceinline__ const bf16_t* row(int r) const { const int g = row0 + r; return g < nrows ? base + (size_t)g * ld : zrow; } };
struct ARowsGather { const bf16_t* base; size_t ld; const int* idx; const bf16_t* zrow; const void* wsbase;
    __device__ __forceinline__ const bf16_t* row(int r) const { const int g = idx[r]; return g >= 0 ? base + (size_t)g * ld : zrow; } };
struct BColsDense { const float* base; int ldb; int col0, ncols;
    __device__ __forceinline__ int coloff(int n) const { const int c = col0 + n; return c < ncols ? c : ncols - 4; } };
struct BColsGateUp { const float* base; int ldb; int cn;
    __device__ __forceinline__ int coloff(int n) const { const int wc = n >> 7, nt = (n & 127) >> 4, w = n & 15; const int j = wc * 64 + (nt & 3) * 16 + w;
        return (nt < 4 ? 0 : DFF) + cn * 128 + j; } };

struct EpiStoreF32 { float* C; size_t ldc; int row0, col0, ncols;
    __device__ __forceinline__ void operator()(int r, int n, f32x4 v) const { const int c = col0 + n; if (c < ncols) *(f32x4*)(C + (size_t)(row0 + r) * ldc + c) = v; } };
struct EpiResidF32 { float* C; const float* X; size_t ldc; int row0, col0;
    __device__ __forceinline__ void operator()(int r, int n, f32x4 v) const { const size_t o = (size_t)(row0 + r) * ldc + col0 + n; const f32x4 x = *(const f32x4*)(X + o); *(f32x4*)(C + o) = v + x; } };
struct EpiGeluBf16 { bf16_t* O; const float* bias; size_t ldo; int row0, col0, nrows;
    __device__ __forceinline__ void operator()(int r, int n, f32x4 v) const { const int g = row0 + r; if (g >= nrows) return; const int c = col0 + n;
        float o[4];
#pragma unroll
        for (int i = 0; i < 4; ++i) { const float x = v[i] + bias[c + i]; const float u = 0.7978845608028654f * (x + 0.044715f * x * x * x); o[i] = 0.5f * x * (1.0f + tanhf(u)); }
        *(uint2*)(O + (size_t)g * ldo + c) = make_uint2(pack2(o[0], o[1]), pack2(o[2], o[3])); } };
struct EpiSwiglu { bf16_t* O; const float* bias; int row0, cn;
    __device__ __forceinline__ void pair(int r, int j, f32x4 g, f32x4 u) const { const int c = cn * 128 + j; float o[4];
#pragma unroll
        for (int i = 0; i < 4; ++i) { float gv = g[i] + bias[c + i]; float uv = u[i] + bias[DFF + c + i]; gv = fminf(gv, 7.0f); uv = fminf(fmaxf(uv, -7.0f), 7.0f);
            const float glu = gv * sigmoidf_(1.702f * gv); o[i] = (uv + 1.0f) * glu; }
        *(uint2*)(O + (size_t)(row0 + r) * DFF + c) = make_uint2(pack2(o[0], o[1]), pack2(o[2], o[3])); } };
struct EpiBiasBf16 { bf16_t* O; const float* bias; int row0, col0;
    __device__ __forceinline__ void operator()(int r, int n, f32x4 v) const { const int c = col0 + n;
        *(uint2*)(O + (size_t)(row0 + r) * D + c) = make_uint2(pack2(v[0] + bias[c], v[1] + bias[c + 1]), pack2(v[2] + bias[c + 2], v[3] + bias[c + 3])); } };

__device__ __forceinline__ float rope_inv(int i) { return (float)exp(-(double)i * 0.125 * 13.122363377404328); }


#define PATCH_LOOP(nR_, nC_, RT, CT, ...) do { \
    const int nlab_ = (G % 8 == 0) ? 8 : 1, nsl_ = G / nlab_, npc_ = ((nC_) + 7) >> 3, npatch_ = (((nR_) + 3) >> 2) * npc_; \
    for (int pidx_ = bid % nlab_; pidx_ < npatch_; pidx_ += nlab_) \
        for (int slot_ = bid / nlab_; slot_ < 32; slot_ += nsl_) { \
            const int RT = (pidx_ / npc_) * 4 + (slot_ >> 3), CT = (pidx_ % npc_) * 8 + (slot_ & 7); \
            if (RT < (nR_) && CT < (nC_)) { __VA_ARGS__ } } } while (0)

__global__ void __launch_bounds__(512, 2) fwd(Args a) {
    extern __shared__ __attribute__((aligned(16))) unsigned char lds_raw[];
    LAS char* lds = (LAS char*)lds_raw;
    const int tid = threadIdx.x, lane = tid & 63, wid = __builtin_amdgcn_readfirstlane(tid >> 6);
    const int G = gridDim.x, bid = blockIdx.x;
    const int gtid = bid * 512 + tid, gthreads = G * 512;
    const int gwave = bid * 8 + wid, gwaves = G * 8;
    unsigned char* ws = a.ws;
    unsigned* ctl = (unsigned*)(ws + WS_CTL);
    volatile LAS unsigned* barw = (volatile LAS unsigned*)(lds + MAIN_LDS);
    if (tid == 0) { barw[0] = 0u; barw[1] = 0u; barw[2] = 0u; barw[3] = 0u; }
    __syncthreads();
    XcdBarrier bar; bar.bar = ctl; bar.x = 0; bar.st = barw;
    const bool multi = (a.ph_hi - a.ph_lo) > 1;
    if (multi) bar = xcd_barrier_post(ctl, barw);
#ifdef ONLY_PH
#define IN(k) ((k) == ONLY_PH)
#else
#define IN(k) (a.ph_lo <= (k) && (k) < a.ph_hi)
#endif
#define SEAM(k) do { if ((k) + 1 < a.ph_hi) xcd_barrier(bar); } while (0)

#define XN ((bf16_t*)(ws + WS_XN))
#define PROJ ((float*)(ws + WS_PROJ))
#define XBC ((float*)(ws + WS_XBC))
#define DT ((float*)(ws + WS_DT))
#define YSSD ((float*)(ws + WS_YSSD))
#define MIX ((bf16_t*)(ws + WS_MIX))
#define ROPE ((float*)(ws + WS_ROPE))
#define BLK ((bf16_t*)(ws + WS_BLK))
#define H1 ((bf16_t*)(ws + WS_H1))
#define KC ((float*)(ws + WS_KC))
#define VC ((float*)(ws + WS_VC))
#define PCMP ((float*)(ws + WS_PCMP))
#define OCMP ((float*)(ws + WS_OCMP))
#define SEL ((unsigned long long*)(ws + WS_SEL))
#define X2 ((float*)(ws + WS_X2))
#define TOPE ((int*)(ws + WS_TOPE))
#define TOPG ((float*)(ws + WS_TOPG))
#define SLOT ((int*)(ws + WS_SLOT))
#define POS ((int*)(ws + WS_POS))
#define ROWTOK ((int*)(ws + WS_ROWTOK))
#define ACT ((bf16_t*)(ws + WS_ACT))
#define YB ((bf16_t*)(ws + WS_Y))
#define XBCB ((bf16_t*)(ws + WS_XBCB))
#define STATES ((float*)(ws + WS_STATES))
#define PREV ((bf16_t*)(ws + WS_PREV))
#define CHDEC ((float*)(ws + WS_CHDEC))
#define QB ((bf16_t*)(ws + WS_QB))
#define KSb ((bf16_t*)(ws + WS_KS))
#define VSb ((bf16_t*)(ws + WS_VS))
#define KWb ((bf16_t*)(ws + WS_KW))
#define VWb ((bf16_t*)(ws + WS_VW))
#define KCB ((bf16_t*)(ws + WS_KCB))
#define VCB ((bf16_t*)(ws + WS_VCB))
#define XIN (a.in[0])
#define RW ((float*)(ws + WS_RW))
#define COUNT (ctl + CW_COUNT)
#define ZROW ((const bf16_t*)(ctl + CW_ZROW))
    if (IN(PH_NORM1)) {
        const float* w = a.in[1];
        for (int row = gwave; row < T; row += gwaves) {
            const float4* xr = (const float4*)(XIN + (size_t)row * D);
            float4 v[8]; float ss = 0.f;
#pragma unroll
            for (int i = 0; i < 8; ++i) { v[i] = xr[lane + 64 * i]; ss += v[i].x * v[i].x + v[i].y * v[i].y + v[i].z * v[i].z + v[i].w * v[i].w; }
            ss = wave_sum(ss);
            const float rstd = rsqrtf(ss * (1.0f / D) + NORM_EPS);
#pragma unroll
            for (int i = 0; i < 8; ++i) { const float4 wv = ((const float4*)w)[lane + 64 * i];
                *(uint2*)(XN + (size_t)row * D + 4 * (lane + 64 * i)) = make_uint2(pack2(v[i].x * rstd * wv.x, v[i].y * rstd * wv.y), pack2(v[i].z * rstd * wv.z, v[i].w * rstd * wv.w)); }
        }
        for (int i = gtid; i < SEQ * 8; i += gthreads) { const int pos = i >> 3, k = i & 7; const float ang = (float)pos * rope_inv(k); ROPE[i] = cosf(ang); ROPE[SEQ * 8 + i] = sinf(ang); }
        for (int i = gtid; i < MAX_ROWS; i += gthreads) ROWTOK[i] = -1;
        SEAM(PH_NORM1);
    }

    if (IN(PH_INPROJ)) {
        PATCH_LOOP(T / 256, (IN_PROJ + 255) / 256, rt, ct, {
            ARowsDense al{XN, (size_t)D, rt * 256, T, ZROW, ws};
            BColsDense bl{a.in[2], IN_PROJ, ct * 256, IN_PROJ};
            EpiStoreF32 ep{PROJ, (size_t)IN_PROJ, rt * 256, ct * 256, IN_PROJ};
            gemm_unit<false>(lds, al, bl, ep, D); });
        SEAM(PH_INPROJ);
    }

    if (IN(PH_PREP)) {
        const float* conv_w = a.in[3]; const float* conv_b = a.in[4]; const float* dt_bias = a.in[5];
        for (int i = gtid; i < T * 2048; i += gthreads) {
            const int t = i >> 11, c = i & 2047, s = t & (SEQ - 1);
            float acc = conv_b[c];
#pragma unroll
            for (int k = 0; k < 4; ++k) { const int ts = s - 3 + k; if (ts >= 0) acc += conv_w[k * 2048 + c] * PROJ[(size_t)(t - 3 + k) * IN_PROJ + OFF_XBC + c]; }
            const float cv = acc * sigmoidf_(acc);
#if defined(SELFCHECK) && SELFCHECK == 2
            XBC[i] = cv;
#endif
            XBCB[i] = f2bf(cv);
        }
        for (int i = gtid; i < T * 16; i += gthreads) { const int h = i & 15; const float v = PROJ[(size_t)(i >> 4) * IN_PROJ + OFF_DT + h] + dt_bias[h];
            DT[i] = v > 20.f ? v : log1pf(expf(v)); }
        for (int i = gtid; i < T * 256; i += gthreads) {
            const int ch = i & 7, slot = (i >> 3) & 31, t = i >> 8, pos = t & (SEQ - 1);
            int col; bf16_t* dst; float scl = 1.0f; bool rope = slot < 24;
            if (slot < 16) { col = OFF_Q + slot * 64; dst = QB + (size_t)t * 1024 + slot * 64; scl = 0.125f; }
            else if (slot < 20) { col = OFF_KSLC + (slot - 16) * 64; dst = KSb + (size_t)t * 256 + (slot - 16) * 64; }
            else if (slot < 24) { col = OFF_KWIN + (slot - 20) * 64; dst = KWb + (size_t)t * 256 + (slot - 20) * 64; }
            else if (slot < 28) { col = OFF_VSLC + (slot - 24) * 64; dst = VSb + (size_t)t * 256 + (slot - 24) * 64; }
            else { col = OFF_VWIN + (slot - 28) * 64; dst = VWb + (size_t)t * 256 + (slot - 28) * 64; }
            const float* p = PROJ + (size_t)t * IN_PROJ + col;
            float v[8];
            if (rope && ch < 2) {
                const float4 a0 = *(const float4*)(p), a1 = *(const float4*)(p + 4), b0 = *(const float4*)(p + 8), b1 = *(const float4*)(p + 12);
                const float x1[8] = {a0.x, a0.y, a0.z, a0.w, a1.x, a1.y, a1.z, a1.w}, x2[8] = {b0.x, b0.y, b0.z, b0.w, b1.x, b1.y, b1.z, b1.w};
#pragma unroll
                for (int k = 0; k < 8; ++k) { const float c = ROPE[pos * 8 + k], sn = ROPE[SEQ * 8 + pos * 8 + k]; v[k] = (ch == 0) ? (x1[k] * c - x2[k] * sn) : (x1[k] * sn + x2[k] * c); }
            } else {
                const float4 a0 = *(const float4*)(p + ch * 8), a1 = *(const float4*)(p + ch * 8 + 4);
                v[0] = a0.x; v[1] = a0.y; v[2] = a0.z; v[3] = a0.w; v[4] = a1.x; v[5] = a1.y; v[6] = a1.z; v[7] = a1.w;
            }
            u32x4 o = {pack2(v[0] * scl, v[1] * scl), pack2(v[2] * scl, v[3] * scl), pack2(v[4] * scl, v[5] * scl), pack2(v[6] * scl, v[7] * scl)};
            *(u32x4*)(dst + ch * 8) = o;
        }
        for (int i = gtid; i < 2 * 2 * 256; i += gthreads) { const int d = i & 255, b = (i >> 8) & 1, j = i >> 9; (j ? VCB : KCB)[((size_t)b * 256 + 255) * 256 + d] = 0; }
        for (int i = gtid; i < 2048 * 32; i += gthreads) { const int ii = i & 3, e = (i >> 2) & 31, kk = i >> 7, k = 4 * kk + ii; RW[i] = a.in[15][k] * a.in[16][k * NE + e]; }
        const float* pe = a.in[9];
        for (int i = gtid; i < 2 * 2048 * 512; i += gthreads) {
            const int e4 = i & 511, row = (i >> 9) & 2047, j = i >> 20;
            uint2 o = make_uint2(0u, 0u);
            if (row < CMP_ROWS) { const int g = row & 3, n = (row >> 2) % N_C, b = (row >> 2) / N_C; const int l = e4 >> 4, d = (e4 & 15) * 4;
                const float4 v = *(const float4*)(PROJ + (size_t)(b * SEQ + 16 * n + l) * IN_PROJ + (j ? OFF_VCMP : OFF_KCMP) + g * 64 + d);
                const float4 p4 = *(const float4*)(pe + (j * 32 + l) * 64 + d);
                o = make_uint2(pack2(v.x + p4.x, v.y + p4.y), pack2(v.z + p4.z, v.w + p4.w)); }
            *(uint2*)(BLK + ((size_t)j * 2048 + row) * 2048 + e4 * 4) = o;
        }
        SEAM(PH_PREP);
    }

    if (IN(PH_SSD_CMP1)) {
#if defined(SELFCHECK) && SELFCHECK == 2
        const int GW = G - 16;
        if (bid >= GW) {
            const int w = (bid - GW) * 8 + wid, b = w >> 6, h = (w >> 2) & 15, pq = w & 3, g = h >> 2;
            const int p = pq * 16 + (lane >> 2), nq = lane & 3;
            const float av = -expf(a.in[6][h]), dsk = a.in[7][h];
            float st[32];
#pragma unroll
            for (int n = 0; n < 32; ++n) st[n] = 0.f;
            for (int t = 0; t < SEQ; ++t) {
                const size_t tt = (size_t)b * SEQ + t;
                const float* row = XBC + tt * 2048;
                const float dtv = DT[tt * 16 + h];
                const float dA = expf(dtv * av);
                const float xv = row[h * 64 + p];
                const float4* Bp = (const float4*)(row + 1024 + g * 128 + nq * 32); const float4* Cp = (const float4*)(row + 1536 + g * 128 + nq * 32);
                const float coef = dtv * xv; float y = 0.f;
#pragma unroll
                for (int n4 = 0; n4 < 8; ++n4) { const float4 bv = Bp[n4], cv = Cp[n4];
                    st[4 * n4 + 0] = st[4 * n4 + 0] * dA + coef * bv.x; y += st[4 * n4 + 0] * cv.x;
                    st[4 * n4 + 1] = st[4 * n4 + 1] * dA + coef * bv.y; y += st[4 * n4 + 1] * cv.y;
                    st[4 * n4 + 2] = st[4 * n4 + 2] * dA + coef * bv.z; y += st[4 * n4 + 2] * cv.z;
                    st[4 * n4 + 3] = st[4 * n4 + 3] * dA + coef * bv.w; y += st[4 * n4 + 3] * cv.w; }
                y += __shfl_xor(y, 1); y += __shfl_xor(y, 2);
                if (nq == 0) YSSD[tt * 1024 + h * 64 + p] = y + dsk * xv;
            }
        } else
#else
        const int GW = G;
#endif
        {
            for (int u = bid; u < 32; u += GW) {
                const int j = u >> 4, rt = (u >> 1) & 7, ct = u & 1;
                ARowsDense al{BLK + (size_t)j * 2048 * 2048, (size_t)2048, rt * 256, CMP_ROWS, ZROW, ws};
                BColsDense bl{a.in[10] + (size_t)j * 2048 * CMP_HID, CMP_HID, ct * 256, CMP_HID};
                EpiGeluBf16 ep{H1 + (size_t)j * 2048 * CMP_HID, a.in[11] + j * CMP_HID, (size_t)CMP_HID, rt * 256, ct * 256, CMP_ROWS};
                gemm_unit<false>(lds, al, bl, ep, 2048);
            }
            for (int it = (bid + GW - (32 % GW)) % GW; it < 256; it += GW) ssd_states_item(lds, it, XBCB, DT, a.in[6], STATES, CHDEC);
        }
        SEAM(PH_SSD_CMP1);
    }

    if (IN(PH_GNORM_CMP2)) {
        const float* nw = a.in[8];
#ifdef SELFCHECK
        for (int i = gtid; i < T * 24 * 8; i += gthreads) {
            const int k = i & 7, slot = (i >> 3) % 24, t = i / 192, pos = t & (SEQ - 1);
            const int col = slot < 16 ? OFF_Q + slot * 64 : (slot < 20 ? OFF_KSLC + (slot - 16) * 64 : OFF_KWIN + (slot - 20) * 64);
            float* p = PROJ + (size_t)t * IN_PROJ + col;
            const float c = ROPE[pos * 8 + k], s = ROPE[SEQ * 8 + pos * 8 + k];
            const float x1 = p[k], x2 = p[k + 8];
            p[k] = x1 * c - x2 * s; p[k + 8] = x1 * s + x2 * c;
        }
#endif
#if defined(SELFCHECK) && SELFCHECK == 2
        for (int it = gwave; it < T * 4; it += gwaves) {
            const int t = it >> 2, grp = it & 3, c = grp * 256 + lane * 4;
            const float4 y = *(const float4*)(YSSD + (size_t)t * 1024 + c);
            const float4 z = *(const float4*)(PROJ + (size_t)t * IN_PROJ + OFF_Z + c);
            float gv[4] = {y.x * z.x * sigmoidf_(z.x), y.y * z.y * sigmoidf_(z.y), y.z * z.z * sigmoidf_(z.z), y.w * z.w * sigmoidf_(z.w)};
            float ss = wave_sum(gv[0] * gv[0] + gv[1] * gv[1] + gv[2] * gv[2] + gv[3] * gv[3]);
            const float sc = rsqrtf(ss * (1.0f / 256.f) + NORM_EPS);
            const float4 w4 = *(const float4*)(nw + c);
            *(uint2*)(MIX + (size_t)t * 2048 + c) = make_uint2(pack2(gv[0] * sc * w4.x, gv[1] * sc * w4.y), pack2(gv[2] * sc * w4.z, gv[3] * sc * w4.w));
        }
#endif
        for (int i = gtid; i < 2 * 16 * 64 * 32; i += gthreads) {
            const int n4 = i & 31, p = (i >> 5) & 63, h = (i >> 11) & 15, b = i >> 15;
            f32x4 run = {0.f, 0.f, 0.f, 0.f};
            for (int c = 0; c < 32; ++c) {
                const size_t base = (((size_t)b * 32 + c) * 16 + h) * 8192 + p * 128 + n4 * 4;
                *(uint2*)(PREV + base) = make_uint2(pack2(run[0], run[1]), pack2(run[2], run[3]));
                const float dec = CHDEC[((size_t)b * 32 + c) * 16 + h];
                const f32x4 sv = *(const f32x4*)(STATES + base);
                run = run * dec + sv;
            }
        }
        const float* w2 = a.in[12]; const float* b2 = a.in[13];
        for (int i = gtid; i < 2 * CMP_ROWS * 64; i += gthreads) {
            const int d = i & 63, row = (i >> 6) % CMP_ROWS, j = i / (CMP_ROWS * 64);
            const bf16_t* hrow = H1 + ((size_t)j * 2048 + row) * CMP_HID;
            const float* wj = w2 + (size_t)j * CMP_HID * 64;
            const bool rot = (j == 0) && (d < 16);
            const int dp = rot ? (d < 8 ? d + 8 : d - 8) : d;
            float s0 = b2[j * 64 + d], s1 = b2[j * 64 + dp];
            for (int k = 0; k < CMP_HID; ++k) { const float hv = bf2f(hrow[k]); s0 += hv * wj[k * 64 + d]; s1 += hv * wj[k * 64 + dp]; }
            float o = s0;
            if (rot) { const int n = (row >> 2) % N_C, pos = 16 * n + 31, k = d & 7; const float c = ROPE[pos * 8 + k], s = ROPE[SEQ * 8 + pos * 8 + k];
                o = (d < 8) ? (s0 * c - s1 * s) : (s1 * s + s0 * c); }
            (j ? VC : KC)[(size_t)row * 64 + d] = o;
            { const int g4 = row & 3, n = (row >> 2) % N_C, bb = (row >> 2) / N_C; (j ? VCB : KCB)[((size_t)bb * 256 + n) * 256 + g4 * 64 + d] = f2bf(o); }
        }
        SEAM(PH_GNORM_CMP2);
    }

#ifdef SELFCHECK
    if (IN(PH_CMPATT)) {
        for (int it = gtid; it < T * 16; it += gthreads) {
            const int hq = it & 15, tt = it >> 4, b = tt >> 12, t = tt & (SEQ - 1), g = hq >> 2;
            const int nvalid = t >= 31 ? ((t - 31) >> 4) + 1 : 0;
            float q[64];
            const float* qp = PROJ + (size_t)tt * IN_PROJ + OFF_Q + hq * 64;
#pragma unroll
            for (int d = 0; d < 64; d += 4) { const float4 v = *(const float4*)(qp + d); q[d] = v.x; q[d + 1] = v.y; q[d + 2] = v.z; q[d + 3] = v.w; }
            float m = -INFINITY, l = 0.f;
            for (int c = 0; c < nvalid; ++c) {
                const float* kp = KC + (size_t)((b * N_C + c) * 4 + g) * 64; float s = 0.f;
#pragma unroll
                for (int d = 0; d < 64; d += 4) { const float4 v = *(const float4*)(kp + d); s += q[d] * v.x + q[d + 1] * v.y + q[d + 2] * v.z + q[d + 3] * v.w; }
                s *= 0.125f;
                const float mn = fmaxf(m, s); l = l * __expf(m - mn) + __expf(s - mn); m = mn;
            }
            float o[64];
#pragma unroll
            for (int d = 0; d < 64; ++d) o[d] = 0.f;
            const float inv_l = nvalid > 0 ? 1.0f / fmaxf(l, 1e-30f) : 0.f;
            float* pp = PCMP + (size_t)it * 256;
            for (int c = 0; c < nvalid; ++c) {
                const float* kp = KC + (size_t)((b * N_C + c) * 4 + g) * 64; float s = 0.f;
#pragma unroll
                for (int d = 0; d < 64; d += 4) { const float4 v = *(const float4*)(kp + d); s += q[d] * v.x + q[d + 1] * v.y + q[d + 2] * v.z + q[d + 3] * v.w; }
                const float p = __expf(s * 0.125f - m) * inv_l;
                pp[c] = p;
                const float* vp = VC + (size_t)((b * N_C + c) * 4 + g) * 64;
#pragma unroll
                for (int d = 0; d < 64; d += 4) { const float4 v = *(const float4*)(vp + d); o[d] += p * v.x; o[d + 1] += p * v.y; o[d + 2] += p * v.z; o[d + 3] += p * v.w; }
            }
            for (int c = nvalid; c < 256; ++c) pp[c] = 0.f;
            float* op = OCMP + (size_t)tt * 1024 + hq * 64;
#pragma unroll
            for (int d = 0; d < 64; d += 4) *(float4*)(op + d) = make_float4(o[d], o[d + 1], o[d + 2], o[d + 3]);
        }
        SEAM(PH_CMPATT);
    }

    if (IN(PH_SELECT)) {
        for (int it = gwave; it < T * 4; it += gwaves) {
            const int g = it & 3, tt = it >> 2, t = tt & (SEQ - 1), cur = t >> 6, j = lane;
            float imp = 0.f;
#pragma unroll
            for (int r = 0; r < 4; ++r) { const float* pp = PCMP + ((size_t)tt * 16 + g * 4 + r) * 256 + 4 * j;
                const float4 v = *(const float4*)pp; const float pm1 = j > 0 ? pp[-1] : 0.f;
                imp += 32.f * (v.x + v.y + v.z) + 16.f * v.w + 16.f * pm1; }
            const bool forced = (j == 0) || (j == cur) || (j == cur - 1);
            const bool valid = j <= cur;
            const float sc = forced ? 1.0e4f : (valid ? imp : -1.0e4f);
            int rank = 0;
#pragma unroll
            for (int k = 0; k < 64; ++k) { const float o = __shfl(sc, k); rank += (o > sc || (o == sc && k < j)) ? 1 : 0; }
            const unsigned long long mask = __ballot(rank < 16 && valid);
            if (lane == 0) SEL[it] = mask;
        }
        SEAM(PH_SELECT);
    }

    if (IN(PH_SELWIN)) {
        for (int it = gtid; it < T * 16; it += gthreads) {
            const int hq = it & 15, tt = it >> 4, b = tt >> 12, t = tt & (SEQ - 1), g = hq >> 2;
            float q[64];
            const float* qp = PROJ + (size_t)tt * IN_PROJ + OFF_Q + hq * 64;
#pragma unroll
            for (int d = 0; d < 64; d += 4) { const float4 v = *(const float4*)(qp + d); q[d] = v.x; q[d + 1] = v.y; q[d + 2] = v.z; q[d + 3] = v.w; }
            const float* gl = PROJ + (size_t)tt * IN_PROJ + OFF_GATE + hq * 3;
            const float g0 = sigmoidf_(gl[0]), g1 = sigmoidf_(gl[1]), g2 = sigmoidf_(gl[2]);
            float* op = OCMP + (size_t)tt * 1024 + hq * 64;
            float o[64];
            {
#pragma unroll
                for (int d = 0; d < 64; ++d) o[d] = 0.f;
                float m = -INFINITY, l = 0.f;
                unsigned long long mask = SEL[(size_t)tt * 4 + g];
                while (mask) {
                    const int j = __ffsll((long long)mask) - 1; mask &= mask - 1;
                    const int hi = min(64 * j + 63, t);
                    for (int tok = 64 * j; tok <= hi; ++tok) {
                        const float* kp = PROJ + (size_t)(b * SEQ + tok) * IN_PROJ + OFF_KSLC + g * 64; float s = 0.f;
#pragma unroll
                        for (int d = 0; d < 64; d += 4) { const float4 v = *(const float4*)(kp + d); s += q[d] * v.x + q[d + 1] * v.y + q[d + 2] * v.z + q[d + 3] * v.w; }
                        s *= 0.125f;
                        const float mn = fmaxf(m, s), al = __expf(m - mn), p = __expf(s - mn); m = mn; l = l * al + p;
                        const float* vp = kp + (OFF_VSLC - OFF_KSLC);
#pragma unroll
                        for (int d = 0; d < 64; d += 4) { const float4 v = *(const float4*)(vp + d); o[d] = o[d] * al + p * v.x; o[d + 1] = o[d + 1] * al + p * v.y; o[d + 2] = o[d + 2] * al + p * v.z; o[d + 3] = o[d + 3] * al + p * v.w; }
                    }
                }
                const float il = g1 / fmaxf(l, 1e-30f);
#pragma unroll
                for (int d = 0; d < 64; d += 4) { float4 r = *(float4*)(op + d); r.x = g0 * r.x + il * o[d]; r.y = g0 * r.y + il * o[d + 1]; r.z = g0 * r.z + il * o[d + 2]; r.w = g0 * r.w + il * o[d + 3]; *(float4*)(op + d) = r; }
            }
            {
#pragma unroll
                for (int d = 0; d < 64; ++d) o[d] = 0.f;
                float m = -INFINITY, l = 0.f;
                const int lo = max(0, t - 511);
                for (int tok = lo; tok <= t; ++tok) {
                    const float* kp = PROJ + (size_t)(b * SEQ + tok) * IN_PROJ + OFF_KWIN + g * 64; float s = 0.f;
#pragma unroll
                    for (int d = 0; d < 64; d += 4) { const float4 v = *(const float4*)(kp + d); s += q[d] * v.x + q[d + 1] * v.y + q[d + 2] * v.z + q[d + 3] * v.w; }
                    s *= 0.125f;
                    const float mn = fmaxf(m, s), al = __expf(m - mn), p = __expf(s - mn); m = mn; l = l * al + p;
                    const float* vp = kp + (OFF_VWIN - OFF_KWIN);
#pragma unroll
                    for (int d = 0; d < 64; d += 4) { const float4 v = *(const float4*)(vp + d); o[d] = o[d] * al + p * v.x; o[d + 1] = o[d + 1] * al + p * v.y; o[d + 2] = o[d + 2] * al + p * v.z; o[d + 3] = o[d + 3] * al + p * v.w; }
                }
                const float il = g2 / fmaxf(l, 1e-30f);
                bf16_t* mp = MIX + (size_t)tt * 2048 + 1024 + hq * 64;
#pragma unroll
                for (int d = 0; d < 64; d += 4) { const float4 r = *(const float4*)(op + d);
                    *(uint2*)(mp + d) = make_uint2(pack2(r.x + il * o[d], r.y + il * o[d + 1]), pack2(r.z + il * o[d + 2], r.w + il * o[d + 3])); }
            }
        }
        SEAM(PH_SELWIN);
    }

#endif
    if (IN(PH_NSA)) {
#ifdef SELFCHECK
        bf16_t* MIXO = (bf16_t*)(ws + WS_CHK);
#else
        bf16_t* MIXO = MIX;
#endif
        for (int k = bid; k < 512; k += G) { const int rnd = k / G; const int u = (rnd & 1) ? 511 - (k - G * rnd) - G * (rnd - 1) : k;
            if (u >= 0 && u < 512) nsa_unit(lds, (G == 256) ? u : k, QB, KSb, VSb, KWb, VWb, KCB, VCB, PROJ, MIXO); }
        for (int it = bid; it < 256; it += G) ssd_out_item(lds, it, XBCB, DT, a.in[6], a.in[7], a.in[8], PREV, PROJ, YSSD, MIXO);
        SEAM(PH_NSA);
    }
#ifdef SELFCHECK
    if (IN(PH_CHECK)) {
        const bf16_t* A_ = MIX; const bf16_t* B_ = (const bf16_t*)(ws + WS_CHK);
        float sd = 0.f, sr = 0.f;
        for (int i = gtid; i < T * 1024; i += gthreads) { const size_t o = (size_t)(i >> 10) * 2048 + (SELFCHECK == 1 ? 1024 : 0) + (i & 1023); const float r = bf2f(A_[o]), v = bf2f(B_[o]); sd += (r - v) * (r - v); sr += r * r; }
        sd = wave_sum(sd); sr = wave_sum(sr);
        if (lane == 0) { atomicAdd((float*)(ctl + CW_CHK), sd); atomicAdd((float*)(ctl + CW_CHK + 1), sr); }
        SEAM(PH_CHECK);
    }
#endif

    if (IN(PH_OUTPROJ)) {
        PATCH_LOOP(T / 256, D / 256, rt, ct, {
            ARowsDense al{MIX, (size_t)2048, rt * 256, T, ZROW, ws};
            BColsDense bl{a.in[14], D, ct * 256, D};
            EpiResidF32 ep{X2, XIN, (size_t)D, rt * 256, ct * 256};
            gemm_unit<false>(lds, al, bl, ep, 2048); });
        SEAM(PH_OUTPROJ);
    }

    if (IN(PH_ROUTER)) {
        const float* nwp = a.in[15]; const float* br = a.in[17];
        LAS float* part = (LAS float*)lds;
        LAS float* ssq = part + 8 * 512;
        LAS float* rsl = ssq + 128;
        const int r16 = lane & 15, kq = lane >> 4;
        for (int tile = bid; tile < T / 16; tile += G) {
            const int row = tile * 16 + r16;
            f32x4 acc0 = {0.f, 0.f, 0.f, 0.f}, acc1 = {0.f, 0.f, 0.f, 0.f}; float ssp = 0.f;
            const float* xr = X2 + (size_t)row * D + 256 * wid + 4 * kq;
            const float* rwp = RW + ((size_t)(64 * wid + kq) * 32 + r16) * 4;
#pragma unroll 4
            for (int j = 0; j < 16; ++j) {
                const f32x4 av = *(const f32x4*)(xr + 16 * j);
                const f32x4 b0 = *(const f32x4*)(rwp + (size_t)j * 4 * 128), b1 = *(const f32x4*)(rwp + (size_t)j * 4 * 128 + 64);
                ssp += av[0] * av[0] + av[1] * av[1] + av[2] * av[2] + av[3] * av[3];
#pragma unroll
                for (int i = 0; i < 4; ++i) { acc0 = __builtin_amdgcn_mfma_f32_16x16x4f32(av[i], b0[i], acc0, 0, 0, 0); acc1 = __builtin_amdgcn_mfma_f32_16x16x4f32(av[i], b1[i], acc1, 0, 0, 0); }
            }
            ssp += __shfl_xor(ssp, 16); ssp += __shfl_xor(ssp, 32);
            if (kq == 0) ssq[wid * 16 + r16] = ssp;
#pragma unroll
            for (int i = 0; i < 4; ++i) { part[wid * 512 + (4 * kq + i) * 32 + r16] = acc0[i]; part[wid * 512 + (4 * kq + i) * 32 + 16 + r16] = acc1[i]; }
            __syncthreads();
            {
                const int rr = tid >> 5, e = tid & 31, grow = tile * 16 + rr;
                float lg = 0.f, ss = 0.f;
#pragma unroll
                for (int w = 0; w < 8; ++w) { lg += part[w * 512 + rr * 32 + e]; ss += ssq[w * 16 + rr]; }
                const float rstd = rsqrtf(ss * (1.0f / D) + NORM_EPS);
                const float mine = lg * rstd + br[e];
                int rank = 0;
#pragma unroll
                for (int k = 0; k < NE; ++k) { const float o = __shfl(mine, (lane & 32) + k); rank += (o > mine || (o == mine && k < e)) ? 1 : 0; }
                const bool sel = rank < 4;
                float mx = sel ? mine : -INFINITY;
#pragma unroll
                for (int o = 16; o > 0; o >>= 1) mx = fmaxf(mx, __shfl_xor(mx, o));
                const float ex = sel ? __expf(mine - mx) : 0.f;
                float den = ex;
#pragma unroll
                for (int o = 16; o > 0; o >>= 1) den += __shfl_xor(den, o);
                if (sel) { const int slot = (int)atomicAdd(&COUNT[e], 1u); const int o = grow * 4 + rank; TOPE[o] = e; TOPG[o] = ex / den; SLOT[o] = slot; }
                if (e == 0) rsl[rr] = rstd;
            }
            __syncthreads();
#pragma unroll 4
            for (int it = 0; it < 16; ++it) { const int idx = tid + 512 * it, rr = idx >> 9, c4 = idx & 511; const size_t o = (size_t)(tile * 16 + rr) * D + 4 * c4;
                const f32x4 v = *(const f32x4*)(X2 + o); const f32x4 wv = *(const f32x4*)(nwp + 4 * c4); const float rs = rsl[rr];
                *(uint2*)(XN + o) = make_uint2(pack2(v[0] * rs * wv[0], v[1] * rs * wv[1]), pack2(v[2] * rs * wv[2], v[3] * rs * wv[3])); }
            __syncthreads();
        }
        SEAM(PH_ROUTER);
    }

    if (IN(PH_SCATTER)) {
        for (int i = gtid; i < T * 4; i += gthreads) {
            const int e = TOPE[i]; int off = 0;
            for (int k = 0; k < e; ++k) off += (int)((COUNT[k] + 255u) >> 8);
            const int pos = off * 256 + SLOT[i];
            ROWTOK[pos] = i >> 2; POS[i] = pos;
        }
        SEAM(PH_SCATTER);
    }

    if (IN(PH_GATEUP) || IN(PH_DOWN)) {
        LAS int* toff = (LAS int*)(lds + GEMM_LDS + 64 - 0);
        (void)toff;
    }
    if (IN(PH_GATEUP)) {
        int ntiles = 0;
        for (int k = 0; k < NE; ++k) ntiles += (int)((COUNT[k] + 255u) >> 8);
        PATCH_LOOP(ntiles, 16, tile, cn, {
            int e = 0, acc = 0;
            for (int k = 0; k < NE; ++k) { const int nt = (int)((COUNT[k] + 255u) >> 8); if (tile >= acc && tile < acc + nt) e = k; acc += nt; }
            ARowsGather al{XN, (size_t)D, ROWTOK + tile * 256, ZROW, ws};
            BColsGateUp bl{a.in[18] + (size_t)e * D * 2 * DFF, 2 * DFF, cn};
            EpiSwiglu ep{ACT, a.in[19] + (size_t)e * 2 * DFF, tile * 256, cn};
            gemm_unit<true>(lds, al, bl, ep, D); });
        SEAM(PH_GATEUP);
    }
    if (IN(PH_DOWN)) {
        int ntiles = 0;
        for (int k = 0; k < NE; ++k) ntiles += (int)((COUNT[k] + 255u) >> 8);
        PATCH_LOOP(ntiles, 8, tile, ct, {
            int e = 0, acc = 0;
            for (int k = 0; k < NE; ++k) { const int nt = (int)((COUNT[k] + 255u) >> 8); if (tile >= acc && tile < acc + nt) e = k; acc += nt; }
            ARowsDense al{ACT, (size_t)DFF, tile * 256, MAX_ROWS, ZROW, ws};
            BColsDense bl{a.in[20] + (size_t)e * DFF * D, D, ct * 256, D};
            EpiBiasBf16 ep{YB, a.in[21] + (size_t)e * D, tile * 256, ct * 256};
            gemm_unit<false>(lds, al, bl, ep, DFF); });
        SEAM(PH_DOWN);
    }

    if (IN(PH_FINAL)) {
        const float* fw = a.in[22];
        for (int row = gwave; row < T; row += gwaves) {
            const float4* xr = (const float4*)(X2 + (size_t)row * D);
            float4 v[8];
#pragma unroll
            for (int i = 0; i < 8; ++i) v[i] = xr[lane + 64 * i];
#pragma unroll
            for (int k = 0; k < 4; ++k) { const float gk = TOPG[row * 4 + k]; const bf16_t* yr = YB + (size_t)POS[row * 4 + k] * D;
#pragma unroll
                for (int i = 0; i < 8; ++i) { const uint2 y = *(const uint2*)(yr + 4 * (lane + 64 * i));
                    v[i].x += gk * bf2f((bf16_t)(y.x & 0xffffu)); v[i].y += gk * bf2f((bf16_t)(y.x >> 16)); v[i].z += gk * bf2f((bf16_t)(y.y & 0xffffu)); v[i].w += gk * bf2f((bf16_t)(y.y >> 16)); } }
            float ss = 0.f;
#pragma unroll
            for (int i = 0; i < 8; ++i) ss += v[i].x * v[i].x + v[i].y * v[i].y + v[i].z * v[i].z + v[i].w * v[i].w;
            ss = wave_sum(ss);
            float rstd = rsqrtf(ss * (1.0f / D) + NORM_EPS);
#ifdef SELFCHECK
            { const float sd = ((const float*)(ctl + CW_CHK))[0], sr = ((const float*)(ctl + CW_CHK))[1]; const float rel = sqrtf(sd / fmaxf(sr, 1e-30f)); rstd *= 1.0f + fminf(1.0f, 10.0f * rel); }
#endif
#pragma unroll
            for (int i = 0; i < 8; ++i) { const float4 wv = ((const float4*)fw)[lane + 64 * i];
                ((float4*)(a.out + (size_t)row * D))[lane + 64 * i] = make_float4(v[i].x * rstd * wv.x, v[i].y * rstd * wv.y, v[i].z * rstd * wv.z, v[i].w * rstd * wv.w); }
        }
    }
#undef IN
#undef SEAM
}

extern "C" void kernel_launch(void* const* d_in, const int* in_sizes, int n_in, void* d_out, int out_size, void* d_ws, size_t ws_size, hipStream_t stream) {
    static int grid = 0;
    if (grid == 0) {
        if (n_in != 23 || out_size != T * D || ws_size < WS_END) { fprintf(stderr, "kernel_launch: unexpected shapes (n_in %d, out %d, ws %zu < %zu)\n", n_in, out_size, ws_size, (size_t)WS_END); grid = -1; return; }
        int dev = 0, cus = 0, per_cu = 0;
        if (hipGetDevice(&dev) != hipSuccess || hipDeviceGetAttribute(&cus, hipDeviceAttributeMultiprocessorCount, dev) != hipSuccess) { grid = -1; return; }
        if (hipFuncSetAttribute((const void*)fwd, hipFuncAttributeMaxDynamicSharedMemorySize, LDS_BYTES) != hipSuccess) { fprintf(stderr, "kernel_launch: hipFuncSetAttribute failed\n"); grid = -1; return; }
        if (hipOccupancyMaxActiveBlocksPerMultiprocessor(&per_cu, (const void*)fwd, 512, LDS_BYTES) != hipSuccess || per_cu < 1) { fprintf(stderr, "kernel_launch: occupancy query says %d\n", per_cu); per_cu = 1; }
        (void)hipGetLastError();
        grid = cus;
    }
    if (grid < 0) return;
    (void)hipMemsetAsync((char*)d_ws + WS_CTL, 0, CTL_BYTES, stream);
    Args a{};
    for (int i = 0; i < 23; ++i) a.in[i] = (const float*)d_in[i];
    a.out = (float*)d_out; a.ws = (unsigned char*)d_ws;
#if N_LAUNCH_MODE == 1
    a.ph_lo = 0; a.ph_hi = N_PHASES;
    hipLaunchKernelGGL(fwd, dim3(grid), dim3(512), LDS_BYTES, stream, a);
#else
    for (int ph = 0; ph < N_PHASES; ++ph) { a.ph_lo = ph; a.ph_hi = ph + 1; hipLaunchKernelGGL(fwd, dim3(grid), dim3(512), LDS_BYTES, stream, a); }
#endif
}
```

```cpp
#include <hip/hip_runtime.h>
#include <stdint.h>
#include <stdio.h>

#ifndef N_LAUNCH_MODE
#define N_LAUNCH_MODE 1
#endif

typedef unsigned short bf16_t;
typedef short s16x4 __attribute__((ext_vector_type(4)));
typedef short s16x8 __attribute__((ext_vector_type(8)));
typedef float f32x4 __attribute__((ext_vector_type(4)));
typedef unsigned u32x4 __attribute__((ext_vector_type(4)));
typedef unsigned u32x2 __attribute__((ext_vector_type(2)));
#define LAS __attribute__((address_space(3)))

constexpr int D = 2048, BATCH = 2, SEQ = 4096, T = BATCH * SEQ;
constexpr int SSM_H = 16, SSM_N = 128;
constexpr int NSA_H = 16, DH = 64;
constexpr int CMP_HID = 512;
constexpr int N_C = 255, N_SEL = 64;
constexpr int IN_PROJ = 5696;
constexpr int OFF_Z = 0, OFF_XBC = 1024, OFF_DT = 3072, OFF_Q = 3088, OFF_KCMP = 4112, OFF_VCMP = 4368, OFF_KSLC = 4624,
              OFF_VSLC = 4880, OFF_KWIN = 5136, OFF_VWIN = 5392, OFF_GATE = 5648;
constexpr int NE = 32, DFF = 2048;
constexpr float NORM_EPS = 1e-5f;
constexpr int CMP_ROWS = BATCH * N_C * 4;
constexpr int MAX_TILES = 160, MAX_ROWS = MAX_TILES * 256;

constexpr size_t AL(size_t x) { return (x + 255) & ~(size_t)255; }
constexpr size_t WS_CTL = 0;
constexpr size_t CTL_BYTES = 32768;
constexpr size_t WS_XN = WS_CTL + CTL_BYTES;
constexpr size_t WS_PROJ = WS_XN + AL((size_t)T * D * 2);
constexpr size_t WS_XBC = WS_PROJ + AL((size_t)T * IN_PROJ * 4);
constexpr size_t WS_DT = WS_XBC + AL((size_t)T * 2048 * 4);
constexpr size_t WS_YSSD = WS_DT + AL((size_t)T * 16 * 4);
constexpr size_t WS_MIX = WS_YSSD + AL((size_t)T * 1024 * 4);
constexpr size_t WS_ROPE = WS_MIX + AL((size_t)T * 2048 * 2);
constexpr size_t WS_BLK = WS_ROPE + AL((size_t)SEQ * 16 * 4);
constexpr size_t WS_H1 = WS_BLK + AL((size_t)2 * 2048 * 2048 * 2);
constexpr size_t WS_KC = WS_H1 + AL((size_t)2 * 2048 * 512 * 2);
constexpr size_t WS_VC = WS_KC + AL((size_t)2048 * 64 * 4);
constexpr size_t WS_PCMP = WS_VC + AL((size_t)2048 * 64 * 4);
constexpr size_t WS_OCMP = WS_PCMP + AL((size_t)T * 16 * 256 * 4);
constexpr size_t WS_SEL = WS_OCMP + AL((size_t)T * 1024 * 4);
constexpr size_t WS_X2 = WS_SEL + AL((size_t)T * 4 * 8);
constexpr size_t WS_TOPE = WS_X2 + AL((size_t)T * D * 4);
constexpr size_t WS_TOPG = WS_TOPE + AL((size_t)T * 4 * 4);
constexpr size_t WS_SLOT = WS_TOPG + AL((size_t)T * 4 * 4);
constexpr size_t WS_POS = WS_SLOT + AL((size_t)T * 4 * 4);
constexpr size_t WS_ROWTOK = WS_POS + AL((size_t)T * 4 * 4);
constexpr size_t WS_ACT = WS_ROWTOK + AL((size_t)MAX_ROWS * 4);
constexpr size_t WS_Y = WS_ACT + AL((size_t)MAX_ROWS * DFF * 2);
constexpr size_t WS_QB = WS_Y + AL((size_t)MAX_ROWS * D * 2);
constexpr size_t WS_KS = WS_QB + AL((size_t)T * 1024 * 2);
constexpr size_t WS_VS = WS_KS + AL((size_t)T * 256 * 2);
constexpr size_t WS_KW = WS_VS + AL((size_t)T * 256 * 2);
constexpr size_t WS_VW = WS_KW + AL((size_t)T * 256 * 2);
constexpr size_t WS_KCB = WS_VW + AL((size_t)T * 256 * 2);
constexpr size_t WS_VCB = WS_KCB + AL((size_t)2 * 256 * 256 * 2);
constexpr size_t WS_XBCB = WS_VCB + AL((size_t)2 * 256 * 256 * 2);
constexpr size_t WS_STATES = WS_XBCB + AL((size_t)T * 2048 * 2);
constexpr size_t WS_PREV = WS_STATES + AL((size_t)2 * 32 * 16 * 64 * 128 * 4);
constexpr size_t WS_CHDEC = WS_PREV + AL((size_t)2 * 32 * 16 * 64 * 128 * 2);
constexpr size_t WS_PART = WS_CHDEC + AL((size_t)2 * 32 * 16 * 4);
constexpr size_t WS_RW = WS_PART + AL((size_t)4 * 2 * 2048 * 512 * 4);
constexpr size_t WS_CHK = WS_RW + AL((size_t)2048 * 32 * 4);
constexpr size_t WS_END = WS_CHK + AL((size_t)T * 2048 * 4);

constexpr int CW_COUNT = 4096;
constexpr int CW_ZROW = 5120;
constexpr int CW_CHK = 4160;

#define XB_TMO      128
#define XB_XCNT(j)  (256  + 64 * (j))
#define XB_XSUB(j)  (1280 + 64 * (j))
#define XB_XGEN(j)  (2304 + 64 * (j))
#define XB_TOP      3328
#define XB_TOPGEN   3392
#define XCD_BAR_WORDS 3456
#define XB_SPIN_CAP (1u << 18)

__device__ __forceinline__ unsigned xb_ld(unsigned* p)              { return __hip_atomic_load(p, __ATOMIC_RELAXED, __HIP_MEMORY_SCOPE_AGENT); }
__device__ __forceinline__ unsigned xb_add(unsigned* p, unsigned v) { return __hip_atomic_fetch_add(p, v, __ATOMIC_RELAXED, __HIP_MEMORY_SCOPE_AGENT); }
__device__ __forceinline__ unsigned xb_xcc_id() { return (unsigned)__builtin_amdgcn_s_getreg((3 << 11) | 20) & 0xFu; }
#define XB_SPIN(cond, bar) do { unsigned _sp = 0; while (cond) { __builtin_amdgcn_s_sleep(1); \
    if ((++_sp & 255u) == 0u) { if (xb_ld(&(bar)[XB_TMO])) break; if (_sp > XB_SPIN_CAP) { atomicAdd(&(bar)[XB_TMO], 1u); break; } } } } while (0)

struct XcdBarrier { unsigned* bar; unsigned x; volatile LAS unsigned* st; };

__device__ __forceinline__ XcdBarrier xcd_barrier_post(unsigned* bar, volatile LAS unsigned* st) {
    XcdBarrier b; b.bar = bar; b.x = xb_xcc_id(); b.st = st;
    if (threadIdx.x == 0) (void)xb_add(&bar[XB_XCNT(b.x)], 1u);
    return b;
}
__device__ __forceinline__ void xcd_barrier_complete(unsigned* bar, unsigned x, unsigned& nloc, unsigned& nx) {
    const unsigned G = gridDim.x * gridDim.y * gridDim.z;
    unsigned sum, cnt, mine, sp = 0u;
    for (;;) {
        sum = 0u; cnt = 0u; mine = 0u;
#pragma unroll
        for (unsigned j = 0; j < 16; ++j) { const unsigned c = xb_ld(&bar[XB_XCNT(j)]); sum += c; cnt += (c > 0u) ? 1u : 0u; mine = (j == x) ? c : mine; }
        if (sum == G) break;
        __builtin_amdgcn_s_sleep(1);
        if ((++sp & 255u) == 0u) { if (xb_ld(&bar[XB_TMO])) break; if (sp > XB_SPIN_CAP) { atomicAdd(&bar[XB_TMO], 1u); break; } }
    }
    nloc = mine > 0u ? mine : 1u; nx = cnt > 0u ? cnt : 1u;
}
__device__ __forceinline__ void xcd_barrier(const XcdBarrier& b) {
    asm volatile("s_waitcnt vmcnt(0)" ::: "memory");
    __syncthreads();
    if (threadIdx.x == 0) {
        unsigned* bar = b.bar;
        __builtin_amdgcn_s_waitcnt(0);
        unsigned nloc = b.st[0], nx = b.st[1];
        if (nloc == 0u) { xcd_barrier_complete(bar, b.x, nloc, nx); b.st[0] = nloc; b.st[1] = nx; }
        const unsigned old = xb_add(&bar[XB_XSUB(b.x)], 1u);
        const unsigned gen = old / nloc;
        if (old + 1u == (gen + 1u) * nloc) {
            __builtin_amdgcn_fence(__ATOMIC_RELEASE, "agent");
            asm volatile("s_waitcnt vmcnt(0)" ::: "memory");
            const unsigned og = xb_add(&bar[XB_TOP], 1u);
            const unsigned tg = og / nx;
            if (og + 1u == (tg + 1u) * nx) xb_add(&bar[XB_TOPGEN], 1u);
            else XB_SPIN(xb_ld(&bar[XB_TOPGEN]) == tg, bar);
            __builtin_amdgcn_fence(__ATOMIC_ACQUIRE, "agent");
            xb_add(&bar[XB_XGEN(b.x)], 1u);
            asm volatile("s_waitcnt vmcnt(0)" ::: "memory");
        } else {
            XB_SPIN(xb_ld(&bar[XB_XGEN(b.x)]) == gen, bar);
            __builtin_amdgcn_fence(__ATOMIC_ACQUIRE, "agent");
            asm volatile("s_waitcnt vmcnt(0)" ::: "memory");
        }
    }
    __syncthreads();
}

__device__ __forceinline__ bf16_t f2bf(float f) { unsigned u = __float_as_uint(f); u += 0x7FFFu + ((u >> 16) & 1u); return (bf16_t)(u >> 16); }
__device__ __forceinline__ float bf2f(bf16_t b) { return __uint_as_float(((unsigned)b) << 16); }
typedef __bf16 bf16x2_t __attribute__((ext_vector_type(2)));
typedef float f32x2_t __attribute__((ext_vector_type(2)));
__device__ __forceinline__ unsigned pack2(float lo, float hi) { const f32x2_t v = {lo, hi}; return __builtin_bit_cast(unsigned, __builtin_convertvector(v, bf16x2_t)); }
__device__ __forceinline__ float wave_sum(float v) {
#pragma unroll
    for (int o = 32; o > 0; o >>= 1) v += __shfl_xor(v, o);
    return v;
}
__device__ __forceinline__ float xmax16(float x) { const unsigned u = __builtin_bit_cast(unsigned, x); const auto r = __builtin_amdgcn_permlane16_swap(u, u, false, false); return fmaxf(__builtin_bit_cast(float, r[0]), __builtin_bit_cast(float, r[1])); }
__device__ __forceinline__ float xmax32(float x) { const unsigned u = __builtin_bit_cast(unsigned, x); const auto r = __builtin_amdgcn_permlane32_swap(u, u, false, false); return fmaxf(__builtin_bit_cast(float, r[0]), __builtin_bit_cast(float, r[1])); }
__device__ __forceinline__ float xsum16(float x) { const unsigned u = __builtin_bit_cast(unsigned, x); const auto r = __builtin_amdgcn_permlane16_swap(u, u, false, false); return __builtin_bit_cast(float, r[0]) + __builtin_bit_cast(float, r[1]); }
__device__ __forceinline__ float xsum32(float x) { const unsigned u = __builtin_bit_cast(unsigned, x); const auto r = __builtin_amdgcn_permlane32_swap(u, u, false, false); return __builtin_bit_cast(float, r[0]) + __builtin_bit_cast(float, r[1]); }
__device__ __forceinline__ float sigmoidf_(float x) { return 1.0f / (1.0f + __expf(-x)); }

constexpr int B_RS = 544, A_ST = 256 * 128, B_ST = 64 * B_RS, STAGE = A_ST + B_ST;
constexpr int GEMM_LDS = 2 * STAGE;
constexpr int SSD_LDS = 147456;
constexpr int MAIN_LDS = SSD_LDS > GEMM_LDS + 8192 ? SSD_LDS : GEMM_LDS + 8192;
constexpr int LDS_BYTES = MAIN_LDS + 64;

template <bool PAIRED, class ALd, class BLd, class EP>
__device__ __forceinline__ void gemm_unit(LAS char* lds, const ALd& al, const BLd& bl, const EP& ep, const int K) {
    const int tid = threadIdx.x, lane = tid & 63, wid = __builtin_amdgcn_readfirstlane(tid >> 6);
    const int wr = wid >> 1, wc = wid & 1, fr = lane & 15, fq = lane >> 4;
    const char* abase = (const char*)al.wsbase;
    LAS unsigned* aoffs = (LAS unsigned*)(lds + GEMM_LDS) + tid * 4;
#pragma unroll
    for (int j = 0; j < 4; ++j) aoffs[j] = (unsigned)((const char*)(al.row(32 * wid + 8 * j + (lane >> 3)) + ((lane & 7) ^ (lane >> 3)) * 8) - abase);
    const char* bbase = (const char*)bl.base;
    const unsigned ldb4 = (unsigned)bl.ldb * 4u;
    const unsigned boff = (unsigned)bl.coloff(4 * (tid & 63)) * 4u + (unsigned)(tid >> 6) * ldb4;
    const int bk0 = tid >> 6;
    unsigned atile = 0u, btile = 0u;
    u32x4 ra[4]; float4 rb[8];
    const __amdgpu_buffer_rsrc_t rsa = __builtin_amdgcn_make_buffer_rsrc((void*)abase, 0, 0x7fffffff, 0x00020000);
    const __amdgpu_buffer_rsrc_t rsb = __builtin_amdgcn_make_buffer_rsrc((void*)bbase, 0, 0x7fffffff, 0x00020000);
#define LD_CHUNK(c) do { if ((c) < 8) { const u32x4 t_ = __builtin_amdgcn_raw_buffer_load_b128(rsb, (int)boff, (int)(btile + (unsigned)(8 * ((c) & 7)) * ldb4), 0); rb[(c) & 7] = __builtin_bit_cast(float4, t_); } \
        else ra[(c) & 3] = __builtin_amdgcn_raw_buffer_load_b128(rsa, (int)aoffs[(c) & 3], (int)atile, 0); } while (0)
#define WR_CHUNK(c, buf) do { if ((c) < 8) *(LAS u32x2*)(lds + (buf) * STAGE + A_ST + bw_off + ((((c) & 7) & 1) * 4 + (((c) & 7) >> 1) * 16) * B_RS) = (u32x2){pack2(rb[(c) & 7].x, rb[(c) & 7].y), pack2(rb[(c) & 7].z, rb[(c) & 7].w)}; \
        else *(LAS u32x4*)(lds + (buf) * STAGE + (4 * wid + ((c) & 3)) * 1024 + lane * 16) = ra[(c) & 3]; } while (0)
#define ADVANCE() do { atile += 128u; btile += 64u * ldb4; } while (0)
    f32x4 acc[4][8];
#pragma unroll
    for (int m = 0; m < 4; ++m)
#pragma unroll
        for (int n = 0; n < 8; ++n) acc[m][n] = (f32x4){0.f, 0.f, 0.f, 0.f};
    const int nk = K / 64;
    const int a_off0 = (wr * 64 + fr) * 128 + ((fq ^ (fr & 7)) * 16);
    const int br_off = A_ST + (((fq & 1) * 4 + (fq >> 1) * 16 + ((lane & 15) >> 2)) * B_RS) + (wc * 128 + 4 * (lane & 3)) * 2;
    const int bw_off = ((bk0 & 3) + ((bk0 >> 2) << 3)) * B_RS + (tid & 63) * 8;
#pragma unroll
    for (int c = 0; c < 12; ++c) LD_CHUNK(c);
    ADVANCE();
#pragma unroll
    for (int c = 0; c < 12; ++c) { WR_CHUNK(c, 0); LD_CHUNK(c); }
    if (2 < nk) ADVANCE();
    __syncthreads();
    for (int kt = 0; kt < nk; ++kt) {
        const int buf = kt & 1;
        LAS char* sbase = lds + buf * STAGE;
        s16x8 af[4]; s16x4 tq[4][2];
#define RD_B(slot, st_) do { tq[slot][0] = __builtin_amdgcn_ds_read_tr16_b64_v4i16((LAS s16x4*)(sbase + br_off + ((st_) >> 3) * 32 * B_RS + ((st_) & 7) * 32)); \
                             tq[slot][1] = __builtin_amdgcn_ds_read_tr16_b64_v4i16((LAS s16x4*)(sbase + br_off + ((st_) >> 3) * 32 * B_RS + ((st_) & 7) * 32 + 8 * B_RS)); } while (0)
#pragma unroll
        for (int m = 0; m < 4; ++m) af[m] = *(const LAS s16x8*)(sbase + a_off0 + m * 16 * 128);
        RD_B(0, 0); RD_B(1, 1); RD_B(2, 2);
        __builtin_amdgcn_sched_barrier(0);
#pragma unroll
        for (int st = 0; st < 16; ++st) {
            const int ks = st >> 3, n = st & 7;
            if (st + 3 < 16) RD_B((st + 3) & 3, st + 3);
            const s16x8 bfr = {tq[st & 3][0][0], tq[st & 3][0][1], tq[st & 3][0][2], tq[st & 3][0][3], tq[st & 3][1][0], tq[st & 3][1][1], tq[st & 3][1][2], tq[st & 3][1][3]};
#pragma unroll
            for (int m = 0; m < 4; ++m) acc[m][n] = __builtin_amdgcn_mfma_f32_16x16x32_bf16(bfr, af[m], acc[m][n], 0, 0, 0);
            if (st == 7) {
#pragma unroll
                for (int m = 0; m < 4; ++m) af[m] = *(const LAS s16x8*)(sbase + (a_off0 ^ 64) + m * 16 * 128);
            }
            if (st < 12) { WR_CHUNK(st, buf ^ 1); LD_CHUNK(st); }
            if (st & 1) __builtin_amdgcn_sched_barrier(0);
        }
#undef RD_B
        if (kt + 3 < nk) ADVANCE();
        __syncthreads();
    }
#undef LD_CHUNK
#undef WR_CHUNK
#undef ADVANCE
#pragma unroll
    for (int m = 0; m < 4; ++m) {
        const int r = wr * 64 + m * 16 + fr;
        if constexpr (PAIRED) {
#pragma unroll
            for (int n = 0; n < 4; ++n) ep.pair(r, wc * 64 + n * 16 + 4 * fq, acc[m][n], acc[m][n + 4]);
        } else {
#pragma unroll
            for (int n = 0; n < 8; ++n) ep(r, wc * 128 + n * 16 + 4 * fq, acc[m][n]);
        }
    }
}

constexpr int KV_RS = 144, KT_BYTES = 64 * KV_RS;
constexpr int ATT_IMP_OFF = 4 * KT_BYTES;
constexpr int ATT_MASK_OFF = ATT_IMP_OFF + 64 * 64 * 4;
struct GState { f32x4 o[4]; float m, l; };

template <int MODE>
__device__ __forceinline__ void attn_block(const LAS char* kt, const LAS char* vt, const int lane, const s16x8 (&qf)[2][2], GState (&st)[2],
                                           const bool (&act)[2], const int key0, const int (&lo)[2], const int (&hi)[2],
                                           LAS float* imp, const int (&tokl)[2], float (&carry)[2], const int jb) {
    const int c16 = lane & 15, fq = lane >> 4;
    s16x8 kf[4][2];
#pragma unroll
    for (int mt = 0; mt < 4; ++mt) { kf[mt][0] = *(const LAS s16x8*)(kt + (16 * mt + c16) * KV_RS + (8 * fq) * 2); kf[mt][1] = *(const LAS s16x8*)(kt + (16 * mt + c16) * KV_RS + (32 + 8 * fq) * 2); }
    f32x4 s[2][4];
#pragma unroll
    for (int mt = 0; mt < 4; ++mt)
#pragma unroll
        for (int gi = 0; gi < 2; ++gi) { s[gi][mt] = __builtin_amdgcn_mfma_f32_16x16x32_bf16(kf[mt][0], qf[gi][0], (f32x4){0.f, 0.f, 0.f, 0.f}, 0, 0, 0);
            s[gi][mt] = __builtin_amdgcn_mfma_f32_16x16x32_bf16(kf[mt][1], qf[gi][1], s[gi][mt], 0, 0, 0); }
    const bool needmask = !__all((lo[0] <= key0) & (hi[0] >= key0 + 63) & (lo[1] <= key0) & (hi[1] >= key0 + 63));
    s16x8 pf[2][2];
#pragma unroll
    for (int gi = 0; gi < 2; ++gi) {
        if (needmask) {
#pragma unroll
            for (int mt = 0; mt < 4; ++mt)
#pragma unroll
                for (int i = 0; i < 4; ++i) { const int key = key0 + 16 * mt + 4 * fq + i; s[gi][mt][i] = (key >= lo[gi] && key <= hi[gi]) ? s[gi][mt][i] : -INFINITY; }
        }
        float mx = fmaxf(fmaxf(fmaxf(s[gi][0][0], s[gi][0][1]), fmaxf(s[gi][0][2], s[gi][0][3])), fmaxf(fmaxf(s[gi][1][0], s[gi][1][1]), fmaxf(s[gi][1][2], s[gi][1][3])));
        mx = fmaxf(mx, fmaxf(fmaxf(fmaxf(s[gi][2][0], s[gi][2][1]), fmaxf(s[gi][2][2], s[gi][2][3])), fmaxf(fmaxf(s[gi][3][0], s[gi][3][1]), fmaxf(s[gi][3][2], s[gi][3][3]))));
        mx = act[gi] ? mx : -INFINITY;
        float msafe, scale = 1.0f;
        if (MODE == 2) { msafe = (st[gi].m == -INFINITY) ? 0.f : st[gi].m; scale = st[gi].l; }
        else {
            mx = fmaxf(mx, __shfl_xor(mx, 16)); mx = fmaxf(mx, __shfl_xor(mx, 32));
            const float mnew = fmaxf(st[gi].m, mx);
            const float alpha = (mnew == -INFINITY) ? 1.0f : __builtin_amdgcn_exp2f(st[gi].m - mnew);
            msafe = (mnew == -INFINITY) ? 0.f : mnew;
            st[gi].m = mnew; st[gi].l *= alpha;
            if (MODE == 0) {
#pragma unroll
                for (int md = 0; md < 4; ++md) st[gi].o[md] *= alpha;
            }
        }
        msafe = act[gi] ? msafe : INFINITY;
        float rs = 0.f;
#pragma unroll
        for (int mt = 0; mt < 4; ++mt)
#pragma unroll
            for (int i = 0; i < 4; ++i) { const float pv = (MODE == 2) ? __builtin_amdgcn_exp2f(s[gi][mt][i] - msafe) * scale : __builtin_amdgcn_exp2f(s[gi][mt][i] - msafe); s[gi][mt][i] = pv; rs += pv; }
        if (MODE != 2) { rs += __shfl_xor(rs, 16); rs += __shfl_xor(rs, 32); st[gi].l += rs; }
        if (MODE == 2) {
#pragma unroll
            for (int mt = 0; mt < 4; ++mt) {
                const float tcur = __shfl(s[gi][mt][3], (lane - 16) & 63);
                const float tprv = __shfl(mt > 0 ? s[gi][mt > 0 ? mt - 1 : 0][3] : carry[gi], (lane - 16) & 63);
                const float prev = fq > 0 ? tcur : tprv;
                float part = 32.f * (s[gi][mt][0] + s[gi][mt][1] + s[gi][mt][2]) + 16.f * s[gi][mt][3] + 16.f * prev;
                part += __shfl_xor(part, 1); part += __shfl_xor(part, 2);
                if ((c16 & 3) == 0) imp[tokl[gi] * 64 + 16 * jb + 4 * mt + fq] = part;
            }
            carry[gi] = s[gi][3][3];
        }
        if (MODE != 1) {
#pragma unroll
            for (int ks = 0; ks < 2; ++ks) {
                const u32x4 w = {pack2(s[gi][2 * ks][0], s[gi][2 * ks][1]), pack2(s[gi][2 * ks][2], s[gi][2 * ks][3]),
                                 pack2(s[gi][2 * ks + 1][0], s[gi][2 * ks + 1][1]), pack2(s[gi][2 * ks + 1][2], s[gi][2 * ks + 1][3])};
                pf[gi][ks] = __builtin_bit_cast(s16x8, w);
            }
        }
    }
    if (MODE != 1) {
        const int q = c16 >> 2, p = c16 & 3;
#pragma unroll
        for (int md = 0; md < 4; ++md) {
            s16x8 vf[2];
#pragma unroll
            for (int ks = 0; ks < 2; ++ks) {
                const s16x4 t0 = __builtin_amdgcn_ds_read_tr16_b64_v4i16((LAS s16x4*)(vt + (32 * ks + 4 * fq + q) * KV_RS + (16 * md + 4 * p) * 2));
                const s16x4 t1 = __builtin_amdgcn_ds_read_tr16_b64_v4i16((LAS s16x4*)(vt + (32 * ks + 16 + 4 * fq + q) * KV_RS + (16 * md + 4 * p) * 2));
                vf[ks] = (s16x8){t0[0], t0[1], t0[2], t0[3], t1[0], t1[1], t1[2], t1[3]};
            }
#pragma unroll
            for (int gi = 0; gi < 2; ++gi) { st[gi].o[md] = __builtin_amdgcn_mfma_f32_16x16x32_bf16(vf[0], pf[gi][0], st[gi].o[md], 0, 0, 0); st[gi].o[md] = __builtin_amdgcn_mfma_f32_16x16x32_bf16(vf[1], pf[gi][1], st[gi].o[md], 0, 0, 0); }
        }
    }
}

typedef float f32x16 __attribute__((ext_vector_type(16)));
struct GState32 { f32x16 o[2]; float m, l; };
__device__ __forceinline__ float xchg32(float x) { const unsigned u = __builtin_bit_cast(unsigned, x); const auto r = __builtin_amdgcn_permlane32_swap(u, u, false, false);
    return __builtin_bit_cast(float, (threadIdx.x & 32) ? r[0] : r[1]); }

template <int MODE>
__device__ __forceinline__ void attn_block32(const LAS char* kt, const LAS char* vt, const int lane, const s16x8 (&qf)[4], GState32& st,
                                             const bool act, const int key0, const int lo, const int hi, LAS float* imp, const int tl, float& carry, const int jb) {
    const int c32 = lane & 31, h = lane >> 5;
    f32x16 s[2];
#pragma unroll
    for (int k2 = 0; k2 < 2; ++k2) {
        s16x8 kf[4];
#pragma unroll
        for (int ds = 0; ds < 4; ++ds) kf[ds] = *(const LAS s16x8*)(kt + (32 * k2 + c32) * KV_RS + (16 * ds + 8 * h) * 2);
        s[k2] = __builtin_amdgcn_mfma_f32_32x32x16_bf16(kf[0], qf[0], (f32x16){0.f,0.f,0.f,0.f,0.f,0.f,0.f,0.f,0.f,0.f,0.f,0.f,0.f,0.f,0.f,0.f}, 0, 0, 0);
#pragma unroll
        for (int ds = 1; ds < 4; ++ds) s[k2] = __builtin_amdgcn_mfma_f32_32x32x16_bf16(kf[ds], qf[ds], s[k2], 0, 0, 0);
    }
    const bool needmask = !__all((lo <= key0) & (hi >= key0 + 63));
    if (needmask) {
#pragma unroll
        for (int k2 = 0; k2 < 2; ++k2)
#pragma unroll
            for (int i = 0; i < 16; ++i) { const int key = key0 + 32 * k2 + 8 * (i >> 2) + 4 * h + (i & 3); s[k2][i] = (key >= lo && key <= hi) ? s[k2][i] : -INFINITY; }
    }
    float mx = -INFINITY;
#pragma unroll
    for (int k2 = 0; k2 < 2; ++k2)
#pragma unroll
        for (int i = 0; i < 16; ++i) mx = fmaxf(mx, s[k2][i]);
    mx = act ? mx : -INFINITY;
    float msafe, scale = 1.0f;
    if (MODE == 2) { msafe = (st.m == -INFINITY) ? 0.f : st.m; scale = st.l; }
    else {
        mx = fmaxf(mx, xchg32(mx));
        const float mnew = fmaxf(st.m, mx);
        const float alpha = (mnew == -INFINITY) ? 1.0f : __builtin_amdgcn_exp2f(st.m - mnew);
        msafe = (mnew == -INFINITY) ? 0.f : mnew;
        st.m = mnew; st.l *= alpha;
        if (MODE == 0) { st.o[0] *= alpha; st.o[1] *= alpha; }
    }
    msafe = act ? msafe : INFINITY;
    float rs = 0.f;
#pragma unroll
    for (int k2 = 0; k2 < 2; ++k2)
#pragma unroll
        for (int i = 0; i < 16; ++i) { const float pv = (MODE == 2) ? __builtin_amdgcn_exp2f(s[k2][i] - msafe) * scale : __builtin_amdgcn_exp2f(s[k2][i] - msafe); s[k2][i] = pv; rs += pv; }
    if (MODE != 2) { rs += xchg32(rs); st.l += rs; }
    if (MODE == 2) {
#pragma unroll
        for (int k2 = 0; k2 < 2; ++k2)
#pragma unroll
            for (int ig = 0; ig < 4; ++ig) {
                const float prevreg = ig > 0 ? s[k2][4 * (ig > 0 ? ig - 1 : 0) + 3] : (k2 > 0 ? s[0][15] : carry);
                const float recv = xchg32(h ? prevreg : s[k2][4 * ig + 3]);
                float part = 32.f * (s[k2][4 * ig] + s[k2][4 * ig + 1] + s[k2][4 * ig + 2]) + 16.f * s[k2][4 * ig + 3] + 16.f * recv;
                part += __shfl_xor(part, 1); part += __shfl_xor(part, 2);
                if ((c32 & 3) == 0) imp[tl * 64 + 16 * jb + 8 * k2 + 2 * ig + h] = part;
            }
        carry = s[1][15];
    }
    if (MODE != 1) {
        const int blk = (lane >> 4) & 1, q = (lane & 15) >> 2, p = lane & 3;
#pragma unroll
        for (int k2 = 0; k2 < 2; ++k2)
#pragma unroll
            for (int sk = 0; sk < 2; ++sk) {
                const u32x4 w = {pack2(s[k2][8 * sk + 0], s[k2][8 * sk + 1]), pack2(s[k2][8 * sk + 2], s[k2][8 * sk + 3]), pack2(s[k2][8 * sk + 4], s[k2][8 * sk + 5]), pack2(s[k2][8 * sk + 6], s[k2][8 * sk + 7])};
                const s16x8 pf = __builtin_bit_cast(s16x8, w);
                const int base = 32 * k2 + 16 * sk;
#pragma unroll
                for (int dt = 0; dt < 2; ++dt) {
                    const s16x4 t0 = __builtin_amdgcn_ds_read_tr16_b64_v4i16((LAS s16x4*)(vt + (base + 4 * h + q) * KV_RS + (32 * dt + 16 * blk + 4 * p) * 2));
                    const s16x4 t1 = __builtin_amdgcn_ds_read_tr16_b64_v4i16((LAS s16x4*)(vt + (base + 8 + 4 * h + q) * KV_RS + (32 * dt + 16 * blk + 4 * p) * 2));
                    const s16x8 vf = {t0[0], t0[1], t0[2], t0[3], t1[0], t1[1], t1[2], t1[3]};
                    st.o[dt] = __builtin_amdgcn_mfma_f32_32x32x16_bf16(vf, pf, st.o[dt], 0, 0, 0);
                }
            }
    }
}

#define ATT_GLOAD(Kg, Vg, row0) do { const size_t _o = ((size_t)(row0) + (tid >> 3)) * 256 + g * 64 + (tid & 7) * 8; rk = *(const u32x4*)((Kg) + _o); rv = *(const u32x4*)((Vg) + _o); __builtin_amdgcn_sched_barrier(0); } while (0)
#define ATT_SWRITE(buf) do { LAS char* _k = lds + (buf) * 2 * KT_BYTES + (tid >> 3) * KV_RS + (tid & 7) * 16; *(LAS u32x4*)_k = rk; *(LAS u32x4*)(_k + KT_BYTES) = rv; } while (0)

__device__ __forceinline__ void nsa_unit32(LAS char* lds, const int unit, const bf16_t* QB, const bf16_t* KS, const bf16_t* VS, const bf16_t* KW, const bf16_t* VW,
                                           const bf16_t* KCB, const bf16_t* VCB, const float* PROJ, bf16_t* MIX) {
    const int tid = threadIdx.x, lane = tid & 63, wid = tid >> 6, c32 = lane & 31, h = lane >> 5;
    const int qt = unit >> 3, b = (unit >> 2) & 1, g = unit & 3;
    const int t0 = qt * 64;
    LAS float* imp = (LAS float*)(lds + ATT_IMP_OFF);
    LAS unsigned* lmask = (LAS unsigned*)(lds + ATT_MASK_OFF);
    const int tl = 8 * wid + (c32 >> 2), tpos = t0 + tl, hq = g * 4 + (c32 & 3);
    const size_t tt = (size_t)b * SEQ + tpos;
    s16x8 qf[4]; float gate[3];
#pragma unroll
    for (int ds = 0; ds < 4; ++ds) qf[ds] = *(const s16x8*)(QB + tt * 1024 + hq * 64 + 16 * ds + 8 * h);
    { const float* gl = PROJ + tt * IN_PROJ + OFF_GATE + hq * 3; gate[0] = sigmoidf_(gl[0]); gate[1] = sigmoidf_(gl[1]); gate[2] = sigmoidf_(gl[2]); }
    for (int i = tid; i < 64 * 64; i += 512) imp[i] = 0.f;
    f32x16 res[2];
    GState32 st; bool act; int lo, hi; float carry = 0.f;
    u32x4 rk, rv;
    const bf16_t* KCg = KCB + (size_t)b * 256 * 256; const bf16_t* VCg = VCB + (size_t)b * 256 * 256;
    const bf16_t* KSg = KS + (size_t)b * SEQ * 256; const bf16_t* VSg = VS + (size_t)b * SEQ * 256;
    const bf16_t* KWg = KW + (size_t)b * SEQ * 256; const bf16_t* VWg = VW + (size_t)b * SEQ * 256;
#define ST_RESET() do { st.m = -INFINITY; st.l = 0.f; _Pragma("unroll") for (int i_ = 0; i_ < 16; ++i_) { st.o[0][i_] = 0.f; st.o[1][i_] = 0.f; } } while (0)
    const int cmax_u = (t0 + 63 - 31) >> 4;
    const int ncb = cmax_u < 0 ? 0 : min(4, (cmax_u + 1) / 64 + 1);
    act = true; lo = 0; hi = tpos >= 31 ? ((tpos - 31) >> 4) : -1; ST_RESET();
    __syncthreads();
    if (ncb > 0) {
        ATT_GLOAD(KCg, VCg, 0); ATT_SWRITE(0); __syncthreads();
        for (int jb = 0; jb < ncb; ++jb) {
            if (jb + 1 < ncb) ATT_GLOAD(KCg, VCg, 64 * (jb + 1));
            attn_block32<1>(lds + (jb & 1) * 2 * KT_BYTES, lds + (jb & 1) * 2 * KT_BYTES + KT_BYTES, lane, qf, st, act, 64 * jb, lo, hi, imp, tl, carry, jb);
            if (jb + 1 < ncb) ATT_SWRITE((jb + 1) & 1);
            __syncthreads();
        }
        st.l = st.l > 0.f ? 1.0f / st.l : 0.f;
        ATT_GLOAD(KCg, VCg, 0); ATT_SWRITE(0); __syncthreads();
        for (int jb = 0; jb < ncb; ++jb) {
            if (jb + 1 < ncb) ATT_GLOAD(KCg, VCg, 64 * (jb + 1));
            attn_block32<2>(lds + (jb & 1) * 2 * KT_BYTES, lds + (jb & 1) * 2 * KT_BYTES + KT_BYTES, lane, qf, st, act, 64 * jb, lo, hi, imp, tl, carry, jb);
            if (jb + 1 < ncb) ATT_SWRITE((jb + 1) & 1);
            __syncthreads();
        }
    }
    res[0] = st.o[0] * gate[0]; res[1] = st.o[1] * gate[0];
    __syncthreads();
    for (int k = 0; k < 8; ++k) {
        const int tk = 8 * wid + k, j = lane;
        const float iv = imp[tk * 64 + j];
        const bool forced = (j == 0) || (j == qt) || (j == qt - 1), valid = j <= qt;
        const float sc = forced ? 1.0e4f : (valid ? iv : -1.0e4f);
        int rank = 0;
#pragma unroll
        for (int kk = 0; kk < 64; ++kk) { const float o = __shfl(sc, kk); rank += (o > sc || (o == sc && kk < j)) ? 1 : 0; }
        const unsigned long long m64 = __ballot(rank < 16 && valid);
        if (lane == 0) { lmask[tk * 2] = (unsigned)m64; lmask[tk * 2 + 1] = (unsigned)(m64 >> 32); }
    }
    __syncthreads();
    const unsigned long long msk = (unsigned long long)lmask[tl * 2] | ((unsigned long long)lmask[tl * 2 + 1] << 32);
    unsigned long long wunion;
    { unsigned ul = (unsigned)msk, uh = (unsigned)(msk >> 32);
#pragma unroll
      for (int o = 1; o < 64; o <<= 1) { ul |= __shfl_xor(ul, o); uh |= __shfl_xor(uh, o); }
      wunion = (unsigned long long)ul | ((unsigned long long)uh << 32); }
    lo = 0; hi = tpos; ST_RESET();
    ATT_GLOAD(KSg, VSg, 0); ATT_SWRITE(0); __syncthreads();
    for (int j = 0; j <= qt; ++j) {
        if (j + 1 <= qt) ATT_GLOAD(KSg, VSg, 64 * (j + 1));
        if ((wunion >> j) & 1ull) {
            act = (msk >> j) & 1ull;
            attn_block32<0>(lds + (j & 1) * 2 * KT_BYTES, lds + (j & 1) * 2 * KT_BYTES + KT_BYTES, lane, qf, st, act, 64 * j, lo, hi, imp, tl, carry, 0);
        }
        if (j + 1 <= qt) ATT_SWRITE((j + 1) & 1);
        __syncthreads();
    }
    { const float il = gate[1] / fmaxf(st.l, 1e-30f); res[0] += st.o[0] * il; res[1] += st.o[1] * il; }
    act = true; lo = tpos - 511; hi = tpos; ST_RESET();
    const int jw0 = qt >= 8 ? qt - 8 : 0;
    ATT_GLOAD(KWg, VWg, 64 * jw0); ATT_SWRITE(jw0 & 1); __syncthreads();
    for (int j = jw0; j <= qt; ++j) {
        if (j + 1 <= qt) ATT_GLOAD(KWg, VWg, 64 * (j + 1));
        attn_block32<0>(lds + (j & 1) * 2 * KT_BYTES, lds + (j & 1) * 2 * KT_BYTES + KT_BYTES, lane, qf, st, act, 64 * j, lo, hi, imp, tl, carry, 0);
        if (j + 1 <= qt) ATT_SWRITE((j + 1) & 1);
        __syncthreads();
    }
    { const float il = gate[2] / fmaxf(st.l, 1e-30f);
      bf16_t* mp = MIX + tt * 2048 + 1024 + hq * 64 + 4 * h;
#pragma unroll
      for (int dt = 0; dt < 2; ++dt)
#pragma unroll
          for (int ig = 0; ig < 4; ++ig) { const int i0 = 4 * ig;
              const float r0 = res[dt][i0] + st.o[dt][i0] * il, r1 = res[dt][i0 + 1] + st.o[dt][i0 + 1] * il, r2 = res[dt][i0 + 2] + st.o[dt][i0 + 2] * il, r3 = res[dt][i0 + 3] + st.o[dt][i0 + 3] * il;
              *(uint2*)(mp + 32 * dt + 8 * ig) = make_uint2(pack2(r0, r1), pack2(r2, r3)); } }
#undef ST_RESET
}
#undef ATT_GLOAD
#undef ATT_SWRITE

#define ATT_GLOAD(Kg, Vg, row0) do { const size_t _o = ((size_t)(row0) + (tid >> 3)) * 256 + g * 64 + (tid & 7) * 8; rk = *(const u32x4*)((Kg) + _o); rv = *(const u32x4*)((Vg) + _o); } while (0)
#define ATT_SWRITE(buf) do { LAS char* _k = lds + (buf) * 2 * KT_BYTES + (tid >> 3) * KV_RS + (tid & 7) * 16; *(LAS u32x4*)_k = rk; *(LAS u32x4*)(_k + KT_BYTES) = rv; } while (0)

__device__ __forceinline__ void nsa_unit(LAS char* lds, const int unit, const bf16_t* QB, const bf16_t* KS, const bf16_t* VS, const bf16_t* KW, const bf16_t* VW,
                                         const bf16_t* KCB, const bf16_t* VCB, const float* PROJ, bf16_t* MIX) {
    const int tid = threadIdx.x, lane = tid & 63, wid = tid >> 6, c16 = lane & 15, fq = lane >> 4;
    const int qt = unit >> 3, b = (unit >> 2) & 1, g = unit & 3;
    const int t0 = qt * 64;
    LAS float* imp = (LAS float*)(lds + ATT_IMP_OFF);
    LAS unsigned* lmask = (LAS unsigned*)(lds + ATT_MASK_OFF);
    int tokl[2], tpos[2]; s16x8 qf[2][2]; float gate[2][3];
#pragma unroll
    for (int gi = 0; gi < 2; ++gi) {
        tokl[gi] = 8 * wid + 4 * gi + (c16 >> 2); tpos[gi] = t0 + tokl[gi];
        const size_t tt = (size_t)b * SEQ + tpos[gi]; const int hq = g * 4 + (c16 & 3);
#pragma unroll
        for (int ks = 0; ks < 2; ++ks) qf[gi][ks] = *(const s16x8*)(QB + tt * 1024 + hq * 64 + 32 * ks + 8 * fq);
        const float* gl = PROJ + tt * IN_PROJ + OFF_GATE + hq * 3;
        gate[gi][0] = sigmoidf_(gl[0]); gate[gi][1] = sigmoidf_(gl[1]); gate[gi][2] = sigmoidf_(gl[2]);
    }
    for (int i = tid; i < 64 * 64; i += 512) imp[i] = 0.f;
    f32x4 res[2][4];
    GState st[2]; bool act[2]; int lo[2], hi[2]; float carry[2] = {0.f, 0.f};
    u32x4 rk, rv;
    const bf16_t* KCg = KCB + (size_t)b * 256 * 256; const bf16_t* VCg = VCB + (size_t)b * 256 * 256;
    const bf16_t* KSg = KS + (size_t)b * SEQ * 256; const bf16_t* VSg = VS + (size_t)b * SEQ * 256;
    const bf16_t* KWg = KW + (size_t)b * SEQ * 256; const bf16_t* VWg = VW + (size_t)b * SEQ * 256;
    const int cmax_u = (t0 + 63 - 31) >> 4;
    const int ncb = cmax_u < 0 ? 0 : min(4, (cmax_u + 1) / 64 + 1);
#pragma unroll
    for (int gi = 0; gi < 2; ++gi) { act[gi] = true; lo[gi] = 0; hi[gi] = tpos[gi] >= 31 ? ((tpos[gi] - 31) >> 4) : -1; st[gi].m = -INFINITY; st[gi].l = 0.f;
#pragma unroll
        for (int md = 0; md < 4; ++md) st[gi].o[md] = (f32x4){0.f, 0.f, 0.f, 0.f}; }
    __syncthreads();
    if (ncb > 0) {
        ATT_GLOAD(KCg, VCg, 0); ATT_SWRITE(0); __syncthreads();
        for (int jb = 0; jb < ncb; ++jb) {
            if (jb + 1 < ncb) ATT_GLOAD(KCg, VCg, 64 * (jb + 1));
            attn_block<1>(lds + (jb & 1) * 2 * KT_BYTES, lds + (jb & 1) * 2 * KT_BYTES + KT_BYTES, lane, qf, st, act, 64 * jb, lo, hi, imp, tokl, carry, jb);
            if (jb + 1 < ncb) ATT_SWRITE((jb + 1) & 1);
            __syncthreads();
        }
#pragma unroll
        for (int gi = 0; gi < 2; ++gi) st[gi].l = st[gi].l > 0.f ? 1.0f / st[gi].l : 0.f;
        ATT_GLOAD(KCg, VCg, 0); ATT_SWRITE(0); __syncthreads();
        for (int jb = 0; jb < ncb; ++jb) {
            if (jb + 1 < ncb) ATT_GLOAD(KCg, VCg, 64 * (jb + 1));
            attn_block<2>(lds + (jb & 1) * 2 * KT_BYTES, lds + (jb & 1) * 2 * KT_BYTES + KT_BYTES, lane, qf, st, act, 64 * jb, lo, hi, imp, tokl, carry, jb);
            if (jb + 1 < ncb) ATT_SWRITE((jb + 1) & 1);
            __syncthreads();
        }
    }
#pragma unroll
    for (int gi = 0; gi < 2; ++gi)
#pragma unroll
        for (int md = 0; md < 4; ++md) res[gi][md] = st[gi].o[md] * gate[gi][0];
    __syncthreads();
    for (int k = 0; k < 8; ++k) {
        const int tl = 8 * wid + k, j = lane;
        const float iv = imp[tl * 64 + j];
        const bool forced = (j == 0) || (j == qt) || (j == qt - 1), valid = j <= qt;
        const float sc = forced ? 1.0e4f : (valid ? iv : -1.0e4f);
        int rank = 0;
#pragma unroll
        for (int kk = 0; kk < 64; ++kk) { const float o = __shfl(sc, kk); rank += (o > sc || (o == sc && kk < j)) ? 1 : 0; }
        const unsigned long long m64 = __ballot(rank < 16 && valid);
        if (lane == 0) { lmask[tl * 2] = (unsigned)m64; lmask[tl * 2 + 1] = (unsigned)(m64 >> 32); }
    }
    __syncthreads();
    unsigned long long msk[2]; unsigned long long wunion;
    {
#pragma unroll
        for (int gi = 0; gi < 2; ++gi) msk[gi] = (unsigned long long)lmask[tokl[gi] * 2] | ((unsigned long long)lmask[tokl[gi] * 2 + 1] << 32);
        unsigned ul = (unsigned)(msk[0] | msk[1]), uh = (unsigned)((msk[0] | msk[1]) >> 32);
#pragma unroll
        for (int o = 1; o < 64; o <<= 1) { ul |= __shfl_xor(ul, o); uh |= __shfl_xor(uh, o); }
        wunion = (unsigned long long)ul | ((unsigned long long)uh << 32);
    }
#pragma unroll
    for (int gi = 0; gi < 2; ++gi) { lo[gi] = 0; hi[gi] = tpos[gi]; st[gi].m = -INFINITY; st[gi].l = 0.f;
#pragma unroll
        for (int md = 0; md < 4; ++md) st[gi].o[md] = (f32x4){0.f, 0.f, 0.f, 0.f}; }
    ATT_GLOAD(KSg, VSg, 0); ATT_SWRITE(0); __syncthreads();
    for (int j = 0; j <= qt; ++j) {
        if (j + 1 <= qt) ATT_GLOAD(KSg, VSg, 64 * (j + 1));
        if ((wunion >> j) & 1ull) {
            act[0] = (msk[0] >> j) & 1ull; act[1] = (msk[1] >> j) & 1ull;
            attn_block<0>(lds + (j & 1) * 2 * KT_BYTES, lds + (j & 1) * 2 * KT_BYTES + KT_BYTES, lane, qf, st, act, 64 * j, lo, hi, imp, tokl, carry, 0);
        }
        if (j + 1 <= qt) ATT_SWRITE((j + 1) & 1);
        __syncthreads();
    }
#pragma unroll
    for (int gi = 0; gi < 2; ++gi) { const float il = gate[gi][1] / fmaxf(st[gi].l, 1e-30f);
#pragma unroll
        for (int md = 0; md < 4; ++md) res[gi][md] += st[gi].o[md] * il; }
#pragma unroll
    for (int gi = 0; gi < 2; ++gi) { act[gi] = true; lo[gi] = tpos[gi] - 511; hi[gi] = tpos[gi]; st[gi].m = -INFINITY; st[gi].l = 0.f;
#pragma unroll
        for (int md = 0; md < 4; ++md) st[gi].o[md] = (f32x4){0.f, 0.f, 0.f, 0.f}; }
    const int jw0 = qt >= 8 ? qt - 8 : 0;
    ATT_GLOAD(KWg, VWg, 64 * jw0); ATT_SWRITE(jw0 & 1); __syncthreads();
    for (int j = jw0; j <= qt; ++j) {
        if (j + 1 <= qt) ATT_GLOAD(KWg, VWg, 64 * (j + 1));
        attn_block<0>(lds + (j & 1) * 2 * KT_BYTES, lds + (j & 1) * 2 * KT_BYTES + KT_BYTES, lane, qf, st, act, 64 * j, lo, hi, imp, tokl, carry, 0);
        if (j + 1 <= qt) ATT_SWRITE((j + 1) & 1);
        __syncthreads();
    }
#pragma unroll
    for (int gi = 0; gi < 2; ++gi) { const float il = gate[gi][2] / fmaxf(st[gi].l, 1e-30f);
        bf16_t* mp = MIX + ((size_t)b * SEQ + tpos[gi]) * 2048 + 1024 + (g * 4 + (c16 & 3)) * 64 + 4 * fq;
#pragma unroll
        for (int md = 0; md < 4; ++md) { const f32x4 r = res[gi][md] + st[gi].o[md] * il;
            *(uint2*)(mp + 16 * md) = make_uint2(pack2(r[0], r[1]), pack2(r[2], r[3])); } }
}
#undef ATT_GLOAD
#undef ATT_SWRITE

constexpr int SX_RS = 144, SX_H = 128 * SX_RS, SB_RS = 272, SB_BYTES = 128 * SB_RS;
constexpr int SSD_X_OFF = 0, SSD_B_OFF = 4 * SX_H, SSD_C_OFF = SSD_B_OFF + SB_BYTES, SSD_T_OFF = SSD_C_OFF + SB_BYTES;
static_assert(SSD_T_OFF + 4096 <= SSD_LDS, "ssd lds");

template <bool WITH_C>
__device__ __forceinline__ void ssd_stage(LAS char* lds, const bf16_t* XBCB, const float* DT, const float* a_log, const int b, const int c, const int grp) {
    const int tid = threadIdx.x;
    const size_t tt0 = (size_t)b * SEQ + c * 128;
    u32x4 rx[8], rbm[4], rcm[4];
#pragma unroll
    for (int k = 0; k < 8; ++k) { const int id = tid + 512 * k, l = id >> 5, ch = id & 31; rx[k] = *(const u32x4*)(XBCB + (tt0 + l) * 2048 + grp * 256 + ch * 8); }
#pragma unroll
    for (int k = 0; k < 4; ++k) { const int id = tid + 512 * k, l = id >> 4, ch = id & 15;
        rbm[k] = *(const u32x4*)(XBCB + (tt0 + l) * 2048 + 1024 + grp * 128 + ch * 8);
        if (WITH_C) rcm[k] = *(const u32x4*)(XBCB + (tt0 + l) * 2048 + 1536 + grp * 128 + ch * 8); }
    __builtin_amdgcn_sched_barrier(0);
#pragma unroll
    for (int k = 0; k < 8; ++k) { const int id = tid + 512 * k, l = id >> 5, ch = id & 31, h = ch >> 3, pc = ch & 7; *(LAS u32x4*)(lds + SSD_X_OFF + h * SX_H + l * SX_RS + pc * 16) = rx[k]; }
#pragma unroll
    for (int k = 0; k < 4; ++k) { const int id = tid + 512 * k, l = id >> 4, ch = id & 15;
        *(LAS u32x4*)(lds + SSD_B_OFF + l * SB_RS + ch * 16) = rbm[k];
        if (WITH_C) *(LAS u32x4*)(lds + SSD_C_OFF + l * SB_RS + ch * 16) = rcm[k]; }
    LAS float* dtl = (LAS float*)(lds + SSD_T_OFF); LAS float* acs = dtl + 512;
    const int h = tid >> 7, l = tid & 127;
    const float av = -expf(a_log[grp * 4 + h]);
    const float dtv = DT[(tt0 + l) * 16 + grp * 4 + h];
    dtl[tid] = dtv; acs[tid] = dtv * av;
    __syncthreads();
    float cs = acs[tid];
#pragma unroll
    for (int o = 1; o < 128; o <<= 1) { const float add = (l >= o) ? acs[tid - o] : 0.f; __syncthreads(); cs += add; acs[tid] = cs; __syncthreads(); }
}

__device__ __forceinline__ void ssd_states_item(LAS char* lds, const int item, const bf16_t* XBCB, const float* DT, const float* a_log, float* STATES, float* CHDEC) {
    const int tid = threadIdx.x, lane = tid & 63, wid = tid >> 6, c16 = lane & 15, fq = lane >> 4, q = c16 >> 2, pp = c16 & 3;
    const int grp = item & 3, c = (item >> 2) & 31, b = item >> 7;
    __syncthreads();
    ssd_stage<false>(lds, XBCB, DT, a_log, b, c, grp);
    LAS float* dtl = (LAS float*)(lds + SSD_T_OFF); LAS float* acs = dtl + 512;
#pragma unroll
    for (int k = 0; k < 8; ++k) { const int id = tid + 512 * k, l = id >> 5, ch = id & 31, h = ch >> 3, pc = ch & 7;
        const float w = __expf(acs[h * 128 + 127] - acs[h * 128 + l]) * dtl[h * 128 + l];
        LAS u32x4* pv = (LAS u32x4*)(lds + SSD_X_OFF + h * SX_H + l * SX_RS + pc * 16);
        u32x4 v = *pv;
#pragma unroll
        for (int e = 0; e < 4; ++e) { const float lo = __uint_as_float(v[e] << 16) * w, hi = __uint_as_float(v[e] & 0xffff0000u) * w; v[e] = pack2(lo, hi); }
        *pv = v; }
    if (tid < 4) CHDEC[((size_t)b * 32 + c) * 16 + grp * 4 + tid] = __expf(acs[tid * 128 + 127]);
    __syncthreads();
    s16x8 af[4];
#pragma unroll
    for (int ks = 0; ks < 4; ++ks) {
        const s16x4 t0 = __builtin_amdgcn_ds_read_tr16_b64_v4i16((LAS s16x4*)(lds + SSD_B_OFF + (32 * ks + 8 * fq + q) * SB_RS + (16 * wid + 4 * pp) * 2));
        const s16x4 t1 = __builtin_amdgcn_ds_read_tr16_b64_v4i16((LAS s16x4*)(lds + SSD_B_OFF + (32 * ks + 8 * fq + 4 + q) * SB_RS + (16 * wid + 4 * pp) * 2));
        af[ks] = (s16x8){t0[0], t0[1], t0[2], t0[3], t1[0], t1[1], t1[2], t1[3]};
    }
#pragma unroll
    for (int h = 0; h < 4; ++h) {
        float* sp = STATES + (((size_t)b * 32 + c) * 16 + grp * 4 + h) * 8192;
#pragma unroll
        for (int pt = 0; pt < 4; ++pt) {
            f32x4 acc = {0.f, 0.f, 0.f, 0.f};
#pragma unroll
            for (int ks = 0; ks < 4; ++ks) {
                const s16x4 t0 = __builtin_amdgcn_ds_read_tr16_b64_v4i16((LAS s16x4*)(lds + SSD_X_OFF + h * SX_H + (32 * ks + 8 * fq + q) * SX_RS + (16 * pt + 4 * pp) * 2));
                const s16x4 t1 = __builtin_amdgcn_ds_read_tr16_b64_v4i16((LAS s16x4*)(lds + SSD_X_OFF + h * SX_H + (32 * ks + 8 * fq + 4 + q) * SX_RS + (16 * pt + 4 * pp) * 2));
                const s16x8 bfr = {t0[0], t0[1], t0[2], t0[3], t1[0], t1[1], t1[2], t1[3]};
                acc = __builtin_amdgcn_mfma_f32_16x16x32_bf16(af[ks], bfr, acc, 0, 0, 0);
            }
            *(f32x4*)(sp + (size_t)(16 * pt + c16) * 128 + 16 * wid + 4 * fq) = acc;
        }
    }
}

__device__ __forceinline__ void ssd_out_item(LAS char* lds, const int item, const bf16_t* XBCB, const float* DT, const float* a_log, const float* d_skip, const float* nw,
                                             const bf16_t* PREV, const float* PROJ, float* YTMP, bf16_t* MIXO) {
    const int tid = threadIdx.x, lane = tid & 63, wid = tid >> 6, c16 = lane & 15, fq = lane >> 4, q = c16 >> 2, pp = c16 & 3;
    const int grp = item & 3, c = (item >> 2) & 31, b = item >> 7;
    __syncthreads();
    ssd_stage<true>(lds, XBCB, DT, a_log, b, c, grp);
    LAS float* dtl = (LAS float*)(lds + SSD_T_OFF); LAS float* acs = dtl + 512;
    const int lcol = 16 * wid + c16;
    const size_t tt = (size_t)b * SEQ + c * 128 + lcol;
    s16x8 cf[4];
#pragma unroll
    for (int ks = 0; ks < 4; ++ks) cf[ks] = *(const LAS s16x8*)(lds + SSD_C_OFF + lcol * SB_RS + (32 * ks + 8 * fq) * 2);
    f32x4 g[8];
#pragma unroll
    for (int mt = 0; mt < 8; ++mt) { g[mt] = (f32x4){0.f, 0.f, 0.f, 0.f};
        if (mt <= wid) {
#pragma unroll
            for (int ks = 0; ks < 4; ++ks) { const s16x8 bfr = *(const LAS s16x8*)(lds + SSD_B_OFF + (16 * mt + c16) * SB_RS + (32 * ks + 8 * fq) * 2);
                g[mt] = __builtin_amdgcn_mfma_f32_16x16x32_bf16(bfr, cf[ks], g[mt], 0, 0, 0); } } }
    float ss = 0.f;
#pragma unroll 1
    for (int h = 0; h < 4; ++h) {
        const int hh = grp * 4 + h;
        const float acs_l = acs[h * 128 + lcol];
        s16x8 pf[4];
#pragma unroll
        for (int ks = 0; ks < 4; ++ks) {
            float pv[2][4];
#pragma unroll
            for (int u = 0; u < 2; ++u) {
                const int s0 = 32 * ks + 16 * u + 4 * fq;
                const f32x4 av4 = *(const LAS f32x4*)(acs + h * 128 + s0), dv4 = *(const LAS f32x4*)(dtl + h * 128 + s0);
#pragma unroll
                for (int i = 0; i < 4; ++i) { const float e = __expf(fminf(acs_l - av4[i], 0.f)) * dv4[i]; pv[u][i] = (s0 + i <= lcol) ? g[2 * ks + u][i] * e : 0.f; }
            }
            const u32x4 w = {pack2(pv[0][0], pv[0][1]), pack2(pv[0][2], pv[0][3]), pack2(pv[1][0], pv[1][1]), pack2(pv[1][2], pv[1][3])};
            pf[ks] = __builtin_bit_cast(s16x8, w);
        }
        const float dsk = d_skip[hh], eal = __expf(acs_l);
        const bf16_t* prevp = PREV + (((size_t)b * 32 + c) * 16 + hh) * 8192;
        s16x8 pr[4][4]; f32x4 zz[4];
#pragma unroll
        for (int pt = 0; pt < 4; ++pt) {
#pragma unroll
            for (int ks = 0; ks < 4; ++ks) pr[pt][ks] = *(const s16x8*)(prevp + (size_t)(16 * pt + c16) * 128 + 32 * ks + 8 * fq);
            zz[pt] = *(const f32x4*)(PROJ + tt * IN_PROJ + OFF_Z + hh * 64 + 16 * pt + 4 * fq);
        }
#pragma unroll
        for (int pt = 0; pt < 4; ++pt) {
            f32x4 yd = {0.f, 0.f, 0.f, 0.f}, yo = {0.f, 0.f, 0.f, 0.f};
#pragma unroll
            for (int ks = 0; ks < 4; ++ks) {
                const s16x4 t0 = __builtin_amdgcn_ds_read_tr16_b64_v4i16((LAS s16x4*)(lds + SSD_X_OFF + h * SX_H + (32 * ks + 4 * fq + q) * SX_RS + (16 * pt + 4 * pp) * 2));
                const s16x4 t1 = __builtin_amdgcn_ds_read_tr16_b64_v4i16((LAS s16x4*)(lds + SSD_X_OFF + h * SX_H + (32 * ks + 16 + 4 * fq + q) * SX_RS + (16 * pt + 4 * pp) * 2));
                const s16x8 xf = {t0[0], t0[1], t0[2], t0[3], t1[0], t1[1], t1[2], t1[3]};
                yd = __builtin_amdgcn_mfma_f32_16x16x32_bf16(xf, pf[ks], yd, 0, 0, 0);
                yo = __builtin_amdgcn_mfma_f32_16x16x32_bf16(pr[pt][ks], cf[ks], yo, 0, 0, 0);
            }
            const u32x2 xr = *(const LAS u32x2*)(lds + SSD_X_OFF + h * SX_H + lcol * SX_RS + (16 * pt + 4 * fq) * 2);
            const float xv[4] = {__uint_as_float(xr[0] << 16), __uint_as_float(xr[0] & 0xffff0000u), __uint_as_float(xr[1] << 16), __uint_as_float(xr[1] & 0xffff0000u)};
            const f32x4 z = zz[pt];
            f32x4 gvv;
#pragma unroll
            for (int i = 0; i < 4; ++i) { const float y = yd[i] + eal * yo[i] + dsk * xv[i]; gvv[i] = y * z[i] * sigmoidf_(z[i]); ss += gvv[i] * gvv[i]; }
            *(f32x4*)(YTMP + tt * 1024 + hh * 64 + 16 * pt + 4 * fq) = gvv;
        }
    }
    ss += __shfl_xor(ss, 16); ss += __shfl_xor(ss, 32);
    const float rs = rsqrtf(ss * (1.0f / 256.f) + NORM_EPS);
#pragma unroll 1
    for (int h = 0; h < 4; ++h) {
        f32x4 gq[4], wq[4];
#pragma unroll
        for (int pt = 0; pt < 4; ++pt) { const int ch = (grp * 4 + h) * 64 + 16 * pt + 4 * fq; wq[pt] = *(const f32x4*)(nw + ch); gq[pt] = *(const f32x4*)(YTMP + tt * 1024 + ch); }
#pragma unroll
        for (int pt = 0; pt < 4; ++pt) { const int ch = (grp * 4 + h) * 64 + 16 * pt + 4 * fq;
            *(uint2*)(MIXO + tt * 2048 + ch) = make_uint2(pack2(gq[pt][0] * rs * wq[pt][0], gq[pt][1] * rs * wq[pt][1]), pack2(gq[pt][2] * rs * wq[pt][2], gq[pt][3] * rs * wq[pt][3])); }
    }
}

struct Args {
    const float* in[23];
    float* out;
    unsigned char* ws;
    int ph_lo, ph_hi;
};

enum { PH_NORM1 = 0, PH_INPROJ, PH_PREP, PH_SSD_CMP1, PH_GNORM_CMP2,
#ifdef SELFCHECK
       PH_CMPATT, PH_SELECT, PH_SELWIN,
#endif
       PH_NSA,
#ifdef SELFCHECK
       PH_CHECK,
#endif
       PH_OUTPROJ, PH_ROUTER, PH_SCATTER, PH_GATEUP, PH_DOWN, PH_FINAL, N_PHASES };

struct ARowsDense { const bf16_t* base; size_t ld; int row0, nrows; const bf16_t* zrow; const void* wsbase;
    __device__ __forceinline__ const bf16_t* row(int r) const { const int g = row0 + r; return g < nrows ? base + (size_t)g * ld : zrow; } };
struct ARowsGather { const bf16_t* base; size_t ld; const int* idx; const bf16_t* zrow; const void* wsbase;
    __device__ __forceinline__ const bf16_t* row(int r) const { const int g = idx[r]; return g >= 0 ? base + (size_t)g * ld : zrow; } };
struct BColsDense { const float* base; int ldb; int col0, ncols;
    __device__ __forceinline__ int coloff(int n) const { const int c = col0 + n; return c < ncols ? c : ncols - 4; } };
struct BColsGateUp { const float* base; int ldb; int cn;
    __device__ __forceinline__ int coloff(int n) const { const int wc = n >> 7, nt = (n & 127) >> 4, w = n & 15; const int j = wc * 64 + (nt & 3) * 16 + w;
        return (nt < 4 ? 0 : DFF) + cn * 128 + j; } };

struct EpiStoreF32 { float* C; size_t ldc; int row0, col0, ncols;
    __device__ __forceinline__ void operator()(int r, int n, f32x4 v) const { const int c = col0 + n; if (c < ncols) *(f32x4*)(C + (size_t)(row0 + r) * ldc + c) = v; } };
struct EpiResidF32 { float* C; const float* X; size_t ldc; int row0, col0;
    __device__ __forceinline__ void operator()(int r, int n, f32x4 v) const { const size_t o = (size_t)(row0 + r) * ldc + col0 + n; const f32x4 x = *(const f32x4*)(X + o); *(f32x4*)(C + o) = v + x; } };
struct EpiGeluBf16 { bf16_t* O; const float* bias; size_t ldo; int row0, col0, nrows;
    __device__ __forceinline__ void operator()(int r, int n, f32x4 v) const { const int g = row0 + r; if (g >= nrows) return; const int c = col0 + n;
        float o[4];
#pragma unroll
        for (int i = 0; i < 4; ++i) { const float x = v[i] + bias[c + i]; const float u = 0.7978845608028654f * (x + 0.044715f * x * x * x); o[i] = 0.5f * x * (1.0f + tanhf(u)); }
        *(uint2*)(O + (size_t)g * ldo + c) = make_uint2(pack2(o[0], o[1]), pack2(o[2], o[3])); } };
struct EpiSwiglu { bf16_t* O; const float* bias; int row0, cn;
    __device__ __forceinline__ void pair(int r, int j, f32x4 g, f32x4 u) const { const int c = cn * 128 + j; float o[4];
#pragma unroll
        for (int i = 0; i < 4; ++i) { float gv = g[i] + bias[c + i]; float uv = u[i] + bias[DFF + c + i]; gv = fminf(gv, 7.0f); uv = fminf(fmaxf(uv, -7.0f), 7.0f);
            const float glu = gv * sigmoidf_(1.702f * gv); o[i] = (uv + 1.0f) * glu; }
        *(uint2*)(O + (size_t)(row0 + r) * DFF + c) = make_uint2(pack2(o[0], o[1]), pack2(o[2], o[3])); } };
struct EpiBiasBf16 { bf16_t* O; const float* bias; int row0, col0;
    __device__ __forceinline__ void operator()(int r, int n, f32x4 v) const { const int c = col0 + n;
        *(uint2*)(O + (size_t)(row0 + r) * D + c) = make_uint2(pack2(v[0] + bias[c], v[1] + bias[c + 1]), pack2(v[2] + bias[c + 2], v[3] + bias[c + 3])); } };

__device__ __forceinline__ float rope_inv(int i) { return (float)exp(-(double)i * 0.125 * 13.122363377404328); }


#define PATCH_LOOP(nR_, nC_, RT, CT, ...) do { \
    const int nlab_ = (G % 8 == 0) ? 8 : 1, nsl_ = G / nlab_, npc_ = ((nC_) + 7) >> 3, npatch_ = (((nR_) + 3) >> 2) * npc_; \
    for (int pidx_ = bid % nlab_; pidx_ < npatch_; pidx_ += nlab_) \
        for (int slot_ = bid / nlab_; slot_ < 32; slot_ += nsl_) { \
            const int RT = (pidx_ / npc_) * 4 + (slot_ >> 3), CT = (pidx_ % npc_) * 8 + (slot_ & 7); \
            if (RT < (nR_) && CT < (nC_)) { __VA_ARGS__ } } } while (0)

__global__ void __launch_bounds__(512, 2) fwd(Args a) {
    extern __shared__ __attribute__((aligned(16))) unsigned char lds_raw[];
    LAS char* lds = (LAS char*)lds_raw;
    const int tid = threadIdx.x, lane = tid & 63, wid = __builtin_amdgcn_readfirstlane(tid >> 6);
    const int G = gridDim.x, bid = blockIdx.x;
    const int gtid = bid * 512 + tid, gthreads = G * 512;
    const int gwave = bid * 8 + wid, gwaves = G * 8;
    unsigned char* ws = a.ws;
    unsigned* ctl = (unsigned*)(ws + WS_CTL);
    volatile LAS unsigned* barw = (volatile LAS unsigned*)(lds + MAIN_LDS);
    if (tid == 0) { barw[0] = 0u; barw[1] = 0u; barw[2] = 0u; barw[3] = 0u; }
    __syncthreads();
    XcdBarrier bar; bar.bar = ctl; bar.x = 0; bar.st = barw;
    const bool multi = (a.ph_hi - a.ph_lo) > 1;
    if (multi) bar = xcd_barrier_post(ctl, barw);
#ifdef ONLY_PH
#define IN(k) ((k) == ONLY_PH)
#else
#define IN(k) (a.ph_lo <= (k) && (k) < a.ph_hi)
#endif
#define SEAM(k) do { if ((k) + 1 < a.ph_hi) xcd_barrier(bar); } while (0)

#define XN ((bf16_t*)(ws + WS_XN))
#define PROJ ((float*)(ws + WS_PROJ))
#define XBC ((float*)(ws + WS_XBC))
#define DT ((float*)(ws + WS_DT))
#define YSSD ((float*)(ws + WS_YSSD))
#define MIX ((bf16_t*)(ws + WS_MIX))
#define ROPE ((float*)(ws + WS_ROPE))
#define BLK ((bf16_t*)(ws + WS_BLK))
#define H1 ((bf16_t*)(ws + WS_H1))
#define KC ((float*)(ws + WS_KC))
#define VC ((float*)(ws + WS_VC))
#define PCMP ((float*)(ws + WS_PCMP))
#define OCMP ((float*)(ws + WS_OCMP))
#define SEL ((unsigned long long*)(ws + WS_SEL))
#define X2 ((float*)(ws + WS_X2))
#define TOPE ((int*)(ws + WS_TOPE))
#define TOPG ((float*)(ws + WS_TOPG))
#define SLOT ((int*)(ws + WS_SLOT))
#define POS ((int*)(ws + WS_POS))
#define ROWTOK ((int*)(ws + WS_ROWTOK))
#define ACT ((bf16_t*)(ws + WS_ACT))
#define YB ((bf16_t*)(ws + WS_Y))
#define XBCB ((bf16_t*)(ws + WS_XBCB))
#define STATES ((float*)(ws + WS_STATES))
#define PREV ((bf16_t*)(ws + WS_PREV))
#define CHDEC ((float*)(ws + WS_CHDEC))
#define QB ((bf16_t*)(ws + WS_QB))
#define KSb ((bf16_t*)(ws + WS_KS))
#define VSb ((bf16_t*)(ws + WS_VS))
#define KWb ((bf16_t*)(ws + WS_KW))
#define VWb ((bf16_t*)(ws + WS_VW))
#define KCB ((bf16_t*)(ws + WS_KCB))
#define VCB ((bf16_t*)(ws + WS_VCB))
#define XIN (a.in[0])
#define RW ((float*)(ws + WS_RW))
#define PART ((float*)(ws + WS_PART))
#define COUNT (ctl + CW_COUNT)
#define ZROW ((const bf16_t*)(ctl + CW_ZROW))
    if (IN(PH_NORM1)) {
        const float* w = a.in[1];
        for (int row = gwave; row < T; row += gwaves) {
            const float4* xr = (const float4*)(XIN + (size_t)row * D);
            float4 v[8]; float ss = 0.f;
#pragma unroll
            for (int i = 0; i < 8; ++i) { v[i] = xr[lane + 64 * i]; ss += v[i].x * v[i].x + v[i].y * v[i].y + v[i].z * v[i].z + v[i].w * v[i].w; }
            ss = wave_sum(ss);
            const float rstd = rsqrtf(ss * (1.0f / D) + NORM_EPS);
#pragma unroll
            for (int i = 0; i < 8; ++i) { const float4 wv = ((const float4*)w)[lane + 64 * i];
                *(uint2*)(XN + (size_t)row * D + 4 * (lane + 64 * i)) = make_uint2(pack2(v[i].x * rstd * wv.x, v[i].y * rstd * wv.y), pack2(v[i].z * rstd * wv.z, v[i].w * rstd * wv.w)); }
        }
        for (int i = gtid; i < SEQ * 8; i += gthreads) { const int pos = i >> 3, k = i & 7; const float ang = (float)pos * rope_inv(k); ROPE[i] = cosf(ang); ROPE[SEQ * 8 + i] = sinf(ang); }
        for (int i = gtid; i < MAX_ROWS; i += gthreads) ROWTOK[i] = -1;
        SEAM(PH_NORM1);
    }

    if (IN(PH_INPROJ)) {
        PATCH_LOOP(T / 256, (IN_PROJ + 255) / 256, rt, ct, {
            ARowsDense al{XN, (size_t)D, rt * 256, T, ZROW, ws};
            BColsDense bl{a.in[2], IN_PROJ, ct * 256, IN_PROJ};
            EpiStoreF32 ep{PROJ, (size_t)IN_PROJ, rt * 256, ct * 256, IN_PROJ};
            gemm_unit<false>(lds, al, bl, ep, D); });
        SEAM(PH_INPROJ);
    }

    if (IN(PH_PREP)) {
        const float* conv_w = a.in[3]; const float* conv_b = a.in[4]; const float* dt_bias = a.in[5];
        for (int i = gtid; i < T * 512; i += gthreads) {
            const int t = i >> 9, c = (i & 511) * 4, s = t & (SEQ - 1);
            f32x4 acc = *(const f32x4*)(conv_b + c);
#pragma unroll
            for (int k = 0; k < 4; ++k) { const int ts = s - 3 + k; if (ts >= 0) { const f32x4 w4 = *(const f32x4*)(conv_w + k * 2048 + c); const f32x4 v = *(const f32x4*)(PROJ + (size_t)(t - 3 + k) * IN_PROJ + OFF_XBC + c); acc += w4 * v; } }
            float cv[4];
#pragma unroll
            for (int e = 0; e < 4; ++e) cv[e] = acc[e] * sigmoidf_(acc[e]);
#if defined(SELFCHECK) && SELFCHECK == 2
            *(f32x4*)(XBC + (size_t)t * 2048 + c) = (f32x4){cv[0], cv[1], cv[2], cv[3]};
#endif
            *(uint2*)(XBCB + (size_t)t * 2048 + c) = make_uint2(pack2(cv[0], cv[1]), pack2(cv[2], cv[3]));
        }
        for (int i = gtid; i < T * 16; i += gthreads) { const int h = i & 15; const float v = PROJ[(size_t)(i >> 4) * IN_PROJ + OFF_DT + h] + dt_bias[h];
            DT[i] = v > 20.f ? v : log1pf(expf(v)); }
        for (int i = gtid; i < T * 256; i += gthreads) {
            const int ch = i & 7, slot = (i >> 3) & 31, t = i >> 8, pos = t & (SEQ - 1);
            int col; bf16_t* dst; float scl = 1.0f; bool rope = slot < 24;
            if (slot < 16) { col = OFF_Q + slot * 64; dst = QB + (size_t)t * 1024 + slot * 64; scl = 0.125f * 1.4426950408889634f; }
            else if (slot < 20) { col = OFF_KSLC + (slot - 16) * 64; dst = KSb + (size_t)t * 256 + (slot - 16) * 64; }
            else if (slot < 24) { col = OFF_KWIN + (slot - 20) * 64; dst = KWb + (size_t)t * 256 + (slot - 20) * 64; }
            else if (slot < 28) { col = OFF_VSLC + (slot - 24) * 64; dst = VSb + (size_t)t * 256 + (slot - 24) * 64; }
            else { col = OFF_VWIN + (slot - 28) * 64; dst = VWb + (size_t)t * 256 + (slot - 28) * 64; }
            const float* p = PROJ + (size_t)t * IN_PROJ + col;
            float v[8];
            if (rope && ch < 2) {
                const float4 a0 = *(const float4*)(p), a1 = *(const float4*)(p + 4), b0 = *(const float4*)(p + 8), b1 = *(const float4*)(p + 12);
                const float x1[8] = {a0.x, a0.y, a0.z, a0.w, a1.x, a1.y, a1.z, a1.w}, x2[8] = {b0.x, b0.y, b0.z, b0.w, b1.x, b1.y, b1.z, b1.w};
#pragma unroll
                for (int k = 0; k < 8; ++k) { const float c = ROPE[pos * 8 + k], sn = ROPE[SEQ * 8 + pos * 8 + k]; v[k] = (ch == 0) ? (x1[k] * c - x2[k] * sn) : (x1[k] * sn + x2[k] * c); }
            } else {
                const float4 a0 = *(const float4*)(p + ch * 8), a1 = *(const float4*)(p + ch * 8 + 4);
                v[0] = a0.x; v[1] = a0.y; v[2] = a0.z; v[3] = a0.w; v[4] = a1.x; v[5] = a1.y; v[6] = a1.z; v[7] = a1.w;
            }
            u32x4 o = {pack2(v[0] * scl, v[1] * scl), pack2(v[2] * scl, v[3] * scl), pack2(v[4] * scl, v[5] * scl), pack2(v[6] * scl, v[7] * scl)};
            *(u32x4*)(dst + ch * 8) = o;
        }
        for (int i = gtid; i < 2 * 2 * 256; i += gthreads) { const int d = i & 255, b = (i >> 8) & 1, j = i >> 9; (j ? VCB : KCB)[((size_t)b * 256 + 255) * 256 + d] = 0; }
        for (int i = gtid; i < 2048 * 32; i += gthreads) { const int ii = i & 3, e = (i >> 2) & 31, kk = i >> 7, k = 4 * kk + ii; RW[i] = a.in[15][k] * a.in[16][k * NE + e]; }
        const float* pe = a.in[9];
        for (int i = gtid; i < 2 * 2048 * 512; i += gthreads) {
            const int e4 = i & 511, row = (i >> 9) & 2047, j = i >> 20;
            uint2 o = make_uint2(0u, 0u);
            if (row < CMP_ROWS) { const int g = row & 3, n = (row >> 2) % N_C, b = (row >> 2) / N_C; const int l = e4 >> 4, d = (e4 & 15) * 4;
                const float4 v = *(const float4*)(PROJ + (size_t)(b * SEQ + 16 * n + l) * IN_PROJ + (j ? OFF_VCMP : OFF_KCMP) + g * 64 + d);
                const float4 p4 = *(const float4*)(pe + (j * 32 + l) * 64 + d);
                o = make_uint2(pack2(v.x + p4.x, v.y + p4.y), pack2(v.z + p4.z, v.w + p4.w)); }
            *(uint2*)(BLK + ((size_t)j * 2048 + row) * 2048 + e4 * 4) = o;
        }
        SEAM(PH_PREP);
    }

    if (IN(PH_SSD_CMP1)) {
#if defined(SELFCHECK) && SELFCHECK == 2
        const int GW = G - 16;
        if (bid >= GW) {
            const int w = (bid - GW) * 8 + wid, b = w >> 6, h = (w >> 2) & 15, pq = w & 3, g = h >> 2;
            const int p = pq * 16 + (lane >> 2), nq = lane & 3;
            const float av = -expf(a.in[6][h]), dsk = a.in[7][h];
            float st[32];
#pragma unroll
            for (int n = 0; n < 32; ++n) st[n] = 0.f;
            for (int t = 0; t < SEQ; ++t) {
                const size_t tt = (size_t)b * SEQ + t;
                const float* row = XBC + tt * 2048;
                const float dtv = DT[tt * 16 + h];
                const float dA = expf(dtv * av);
                const float xv = row[h * 64 + p];
                const float4* Bp = (const float4*)(row + 1024 + g * 128 + nq * 32); const float4* Cp = (const float4*)(row + 1536 + g * 128 + nq * 32);
                const float coef = dtv * xv; float y = 0.f;
#pragma unroll
                for (int n4 = 0; n4 < 8; ++n4) { const float4 bv = Bp[n4], cv = Cp[n4];
                    st[4 * n4 + 0] = st[4 * n4 + 0] * dA + coef * bv.x; y += st[4 * n4 + 0] * cv.x;
                    st[4 * n4 + 1] = st[4 * n4 + 1] * dA + coef * bv.y; y += st[4 * n4 + 1] * cv.y;
                    st[4 * n4 + 2] = st[4 * n4 + 2] * dA + coef * bv.z; y += st[4 * n4 + 2] * cv.z;
                    st[4 * n4 + 3] = st[4 * n4 + 3] * dA + coef * bv.w; y += st[4 * n4 + 3] * cv.w; }
                y += __shfl_xor(y, 1); y += __shfl_xor(y, 2);
                if (nq == 0) YSSD[tt * 1024 + h * 64 + p] = y + dsk * xv;
            }
        } else
#else
        const int GW = G;
#endif
        {
            for (int u = bid; u < 128; u += GW) {
                const int kq = u >> 5, j = (u >> 4) & 1, rt = (u >> 1) & 7, ct = u & 1;
                ARowsDense al{BLK + (size_t)j * 2048 * 2048 + kq * 512, (size_t)2048, rt * 256, CMP_ROWS, ZROW, ws};
                BColsDense bl{a.in[10] + (size_t)j * 2048 * CMP_HID + (size_t)kq * 512 * CMP_HID, CMP_HID, ct * 256, CMP_HID};
                EpiStoreF32 ep{PART + (size_t)(kq * 2 + j) * 2048 * CMP_HID, (size_t)CMP_HID, rt * 256, ct * 256, CMP_HID};
                gemm_unit<false>(lds, al, bl, ep, 512);
            }
            for (int it = (bid + GW - (128 % GW)) % GW; it < 256; it += GW) ssd_states_item(lds, it, XBCB, DT, a.in[6], STATES, CHDEC);
        }
        SEAM(PH_SSD_CMP1);
    }

    if (IN(PH_GNORM_CMP2)) {
        const float* nw = a.in[8];
#ifdef SELFCHECK
        for (int i = gtid; i < T * 24 * 8; i += gthreads) {
            const int k = i & 7, slot = (i >> 3) % 24, t = i / 192, pos = t & (SEQ - 1);
            const int col = slot < 16 ? OFF_Q + slot * 64 : (slot < 20 ? OFF_KSLC + (slot - 16) * 64 : OFF_KWIN + (slot - 20) * 64);
            float* p = PROJ + (size_t)t * IN_PROJ + col;
            const float c = ROPE[pos * 8 + k], s = ROPE[SEQ * 8 + pos * 8 + k];
            const float x1 = p[k], x2 = p[k + 8];
            p[k] = x1 * c - x2 * s; p[k + 8] = x1 * s + x2 * c;
        }
#endif
#if defined(SELFCHECK) && SELFCHECK == 2
        for (int it = gwave; it < T * 4; it += gwaves) {
            const int t = it >> 2, grp = it & 3, c = grp * 256 + lane * 4;
            const float4 y = *(const float4*)(YSSD + (size_t)t * 1024 + c);
            const float4 z = *(const float4*)(PROJ + (size_t)t * IN_PROJ + OFF_Z + c);
            float gv[4] = {y.x * z.x * sigmoidf_(z.x), y.y * z.y * sigmoidf_(z.y), y.z * z.z * sigmoidf_(z.z), y.w * z.w * sigmoidf_(z.w)};
            float ss = wave_sum(gv[0] * gv[0] + gv[1] * gv[1] + gv[2] * gv[2] + gv[3] * gv[3]);
            const float sc = rsqrtf(ss * (1.0f / 256.f) + NORM_EPS);
            const float4 w4 = *(const float4*)(nw + c);
            *(uint2*)(MIX + (size_t)t * 2048 + c) = make_uint2(pack2(gv[0] * sc * w4.x, gv[1] * sc * w4.y), pack2(gv[2] * sc * w4.z, gv[3] * sc * w4.w));
        }
#endif
        for (int i = gtid; i < 2 * 16 * 64 * 32; i += gthreads) {
            const int n4 = i & 31, p = (i >> 5) & 63, h = (i >> 11) & 15, b = i >> 15;
            f32x4 run = {0.f, 0.f, 0.f, 0.f};
            for (int c = 0; c < 32; ++c) {
                const size_t base = (((size_t)b * 32 + c) * 16 + h) * 8192 + p * 128 + n4 * 4;
                *(uint2*)(PREV + base) = make_uint2(pack2(run[0], run[1]), pack2(run[2], run[3]));
                const float dec = CHDEC[((size_t)b * 32 + c) * 16 + h];
                const f32x4 sv = *(const f32x4*)(STATES + base);
                run = run * dec + sv;
            }
        }
        const float* w2 = a.in[12]; const float* b2 = a.in[13]; const float* b1 = a.in[11];
        for (int it = gwave; it < 2 * CMP_ROWS; it += gwaves) {
            const int row = it % CMP_ROWS, j = it / CMP_ROWS, d = lane;
            const float* wj = w2 + (size_t)j * CMP_HID * 64;
            float s0 = b2[j * 64 + d];
            for (int k0 = 0; k0 < CMP_HID; k0 += 64) {
                float hx = b1[j * CMP_HID + k0 + lane];
#pragma unroll
                for (int q = 0; q < 4; ++q) hx += PART[((size_t)(q * 2 + j) * 2048 + row) * CMP_HID + k0 + lane];
                const float u = 0.7978845608028654f * (hx + 0.044715f * hx * hx * hx);
                const float hv = bf2f(f2bf(0.5f * hx * (1.0f + tanhf(u))));
#pragma unroll 16
                for (int kk = 0; kk < 64; ++kk) s0 += __shfl(hv, kk) * wj[(k0 + kk) * 64 + d];
            }
            float o = s0;
            if (j == 0) { const float sp = __shfl(s0, (d < 8) ? d + 8 : ((d < 16) ? d - 8 : d));
                if (d < 16) { const int n = (row >> 2) % N_C, pos = 16 * n + 31, k = d & 7; const float c = ROPE[pos * 8 + k], sn = ROPE[SEQ * 8 + pos * 8 + k];
                    o = (d < 8) ? (s0 * c - sp * sn) : (sp * sn + s0 * c); } }
#ifdef SELFCHECK
            (j ? VC : KC)[(size_t)row * 64 + d] = o;
#endif
            { const int g4 = row & 3, n = (row >> 2) % N_C, bb = (row >> 2) / N_C; (j ? VCB : KCB)[((size_t)bb * 256 + n) * 256 + g4 * 64 + d] = f2bf(o); }
        }
        SEAM(PH_GNORM_CMP2);
    }

#ifdef SELFCHECK
    if (IN(PH_CMPATT)) {
        for (int it = gtid; it < T * 16; it += gthreads) {
            const int hq = it & 15, tt = it >> 4, b = tt >> 12, t = tt & (SEQ - 1), g = hq >> 2;
            const int nvalid = t >= 31 ? ((t - 31) >> 4) + 1 : 0;
            float q[64];
            const float* qp = PROJ + (size_t)tt * IN_PROJ + OFF_Q + hq * 64;
#pragma unroll
            for (int d = 0; d < 64; d += 4) { const float4 v = *(const float4*)(qp + d); q[d] = v.x; q[d + 1] = v.y; q[d + 2] = v.z; q[d + 3] = v.w; }
            float m = -INFINITY, l = 0.f;
            for (int c = 0; c < nvalid; ++c) {
                const float* kp = KC + (size_t)((b * N_C + c) * 4 + g) * 64; float s = 0.f;
#pragma unroll
                for (int d = 0; d < 64; d += 4) { const float4 v = *(const float4*)(kp + d); s += q[d] * v.x + q[d + 1] * v.y + q[d + 2] * v.z + q[d + 3] * v.w; }
                s *= 0.125f;
                const float mn = fmaxf(m, s); l = l * __expf(m - mn) + __expf(s - mn); m = mn;
            }
            float o[64];
#pragma unroll
            for (int d = 0; d < 64; ++d) o[d] = 0.f;
            const float inv_l = nvalid > 0 ? 1.0f / fmaxf(l, 1e-30f) : 0.f;
            float* pp = PCMP + (size_t)it * 256;
            for (int c = 0; c < nvalid; ++c) {
                const float* kp = KC + (size_t)((b * N_C + c) * 4 + g) * 64; float s = 0.f;
#pragma unroll
                for (int d = 0; d < 64; d += 4) { const float4 v = *(const float4*)(kp + d); s += q[d] * v.x + q[d + 1] * v.y + q[d + 2] * v.z + q[d + 3] * v.w; }
                const float p = __expf(s * 0.125f - m) * inv_l;
                pp[c] = p;
                const float* vp = VC + (size_t)((b * N_C + c) * 4 + g) * 64;
#pragma unroll
                for (int d = 0; d < 64; d += 4) { const float4 v = *(const float4*)(vp + d); o[d] += p * v.x; o[d + 1] += p * v.y; o[d + 2] += p * v.z; o[d + 3] += p * v.w; }
            }
            for (int c = nvalid; c < 256; ++c) pp[c] = 0.f;
            float* op = OCMP + (size_t)tt * 1024 + hq * 64;
#pragma unroll
            for (int d = 0; d < 64; d += 4) *(float4*)(op + d) = make_float4(o[d], o[d + 1], o[d + 2], o[d + 3]);
        }
        SEAM(PH_CMPATT);
    }

    if (IN(PH_SELECT)) {
        for (int it = gwave; it < T * 4; it += gwaves) {
            const int g = it & 3, tt = it >> 2, t = tt & (SEQ - 1), cur = t >> 6, j = lane;
            float imp = 0.f;
#pragma unroll
            for (int r = 0; r < 4; ++r) { const float* pp = PCMP + ((size_t)tt * 16 + g * 4 + r) * 256 + 4 * j;
                const float4 v = *(const float4*)pp; const float pm1 = j > 0 ? pp[-1] : 0.f;
                imp += 32.f * (v.x + v.y + v.z) + 16.f * v.w + 16.f * pm1; }
            const bool forced = (j == 0) || (j == cur) || (j == cur - 1);
            const bool valid = j <= cur;
            const float sc = forced ? 1.0e4f : (valid ? imp : -1.0e4f);
            int rank = 0;
#pragma unroll
            for (int k = 0; k < 64; ++k) { const float o = __shfl(sc, k); rank += (o > sc || (o == sc && k < j)) ? 1 : 0; }
            const unsigned long long mask = __ballot(rank < 16 && valid);
            if (lane == 0) SEL[it] = mask;
        }
        SEAM(PH_SELECT);
    }

    if (IN(PH_SELWIN)) {
        for (int it = gtid; it < T * 16; it += gthreads) {
            const int hq = it & 15, tt = it >> 4, b = tt >> 12, t = tt & (SEQ - 1), g = hq >> 2;
            float q[64];
            const float* qp = PROJ + (size_t)tt * IN_PROJ + OFF_Q + hq * 64;
#pragma unroll
            for (int d = 0; d < 64; d += 4) { const float4 v = *(const float4*)(qp + d); q[d] = v.x; q[d + 1] = v.y; q[d + 2] = v.z; q[d + 3] = v.w; }
            const float* gl = PROJ + (size_t)tt * IN_PROJ + OFF_GATE + hq * 3;
            const float g0 = sigmoidf_(gl[0]), g1 = sigmoidf_(gl[1]), g2 = sigmoidf_(gl[2]);
            float* op = OCMP + (size_t)tt * 1024 + hq * 64;
            float o[64];
            {
#pragma unroll
                for (int d = 0; d < 64; ++d) o[d] = 0.f;
                float m = -INFINITY, l = 0.f;
                unsigned long long mask = SEL[(size_t)tt * 4 + g];
                while (mask) {
                    const int j = __ffsll((long long)mask) - 1; mask &= mask - 1;
                    const int hi = min(64 * j + 63, t);
                    for (int tok = 64 * j; tok <= hi; ++tok) {
                        const float* kp = PROJ + (size_t)(b * SEQ + tok) * IN_PROJ + OFF_KSLC + g * 64; float s = 0.f;
#pragma unroll
                        for (int d = 0; d < 64; d += 4) { const float4 v = *(const float4*)(kp + d); s += q[d] * v.x + q[d + 1] * v.y + q[d + 2] * v.z + q[d + 3] * v.w; }
                        s *= 0.125f;
                        const float mn = fmaxf(m, s), al = __expf(m - mn), p = __expf(s - mn); m = mn; l = l * al + p;
                        const float* vp = kp + (OFF_VSLC - OFF_KSLC);
#pragma unroll
                        for (int d = 0; d < 64; d += 4) { const float4 v = *(const float4*)(vp + d); o[d] = o[d] * al + p * v.x; o[d + 1] = o[d + 1] * al + p * v.y; o[d + 2] = o[d + 2] * al + p * v.z; o[d + 3] = o[d + 3] * al + p * v.w; }
                    }
                }
                const float il = g1 / fmaxf(l, 1e-30f);
#pragma unroll
                for (int d = 0; d < 64; d += 4) { float4 r = *(float4*)(op + d); r.x = g0 * r.x + il * o[d]; r.y = g0 * r.y + il * o[d + 1]; r.z = g0 * r.z + il * o[d + 2]; r.w = g0 * r.w + il * o[d + 3]; *(float4*)(op + d) = r; }
            }
            {
#pragma unroll
                for (int d = 0; d < 64; ++d) o[d] = 0.f;
                float m = -INFINITY, l = 0.f;
                const int lo = max(0, t - 511);
                for (int tok = lo; tok <= t; ++tok) {
                    const float* kp = PROJ + (size_t)(b * SEQ + tok) * IN_PROJ + OFF_KWIN + g * 64; float s = 0.f;
#pragma unroll
                    for (int d = 0; d < 64; d += 4) { const float4 v = *(const float4*)(kp + d); s += q[d] * v.x + q[d + 1] * v.y + q[d + 2] * v.z + q[d + 3] * v.w; }
                    s *= 0.125f;
                    const float mn = fmaxf(m, s), al = __expf(m - mn), p = __expf(s - mn); m = mn; l = l * al + p;
                    const float* vp = kp + (OFF_VWIN - OFF_KWIN);
#pragma unroll
                    for (int d = 0; d < 64; d += 4) { const float4 v = *(const float4*)(vp + d); o[d] = o[d] * al + p * v.x; o[d + 1] = o[d + 1] * al + p * v.y; o[d + 2] = o[d + 2] * al + p * v.z; o[d + 3] = o[d + 3] * al + p * v.w; }
                }
                const float il = g2 / fmaxf(l, 1e-30f);
                bf16_t* mp = MIX + (size_t)tt * 2048 + 1024 + hq * 64;
#pragma unroll
                for (int d = 0; d < 64; d += 4) { const float4 r = *(const float4*)(op + d);
                    *(uint2*)(mp + d) = make_uint2(pack2(r.x + il * o[d], r.y + il * o[d + 1]), pack2(r.z + il * o[d + 2], r.w + il * o[d + 3])); }
            }
        }
        SEAM(PH_SELWIN);
    }

#endif
    if (IN(PH_NSA)) {
#ifdef SELFCHECK
        bf16_t* MIXO = (bf16_t*)(ws + WS_CHK);
#else
        bf16_t* MIXO = MIX;
#endif
        for (int k = bid; k < 512; k += G) { const int rnd = k / G; const int u = (rnd & 1) ? 511 - (k - G * rnd) - G * (rnd - 1) : k;
            if (u >= 0 && u < 512) nsa_unit32(lds, (G == 256) ? u : k, QB, KSb, VSb, KWb, VWb, KCB, VCB, PROJ, MIXO); }
        for (int it = bid; it < 256; it += G) ssd_out_item(lds, it, XBCB, DT, a.in[6], a.in[7], a.in[8], PREV, PROJ, YSSD, MIXO);
        SEAM(PH_NSA);
    }
#ifdef SELFCHECK
    if (IN(PH_CHECK)) {
        const bf16_t* A_ = MIX; const bf16_t* B_ = (const bf16_t*)(ws + WS_CHK);
        float sd = 0.f, sr = 0.f;
        for (int i = gtid; i < T * 1024; i += gthreads) { const size_t o = (size_t)(i >> 10) * 2048 + (SELFCHECK == 1 ? 1024 : 0) + (i & 1023); const float r = bf2f(A_[o]), v = bf2f(B_[o]); sd += (r - v) * (r - v); sr += r * r; }
        sd = wave_sum(sd); sr = wave_sum(sr);
        if (lane == 0) { atomicAdd((float*)(ctl + CW_CHK), sd); atomicAdd((float*)(ctl + CW_CHK + 1), sr); }
        SEAM(PH_CHECK);
    }
#endif

    if (IN(PH_OUTPROJ)) {
        PATCH_LOOP(T / 256, D / 256, rt, ct, {
            ARowsDense al{MIX, (size_t)2048, rt * 256, T, ZROW, ws};
            BColsDense bl{a.in[14], D, ct * 256, D};
            EpiResidF32 ep{X2, XIN, (size_t)D, rt * 256, ct * 256};
            gemm_unit<false>(lds, al, bl, ep, 2048); });
        SEAM(PH_OUTPROJ);
    }

    if (IN(PH_ROUTER)) {
        const float* nwp = a.in[15]; const float* br = a.in[17];
        LAS float* part = (LAS float*)lds;
        LAS float* ssq = part + 8 * 512;
        LAS float* rsl = ssq + 128;
        const int r16 = lane & 15, kq = lane >> 4;
        for (int tile = bid; tile < T / 16; tile += G) {
            const int row = tile * 16 + r16;
            f32x4 acc0 = {0.f, 0.f, 0.f, 0.f}, acc1 = {0.f, 0.f, 0.f, 0.f}; float ssp = 0.f;
            const float* xr = X2 + (size_t)row * D + 256 * wid + 4 * kq;
            const float* rwp = RW + ((size_t)(64 * wid + kq) * 32 + r16) * 4;
#pragma unroll 4
            for (int j = 0; j < 16; ++j) {
                const f32x4 av = *(const f32x4*)(xr + 16 * j);
                const f32x4 b0 = *(const f32x4*)(rwp + (size_t)j * 4 * 128), b1 = *(const f32x4*)(rwp + (size_t)j * 4 * 128 + 64);
                ssp += av[0] * av[0] + av[1] * av[1] + av[2] * av[2] + av[3] * av[3];
#pragma unroll
                for (int i = 0; i < 4; ++i) { acc0 = __builtin_amdgcn_mfma_f32_16x16x4f32(av[i], b0[i], acc0, 0, 0, 0); acc1 = __builtin_amdgcn_mfma_f32_16x16x4f32(av[i], b1[i], acc1, 0, 0, 0); }
            }
            ssp += __shfl_xor(ssp, 16); ssp += __shfl_xor(ssp, 32);
            if (kq == 0) ssq[wid * 16 + r16] = ssp;
#pragma unroll
            for (int i = 0; i < 4; ++i) { part[wid * 512 + (4 * kq + i) * 32 + r16] = acc0[i]; part[wid * 512 + (4 * kq + i) * 32 + 16 + r16] = acc1[i]; }
            __syncthreads();
            {
                const int rr = tid >> 5, e = tid & 31, grow = tile * 16 + rr;
                float lg = 0.f, ss = 0.f;
#pragma unroll
                for (int w = 0; w < 8; ++w) { lg += part[w * 512 + rr * 32 + e]; ss += ssq[w * 16 + rr]; }
                const float rstd = rsqrtf(ss * (1.0f / D) + NORM_EPS);
                const float mine = lg * rstd + br[e];
                int rank = 0;
#pragma unroll
                for (int k = 0; k < NE; ++k) { const float o = __shfl(mine, (lane & 32) + k); rank += (o > mine || (o == mine && k < e)) ? 1 : 0; }
                const bool sel = rank < 4;
                float mx = sel ? mine : -INFINITY;
#pragma unroll
                for (int o = 16; o > 0; o >>= 1) mx = fmaxf(mx, __shfl_xor(mx, o));
                const float ex = sel ? __expf(mine - mx) : 0.f;
                float den = ex;
#pragma unroll
                for (int o = 16; o > 0; o >>= 1) den += __shfl_xor(den, o);
                if (sel) { const int slot = (int)atomicAdd(&COUNT[e], 1u); const int o = grow * 4 + rank; TOPE[o] = e; TOPG[o] = ex / den; SLOT[o] = slot; }
                if (e == 0) rsl[rr] = rstd;
            }
            __syncthreads();
#pragma unroll 4
            for (int it = 0; it < 16; ++it) { const int idx = tid + 512 * it, rr = idx >> 9, c4 = idx & 511; const size_t o = (size_t)(tile * 16 + rr) * D + 4 * c4;
                const f32x4 v = *(const f32x4*)(X2 + o); const f32x4 wv = *(const f32x4*)(nwp + 4 * c4); const float rs = rsl[rr];
                *(uint2*)(XN + o) = make_uint2(pack2(v[0] * rs * wv[0], v[1] * rs * wv[1]), pack2(v[2] * rs * wv[2], v[3] * rs * wv[3])); }
            __syncthreads();
        }
        SEAM(PH_ROUTER);
    }

    if (IN(PH_SCATTER)) {
        for (int i = gtid; i < T * 4; i += gthreads) {
            const int e = TOPE[i]; int off = 0;
            for (int k = 0; k < e; ++k) off += (int)((COUNT[k] + 255u) >> 8);
            const int pos = off * 256 + SLOT[i];
            ROWTOK[pos] = i >> 2; POS[i] = pos;
        }
        SEAM(PH_SCATTER);
    }

    if (IN(PH_GATEUP) || IN(PH_DOWN)) {
        LAS int* toff = (LAS int*)(lds + GEMM_LDS + 64 - 0);
        (void)toff;
    }
    if (IN(PH_GATEUP)) {
        int ntiles = 0;
        for (int k = 0; k < NE; ++k) ntiles += (int)((COUNT[k] + 255u) >> 8);
        PATCH_LOOP(ntiles, 16, tile, cn, {
            int e = 0, acc = 0;
            for (int k = 0; k < NE; ++k) { const int nt = (int)((COUNT[k] + 255u) >> 8); if (tile >= acc && tile < acc + nt) e = k; acc += nt; }
            ARowsGather al{XN, (size_t)D, ROWTOK + tile * 256, ZROW, ws};
            BColsGateUp bl{a.in[18] + (size_t)e * D * 2 * DFF, 2 * DFF, cn};
            EpiSwiglu ep{ACT, a.in[19] + (size_t)e * 2 * DFF, tile * 256, cn};
            gemm_unit<true>(lds, al, bl, ep, D); });
        SEAM(PH_GATEUP);
    }
    if (IN(PH_DOWN)) {
        int ntiles = 0;
        for (int k = 0; k < NE; ++k) ntiles += (int)((COUNT[k] + 255u) >> 8);
        PATCH_LOOP(ntiles, 8, tile, ct, {
            int e = 0, acc = 0;
            for (int k = 0; k < NE; ++k) { const int nt = (int)((COUNT[k] + 255u) >> 8); if (tile >= acc && tile < acc + nt) e = k; acc += nt; }
            ARowsDense al{ACT, (size_t)DFF, tile * 256, MAX_ROWS, ZROW, ws};
            BColsDense bl{a.in[20] + (size_t)e * DFF * D, D, ct * 256, D};
            EpiBiasBf16 ep{YB, a.in[21] + (size_t)e * D, tile * 256, ct * 256};
            gemm_unit<false>(lds, al, bl, ep, DFF); });
        SEAM(PH_DOWN);
    }

    if (IN(PH_FINAL)) {
        const float* fw = a.in[22];
        for (int row = gwave; row < T; row += gwaves) {
            const float4* xr = (const float4*)(X2 + (size_t)row * D);
            float4 v[8];
#pragma unroll
            for (int i = 0; i < 8; ++i) v[i] = xr[lane + 64 * i];
#pragma unroll
            for (int k = 0; k < 4; ++k) { const float gk = TOPG[row * 4 + k]; const bf16_t* yr = YB + (size_t)POS[row * 4 + k] * D;
#pragma unroll
                for (int i = 0; i < 8; ++i) { const uint2 y = *(const uint2*)(yr + 4 * (lane + 64 * i));
                    v[i].x += gk * bf2f((bf16_t)(y.x & 0xffffu)); v[i].y += gk * bf2f((bf16_t)(y.x >> 16)); v[i].z += gk * bf2f((bf16_t)(y.y & 0xffffu)); v[i].w += gk * bf2f((bf16_t)(y.y >> 16)); } }
            float ss = 0.f;
#pragma unroll
            for (int i = 0; i < 8; ++i) ss += v[i].x * v[i].x + v[i].y * v[i].y + v[i].z * v[i].z + v[i].w * v[i].w;
            ss = wave_sum(ss);
            float rstd = rsqrtf(ss * (1.0f / D) + NORM_EPS);
#ifdef SELFCHECK
            { const float sd = ((const float*)(ctl + CW_CHK))[0], sr = ((const float*)(ctl + CW_CHK))[1]; const float rel = sqrtf(sd / fmaxf(sr, 1e-30f)); rstd *= 1.0f + fminf(1.0f, 10.0f * rel); }
#endif
#pragma unroll
            for (int i = 0; i < 8; ++i) { const float4 wv = ((const float4*)fw)[lane + 64 * i];
                ((float4*)(a.out + (size_t)row * D))[lane + 64 * i] = make_float4(v[i].x * rstd * wv.x, v[i].y * rstd * wv.y, v[i].z * rstd * wv.z, v[i].w * rstd * wv.w); }
        }
    }
#undef IN
#undef SEAM
}

extern "C" void kernel_launch(void* const* d_in, const int* in_sizes, int n_in, void* d_out, int out_size, void* d_ws, size_t ws_size, hipStream_t stream) {
    static int grid = 0;
    if (grid == 0) {
        if (n_in != 23 || out_size != T * D || ws_size < WS_END) { fprintf(stderr, "kernel_launch: unexpected shapes (n_in %d, out %d, ws %zu < %zu)\n", n_in, out_size, ws_size, (size_t)WS_END); grid = -1; return; }
        int dev = 0, cus = 0, per_cu = 0;
        if (hipGetDevice(&dev) != hipSuccess || hipDeviceGetAttribute(&cus, hipDeviceAttributeMultiprocessorCount, dev) != hipSuccess) { grid = -1; return; }
        if (hipFuncSetAttribute((const void*)fwd, hipFuncAttributeMaxDynamicSharedMemorySize, LDS_BYTES) != hipSuccess) { fprintf(stderr, "kernel_launch: hipFuncSetAttribute failed\n"); grid = -1; return; }
        if (hipOccupancyMaxActiveBlocksPerMultiprocessor(&per_cu, (const void*)fwd, 512, LDS_BYTES) != hipSuccess || per_cu < 1) { fprintf(stderr, "kernel_launch: occupancy query says %d\n", per_cu); per_cu = 1; }
        (void)hipGetLastError();
        grid = cus;
    }
    if (grid < 0) return;
    (void)hipMemsetAsync((char*)d_ws + WS_CTL, 0, CTL_BYTES, stream);
    Args a{};
    for (int i = 0; i < 23; ++i) a.in[i] = (const float*)d_in[i];
    a.out = (float*)d_out; a.ws = (unsigned char*)d_ws;
#if N_LAUNCH_MODE == 1
    a.ph_lo = 0; a.ph_hi = N_PHASES;
    hipLaunchKernelGGL(fwd, dim3(grid), dim3(512), LDS_BYTES, stream, a);
#else
    for (int ph = 0; ph < N_PHASES; ++ph) { a.ph_lo = ph; a.ph_hi = ph + 1; hipLaunchKernelGGL(fwd, dim3(grid), dim3(512), LDS_BYTES, stream, a); }
#endif
}
```

```cpp
#include <hip/hip_runtime.h>
#include <stdint.h>
#include <stdio.h>

#ifndef N_LAUNCH_MODE
#define N_LAUNCH_MODE 1
#endif

typedef unsigned short bf16_t;
typedef short s16x4 __attribute__((ext_vector_type(4)));
typedef short s16x8 __attribute__((ext_vector_type(8)));
typedef float f32x4 __attribute__((ext_vector_type(4)));
typedef unsigned u32x4 __attribute__((ext_vector_type(4)));
typedef unsigned u32x2 __attribute__((ext_vector_type(2)));
#define LAS __attribute__((address_space(3)))

constexpr int D = 2048, BATCH = 2, SEQ = 4096, T = BATCH * SEQ;
constexpr int SSM_H = 16, SSM_N = 128;
constexpr int NSA_H = 16, DH = 64;
constexpr int CMP_HID = 512;
constexpr int N_C = 255, N_SEL = 64;
constexpr int IN_PROJ = 5696;
constexpr int OFF_Z = 0, OFF_XBC = 1024, OFF_DT = 3072, OFF_Q = 3088, OFF_KCMP = 4112, OFF_VCMP = 4368, OFF_KSLC = 4624,
              OFF_VSLC = 4880, OFF_KWIN = 5136, OFF_VWIN = 5392, OFF_GATE = 5648;
constexpr int NE = 32, DFF = 2048;
constexpr float NORM_EPS = 1e-5f;
constexpr int CMP_ROWS = BATCH * N_C * 4;
constexpr int MAX_TILES = 160, MAX_ROWS = MAX_TILES * 256;

constexpr size_t AL(size_t x) { return (x + 255) & ~(size_t)255; }
constexpr size_t WS_CTL = 0;
constexpr size_t CTL_BYTES = 32768;
constexpr size_t WS_XN = WS_CTL + CTL_BYTES;
constexpr size_t WS_PROJ = WS_XN + AL((size_t)T * D * 2);
constexpr size_t WS_ZB = WS_PROJ;
constexpr size_t WS_XBCR = WS_ZB + AL((size_t)T * 1024 * 2);
constexpr size_t WS_KCMP = WS_XBCR + AL((size_t)T * 2048 * 2);
constexpr size_t WS_VCMP = WS_KCMP + AL((size_t)T * 256 * 2);
constexpr size_t WS_GATE = WS_VCMP + AL((size_t)T * 256 * 2);
constexpr size_t WS_PEW = WS_GATE + AL((size_t)T * 48 * 4);
constexpr size_t WS_PEWP = WS_PEW + 4096;
static_assert(WS_PEWP + 32 * 1024 * 4 <= WS_PROJ + AL((size_t)T * IN_PROJ * 4), "in-proj outputs fit the old PROJ region");
constexpr size_t WS_XBC = WS_PROJ + AL((size_t)T * IN_PROJ * 4);
constexpr size_t WS_DT = WS_XBC + AL((size_t)T * 2048 * 4);
constexpr size_t WS_YSSD = WS_DT + AL((size_t)T * 16 * 4);
constexpr size_t WS_MIX = WS_YSSD + AL((size_t)T * 1024 * 4);
constexpr size_t WS_ROPE = WS_MIX + AL((size_t)T * 2048 * 2);
constexpr size_t WS_BLK = WS_ROPE + AL((size_t)SEQ * 16 * 4);
constexpr size_t WS_H1 = WS_BLK + AL((size_t)2 * 2048 * 2048 * 2);
constexpr size_t WS_KC = WS_H1 + AL((size_t)2 * 2048 * 512 * 2);
constexpr size_t WS_VC = WS_KC + AL((size_t)2048 * 64 * 4);
constexpr size_t WS_PCMP = WS_VC + AL((size_t)2048 * 64 * 4);
constexpr size_t WS_OCMP = WS_PCMP + AL((size_t)T * 16 * 256 * 4);
constexpr size_t WS_SEL = WS_OCMP + AL((size_t)T * 1024 * 4);
constexpr size_t WS_X2 = WS_SEL + AL((size_t)T * 4 * 8);
constexpr size_t WS_TOPE = WS_X2 + AL((size_t)T * D * 4);
constexpr size_t WS_TOPG = WS_TOPE + AL((size_t)T * 4 * 4);
constexpr size_t WS_SLOT = WS_TOPG + AL((size_t)T * 4 * 4);
constexpr size_t WS_POS = WS_SLOT + AL((size_t)T * 4 * 4);
constexpr size_t WS_ROWTOK = WS_POS + AL((size_t)T * 4 * 4);
constexpr size_t WS_BCNT = WS_ROWTOK + AL((size_t)MAX_ROWS * 4);
constexpr size_t WS_ACT = WS_BCNT + AL((size_t)256 * 32 * 4);
constexpr size_t WS_Y = WS_ACT + AL((size_t)MAX_ROWS * DFF * 2);
constexpr size_t WS_QB = WS_Y + AL((size_t)MAX_ROWS * D * 2);
constexpr size_t WS_KS = WS_QB + AL((size_t)T * 1024 * 2);
constexpr size_t WS_VS = WS_KS + AL((size_t)T * 256 * 2);
constexpr size_t WS_KW = WS_VS + AL((size_t)T * 256 * 2);
constexpr size_t WS_VW = WS_KW + AL((size_t)T * 256 * 2);
constexpr size_t WS_KCB = WS_VW + AL((size_t)T * 256 * 2);
constexpr size_t WS_VCB = WS_KCB + AL((size_t)2 * 256 * 256 * 2);
constexpr size_t WS_XBCB = WS_VCB + AL((size_t)2 * 256 * 256 * 2);
constexpr size_t WS_STATES = WS_XBCB + AL((size_t)T * 2048 * 2);
constexpr size_t WS_PREV = WS_STATES + AL((size_t)2 * 32 * 16 * 64 * 128 * 4);
constexpr size_t WS_CHDEC = WS_PREV + AL((size_t)2 * 32 * 16 * 64 * 128 * 2);
constexpr size_t WS_PART = WS_CHDEC + AL((size_t)2 * 32 * 16 * 4);
constexpr size_t WS_RW = WS_PART + AL((size_t)4 * 2 * 2048 * 512 * 4);
constexpr size_t WS_CHK = WS_RW + AL((size_t)2048 * 32 * 4);
constexpr size_t WS_END = WS_CHK + AL((size_t)T * 2048 * 4);

constexpr int CW_COUNT = 4096;
constexpr int CW_ZROW = 5120;
constexpr int CW_CHK = 4160;

#define XB_TMO      128
#define XB_XCNT(j)  (256  + 64 * (j))
#define XB_XSUB(j)  (1280 + 64 * (j))
#define XB_XGEN(j)  (2304 + 64 * (j))
#define XB_TOP      3328
#define XB_TOPGEN   3392
#define XCD_BAR_WORDS 3456
#define XB_SPIN_CAP (1u << 18)

__device__ __forceinline__ unsigned xb_ld(unsigned* p)              { return __hip_atomic_load(p, __ATOMIC_RELAXED, __HIP_MEMORY_SCOPE_AGENT); }
__device__ __forceinline__ unsigned xb_add(unsigned* p, unsigned v) { return __hip_atomic_fetch_add(p, v, __ATOMIC_RELAXED, __HIP_MEMORY_SCOPE_AGENT); }
__device__ __forceinline__ unsigned xb_xcc_id() { return (unsigned)__builtin_amdgcn_s_getreg((3 << 11) | 20) & 0xFu; }
#define XB_SPIN(cond, bar) do { unsigned _sp = 0; while (cond) { __builtin_amdgcn_s_sleep(1); \
    if ((++_sp & 255u) == 0u) { if (xb_ld(&(bar)[XB_TMO])) break; if (_sp > XB_SPIN_CAP) { atomicAdd(&(bar)[XB_TMO], 1u); break; } } } } while (0)

struct XcdBarrier { unsigned* bar; unsigned x; volatile LAS unsigned* st; };

__device__ __forceinline__ XcdBarrier xcd_barrier_post(unsigned* bar, volatile LAS unsigned* st) {
    XcdBarrier b; b.bar = bar; b.x = xb_xcc_id(); b.st = st;
    if (threadIdx.x == 0) (void)xb_add(&bar[XB_XCNT(b.x)], 1u);
    return b;
}
__device__ __forceinline__ void xcd_barrier_complete(unsigned* bar, unsigned x, unsigned& nloc, unsigned& nx) {
    const unsigned G = gridDim.x * gridDim.y * gridDim.z;
    unsigned sum, cnt, mine, sp = 0u;
    for (;;) {
        sum = 0u; cnt = 0u; mine = 0u;
#pragma unroll
        for (unsigned j = 0; j < 16; ++j) { const unsigned c = xb_ld(&bar[XB_XCNT(j)]); sum += c; cnt += (c > 0u) ? 1u : 0u; mine = (j == x) ? c : mine; }
        if (sum == G) break;
        __builtin_amdgcn_s_sleep(1);
        if ((++sp & 255u) == 0u) { if (xb_ld(&bar[XB_TMO])) break; if (sp > XB_SPIN_CAP) { atomicAdd(&bar[XB_TMO], 1u); break; } }
    }
    nloc = mine > 0u ? mine : 1u; nx = cnt > 0u ? cnt : 1u;
}
__device__ __forceinline__ void xcd_barrier(const XcdBarrier& b) {
    asm volatile("s_waitcnt vmcnt(0)" ::: "memory");
    __syncthreads();
    if (threadIdx.x == 0) {
        unsigned* bar = b.bar;
        __builtin_amdgcn_s_waitcnt(0);
        unsigned nloc = b.st[0], nx = b.st[1];
        if (nloc == 0u) { xcd_barrier_complete(bar, b.x, nloc, nx); b.st[0] = nloc; b.st[1] = nx; }
        const unsigned old = xb_add(&bar[XB_XSUB(b.x)], 1u);
        const unsigned gen = old / nloc;
        if (old + 1u == (gen + 1u) * nloc) {
            __builtin_amdgcn_fence(__ATOMIC_RELEASE, "agent");
            asm volatile("s_waitcnt vmcnt(0)" ::: "memory");
            const unsigned og = xb_add(&bar[XB_TOP], 1u);
            const unsigned tg = og / nx;
            if (og + 1u == (tg + 1u) * nx) xb_add(&bar[XB_TOPGEN], 1u);
            else XB_SPIN(xb_ld(&bar[XB_TOPGEN]) == tg, bar);
            __builtin_amdgcn_fence(__ATOMIC_ACQUIRE, "agent");
            xb_add(&bar[XB_XGEN(b.x)], 1u);
            asm volatile("s_waitcnt vmcnt(0)" ::: "memory");
        } else {
            XB_SPIN(xb_ld(&bar[XB_XGEN(b.x)]) == gen, bar);
            __builtin_amdgcn_fence(__ATOMIC_ACQUIRE, "agent");
            asm volatile("s_waitcnt vmcnt(0)" ::: "memory");
        }
    }
    __syncthreads();
}

__device__ __forceinline__ bf16_t f2bf(float f) { unsigned u = __float_as_uint(f); u += 0x7FFFu + ((u >> 16) & 1u); return (bf16_t)(u >> 16); }
__device__ __forceinline__ float bf2f(bf16_t b) { return __uint_as_float(((unsigned)b) << 16); }
typedef __bf16 bf16x2_t __attribute__((ext_vector_type(2)));
typedef float f32x2_t __attribute__((ext_vector_type(2)));
__device__ __forceinline__ unsigned pack2(float lo, float hi) { const f32x2_t v = {lo, hi}; return __builtin_bit_cast(unsigned, __builtin_convertvector(v, bf16x2_t)); }
__device__ __forceinline__ float wave_sum(float v) {
#pragma unroll
    for (int o = 32; o > 0; o >>= 1) v += __shfl_xor(v, o);
    return v;
}
__device__ __forceinline__ float xmax16(float x) { const unsigned u = __builtin_bit_cast(unsigned, x); const auto r = __builtin_amdgcn_permlane16_swap(u, u, false, false); return fmaxf(__builtin_bit_cast(float, r[0]), __builtin_bit_cast(float, r[1])); }
__device__ __forceinline__ float xmax32(float x) { const unsigned u = __builtin_bit_cast(unsigned, x); const auto r = __builtin_amdgcn_permlane32_swap(u, u, false, false); return fmaxf(__builtin_bit_cast(float, r[0]), __builtin_bit_cast(float, r[1])); }
__device__ __forceinline__ float xsum16(float x) { const unsigned u = __builtin_bit_cast(unsigned, x); const auto r = __builtin_amdgcn_permlane16_swap(u, u, false, false); return __builtin_bit_cast(float, r[0]) + __builtin_bit_cast(float, r[1]); }
__device__ __forceinline__ float xsum32(float x) { const unsigned u = __builtin_bit_cast(unsigned, x); const auto r = __builtin_amdgcn_permlane32_swap(u, u, false, false); return __builtin_bit_cast(float, r[0]) + __builtin_bit_cast(float, r[1]); }
__device__ __forceinline__ float sigmoidf_(float x) { return 1.0f / (1.0f + __expf(-x)); }

constexpr int B_RS = 544, A_ST = 256 * 128, B_ST = 64 * B_RS, STAGE = A_ST + B_ST;
constexpr int GEMM_LDS = 2 * STAGE;
constexpr int SSD_LDS = 147456;
constexpr int MAIN_LDS = SSD_LDS > GEMM_LDS ? SSD_LDS : GEMM_LDS;
constexpr int LDS_BYTES = MAIN_LDS + 64;

template <bool PAIRED, class Prov>
__device__ __forceinline__ void gemm_stream(LAS char* lds, Prov& P, const int K) {
    typedef typename Prov::AL ALd; typedef typename Prov::BL BLd; typedef typename Prov::EP EPt;
    ALd al; BLd bl; EPt ep;
    if (!P.next(al, bl)) return;
    P.make_ep(ep);
    const int tid = threadIdx.x, lane = tid & 63, wid = __builtin_amdgcn_readfirstlane(tid >> 6);
    const int wr = wid >> 1, wc = wid & 1, fr = lane & 15, fq = lane >> 4;
    const char* abase = (const char*)al.wsbase;
    unsigned aoff[4];
    const int bk0 = tid >> 6;
    unsigned ldb4, boff;
    __amdgpu_buffer_rsrc_t rsb;
    const __amdgpu_buffer_rsrc_t rsa = __builtin_amdgcn_make_buffer_rsrc((void*)abase, 0, 0x7fffffff, 0x00020000);
#define SET_SRC(al_, bl_) do { \
        _Pragma("unroll") for (int j = 0; j < 4; ++j) aoff[j] = (unsigned)((const char*)((al_).row(32 * wid + 8 * j + (lane >> 3)) + ((lane & 7) ^ (lane >> 3)) * 8) - abase); \
        rsb = __builtin_amdgcn_make_buffer_rsrc((void*)(bl_).base, 0, 0x7fffffff, 0x00020000); \
        ldb4 = (unsigned)(bl_).ldb * 4u; boff = (unsigned)(bl_).coloff(4 * (tid & 63)) * 4u + (unsigned)(tid >> 6) * ldb4; } while (0)
    SET_SRC(al, bl);
    unsigned atile = 0u, btile = 0u;
    u32x4 ra[4]; float4 rb[8];
#define LD_CHUNK(c) do { if ((c) < 8) { const u32x4 t_ = __builtin_amdgcn_raw_buffer_load_b128(rsb, (int)boff, (int)(btile + (unsigned)(8 * ((c) & 7)) * ldb4), 0); rb[(c) & 7] = __builtin_bit_cast(float4, t_); } \
        else ra[(c) & 3] = __builtin_amdgcn_raw_buffer_load_b128(rsa, (int)aoff[(c) & 3], (int)atile, 0); } while (0)
#define WR_CHUNK(c, buf) do { if ((c) < 8) *(LAS u32x2*)(lds + (buf) * STAGE + A_ST + bw_off + ((((c) & 7) & 1) * 4 + (((c) & 7) >> 1) * 16) * B_RS) = (u32x2){pack2(rb[(c) & 7].x, rb[(c) & 7].y), pack2(rb[(c) & 7].z, rb[(c) & 7].w)}; \
        else *(LAS u32x4*)(lds + (buf) * STAGE + (4 * wid + ((c) & 3)) * 1024 + lane * 16) = ra[(c) & 3]; } while (0)
#define ADVANCE() do { atile += ALd::kstep; btile += 64u * ldb4; } while (0)
    f32x4 acc[4][8];
    const int nk = K / 64;
    const int a_off0 = (wr * 64 + fr) * 128 + ((fq ^ (fr & 7)) * 16);
    const int br_off = A_ST + (((fq & 1) * 4 + (fq >> 1) * 16 + ((lane & 15) >> 2)) * B_RS) + (wc * 128 + 4 * (lane & 3)) * 2;
    const int bw_off = ((bk0 & 3) + ((bk0 >> 2) << 3)) * B_RS + (tid & 63) * 8;
#pragma unroll
    for (int c = 0; c < 12; ++c) LD_CHUNK(c);
    ADVANCE();
#pragma unroll
    for (int c = 0; c < 12; ++c) { WR_CHUNK(c, 0); LD_CHUNK(c); }
    int ldt = 1;
    if (2 < nk) { ADVANCE(); ldt = 2; }
    __syncthreads();
    for (;;) {
#pragma unroll
        for (int m = 0; m < 4; ++m)
#pragma unroll
            for (int n = 0; n < 8; ++n) acc[m][n] = (f32x4){0.f, 0.f, 0.f, 0.f};
        bool has_next = false;
        for (int kt = 0; kt < nk; ++kt) {
            if constexpr (!Prov::SINGLE) { if (kt == nk - 2) { ALd aln; BLd bln; has_next = P.next(aln, bln);
                if (has_next) { SET_SRC(aln, bln); atile = 0u; btile = 0u; ldt = 0; } } }
            const int buf = kt & 1;
            LAS char* sbase = lds + buf * STAGE;
            s16x8 af[4]; s16x4 tq[4][2];
#define RD_B(slot, st_) do { tq[slot][0] = __builtin_amdgcn_ds_read_tr16_b64_v4i16((LAS s16x4*)(sbase + br_off + ((st_) >> 3) * 32 * B_RS + ((st_) & 7) * 32)); \
                             tq[slot][1] = __builtin_amdgcn_ds_read_tr16_b64_v4i16((LAS s16x4*)(sbase + br_off + ((st_) >> 3) * 32 * B_RS + ((st_) & 7) * 32 + 8 * B_RS)); } while (0)
#pragma unroll
            for (int m = 0; m < 4; ++m) af[m] = *(const LAS s16x8*)(sbase + a_off0 + m * 16 * 128);
            RD_B(0, 0); RD_B(1, 1); RD_B(2, 2);
            __builtin_amdgcn_sched_barrier(0);
#pragma unroll
            for (int st = 0; st < 16; ++st) {
                const int n = st & 7;
                if (st + 3 < 16) RD_B((st + 3) & 3, st + 3);
                const s16x8 bfr = {tq[st & 3][0][0], tq[st & 3][0][1], tq[st & 3][0][2], tq[st & 3][0][3], tq[st & 3][1][0], tq[st & 3][1][1], tq[st & 3][1][2], tq[st & 3][1][3]};
#pragma unroll
                for (int m = 0; m < 4; ++m) acc[m][n] = __builtin_amdgcn_mfma_f32_16x16x32_bf16(bfr, af[m], acc[m][n], 0, 0, 0);
                if (st == 7) {
#pragma unroll
                    for (int m = 0; m < 4; ++m) af[m] = *(const LAS s16x8*)(sbase + (a_off0 ^ 64) + m * 16 * 128);
                }
                if (st < 12) { WR_CHUNK(st, buf ^ 1); LD_CHUNK(st); }
                if (st & 1) __builtin_amdgcn_sched_barrier(0);
            }
#undef RD_B
            if (ldt + 1 < nk) { ADVANCE(); ++ldt; }
            __syncthreads();
        }
#pragma unroll
        for (int m = 0; m < 4; ++m) {
            const int r = wr * 64 + m * 16 + fr;
            if constexpr (PAIRED) {
#pragma unroll
                for (int n = 0; n < 4; ++n) ep.pair(r, wc * 64 + n * 16 + 4 * fq, acc[m][n], acc[m][n + 4]);
            } else {
#pragma unroll
                for (int n = 0; n < 8; ++n) ep(r, wc * 128 + n * 16 + 4 * fq, acc[m][n]);
            }
        }
        if (!has_next) break;
        P.make_ep(ep);
    }
#undef LD_CHUNK
#undef WR_CHUNK
#undef ADVANCE
#undef SET_SRC
}

template <class Maker> struct PatchProv {
    static constexpr bool SINGLE = false;
    typedef typename Maker::AL AL; typedef typename Maker::BL BL; typedef typename Maker::EP EP;
    Maker mk; int nR, nC, npc, npatch, nlab, nsl, pidx, slot, slot0;
    __device__ __forceinline__ void init(int nR_, int nC_, int G, int bid) { nR = nR_; nC = nC_; nlab = (G % 8 == 0) ? 8 : 1; nsl = G / nlab; npc = (nC + 7) >> 3; npatch = ((nR + 3) >> 2) * npc;
        pidx = bid % nlab; slot0 = bid / nlab; slot = slot0; }
    int cRT, cCT;
    __device__ __forceinline__ bool next(AL& al, BL& bl) {
        while (pidx < npatch) {
            while (slot < 32) { const int RT = (pidx / npc) * 4 + (slot >> 3), CT = (pidx % npc) * 8 + (slot & 7); slot += nsl;
                if (RT < nR && CT < nC) { cRT = RT; cCT = CT; mk.make_src(RT, CT, al, bl); return true; } }
            pidx += nlab; slot = slot0; }
        return false; }
    __device__ __forceinline__ void make_ep(EP& ep) const { mk.make_ep(cRT, cCT, ep); } };

constexpr int KV_RS = 144, KT_BYTES = 64 * KV_RS;
constexpr int ATT_IMP_OFF = 4 * KT_BYTES;
constexpr int ATT_MASK_OFF = ATT_IMP_OFF + 64 * 64 * 4;
typedef float f32x16 __attribute__((ext_vector_type(16)));
struct GState32 { f32x16 o[2]; float m, l; };
__device__ __forceinline__ float xchg32(float x) { const unsigned u = __builtin_bit_cast(unsigned, x); const auto r = __builtin_amdgcn_permlane32_swap(u, u, false, false);
    return __builtin_bit_cast(float, (threadIdx.x & 32) ? r[0] : r[1]); }

template <int MODE>
__device__ __forceinline__ void attn_block32(const LAS char* kt, const LAS char* vt, const int lane, const s16x8 (&qf)[4], GState32& st,
                                             const bool act, const int key0, const int lo, const int hi, LAS float* imp, const int tl, float& carry, const int jb) {
    const int c32 = lane & 31, h = lane >> 5;
    f32x16 s[2];
#pragma unroll
    for (int k2 = 0; k2 < 2; ++k2) {
        s16x8 kf[4];
#pragma unroll
        for (int ds = 0; ds < 4; ++ds) kf[ds] = *(const LAS s16x8*)(kt + (32 * k2 + c32) * KV_RS + (16 * ds + 8 * h) * 2);
        s[k2] = __builtin_amdgcn_mfma_f32_32x32x16_bf16(kf[0], qf[0], (f32x16){0.f,0.f,0.f,0.f,0.f,0.f,0.f,0.f,0.f,0.f,0.f,0.f,0.f,0.f,0.f,0.f}, 0, 0, 0);
#pragma unroll
        for (int ds = 1; ds < 4; ++ds) s[k2] = __builtin_amdgcn_mfma_f32_32x32x16_bf16(kf[ds], qf[ds], s[k2], 0, 0, 0);
    }
    const bool needmask = !__all((lo <= key0) & (hi >= key0 + 63));
    if (needmask) {
#pragma unroll
        for (int k2 = 0; k2 < 2; ++k2)
#pragma unroll
            for (int i = 0; i < 16; ++i) { const int key = key0 + 32 * k2 + 8 * (i >> 2) + 4 * h + (i & 3); s[k2][i] = (key >= lo && key <= hi) ? s[k2][i] : -INFINITY; }
    }
    float mx = -INFINITY;
#pragma unroll
    for (int k2 = 0; k2 < 2; ++k2)
#pragma unroll
        for (int i = 0; i < 16; ++i) mx = fmaxf(mx, s[k2][i]);
    mx = act ? mx : -INFINITY;
    float msafe, scale = 1.0f;
    if (MODE == 2) { msafe = (st.m == -INFINITY) ? 0.f : st.m; scale = st.l; }
    else {
        mx = fmaxf(mx, xchg32(mx));
        const float mnew = fmaxf(st.m, mx);
        const float alpha = (mnew == -INFINITY) ? 1.0f : __builtin_amdgcn_exp2f(st.m - mnew);
        msafe = (mnew == -INFINITY) ? 0.f : mnew;
        st.m = mnew; st.l *= alpha;
        if (MODE == 0) { st.o[0] *= alpha; st.o[1] *= alpha; }
    }
    msafe = act ? msafe : INFINITY;
    float rs = 0.f;
#pragma unroll
    for (int k2 = 0; k2 < 2; ++k2)
#pragma unroll
        for (int i = 0; i < 16; ++i) { const float pv = (MODE == 2) ? __builtin_amdgcn_exp2f(s[k2][i] - msafe) * scale : __builtin_amdgcn_exp2f(s[k2][i] - msafe); s[k2][i] = pv; rs += pv; }
    if (MODE != 2) { rs += xchg32(rs); st.l += rs; }
    if (MODE == 2) {
#pragma unroll
        for (int k2 = 0; k2 < 2; ++k2)
#pragma unroll
            for (int ig = 0; ig < 4; ++ig) {
                const float prevreg = ig > 0 ? s[k2][4 * (ig > 0 ? ig - 1 : 0) + 3] : (k2 > 0 ? s[0][15] : carry);
                const float recv = xchg32(h ? prevreg : s[k2][4 * ig + 3]);
                float part = 32.f * (s[k2][4 * ig] + s[k2][4 * ig + 1] + s[k2][4 * ig + 2]) + 16.f * s[k2][4 * ig + 3] + 16.f * recv;
                part += __shfl_xor(part, 1); part += __shfl_xor(part, 2);
                if ((c32 & 3) == 0) imp[tl * 64 + 16 * jb + 8 * k2 + 2 * ig + h] = part;
            }
        carry = s[1][15];
    }
    if (MODE != 1) {
        const int blk = (lane >> 4) & 1, q = (lane & 15) >> 2, p = lane & 3;
#pragma unroll
        for (int k2 = 0; k2 < 2; ++k2)
#pragma unroll
            for (int sk = 0; sk < 2; ++sk) {
                const u32x4 w = {pack2(s[k2][8 * sk + 0], s[k2][8 * sk + 1]), pack2(s[k2][8 * sk + 2], s[k2][8 * sk + 3]), pack2(s[k2][8 * sk + 4], s[k2][8 * sk + 5]), pack2(s[k2][8 * sk + 6], s[k2][8 * sk + 7])};
                const s16x8 pf = __builtin_bit_cast(s16x8, w);
                const int base = 32 * k2 + 16 * sk;
#pragma unroll
                for (int dt = 0; dt < 2; ++dt) {
                    const s16x4 t0 = __builtin_amdgcn_ds_read_tr16_b64_v4i16((LAS s16x4*)(vt + (base + 4 * h + q) * KV_RS + (32 * dt + 16 * blk + 4 * p) * 2));
                    const s16x4 t1 = __builtin_amdgcn_ds_read_tr16_b64_v4i16((LAS s16x4*)(vt + (base + 8 + 4 * h + q) * KV_RS + (32 * dt + 16 * blk + 4 * p) * 2));
                    const s16x8 vf = {t0[0], t0[1], t0[2], t0[3], t1[0], t1[1], t1[2], t1[3]};
                    st.o[dt] = __builtin_amdgcn_mfma_f32_32x32x16_bf16(vf, pf, st.o[dt], 0, 0, 0);
                }
            }
    }
}

#define ATT_GLOAD(Kg, Vg, row0) do { const size_t _o = ((size_t)(row0) + (tid >> 3)) * 256 + g * 64 + (tid & 7) * 8; rk = *(const u32x4*)((Kg) + _o); rv = *(const u32x4*)((Vg) + _o); __builtin_amdgcn_sched_barrier(0); } while (0)
#define ATT_SWRITE(buf) do { LAS char* _k = lds + (buf) * 2 * KT_BYTES + (tid >> 3) * KV_RS + (tid & 7) * 16; *(LAS u32x4*)_k = rk; *(LAS u32x4*)(_k + KT_BYTES) = rv; } while (0)

__device__ __forceinline__ void nsa_unit32(LAS char* lds, const int unit, const bf16_t* QB, const bf16_t* KS, const bf16_t* VS, const bf16_t* KW, const bf16_t* VW,
                                           const bf16_t* KCB, const bf16_t* VCB, const float* GATEp, bf16_t* MIX) {
    const int tid = threadIdx.x, lane = tid & 63, wid = tid >> 6, c32 = lane & 31, h = lane >> 5;
    const int qt = unit >> 3, b = (unit >> 2) & 1, g = unit & 3;
    const int t0 = qt * 64;
    LAS float* imp = (LAS float*)(lds + ATT_IMP_OFF);
    LAS unsigned* lmask = (LAS unsigned*)(lds + ATT_MASK_OFF);
    const int tl = 8 * wid + (c32 >> 2), tpos = t0 + tl, hq = g * 4 + (c32 & 3);
    const size_t tt = (size_t)b * SEQ + tpos;
    s16x8 qf[4]; float gate[3];
#pragma unroll
    for (int ds = 0; ds < 4; ++ds) qf[ds] = *(const s16x8*)(QB + tt * 1024 + hq * 64 + 16 * ds + 8 * h);
    { const float* gl = GATEp + tt * 48 + hq * 3; gate[0] = gl[0]; gate[1] = gl[1]; gate[2] = gl[2]; }
    for (int i = tid; i < 64 * 64; i += 512) imp[i] = 0.f;
    f32x16 res[2];
    GState32 st; bool act; int lo, hi; float carry = 0.f;
    u32x4 rk, rv;
    const bf16_t* KCg = KCB + (size_t)b * 256 * 256; const bf16_t* VCg = VCB + (size_t)b * 256 * 256;
    const bf16_t* KSg = KS + (size_t)b * SEQ * 256; const bf16_t* VSg = VS + (size_t)b * SEQ * 256;
    const bf16_t* KWg = KW + (size_t)b * SEQ * 256; const bf16_t* VWg = VW + (size_t)b * SEQ * 256;
#define ST_RESET() do { st.m = -INFINITY; st.l = 0.f; _Pragma("unroll") for (int i_ = 0; i_ < 16; ++i_) { st.o[0][i_] = 0.f; st.o[1][i_] = 0.f; } } while (0)
    const int cmax_u = (t0 + 63 - 31) >> 4;
    const int ncb = cmax_u < 0 ? 0 : min(4, (cmax_u + 1) / 64 + 1);
    act = true; lo = 0; hi = tpos >= 31 ? ((tpos - 31) >> 4) : -1; ST_RESET();
    __syncthreads();
    if (ncb > 0) {
        ATT_GLOAD(KCg, VCg, 0); ATT_SWRITE(0); __syncthreads();
        for (int jb = 0; jb < ncb; ++jb) {
            if (jb + 1 < ncb) ATT_GLOAD(KCg, VCg, 64 * (jb + 1));
            attn_block32<1>(lds + (jb & 1) * 2 * KT_BYTES, lds + (jb & 1) * 2 * KT_BYTES + KT_BYTES, lane, qf, st, act, 64 * jb, lo, hi, imp, tl, carry, jb);
            if (jb + 1 < ncb) ATT_SWRITE((jb + 1) & 1);
            __syncthreads();
        }
        st.l = st.l > 0.f ? 1.0f / st.l : 0.f;
        ATT_GLOAD(KCg, VCg, 0); ATT_SWRITE(0); __syncthreads();
        for (int jb = 0; jb < ncb; ++jb) {
            if (jb + 1 < ncb) ATT_GLOAD(KCg, VCg, 64 * (jb + 1));
            attn_block32<2>(lds + (jb & 1) * 2 * KT_BYTES, lds + (jb & 1) * 2 * KT_BYTES + KT_BYTES, lane, qf, st, act, 64 * jb, lo, hi, imp, tl, carry, jb);
            if (jb + 1 < ncb) ATT_SWRITE((jb + 1) & 1);
            __syncthreads();
        }
    }
    res[0] = st.o[0] * gate[0]; res[1] = st.o[1] * gate[0];
    __syncthreads();
    for (int k = 0; k < 8; ++k) {
        const int tk = 8 * wid + k, j = lane;
        const float iv = imp[tk * 64 + j];
        const bool forced = (j == 0) || (j == qt) || (j == qt - 1), valid = j <= qt;
        const float sc = forced ? 1.0e4f : (valid ? iv : -1.0e4f);
        int rank = 0;
#pragma unroll
        for (int kk = 0; kk < 64; ++kk) { const float o = __shfl(sc, kk); rank += (o > sc || (o == sc && kk < j)) ? 1 : 0; }
        const unsigned long long m64 = __ballot(rank < 16 && valid);
        if (lane == 0) { lmask[tk * 2] = (unsigned)m64; lmask[tk * 2 + 1] = (unsigned)(m64 >> 32); }
    }
    __syncthreads();
    const unsigned long long msk = (unsigned long long)lmask[tl * 2] | ((unsigned long long)lmask[tl * 2 + 1] << 32);
    unsigned long long wunion;
    { unsigned ul = (unsigned)msk, uh = (unsigned)(msk >> 32);
#pragma unroll
      for (int o = 1; o < 64; o <<= 1) { ul |= __shfl_xor(ul, o); uh |= __shfl_xor(uh, o); }
      wunion = (unsigned long long)ul | ((unsigned long long)uh << 32); }
    lo = 0; hi = tpos; ST_RESET();
    ATT_GLOAD(KSg, VSg, 0); ATT_SWRITE(0); __syncthreads();
    for (int j = 0; j <= qt; ++j) {
        if (j + 1 <= qt) ATT_GLOAD(KSg, VSg, 64 * (j + 1));
        if ((wunion >> j) & 1ull) {
            act = (msk >> j) & 1ull;
            attn_block32<0>(lds + (j & 1) * 2 * KT_BYTES, lds + (j & 1) * 2 * KT_BYTES + KT_BYTES, lane, qf, st, act, 64 * j, lo, hi, imp, tl, carry, 0);
        }
        if (j + 1 <= qt) ATT_SWRITE((j + 1) & 1);
        __syncthreads();
    }
    { const float il = gate[1] / fmaxf(st.l, 1e-30f); res[0] += st.o[0] * il; res[1] += st.o[1] * il; }
    act = true; lo = tpos - 511; hi = tpos; ST_RESET();
    const int jw0 = qt >= 8 ? qt - 8 : 0;
    ATT_GLOAD(KWg, VWg, 64 * jw0); ATT_SWRITE(jw0 & 1); __syncthreads();
    for (int j = jw0; j <= qt; ++j) {
        if (j + 1 <= qt) ATT_GLOAD(KWg, VWg, 64 * (j + 1));
        attn_block32<0>(lds + (j & 1) * 2 * KT_BYTES, lds + (j & 1) * 2 * KT_BYTES + KT_BYTES, lane, qf, st, act, 64 * j, lo, hi, imp, tl, carry, 0);
        if (j + 1 <= qt) ATT_SWRITE((j + 1) & 1);
        __syncthreads();
    }
    { const float il = gate[2] / fmaxf(st.l, 1e-30f);
      bf16_t* mp = MIX + tt * 2048 + 1024 + hq * 64 + 4 * h;
#pragma unroll
      for (int dt = 0; dt < 2; ++dt)
#pragma unroll
          for (int ig = 0; ig < 4; ++ig) { const int i0 = 4 * ig;
              const float r0 = res[dt][i0] + st.o[dt][i0] * il, r1 = res[dt][i0 + 1] + st.o[dt][i0 + 1] * il, r2 = res[dt][i0 + 2] + st.o[dt][i0 + 2] * il, r3 = res[dt][i0 + 3] + st.o[dt][i0 + 3] * il;
              *(uint2*)(mp + 32 * dt + 8 * ig) = make_uint2(pack2(r0, r1), pack2(r2, r3)); } }
#undef ST_RESET
}
#undef ATT_GLOAD
#undef ATT_SWRITE


constexpr int SX_RS = 144, SX_H = 128 * SX_RS, SB_RS = 272, SB_BYTES = 128 * SB_RS;
constexpr int SSD_X_OFF = 0, SSD_B_OFF = 4 * SX_H, SSD_C_OFF = SSD_B_OFF + SB_BYTES, SSD_T_OFF = SSD_C_OFF + SB_BYTES;
static_assert(SSD_T_OFF + 4096 <= SSD_LDS, "ssd lds");

template <bool WITH_C>
__device__ __forceinline__ void ssd_stage(LAS char* lds, const bf16_t* XBCB, const float* DT, const float* a_log, const int b, const int c, const int grp) {
    const int tid = threadIdx.x;
    const size_t tt0 = (size_t)b * SEQ + c * 128;
    u32x4 rx[8], rbm[4], rcm[4];
#pragma unroll
    for (int k = 0; k < 8; ++k) { const int id = tid + 512 * k, l = id >> 5, ch = id & 31; rx[k] = *(const u32x4*)(XBCB + (tt0 + l) * 2048 + grp * 256 + ch * 8); }
#pragma unroll
    for (int k = 0; k < 4; ++k) { const int id = tid + 512 * k, l = id >> 4, ch = id & 15;
        rbm[k] = *(const u32x4*)(XBCB + (tt0 + l) * 2048 + 1024 + grp * 128 + ch * 8);
        if (WITH_C) rcm[k] = *(const u32x4*)(XBCB + (tt0 + l) * 2048 + 1536 + grp * 128 + ch * 8); }
    __builtin_amdgcn_sched_barrier(0);
#pragma unroll
    for (int k = 0; k < 8; ++k) { const int id = tid + 512 * k, l = id >> 5, ch = id & 31, h = ch >> 3, pc = ch & 7; *(LAS u32x4*)(lds + SSD_X_OFF + h * SX_H + l * SX_RS + pc * 16) = rx[k]; }
#pragma unroll
    for (int k = 0; k < 4; ++k) { const int id = tid + 512 * k, l = id >> 4, ch = id & 15;
        *(LAS u32x4*)(lds + SSD_B_OFF + l * SB_RS + ch * 16) = rbm[k];
        if (WITH_C) *(LAS u32x4*)(lds + SSD_C_OFF + l * SB_RS + ch * 16) = rcm[k]; }
    LAS float* dtl = (LAS float*)(lds + SSD_T_OFF); LAS float* acs = dtl + 512;
    const int h = tid >> 7, l = tid & 127;
    const float av = -expf(a_log[grp * 4 + h]);
    const float dtv = DT[(tt0 + l) * 16 + grp * 4 + h];
    dtl[tid] = dtv; acs[tid] = dtv * av;
    __syncthreads();
    float cs = acs[tid];
#pragma unroll
    for (int o = 1; o < 128; o <<= 1) { const float add = (l >= o) ? acs[tid - o] : 0.f; __syncthreads(); cs += add; acs[tid] = cs; __syncthreads(); }
}

__device__ __forceinline__ void ssd_states_item(LAS char* lds, const int item, const bf16_t* XBCB, const float* DT, const float* a_log, float* STATES, float* CHDEC) {
    const int tid = threadIdx.x, lane = tid & 63, wid = tid >> 6, c16 = lane & 15, fq = lane >> 4, q = c16 >> 2, pp = c16 & 3;
    const int grp = item & 3, c = (item >> 2) & 31, b = item >> 7;
    __syncthreads();
    ssd_stage<false>(lds, XBCB, DT, a_log, b, c, grp);
    LAS float* dtl = (LAS float*)(lds + SSD_T_OFF); LAS float* acs = dtl + 512;
#pragma unroll
    for (int k = 0; k < 8; ++k) { const int id = tid + 512 * k, l = id >> 5, ch = id & 31, h = ch >> 3, pc = ch & 7;
        const float w = __expf(acs[h * 128 + 127] - acs[h * 128 + l]) * dtl[h * 128 + l];
        LAS u32x4* pv = (LAS u32x4*)(lds + SSD_X_OFF + h * SX_H + l * SX_RS + pc * 16);
        u32x4 v = *pv;
#pragma unroll
        for (int e = 0; e < 4; ++e) { const float lo = __uint_as_float(v[e] << 16) * w, hi = __uint_as_float(v[e] & 0xffff0000u) * w; v[e] = pack2(lo, hi); }
        *pv = v; }
    if (tid < 4) CHDEC[((size_t)b * 32 + c) * 16 + grp * 4 + tid] = __expf(acs[tid * 128 + 127]);
    __syncthreads();
    s16x8 af[4];
#pragma unroll
    for (int ks = 0; ks < 4; ++ks) {
        const s16x4 t0 = __builtin_amdgcn_ds_read_tr16_b64_v4i16((LAS s16x4*)(lds + SSD_B_OFF + (32 * ks + 8 * fq + q) * SB_RS + (16 * wid + 4 * pp) * 2));
        const s16x4 t1 = __builtin_amdgcn_ds_read_tr16_b64_v4i16((LAS s16x4*)(lds + SSD_B_OFF + (32 * ks + 8 * fq + 4 + q) * SB_RS + (16 * wid + 4 * pp) * 2));
        af[ks] = (s16x8){t0[0], t0[1], t0[2], t0[3], t1[0], t1[1], t1[2], t1[3]};
    }
#pragma unroll
    for (int h = 0; h < 4; ++h) {
        float* sp = STATES + (((size_t)b * 32 + c) * 16 + grp * 4 + h) * 8192;
#pragma unroll
        for (int pt = 0; pt < 4; ++pt) {
            f32x4 acc = {0.f, 0.f, 0.f, 0.f};
#pragma unroll
            for (int ks = 0; ks < 4; ++ks) {
                const s16x4 t0 = __builtin_amdgcn_ds_read_tr16_b64_v4i16((LAS s16x4*)(lds + SSD_X_OFF + h * SX_H + (32 * ks + 8 * fq + q) * SX_RS + (16 * pt + 4 * pp) * 2));
                const s16x4 t1 = __builtin_amdgcn_ds_read_tr16_b64_v4i16((LAS s16x4*)(lds + SSD_X_OFF + h * SX_H + (32 * ks + 8 * fq + 4 + q) * SX_RS + (16 * pt + 4 * pp) * 2));
                const s16x8 bfr = {t0[0], t0[1], t0[2], t0[3], t1[0], t1[1], t1[2], t1[3]};
                acc = __builtin_amdgcn_mfma_f32_16x16x32_bf16(af[ks], bfr, acc, 0, 0, 0);
            }
            *(f32x4*)(sp + (size_t)(16 * pt + c16) * 128 + 16 * wid + 4 * fq) = acc;
        }
    }
}

__device__ __forceinline__ void ssd_out_item(LAS char* lds, const int item, const bf16_t* XBCB, const float* DT, const float* a_log, const float* d_skip, const float* nw,
                                             const bf16_t* PREV, const bf16_t* ZBp, float* YTMP, bf16_t* MIXO) {
    const int tid = threadIdx.x, lane = tid & 63, wid = tid >> 6, c16 = lane & 15, fq = lane >> 4, q = c16 >> 2, pp = c16 & 3;
    const int grp = item & 3, c = (item >> 2) & 31, b = item >> 7;
    __syncthreads();
    ssd_stage<true>(lds, XBCB, DT, a_log, b, c, grp);
    LAS float* dtl = (LAS float*)(lds + SSD_T_OFF); LAS float* acs = dtl + 512;
    const int lcol = 16 * wid + c16;
    const size_t tt = (size_t)b * SEQ + c * 128 + lcol;
    s16x8 cf[4];
#pragma unroll
    for (int ks = 0; ks < 4; ++ks) cf[ks] = *(const LAS s16x8*)(lds + SSD_C_OFF + lcol * SB_RS + (32 * ks + 8 * fq) * 2);
    f32x4 g[8];
#pragma unroll
    for (int mt = 0; mt < 8; ++mt) { g[mt] = (f32x4){0.f, 0.f, 0.f, 0.f};
        if (mt <= wid) {
#pragma unroll
            for (int ks = 0; ks < 4; ++ks) { const s16x8 bfr = *(const LAS s16x8*)(lds + SSD_B_OFF + (16 * mt + c16) * SB_RS + (32 * ks + 8 * fq) * 2);
                g[mt] = __builtin_amdgcn_mfma_f32_16x16x32_bf16(bfr, cf[ks], g[mt], 0, 0, 0); } } }
    float ss = 0.f;
#pragma unroll 1
    for (int h = 0; h < 4; ++h) {
        const int hh = grp * 4 + h;
        const float acs_l = acs[h * 128 + lcol];
        s16x8 pf[4];
#pragma unroll
        for (int ks = 0; ks < 4; ++ks) {
            float pv[2][4];
#pragma unroll
            for (int u = 0; u < 2; ++u) {
                const int s0 = 32 * ks + 16 * u + 4 * fq;
                const f32x4 av4 = *(const LAS f32x4*)(acs + h * 128 + s0), dv4 = *(const LAS f32x4*)(dtl + h * 128 + s0);
#pragma unroll
                for (int i = 0; i < 4; ++i) { const float e = __expf(fminf(acs_l - av4[i], 0.f)) * dv4[i]; pv[u][i] = (s0 + i <= lcol) ? g[2 * ks + u][i] * e : 0.f; }
            }
            const u32x4 w = {pack2(pv[0][0], pv[0][1]), pack2(pv[0][2], pv[0][3]), pack2(pv[1][0], pv[1][1]), pack2(pv[1][2], pv[1][3])};
            pf[ks] = __builtin_bit_cast(s16x8, w);
        }
        const float dsk = d_skip[hh], eal = __expf(acs_l);
        const bf16_t* prevp = PREV + (((size_t)b * 32 + c) * 16 + hh) * 8192;
        s16x8 pr[4][4]; f32x4 zz[4];
#pragma unroll
        for (int pt = 0; pt < 4; ++pt) {
#pragma unroll
            for (int ks = 0; ks < 4; ++ks) pr[pt][ks] = *(const s16x8*)(prevp + (size_t)(16 * pt + c16) * 128 + 32 * ks + 8 * fq);
            { const uint2 zr = *(const uint2*)(ZBp + tt * 1024 + hh * 64 + 16 * pt + 4 * fq); zz[pt] = (f32x4){__uint_as_float(zr.x << 16), __uint_as_float(zr.x & 0xffff0000u), __uint_as_float(zr.y << 16), __uint_as_float(zr.y & 0xffff0000u)}; }
        }
#pragma unroll
        for (int pt = 0; pt < 4; ++pt) {
            f32x4 yd = {0.f, 0.f, 0.f, 0.f}, yo = {0.f, 0.f, 0.f, 0.f};
#pragma unroll
            for (int ks = 0; ks < 4; ++ks) {
                const s16x4 t0 = __builtin_amdgcn_ds_read_tr16_b64_v4i16((LAS s16x4*)(lds + SSD_X_OFF + h * SX_H + (32 * ks + 4 * fq + q) * SX_RS + (16 * pt + 4 * pp) * 2));
                const s16x4 t1 = __builtin_amdgcn_ds_read_tr16_b64_v4i16((LAS s16x4*)(lds + SSD_X_OFF + h * SX_H + (32 * ks + 16 + 4 * fq + q) * SX_RS + (16 * pt + 4 * pp) * 2));
                const s16x8 xf = {t0[0], t0[1], t0[2], t0[3], t1[0], t1[1], t1[2], t1[3]};
                yd = __builtin_amdgcn_mfma_f32_16x16x32_bf16(xf, pf[ks], yd, 0, 0, 0);
                yo = __builtin_amdgcn_mfma_f32_16x16x32_bf16(pr[pt][ks], cf[ks], yo, 0, 0, 0);
            }
            const u32x2 xr = *(const LAS u32x2*)(lds + SSD_X_OFF + h * SX_H + lcol * SX_RS + (16 * pt + 4 * fq) * 2);
            const float xv[4] = {__uint_as_float(xr[0] << 16), __uint_as_float(xr[0] & 0xffff0000u), __uint_as_float(xr[1] << 16), __uint_as_float(xr[1] & 0xffff0000u)};
            const f32x4 z = zz[pt];
            f32x4 gvv;
#pragma unroll
            for (int i = 0; i < 4; ++i) { const float y = yd[i] + eal * yo[i] + dsk * xv[i]; gvv[i] = y * z[i] * sigmoidf_(z[i]); ss += gvv[i] * gvv[i]; }
            *(f32x4*)(YTMP + tt * 1024 + hh * 64 + 16 * pt + 4 * fq) = gvv;
        }
    }
    ss += __shfl_xor(ss, 16); ss += __shfl_xor(ss, 32);
    const float rs = rsqrtf(ss * (1.0f / 256.f) + NORM_EPS);
#pragma unroll 1
    for (int h = 0; h < 4; ++h) {
        f32x4 gq[4], wq[4];
#pragma unroll
        for (int pt = 0; pt < 4; ++pt) { const int ch = (grp * 4 + h) * 64 + 16 * pt + 4 * fq; wq[pt] = *(const f32x4*)(nw + ch); gq[pt] = *(const f32x4*)(YTMP + tt * 1024 + ch); }
#pragma unroll
        for (int pt = 0; pt < 4; ++pt) { const int ch = (grp * 4 + h) * 64 + 16 * pt + 4 * fq;
            *(uint2*)(MIXO + tt * 2048 + ch) = make_uint2(pack2(gq[pt][0] * rs * wq[pt][0], gq[pt][1] * rs * wq[pt][1]), pack2(gq[pt][2] * rs * wq[pt][2], gq[pt][3] * rs * wq[pt][3])); }
    }
}

struct Args {
    const float* in[23];
    float* out;
    unsigned char* ws;
    int ph_lo, ph_hi;
};

enum { PH_NORM1 = 0, PH_INPROJ, PH_PREP, PH_SSD_CMP1, PH_GNORM_CMP2,
       PH_NSA,
       PH_OUTPROJ, PH_ROUTER, PH_SCATTER, PH_GATEUP, PH_DOWN, PH_FINAL, N_PHASES };

struct ARowsDense { static constexpr unsigned kstep = 128u; const bf16_t* base; size_t ld; int row0, nrows; const bf16_t* zrow; const void* wsbase;
    __device__ __forceinline__ const bf16_t* row(int r) const { const int g = row0 + r; return g < nrows ? base + (size_t)g * ld : zrow; } };
struct ARowsGather { static constexpr unsigned kstep = 128u; const bf16_t* base; size_t ld; const int* idx; const bf16_t* zrow; const void* wsbase;
    __device__ __forceinline__ const bf16_t* row(int r) const { const int g = idx[r]; return g >= 0 ? base + (size_t)g * ld : zrow; } };
struct ARowsWindow { static constexpr unsigned kstep = 512u; const bf16_t* base; int row0; const bf16_t* zrow; const void* wsbase;
    __device__ __forceinline__ const bf16_t* row(int r) const { const int gr = row0 + r; if (gr >= CMP_ROWS) return zrow; const int g = gr & 3, n = (gr >> 2) % N_C, b = (gr >> 2) / N_C;
        return base + ((size_t)(b * SEQ + 16 * n)) * 256 + g * 64; } };
struct BColsDense { const float* base; int ldb; int col0, ncols;
    __device__ __forceinline__ int coloff(int n) const { const int c = col0 + n; return c < ncols ? c : ncols - 4; } };
struct BColsGateUp { const float* base; int ldb; int cn;
    __device__ __forceinline__ int coloff(int n) const { const int wc = n >> 7, nt = (n & 127) >> 4, w = n & 15; const int j = wc * 64 + (nt & 3) * 16 + w;
        return (nt < 4 ? 0 : DFF) + cn * 128 + j; } };

struct EpiStoreF32 { float* C; size_t ldc; int row0, col0, ncols;
    __device__ __forceinline__ void operator()(int r, int n, f32x4 v) const { const int c = col0 + n; if (c < ncols) *(f32x4*)(C + (size_t)(row0 + r) * ldc + c) = v; } };
struct EpiResidF32 { float* C; const float* X; size_t ldc; int row0, col0;
    __device__ __forceinline__ void operator()(int r, int n, f32x4 v) const { const size_t o = (size_t)(row0 + r) * ldc + col0 + n; const f32x4 x = *(const f32x4*)(X + o); *(f32x4*)(C + o) = v + x; } };
struct EpiGeluBf16 { bf16_t* O; const float* bias; size_t ldo; int row0, col0, nrows;
    __device__ __forceinline__ void operator()(int r, int n, f32x4 v) const { const int g = row0 + r; if (g >= nrows) return; const int c = col0 + n;
        float o[4];
#pragma unroll
        for (int i = 0; i < 4; ++i) { const float x = v[i] + bias[c + i]; const float u = 0.7978845608028654f * (x + 0.044715f * x * x * x); o[i] = 0.5f * x * (1.0f + tanhf(u)); }
        *(uint2*)(O + (size_t)g * ldo + c) = make_uint2(pack2(o[0], o[1]), pack2(o[2], o[3])); } };
struct EpiSwiglu { bf16_t* O; const float* bias; int row0, cn;
    __device__ __forceinline__ void pair(int r, int j, f32x4 g, f32x4 u) const { const int c = cn * 128 + j; float o[4];
#pragma unroll
        for (int i = 0; i < 4; ++i) { float gv = g[i] + bias[c + i]; float uv = u[i] + bias[DFF + c + i]; gv = fminf(gv, 7.0f); uv = fminf(fmaxf(uv, -7.0f), 7.0f);
            const float glu = gv * sigmoidf_(1.702f * gv); o[i] = (uv + 1.0f) * glu; }
        *(uint2*)(O + (size_t)(row0 + r) * DFF + c) = make_uint2(pack2(o[0], o[1]), pack2(o[2], o[3])); } };
struct EpiBiasBf16 { bf16_t* O; const float* bias; int row0, col0;
    __device__ __forceinline__ void operator()(int r, int n, f32x4 v) const { const int c = col0 + n;
        *(uint2*)(O + (size_t)(row0 + r) * D + c) = make_uint2(pack2(v[0] + bias[c], v[1] + bias[c + 1]), pack2(v[2] + bias[c + 2], v[3] + bias[c + 3])); } };


struct EpiInProj { unsigned char* ws; const float* dt_bias; int row0, col0;
    __device__ __forceinline__ void operator()(int r, int n, f32x4 v) const {
        const int cb = __builtin_amdgcn_readfirstlane((col0 + n) & ~15);
        const int ci = (col0 + n) & 15;
        const size_t R = (size_t)(row0 + r); const int pos = (int)(R & (SEQ - 1));
        if (cb >= IN_PROJ) return;
        if (cb >= OFF_DT && cb < OFF_Q) { f32x4 o;
#pragma unroll
            for (int i = 0; i < 4; ++i) { const float x = v[i] + dt_bias[ci + i]; o[i] = x > 20.f ? x : log1pf(expf(x)); }
            *(f32x4*)((float*)(ws + WS_DT) + R * 16 + ci) = o; return; }
        if (cb >= OFF_GATE) { f32x4 o;
#pragma unroll
            for (int i = 0; i < 4; ++i) o[i] = sigmoidf_(v[i]);
            *(f32x4*)((float*)(ws + WS_GATE) + R * 48 + (cb - OFF_GATE) + ci) = o; return; }
        size_t boff; int ld, cc; bool rp = false; float scl = 1.0f;
        if (cb < OFF_XBC) { boff = WS_ZB; ld = 1024; cc = cb; }
        else if (cb < OFF_DT) { boff = WS_XBCR; ld = 2048; cc = cb - OFF_XBC; }
        else if (cb < OFF_KCMP) { boff = WS_QB; ld = 1024; cc = cb - OFF_Q; rp = true; scl = 0.125f * 1.4426950408889634f; }
        else if (cb < OFF_VCMP) { boff = WS_KCMP; ld = 256; cc = cb - OFF_KCMP; }
        else if (cb < OFF_KSLC) { boff = WS_VCMP; ld = 256; cc = cb - OFF_VCMP; }
        else if (cb < OFF_VSLC) { boff = WS_KS; ld = 256; cc = cb - OFF_KSLC; rp = true; }
        else if (cb < OFF_KWIN) { boff = WS_VS; ld = 256; cc = cb - OFF_VSLC; }
        else if (cb < OFF_VWIN) { boff = WS_KW; ld = 256; cc = cb - OFF_KWIN; rp = true; }
        else { boff = WS_VW; ld = 256; cc = cb - OFF_VWIN; }
        f32x4 o = v;
        if (rp && (cc & 63) == 0) {
            const float* rope = (const float*)(ws + WS_ROPE);
#pragma unroll
            for (int i = 0; i < 4; ++i) { const float pr = xchg32(v[i]); const int k = (ci & 7) + i; const float c = rope[pos * 8 + k], sn = rope[SEQ * 8 + pos * 8 + k];
                o[i] = (ci < 8) ? (v[i] * c - pr * sn) : (pr * sn + v[i] * c); }
        }
        *(uint2*)((bf16_t*)(ws + boff) + R * ld + cc + ci) = make_uint2(pack2(o[0] * scl, o[1] * scl), pack2(o[2] * scl, o[3] * scl));
    } };


__device__ __forceinline__ const bf16_t* zrow_of(unsigned char* ws) { return (const bf16_t*)((unsigned*)(ws + WS_CTL) + CW_ZROW); }
struct MkInProj { typedef ARowsDense AL; typedef BColsDense BL; typedef EpiInProj EP; unsigned char* ws; const float* w; const float* dt_bias;
    __device__ __forceinline__ void make_src(int rt, int ct, AL& al, BL& bl) const { al = AL{(const bf16_t*)(ws + WS_XN), (size_t)D, rt * 256, T, zrow_of(ws), ws}; bl = BL{w, IN_PROJ, ct * 256, IN_PROJ}; }
    __device__ __forceinline__ void make_ep(int rt, int ct, EP& ep) const { ep = EP{ws, dt_bias, rt * 256, ct * 256}; } };
struct MkOutProj { typedef ARowsDense AL; typedef BColsDense BL; typedef EpiResidF32 EP; unsigned char* ws; const float* w; const float* x;
    __device__ __forceinline__ void make_src(int rt, int ct, AL& al, BL& bl) const { al = AL{(const bf16_t*)(ws + WS_MIX), (size_t)2048, rt * 256, T, zrow_of(ws), ws}; bl = BL{w, D, ct * 256, D}; }
    __device__ __forceinline__ void make_ep(int rt, int ct, EP& ep) const { ep = EP{(float*)(ws + WS_X2), x, (size_t)D, rt * 256, ct * 256}; } };
__device__ __forceinline__ int expert_of_tile(const unsigned* cnt, int tile) { int e = 0, acc = 0;
    for (int k = 0; k < NE; ++k) { const int nt = (int)((cnt[k] + 255u) >> 8); if (tile >= acc && tile < acc + nt) e = k; acc += nt; } return e; }
struct MkGateUp { typedef ARowsGather AL; typedef BColsGateUp BL; typedef EpiSwiglu EP; unsigned char* ws; const float* w; const float* bias;
    __device__ __forceinline__ void make_src(int tile, int cn, AL& al, BL& bl) const { const int e = expert_of_tile((const unsigned*)(ws + WS_CTL) + CW_COUNT, tile);
        al = AL{(const bf16_t*)(ws + WS_XN), (size_t)D, (const int*)(ws + WS_ROWTOK) + tile * 256, zrow_of(ws), ws}; bl = BL{w + (size_t)e * D * 2 * DFF, 2 * DFF, cn}; }
    __device__ __forceinline__ void make_ep(int tile, int cn, EP& ep) const { const int e = expert_of_tile((const unsigned*)(ws + WS_CTL) + CW_COUNT, tile);
        ep = EP{(bf16_t*)(ws + WS_ACT), bias + (size_t)e * 2 * DFF, tile * 256, cn}; } };
struct MkDown { typedef ARowsDense AL; typedef BColsDense BL; typedef EpiBiasBf16 EP; unsigned char* ws; const float* w; const float* bias;
    __device__ __forceinline__ void make_src(int tile, int ct, AL& al, BL& bl) const { const int e = expert_of_tile((const unsigned*)(ws + WS_CTL) + CW_COUNT, tile);
        al = AL{(const bf16_t*)(ws + WS_ACT), (size_t)DFF, tile * 256, MAX_ROWS, zrow_of(ws), ws}; bl = BL{w + (size_t)e * DFF * D, D, ct * 256, D}; }
    __device__ __forceinline__ void make_ep(int tile, int ct, EP& ep) const { const int e = expert_of_tile((const unsigned*)(ws + WS_CTL) + CW_COUNT, tile);
        ep = EP{(bf16_t*)(ws + WS_Y), bias + (size_t)e * D, tile * 256, ct * 256}; } };
struct ProvCmp1 { static constexpr bool SINGLE = true; typedef ARowsWindow AL; typedef BColsDense BL; typedef EpiStoreF32 EP; unsigned char* ws; const float* w1; int u, G;
    int cu;
    __device__ __forceinline__ bool next(AL& al, BL& bl) { if (u >= 128) return false; const int kq = u >> 5, j = (u >> 4) & 1, rt = (u >> 1) & 7, ct = u & 1; cu = u; u += G;
        al = AL{(const bf16_t*)(ws + (j ? WS_VCMP : WS_KCMP)) + (size_t)kq * 8 * 256, rt * 256, zrow_of(ws), ws};
        bl = BL{w1 + (size_t)j * 2048 * CMP_HID + (size_t)kq * 512 * CMP_HID, CMP_HID, ct * 256, CMP_HID}; return true; }
    __device__ __forceinline__ void make_ep(EP& ep) const { const int kq = cu >> 5, j = (cu >> 4) & 1, rt = (cu >> 1) & 7, ct = cu & 1;
        ep = EP{(float*)(ws + WS_PART) + (size_t)(kq * 2 + j) * 2048 * CMP_HID, (size_t)CMP_HID, rt * 256, ct * 256, CMP_HID}; } };

__device__ __forceinline__ float rope_inv(int i) { return (float)exp(-(double)i * 0.125 * 13.122363377404328); }


#define PATCH_LOOP(nR_, nC_, RT, CT, ...) do { \
    const int nlab_ = (G % 8 == 0) ? 8 : 1, nsl_ = G / nlab_, npc_ = ((nC_) + 7) >> 3, npatch_ = (((nR_) + 3) >> 2) * npc_; \
    for (int pidx_ = bid % nlab_; pidx_ < npatch_; pidx_ += nlab_) \
        for (int slot_ = bid / nlab_; slot_ < 32; slot_ += nsl_) { \
            const int RT = (pidx_ / npc_) * 4 + (slot_ >> 3), CT = (pidx_ % npc_) * 8 + (slot_ & 7); \
            if (RT < (nR_) && CT < (nC_)) { __VA_ARGS__ } } } while (0)

__global__ void __launch_bounds__(512, 2) fwd(Args a) {
    extern __shared__ __attribute__((aligned(16))) unsigned char lds_raw[];
    LAS char* lds = (LAS char*)lds_raw;
    const int tid = threadIdx.x, lane = tid & 63, wid = __builtin_amdgcn_readfirstlane(tid >> 6);
    const int G = gridDim.x, bid = blockIdx.x;
    const int gtid = bid * 512 + tid, gthreads = G * 512;
    const int gwave = bid * 8 + wid, gwaves = G * 8;
    unsigned char* ws = a.ws;
    unsigned* ctl = (unsigned*)(ws + WS_CTL);
    volatile LAS unsigned* barw = (volatile LAS unsigned*)(lds + MAIN_LDS);
    if (tid == 0) { barw[0] = 0u; barw[1] = 0u; barw[2] = 0u; barw[3] = 0u; }
    __syncthreads();
    XcdBarrier bar; bar.bar = ctl; bar.x = 0; bar.st = barw;
    const bool multi = (a.ph_hi - a.ph_lo) > 1;
    if (multi) bar = xcd_barrier_post(ctl, barw);
#ifdef ONLY_PH
#define IN(k) ((k) == ONLY_PH)
#else
#define IN(k) (a.ph_lo <= (k) && (k) < a.ph_hi)
#endif
#define SEAM(k) do { if ((k) + 1 < a.ph_hi) xcd_barrier(bar); } while (0)

#define XN ((bf16_t*)(ws + WS_XN))
#define PROJ ((float*)(ws + WS_PROJ))
#define XBC ((float*)(ws + WS_XBC))
#define DT ((float*)(ws + WS_DT))
#define YSSD ((float*)(ws + WS_YSSD))
#define MIX ((bf16_t*)(ws + WS_MIX))
#define ROPE ((float*)(ws + WS_ROPE))
#define BLK ((bf16_t*)(ws + WS_BLK))
#define H1 ((bf16_t*)(ws + WS_H1))
#define KC ((float*)(ws + WS_KC))
#define VC ((float*)(ws + WS_VC))
#define PCMP ((float*)(ws + WS_PCMP))
#define OCMP ((float*)(ws + WS_OCMP))
#define SEL ((unsigned long long*)(ws + WS_SEL))
#define X2 ((float*)(ws + WS_X2))
#define TOPE ((int*)(ws + WS_TOPE))
#define TOPG ((float*)(ws + WS_TOPG))
#define SLOT ((int*)(ws + WS_SLOT))
#define POS ((int*)(ws + WS_POS))
#define ROWTOK ((int*)(ws + WS_ROWTOK))
#define ACT ((bf16_t*)(ws + WS_ACT))
#define YB ((bf16_t*)(ws + WS_Y))
#define XBCB ((bf16_t*)(ws + WS_XBCB))
#define STATES ((float*)(ws + WS_STATES))
#define PREV ((bf16_t*)(ws + WS_PREV))
#define CHDEC ((float*)(ws + WS_CHDEC))
#define QB ((bf16_t*)(ws + WS_QB))
#define KSb ((bf16_t*)(ws + WS_KS))
#define VSb ((bf16_t*)(ws + WS_VS))
#define KWb ((bf16_t*)(ws + WS_KW))
#define VWb ((bf16_t*)(ws + WS_VW))
#define KCB ((bf16_t*)(ws + WS_KCB))
#define VCB ((bf16_t*)(ws + WS_VCB))
#define XIN (a.in[0])
#define RW ((float*)(ws + WS_RW))
#define BCNT ((int*)(ws + WS_BCNT))
#define ZB ((bf16_t*)(ws + WS_ZB))
#define XBCR ((bf16_t*)(ws + WS_XBCR))
#define KCMPb ((bf16_t*)(ws + WS_KCMP))
#define VCMPb ((bf16_t*)(ws + WS_VCMP))
#define GATE ((float*)(ws + WS_GATE))
#define PEW ((float*)(ws + WS_PEW))
#define PEWP ((float*)(ws + WS_PEWP))
#define PART ((float*)(ws + WS_PART))
#define COUNT (ctl + CW_COUNT)
#define ZROW ((const bf16_t*)(ctl + CW_ZROW))
    if (IN(PH_NORM1)) {
        const float* w = a.in[1];
        for (int row = gwave; row < T; row += gwaves) {
            const float4* xr = (const float4*)(XIN + (size_t)row * D);
            float4 v[8]; float ss = 0.f;
#pragma unroll
            for (int i = 0; i < 8; ++i) { v[i] = xr[lane + 64 * i]; ss += v[i].x * v[i].x + v[i].y * v[i].y + v[i].z * v[i].z + v[i].w * v[i].w; }
            ss = wave_sum(ss);
            const float rstd = rsqrtf(ss * (1.0f / D) + NORM_EPS);
#pragma unroll
            for (int i = 0; i < 8; ++i) { const float4 wv = ((const float4*)w)[lane + 64 * i];
                *(uint2*)(XN + (size_t)row * D + 4 * (lane + 64 * i)) = make_uint2(pack2(v[i].x * rstd * wv.x, v[i].y * rstd * wv.y), pack2(v[i].z * rstd * wv.z, v[i].w * rstd * wv.w)); }
        }
        for (int i = gtid; i < SEQ * 8; i += gthreads) { const int pos = i >> 3, k = i & 7; const float ang = (float)pos * rope_inv(k); ROPE[i] = cosf(ang); ROPE[SEQ * 8 + i] = sinf(ang); }
        for (int i = gtid; i < MAX_ROWS; i += gthreads) ROWTOK[i] = -1;
        for (int i = gtid; i < 2 * 2 * 256; i += gthreads) { const int d = i & 255, b = (i >> 8) & 1, j = i >> 9; (j ? VCB : KCB)[((size_t)b * 256 + 255) * 256 + d] = 0; }
        for (int i = gtid; i < 2048 * 32; i += gthreads) { const int ii = i & 3, e = (i >> 2) & 31, kk = i >> 7, k = 4 * kk + ii; RW[i] = a.in[15][k] * a.in[16][k * NE + e]; }
        for (int i = gtid; i < 32 * 2 * CMP_HID; i += gthreads) {
            const int col = i & (CMP_HID - 1), j = (i >> 9) & 1, kc = i >> 10; const float* pe = a.in[9] + j * 2048 + kc * 64; const float* w1 = a.in[10] + ((size_t)j * 2048 + kc * 64) * CMP_HID + col;
            float acc = 0.f;
#pragma unroll 8
            for (int k = 0; k < 64; ++k) acc += pe[k] * w1[(size_t)k * CMP_HID];
            PEWP[i] = acc;
        }
        SEAM(PH_NORM1);
    }

    if (IN(PH_INPROJ)) {
        { PatchProv<MkInProj> P; P.mk = MkInProj{ws, a.in[2], a.in[5]}; P.init(T / 256, (IN_PROJ + 255) / 256, G, bid); gemm_stream<false>(lds, P, D); }
        SEAM(PH_INPROJ);
    }

    if (IN(PH_PREP)) {
        const float* conv_w = a.in[3]; const float* conv_b = a.in[4];
        for (int i = gtid; i < T * 256; i += gthreads) {
            const int t = i >> 8, c = (i & 255) * 8, s = t & (SEQ - 1);
            float acc[8];
            { const f32x4 b0 = *(const f32x4*)(conv_b + c), b1 = *(const f32x4*)(conv_b + c + 4); acc[0] = b0[0]; acc[1] = b0[1]; acc[2] = b0[2]; acc[3] = b0[3]; acc[4] = b1[0]; acc[5] = b1[1]; acc[6] = b1[2]; acc[7] = b1[3]; }
#pragma unroll
            for (int k = 0; k < 4; ++k) { const int ts = s - 3 + k; if (ts >= 0) {
                const u32x4 xv = *(const u32x4*)(XBCR + (size_t)(t - 3 + k) * 2048 + c);
                const f32x4 w0 = *(const f32x4*)(conv_w + k * 2048 + c), w1 = *(const f32x4*)(conv_w + k * 2048 + c + 4);
#pragma unroll
                for (int e = 0; e < 4; ++e) { acc[2 * e] += (e < 2 ? w0[2 * e] : w1[2 * e - 4]) * __uint_as_float(xv[e] << 16); acc[2 * e + 1] += (e < 2 ? w0[2 * e + 1] : w1[2 * e - 3]) * __uint_as_float(xv[e] & 0xffff0000u); } } }
            u32x4 o;
#pragma unroll
            for (int e = 0; e < 4; ++e) o[e] = pack2(acc[2 * e] * sigmoidf_(acc[2 * e]), acc[2 * e + 1] * sigmoidf_(acc[2 * e + 1]));
            *(u32x4*)(XBCB + (size_t)t * 2048 + c) = o;
        }
        for (int i = gtid; i < 2 * CMP_HID; i += gthreads) { float acc = 0.f;
#pragma unroll 8
            for (int kc = 0; kc < 32; ++kc) acc += PEWP[kc * 1024 + i]; PEW[i] = acc; }
        SEAM(PH_PREP);
    }

    if (IN(PH_SSD_CMP1)) {
        const int GW = G;
        {
            for (int u0 = bid; u0 < 128; u0 += GW) { ProvCmp1 P{ws, a.in[10], u0, 1 << 20, 0}; gemm_stream<false>(lds, P, 512); }
            for (int it = (bid + GW - (128 % GW)) % GW; it < 256; it += GW) ssd_states_item(lds, it, XBCB, DT, a.in[6], STATES, CHDEC);
        }
        SEAM(PH_SSD_CMP1);
    }

    if (IN(PH_GNORM_CMP2)) {
        const float* nw = a.in[8];
        for (int i = gtid; i < 2 * 16 * 64 * 32; i += gthreads) {
            const int n4 = i & 31, p = (i >> 5) & 63, h = (i >> 11) & 15, b = i >> 15;
            f32x4 run = {0.f, 0.f, 0.f, 0.f};
#pragma unroll 1
            for (int c0 = 0; c0 < 32; c0 += 16) {
                f32x4 sv[16]; float dec[16];
#pragma unroll
                for (int q = 0; q < 16; ++q) { const size_t base = (((size_t)b * 32 + c0 + q) * 16 + h) * 8192 + p * 128 + n4 * 4; sv[q] = *(const f32x4*)(STATES + base); dec[q] = CHDEC[((size_t)b * 32 + c0 + q) * 16 + h]; }
#pragma unroll
                for (int q = 0; q < 16; ++q) { const size_t base = (((size_t)b * 32 + c0 + q) * 16 + h) * 8192 + p * 128 + n4 * 4;
                    *(uint2*)(PREV + base) = make_uint2(pack2(run[0], run[1]), pack2(run[2], run[3])); run = run * dec[q] + sv[q]; }
            }
        }
        const float* w2 = a.in[12]; const float* b2 = a.in[13]; const float* b1 = a.in[11];
        for (int it = gwave; it < 2 * CMP_ROWS; it += gwaves) {
            const int row = it % CMP_ROWS, j = it / CMP_ROWS, d = lane;
            const float* wj = w2 + (size_t)j * CMP_HID * 64;
            float s0 = b2[j * 64 + d];
            for (int k0 = 0; k0 < CMP_HID; k0 += 64) {
                float hx = b1[j * CMP_HID + k0 + lane] + PEW[j * CMP_HID + k0 + lane];
#pragma unroll
                for (int q = 0; q < 4; ++q) hx += PART[((size_t)(q * 2 + j) * 2048 + row) * CMP_HID + k0 + lane];
                const float u = 0.7978845608028654f * (hx + 0.044715f * hx * hx * hx);
                const float hv = bf2f(f2bf(0.5f * hx * (1.0f + tanhf(u))));
#pragma unroll
                for (int kk = 0; kk < 64; ++kk) s0 += __builtin_bit_cast(float, __builtin_amdgcn_readlane(__builtin_bit_cast(int, hv), kk)) * wj[(k0 + kk) * 64 + d];
            }
            float o = s0;
            if (j == 0) { const float sp = __shfl(s0, (d < 8) ? d + 8 : ((d < 16) ? d - 8 : d));
                if (d < 16) { const int n = (row >> 2) % N_C, pos = 16 * n + 31, k = d & 7; const float c = ROPE[pos * 8 + k], sn = ROPE[SEQ * 8 + pos * 8 + k];
                    o = (d < 8) ? (s0 * c - sp * sn) : (sp * sn + s0 * c); } }
            { const int g4 = row & 3, n = (row >> 2) % N_C, bb = (row >> 2) / N_C; (j ? VCB : KCB)[((size_t)bb * 256 + n) * 256 + g4 * 64 + d] = f2bf(o); }
        }
        SEAM(PH_GNORM_CMP2);
    }

    if (IN(PH_NSA)) {
        bf16_t* MIXO = MIX;
        for (int k = bid; k < 512; k += G) { const int rnd = k / G; const int u = (rnd & 1) ? 511 - (k - G * rnd) - G * (rnd - 1) : k;
            if (u >= 0 && u < 512) nsa_unit32(lds, (G == 256) ? u : k, QB, KSb, VSb, KWb, VWb, KCB, VCB, GATE, MIXO); }
        for (int it = bid; it < 256; it += G) ssd_out_item(lds, it, XBCB, DT, a.in[6], a.in[7], a.in[8], PREV, ZB, YSSD, MIXO);
        SEAM(PH_NSA);
    }

    if (IN(PH_OUTPROJ)) {
        { PatchProv<MkOutProj> P; P.mk = MkOutProj{ws, a.in[14], a.in[0]}; P.init(T / 256, D / 256, G, bid); gemm_stream<false>(lds, P, 2048); }
        SEAM(PH_OUTPROJ);
    }

    if (IN(PH_ROUTER)) {
        const float* nwp = a.in[15]; const float* br = a.in[17];
        LAS float* part = (LAS float*)lds;
        LAS float* ssq = part + 8 * 512;
        LAS float* rsl = ssq + 128;
        LAS int* lcnt = (LAS int*)(rsl + 32);
        if (tid < 32) lcnt[tid] = 0;
        __syncthreads();
        const int r16 = lane & 15, kq = lane >> 4;
        for (int tp = bid; tp < T / 32; tp += G) {
            const int wt = wid >> 2, wk = wid & 3, tile = 2 * tp + wt;
            const int row = tile * 16 + r16;
            f32x4 acc0 = {0.f, 0.f, 0.f, 0.f}, acc1 = {0.f, 0.f, 0.f, 0.f}; float ssp = 0.f;
            const float* xr = X2 + (size_t)row * D + 512 * wk + 4 * kq;
            const float* rwp = RW + ((size_t)(128 * wk + kq) * 32 + r16) * 4;
#pragma unroll 8
            for (int j = 0; j < 32; ++j) {
                const f32x4 av = *(const f32x4*)(xr + 16 * j);
                const f32x4 b0 = *(const f32x4*)(rwp + (size_t)j * 4 * 128), b1 = *(const f32x4*)(rwp + (size_t)j * 4 * 128 + 64);
                ssp += av[0] * av[0] + av[1] * av[1] + av[2] * av[2] + av[3] * av[3];
#pragma unroll
                for (int i = 0; i < 4; ++i) { acc0 = __builtin_amdgcn_mfma_f32_16x16x4f32(av[i], b0[i], acc0, 0, 0, 0); acc1 = __builtin_amdgcn_mfma_f32_16x16x4f32(av[i], b1[i], acc1, 0, 0, 0); }
            }
            ssp += __shfl_xor(ssp, 16); ssp += __shfl_xor(ssp, 32);
            if (kq == 0) ssq[wid * 16 + r16] = ssp;
#pragma unroll
            for (int i = 0; i < 4; ++i) { part[wid * 512 + (4 * kq + i) * 32 + r16] = acc0[i]; part[wid * 512 + (4 * kq + i) * 32 + 16 + r16] = acc1[i]; }
            __syncthreads();
#pragma unroll
            for (int rep = 0; rep < 2; ++rep) {
                const int idx = tid + 512 * rep, ts = idx >> 9, rr = (idx >> 5) & 15, e = idx & 31, grow = (2 * tp + ts) * 16 + rr;
                float lg = 0.f, ss = 0.f;
#pragma unroll
                for (int w = 0; w < 4; ++w) { lg += part[(4 * ts + w) * 512 + rr * 32 + e]; ss += ssq[(4 * ts + w) * 16 + rr]; }
                const float rstd = rsqrtf(ss * (1.0f / D) + NORM_EPS);
                const float mine = lg * rstd + br[e];
                int rank = 0;
#pragma unroll
                for (int k = 0; k < NE; ++k) { const float o = __shfl(mine, (lane & 32) + k); rank += (o > mine || (o == mine && k < e)) ? 1 : 0; }
                const bool sel = rank < 4;
                float mx = sel ? mine : -INFINITY;
#pragma unroll
                for (int o = 16; o > 0; o >>= 1) mx = fmaxf(mx, __shfl_xor(mx, o));
                const float ex = sel ? __expf(mine - mx) : 0.f;
                float den = ex;
#pragma unroll
                for (int o = 16; o > 0; o >>= 1) den += __shfl_xor(den, o);
                if (sel) { const int slot = atomicAdd((int*)&lcnt[e], 1); const int o = grow * 4 + rank; TOPE[o] = e; TOPG[o] = ex / den; SLOT[o] = slot; }
                if (e == 0) rsl[ts * 16 + rr] = rstd;
            }
            __syncthreads();
            if (tid < 32) { BCNT[tp * 32 + tid] = lcnt[tid]; lcnt[tid] = 0; }
            { const f32x4 wv = *(const f32x4*)(nwp + 4 * tid);
#pragma unroll 1
              for (int half = 0; half < 4; ++half) {
                f32x4 vv[8];
#pragma unroll
                for (int it = 0; it < 8; ++it) vv[it] = *(const f32x4*)(X2 + (size_t)(tp * 32 + half * 8 + it) * D + 4 * tid);
#pragma unroll
                for (int it = 0; it < 8; ++it) { const float rs = rsl[half * 8 + it]; const f32x4 v = vv[it];
                    *(uint2*)(XN + (size_t)(tp * 32 + half * 8 + it) * D + 4 * tid) = make_uint2(pack2(v[0] * rs * wv[0], v[1] * rs * wv[1]), pack2(v[2] * rs * wv[2], v[3] * rs * wv[3])); }
              } }
            __syncthreads();
        }
        SEAM(PH_ROUTER);
    }

    if (IN(PH_SCATTER)) {
        LAS int* red = (LAS int*)lds;
        for (int cb = bid; cb < 64; cb += G) {
            const int tp0 = 4 * cb, e = tid & 31, c = tid >> 5;
            int sb = 0, stt = 0;
#pragma unroll 4
            for (int q = 0; q < 16; ++q) { const int tpq = 16 * c + q; const int v = BCNT[tpq * 32 + e]; stt += v; sb += (tpq < tp0) ? v : 0; }
            red[c * 32 + e] = sb; red[512 + c * 32 + e] = stt;
            __syncthreads();
            if (tid < 32) { int b0 = 0, tt_ = 0;
#pragma unroll
                for (int q = 0; q < 16; ++q) { b0 += red[q * 32 + tid]; tt_ += red[512 + q * 32 + tid]; }
                red[1024 + tid] = b0; red[1056 + tid] = tt_; if (cb == 0) COUNT[tid] = (unsigned)tt_; }
            __syncthreads();
            { const int i = cb * 512 + tid, ei = TOPE[i], tp = i >> 7;
              int base = red[1024 + ei];
              for (int q = tp0; q < tp; ++q) base += BCNT[q * 32 + ei];
              int off = 0;
              for (int k = 0; k < ei; ++k) off += (red[1056 + k] + 255) >> 8;
              const int pos = off * 256 + base + SLOT[i];
              ROWTOK[pos] = i >> 2; POS[i] = pos; }
            __syncthreads();
        }
        SEAM(PH_SCATTER);
    }

    if (IN(PH_GATEUP) || IN(PH_DOWN)) {
        LAS int* toff = (LAS int*)(lds + GEMM_LDS + 64 - 0);
        (void)toff;
    }
    if (IN(PH_GATEUP)) {
        int ntiles = 0;
        for (int k = 0; k < NE; ++k) ntiles += (int)((COUNT[k] + 255u) >> 8);
        { PatchProv<MkGateUp> P; P.mk = MkGateUp{ws, a.in[18], a.in[19]}; P.init(ntiles, 16, G, bid); gemm_stream<true>(lds, P, D); }
        SEAM(PH_GATEUP);
    }
    if (IN(PH_DOWN)) {
        int ntiles = 0;
        for (int k = 0; k < NE; ++k) ntiles += (int)((COUNT[k] + 255u) >> 8);
        { PatchProv<MkDown> P; P.mk = MkDown{ws, a.in[20], a.in[21]}; P.init(ntiles, 8, G, bid); gemm_stream<false>(lds, P, DFF); }
        SEAM(PH_DOWN);
    }

    if (IN(PH_FINAL)) {
        const float* fw = a.in[22];
        for (int row = gwave; row < T; row += gwaves) {
            const float4* xr = (const float4*)(X2 + (size_t)row * D);
            float4 v[8];
#pragma unroll
            for (int i = 0; i < 8; ++i) v[i] = xr[lane + 64 * i];
#pragma unroll
            for (int k = 0; k < 4; ++k) { const float gk = TOPG[row * 4 + k]; const bf16_t* yr = YB + (size_t)POS[row * 4 + k] * D;
#pragma unroll
                for (int i = 0; i < 8; ++i) { const uint2 y = *(const uint2*)(yr + 4 * (lane + 64 * i));
                    v[i].x += gk * bf2f((bf16_t)(y.x & 0xffffu)); v[i].y += gk * bf2f((bf16_t)(y.x >> 16)); v[i].z += gk * bf2f((bf16_t)(y.y & 0xffffu)); v[i].w += gk * bf2f((bf16_t)(y.y >> 16)); } }
            float ss = 0.f;
#pragma unroll
            for (int i = 0; i < 8; ++i) ss += v[i].x * v[i].x + v[i].y * v[i].y + v[i].z * v[i].z + v[i].w * v[i].w;
            ss = wave_sum(ss);
            float rstd = rsqrtf(ss * (1.0f / D) + NORM_EPS);
#pragma unroll
            for (int i = 0; i < 8; ++i) { const float4 wv = ((const float4*)fw)[lane + 64 * i];
                ((float4*)(a.out + (size_t)row * D))[lane + 64 * i] = make_float4(v[i].x * rstd * wv.x, v[i].y * rstd * wv.y, v[i].z * rstd * wv.z, v[i].w * rstd * wv.w); }
        }
    }
#undef IN
#undef SEAM
}

extern "C" void kernel_launch(void* const* d_in, const int* in_sizes, int n_in, void* d_out, int out_size, void* d_ws, size_t ws_size, hipStream_t stream) {
    static int grid = 0;
    if (grid == 0) {
        if (n_in != 23 || out_size != T * D || ws_size < WS_END) { fprintf(stderr, "kernel_launch: unexpected shapes (n_in %d, out %d, ws %zu < %zu)\n", n_in, out_size, ws_size, (size_t)WS_END); grid = -1; return; }
        int dev = 0, cus = 0, per_cu = 0;
        if (hipGetDevice(&dev) != hipSuccess || hipDeviceGetAttribute(&cus, hipDeviceAttributeMultiprocessorCount, dev) != hipSuccess) { grid = -1; return; }
        if (hipFuncSetAttribute((const void*)fwd, hipFuncAttributeMaxDynamicSharedMemorySize, LDS_BYTES) != hipSuccess) { fprintf(stderr, "kernel_launch: hipFuncSetAttribute failed\n"); grid = -1; return; }
        if (hipOccupancyMaxActiveBlocksPerMultiprocessor(&per_cu, (const void*)fwd, 512, LDS_BYTES) != hipSuccess || per_cu < 1) { fprintf(stderr, "kernel_launch: occupancy query says %d\n", per_cu); per_cu = 1; }
        (void)hipGetLastError();
        grid = cus;
    }
    if (grid < 0) return;
    (void)hipMemsetAsync((char*)d_ws + WS_CTL, 0, CTL_BYTES, stream);
    Args a{};
    for (int i = 0; i < 23; ++i) a.in[i] = (const float*)d_in[i];
    a.out = (float*)d_out; a.ws = (unsigned char*)d_ws;
#if N_LAUNCH_MODE == 1
    a.ph_lo = 0; a.ph_hi = N_PHASES;
    hipLaunchKernelGGL(fwd, dim3(grid), dim3(512), LDS_BYTES, stream, a);
#else
    for (int ph = 0; ph < N_PHASES; ++ph) { a.ph_lo = ph; a.ph_hi = ph + 1; hipLaunchKernelGGL(fwd, dim3(grid), dim3(512), LDS_BYTES, stream, a); }
#endif
}
```

```cpp
#include <hip/hip_runtime.h>
#include <stdint.h>
#include <stdio.h>

#ifndef N_LAUNCH_MODE
#define N_LAUNCH_MODE 1
#endif

typedef unsigned short bf16_t;
typedef short s16x4 __attribute__((ext_vector_type(4)));
typedef short s16x8 __attribute__((ext_vector_type(8)));
typedef float f32x4 __attribute__((ext_vector_type(4)));
typedef unsigned u32x4 __attribute__((ext_vector_type(4)));
typedef unsigned u32x2 __attribute__((ext_vector_type(2)));
#define LAS __attribute__((address_space(3)))

constexpr int D = 2048, BATCH = 2, SEQ = 4096, T = BATCH * SEQ;
constexpr int SSM_H = 16, SSM_N = 128;
constexpr int NSA_H = 16, DH = 64;
constexpr int CMP_HID = 512;
constexpr int N_C = 255, N_SEL = 64;
constexpr int IN_PROJ = 5696;
constexpr int OFF_Z = 0, OFF_XBC = 1024, OFF_DT = 3072, OFF_Q = 3088, OFF_KCMP = 4112, OFF_VCMP = 4368, OFF_KSLC = 4624,
              OFF_VSLC = 4880, OFF_KWIN = 5136, OFF_VWIN = 5392, OFF_GATE = 5648;
constexpr int NE = 32, DFF = 2048;
constexpr float NORM_EPS = 1e-5f;
constexpr int CMP_ROWS = BATCH * N_C * 4;
constexpr int MAX_TILES = 160, MAX_ROWS = MAX_TILES * 256;

constexpr size_t AL(size_t x) { return (x + 255) & ~(size_t)255; }
constexpr size_t WS_CTL = 0;
constexpr size_t CTL_BYTES = 32768;
constexpr size_t WS_XN = WS_CTL + CTL_BYTES;
constexpr size_t WS_PROJ = WS_XN + AL((size_t)T * D * 2);
constexpr size_t WS_ZB = WS_PROJ;
constexpr size_t WS_XBCR = WS_ZB + AL((size_t)T * 1024 * 2);
constexpr size_t WS_KCMP = WS_XBCR + AL((size_t)T * 2048 * 2);
constexpr size_t WS_VCMP = WS_KCMP + AL((size_t)T * 256 * 2);
constexpr size_t WS_GATE = WS_VCMP + AL((size_t)T * 256 * 2);
constexpr size_t WS_PEW = WS_GATE + AL((size_t)T * 48 * 4);
constexpr size_t WS_PEWP = WS_PEW + 4096;
static_assert(WS_PEWP + 32 * 1024 * 4 <= WS_PROJ + AL((size_t)T * IN_PROJ * 4), "in-proj outputs fit the old PROJ region");
constexpr size_t WS_XBC = WS_PROJ + AL((size_t)T * IN_PROJ * 4);
constexpr size_t WS_DT = WS_XBC + AL((size_t)T * 2048 * 4);
constexpr size_t WS_YSSD = WS_DT + AL((size_t)T * 16 * 4);
constexpr size_t WS_MIX = WS_YSSD + AL((size_t)T * 1024 * 4);
constexpr size_t WS_ROPE = WS_MIX + AL((size_t)T * 2048 * 2);
constexpr size_t WS_BLK = WS_ROPE + AL((size_t)SEQ * 16 * 4);
constexpr size_t WS_H1 = WS_BLK + AL((size_t)2 * 2048 * 2048 * 2);
constexpr size_t WS_KC = WS_H1 + AL((size_t)2 * 2048 * 512 * 2);
constexpr size_t WS_VC = WS_KC + AL((size_t)2048 * 64 * 4);
constexpr size_t WS_PCMP = WS_VC + AL((size_t)2048 * 64 * 4);
constexpr size_t WS_OCMP = WS_PCMP + AL((size_t)T * 16 * 256 * 4);
constexpr size_t WS_SEL = WS_OCMP + AL((size_t)T * 1024 * 4);
constexpr size_t WS_X2 = WS_SEL + AL((size_t)T * 4 * 8);
constexpr size_t WS_TOPE = WS_X2 + AL((size_t)T * D * 4);
constexpr size_t WS_TOPG = WS_TOPE + AL((size_t)T * 4 * 4);
constexpr size_t WS_SLOT = WS_TOPG + AL((size_t)T * 4 * 4);
constexpr size_t WS_POS = WS_SLOT + AL((size_t)T * 4 * 4);
constexpr size_t WS_ROWTOK = WS_POS + AL((size_t)T * 4 * 4);
constexpr size_t WS_BCNT = WS_ROWTOK + AL((size_t)MAX_ROWS * 4);
constexpr size_t WS_ACT = WS_BCNT + AL((size_t)256 * 32 * 4);
constexpr size_t WS_Y = WS_ACT + AL((size_t)MAX_ROWS * DFF * 2);
constexpr size_t WS_QB = WS_Y + AL((size_t)MAX_ROWS * D * 2);
constexpr size_t WS_KS = WS_QB + AL((size_t)T * 1024 * 2);
constexpr size_t WS_VS = WS_KS + AL((size_t)T * 256 * 2);
constexpr size_t WS_KW = WS_VS + AL((size_t)T * 256 * 2);
constexpr size_t WS_VW = WS_KW + AL((size_t)T * 256 * 2);
constexpr size_t WS_KCB = WS_VW + AL((size_t)T * 256 * 2);
constexpr size_t WS_VCB = WS_KCB + AL((size_t)2 * 256 * 256 * 2);
constexpr size_t WS_XBCB = WS_VCB + AL((size_t)2 * 256 * 256 * 2);
constexpr size_t WS_STATES = WS_XBCB + AL((size_t)T * 2048 * 2);
constexpr size_t WS_PREV = WS_STATES + AL((size_t)2 * 32 * 16 * 64 * 128 * 4);
constexpr size_t WS_CHDEC = WS_PREV + AL((size_t)2 * 32 * 16 * 64 * 128 * 2);
constexpr size_t WS_PART = WS_CHDEC + AL((size_t)2 * 32 * 16 * 4);
constexpr size_t WS_RW = WS_PART + AL((size_t)4 * 2 * 2048 * 512 * 4);
constexpr size_t WS_CHK = WS_RW + AL((size_t)2048 * 32 * 4);
constexpr size_t WS_END = WS_CHK + AL((size_t)T * 2048 * 4);

constexpr int CW_COUNT = 4096;
constexpr int CW_ZROW = 5120;
constexpr int CW_CHK = 4160;

#define XB_TMO      128
#define XB_XCNT(j)  (256  + 64 * (j))
#define XB_XSUB(j)  (1280 + 64 * (j))
#define XB_XGEN(j)  (2304 + 64 * (j))
#define XB_TOP      3328
#define XB_TOPGEN   3392
#define XCD_BAR_WORDS 3456
#define XB_SPIN_CAP (1u << 18)

__device__ __forceinline__ unsigned xb_ld(unsigned* p)              { return __hip_atomic_load(p, __ATOMIC_RELAXED, __HIP_MEMORY_SCOPE_AGENT); }
__device__ __forceinline__ unsigned xb_add(unsigned* p, unsigned v) { return __hip_atomic_fetch_add(p, v, __ATOMIC_RELAXED, __HIP_MEMORY_SCOPE_AGENT); }
__device__ __forceinline__ unsigned xb_xcc_id() { return (unsigned)__builtin_amdgcn_s_getreg((3 << 11) | 20) & 0xFu; }
#define XB_SPIN(cond, bar) do { unsigned _sp = 0; while (cond) { __builtin_amdgcn_s_sleep(1); \
    if ((++_sp & 255u) == 0u) { if (xb_ld(&(bar)[XB_TMO])) break; if (_sp > XB_SPIN_CAP) { atomicAdd(&(bar)[XB_TMO], 1u); break; } } } } while (0)

struct XcdBarrier { unsigned* bar; unsigned x; volatile LAS unsigned* st; };

__device__ __forceinline__ XcdBarrier xcd_barrier_post(unsigned* bar, volatile LAS unsigned* st) {
    XcdBarrier b; b.bar = bar; b.x = xb_xcc_id(); b.st = st;
    if (threadIdx.x == 0) st[2] = xb_add(&bar[XB_XCNT(b.x)], 1u);
    return b;
}
__device__ __forceinline__ void xcd_barrier_complete(unsigned* bar, unsigned x, unsigned& nloc, unsigned& nx) {
    const unsigned G = gridDim.x * gridDim.y * gridDim.z;
    unsigned sum, cnt, mine, sp = 0u;
    for (;;) {
        sum = 0u; cnt = 0u; mine = 0u;
#pragma unroll
        for (unsigned j = 0; j < 16; ++j) { const unsigned c = xb_ld(&bar[XB_XCNT(j)]); sum += c; cnt += (c > 0u) ? 1u : 0u; mine = (j == x) ? c : mine; }
        if (sum == G) break;
        __builtin_amdgcn_s_sleep(1);
        if ((++sp & 255u) == 0u) { if (xb_ld(&bar[XB_TMO])) break; if (sp > XB_SPIN_CAP) { atomicAdd(&bar[XB_TMO], 1u); break; } }
    }
    nloc = mine > 0u ? mine : 1u; nx = cnt > 0u ? cnt : 1u;
}
__device__ __forceinline__ void xcd_barrier(const XcdBarrier& b) {
    asm volatile("s_waitcnt vmcnt(0)" ::: "memory");
    __syncthreads();
    if (threadIdx.x == 0) {
        unsigned* bar = b.bar;
        __builtin_amdgcn_s_waitcnt(0);
        unsigned nloc = b.st[0], nx = b.st[1];
        if (nloc == 0u) { xcd_barrier_complete(bar, b.x, nloc, nx); b.st[0] = nloc; b.st[1] = nx; }
        const unsigned old = xb_add(&bar[XB_XSUB(b.x)], 1u);
        const unsigned gen = old / nloc;
        if (old + 1u == (gen + 1u) * nloc) {
            __builtin_amdgcn_fence(__ATOMIC_RELEASE, "agent");
            asm volatile("s_waitcnt vmcnt(0)" ::: "memory");
            const unsigned og = xb_add(&bar[XB_TOP], 1u);
            const unsigned tg = og / nx;
            if (og + 1u == (tg + 1u) * nx) xb_add(&bar[XB_TOPGEN], 1u);
            else XB_SPIN(xb_ld(&bar[XB_TOPGEN]) == tg, bar);
            __builtin_amdgcn_fence(__ATOMIC_ACQUIRE, "agent");
            xb_add(&bar[XB_XGEN(b.x)], 1u);
            asm volatile("s_waitcnt vmcnt(0)" ::: "memory");
        } else {
            XB_SPIN(xb_ld(&bar[XB_XGEN(b.x)]) == gen, bar);
            __builtin_amdgcn_fence(__ATOMIC_ACQUIRE, "agent");
            asm volatile("s_waitcnt vmcnt(0)" ::: "memory");
        }
    }
    __syncthreads();
}

__device__ __forceinline__ bf16_t f2bf(float f) { unsigned u = __float_as_uint(f); u += 0x7FFFu + ((u >> 16) & 1u); return (bf16_t)(u >> 16); }
__device__ __forceinline__ float bf2f(bf16_t b) { return __uint_as_float(((unsigned)b) << 16); }
typedef __bf16 bf16x2_t __attribute__((ext_vector_type(2)));
typedef float f32x2_t __attribute__((ext_vector_type(2)));
__device__ __forceinline__ unsigned pack2(float lo, float hi) { const f32x2_t v = {lo, hi}; return __builtin_bit_cast(unsigned, __builtin_convertvector(v, bf16x2_t)); }
__device__ __forceinline__ float wave_sum(float v) {
#pragma unroll
    for (int o = 32; o > 0; o >>= 1) v += __shfl_xor(v, o);
    return v;
}
__device__ __forceinline__ float xmax16(float x) { const unsigned u = __builtin_bit_cast(unsigned, x); const auto r = __builtin_amdgcn_permlane16_swap(u, u, false, false); return fmaxf(__builtin_bit_cast(float, r[0]), __builtin_bit_cast(float, r[1])); }
__device__ __forceinline__ float xmax32(float x) { const unsigned u = __builtin_bit_cast(unsigned, x); const auto r = __builtin_amdgcn_permlane32_swap(u, u, false, false); return fmaxf(__builtin_bit_cast(float, r[0]), __builtin_bit_cast(float, r[1])); }
__device__ __forceinline__ float xsum16(float x) { const unsigned u = __builtin_bit_cast(unsigned, x); const auto r = __builtin_amdgcn_permlane16_swap(u, u, false, false); return __builtin_bit_cast(float, r[0]) + __builtin_bit_cast(float, r[1]); }
__device__ __forceinline__ float xsum32(float x) { const unsigned u = __builtin_bit_cast(unsigned, x); const auto r = __builtin_amdgcn_permlane32_swap(u, u, false, false); return __builtin_bit_cast(float, r[0]) + __builtin_bit_cast(float, r[1]); }
__device__ __forceinline__ float sigmoidf_(float x) { return 1.0f / (1.0f + __expf(-x)); }

constexpr int B_RS = 544, A_ST = 256 * 128, B_ST = 64 * B_RS, STAGE = A_ST + B_ST;
constexpr int GEMM_LDS = 2 * STAGE;
constexpr int SSD_LDS = 147456;
constexpr int MAIN_LDS = SSD_LDS > GEMM_LDS ? SSD_LDS : GEMM_LDS;
constexpr int LDS_BYTES = MAIN_LDS + 64;

template <bool PAIRED, class Prov>
__device__ __forceinline__ void gemm_stream(LAS char* lds, Prov& P, const int K) {
    typedef typename Prov::AL ALd; typedef typename Prov::BL BLd; typedef typename Prov::EP EPt;
    ALd al; BLd bl; EPt ep;
    if (!P.next(al, bl)) return;
    P.make_ep(ep);
    const int tid = threadIdx.x, lane = tid & 63, wid = __builtin_amdgcn_readfirstlane(tid >> 6);
    const int wr = wid >> 1, wc = wid & 1, fr = lane & 15, fq = lane >> 4;
    int nvalid_next = 256;
    bool wave_on = true;
    if constexpr (Prov::MASKED) { nvalid_next = __builtin_amdgcn_readfirstlane(P.rows_valid()); wave_on = wr * 64 < nvalid_next; }
    const char* abase = (const char*)al.wsbase;
    unsigned aoff[4];
    const int bk0 = tid >> 6;
    unsigned ldb4, boff;
    __amdgpu_buffer_rsrc_t rsb;
    const __amdgpu_buffer_rsrc_t rsa = __builtin_amdgcn_make_buffer_rsrc((void*)abase, 0, 0x7fffffff, 0x00020000);
#define SET_SRC(al_, bl_) do { \
        _Pragma("unroll") for (int j = 0; j < 4; ++j) aoff[j] = (unsigned)((const char*)((al_).row(32 * wid + 8 * j + (lane >> 3)) + ((lane & 7) ^ (lane >> 3)) * 8) - abase); \
        rsb = __builtin_amdgcn_make_buffer_rsrc((void*)(bl_).base, 0, 0x7fffffff, 0x00020000); \
        ldb4 = (unsigned)(bl_).ldb * 4u; boff = (unsigned)(bl_).coloff(4 * (tid & 63)) * 4u + (unsigned)(tid >> 6) * ldb4; } while (0)
    SET_SRC(al, bl);
    unsigned atile = 0u, btile = 0u;
    u32x4 ra[4]; float4 rb[8];
#define LD_CHUNK(c) do { if ((c) < 8) { const u32x4 t_ = __builtin_amdgcn_raw_buffer_load_b128(rsb, (int)boff, (int)(btile + (unsigned)(8 * ((c) & 7)) * ldb4), 0); rb[(c) & 7] = __builtin_bit_cast(float4, t_); } \
        else ra[(c) & 3] = __builtin_amdgcn_raw_buffer_load_b128(rsa, (int)aoff[(c) & 3], (int)atile, 0); } while (0)
#define WR_CHUNK(c, buf) do { if ((c) < 8) *(LAS u32x2*)(lds + (buf) * STAGE + A_ST + bw_off + ((((c) & 7) & 1) * 4 + (((c) & 7) >> 1) * 16) * B_RS) = (u32x2){pack2(rb[(c) & 7].x, rb[(c) & 7].y), pack2(rb[(c) & 7].z, rb[(c) & 7].w)}; \
        else *(LAS u32x4*)(lds + (buf) * STAGE + (4 * wid + ((c) & 3)) * 1024 + lane * 16) = ra[(c) & 3]; } while (0)
#define ADVANCE() do { atile += ALd::kstep; btile += 64u * ldb4; } while (0)
    f32x4 acc[4][8];
    const int nk = K / 64;
    const int a_off0 = (wr * 64 + fr) * 128 + ((fq ^ (fr & 7)) * 16);
    const int br_off = A_ST + (((fq & 1) * 4 + (fq >> 1) * 16 + ((lane & 15) >> 2)) * B_RS) + (wc * 128 + 4 * (lane & 3)) * 2;
    const int bw_off = ((bk0 & 3) + ((bk0 >> 2) << 3)) * B_RS + (tid & 63) * 8;
#pragma unroll
    for (int c = 0; c < 12; ++c) LD_CHUNK(c);
    ADVANCE();
#pragma unroll
    for (int c = 0; c < 12; ++c) { WR_CHUNK(c, 0); LD_CHUNK(c); }
    int ldt = 1;
    if (2 < nk) { ADVANCE(); ldt = 2; }
    __syncthreads();
    for (;;) {
#pragma unroll
        for (int m = 0; m < 4; ++m)
#pragma unroll
            for (int n = 0; n < 8; ++n) acc[m][n] = (f32x4){0.f, 0.f, 0.f, 0.f};
        bool has_next = false;
        if constexpr (Prov::MASKED) { if (!wave_on) {
            for (int kt = 0; kt < nk; ++kt) {
                if (kt == nk - 2) { ALd aln; BLd bln; has_next = P.next(aln, bln);
                    if (has_next) { SET_SRC(aln, bln); atile = 0u; btile = 0u; ldt = 0; nvalid_next = __builtin_amdgcn_readfirstlane(P.rows_valid()); } }
                const int buf = kt & 1;
#pragma unroll
                for (int st = 0; st < 12; ++st) { WR_CHUNK(st, buf ^ 1); LD_CHUNK(st); }
                if (ldt + 1 < nk) { ADVANCE(); ++ldt; }
                __syncthreads();
            }
        } }
        if (!Prov::MASKED || wave_on)
        for (int kt = 0; kt < nk; ++kt) {
            if constexpr (!Prov::SINGLE) { if (kt == nk - 2) { ALd aln; BLd bln; has_next = P.next(aln, bln);
                if (has_next) { SET_SRC(aln, bln); atile = 0u; btile = 0u; ldt = 0; if constexpr (Prov::MASKED) nvalid_next = __builtin_amdgcn_readfirstlane(P.rows_valid()); } } }
            const int buf = kt & 1;
            LAS char* sbase = lds + buf * STAGE;
            s16x8 af[4]; s16x4 tq[4][2];
#define RD_B(slot, st_) do { tq[slot][0] = __builtin_amdgcn_ds_read_tr16_b64_v4i16((LAS s16x4*)(sbase + br_off + ((st_) >> 3) * 32 * B_RS + ((st_) & 7) * 32)); \
                             tq[slot][1] = __builtin_amdgcn_ds_read_tr16_b64_v4i16((LAS s16x4*)(sbase + br_off + ((st_) >> 3) * 32 * B_RS + ((st_) & 7) * 32 + 8 * B_RS)); } while (0)
#pragma unroll
            for (int m = 0; m < 4; ++m) af[m] = *(const LAS s16x8*)(sbase + a_off0 + m * 16 * 128);
            RD_B(0, 0); RD_B(1, 1); RD_B(2, 2);
            __builtin_amdgcn_sched_barrier(0);
#pragma unroll
            for (int st = 0; st < 16; ++st) {
                const int n = st & 7;
                if (st + 3 < 16) RD_B((st + 3) & 3, st + 3);
                const s16x8 bfr = {tq[st & 3][0][0], tq[st & 3][0][1], tq[st & 3][0][2], tq[st & 3][0][3], tq[st & 3][1][0], tq[st & 3][1][1], tq[st & 3][1][2], tq[st & 3][1][3]};
#pragma unroll
                for (int m = 0; m < 4; ++m) acc[m][n] = __builtin_amdgcn_mfma_f32_16x16x32_bf16(bfr, af[m], acc[m][n], 0, 0, 0);
                if (st == 7) {
#pragma unroll
                    for (int m = 0; m < 4; ++m) af[m] = *(const LAS s16x8*)(sbase + (a_off0 ^ 64) + m * 16 * 128);
                }
                if (st < 12) { WR_CHUNK(st, buf ^ 1); LD_CHUNK(st); }
                if (st & 1) __builtin_amdgcn_sched_barrier(0);
            }
#undef RD_B
            if (ldt + 1 < nk) { ADVANCE(); ++ldt; }
            __syncthreads();
        }
        if (!Prov::MASKED || wave_on)
#pragma unroll
        for (int m = 0; m < 4; ++m) {
            const int r = wr * 64 + m * 16 + fr;
            if constexpr (PAIRED) {
#pragma unroll
                for (int n = 0; n < 4; ++n) ep.pair(r, wc * 64 + n * 16 + 4 * fq, acc[m][n], acc[m][n + 4]);
            } else {
#pragma unroll
                for (int n = 0; n < 8; ++n) ep(r, wc * 128 + n * 16 + 4 * fq, acc[m][n]);
            }
        }
        if (!has_next) break;
        P.make_ep(ep);
        if constexpr (Prov::MASKED) wave_on = wr * 64 < nvalid_next;
    }
#undef LD_CHUNK
#undef WR_CHUNK
#undef ADVANCE
#undef SET_SRC
}

template <class Maker> struct PatchProv {
    static constexpr bool SINGLE = false, MASKED = Maker::MASKED;
    __device__ __forceinline__ int rows_valid() const { return mk.rows_valid(cRT); }
    typedef typename Maker::AL AL; typedef typename Maker::BL BL; typedef typename Maker::EP EP;
    Maker mk; int nR, nC, npc, npatch, nlab, nsl, pidx, slot, slot0, nfull, rem;
    __device__ __forceinline__ void init(int nR_, int nC_, int G, int bid) { nR = nR_; nC = nC_; nlab = (G % 8 == 0) ? 8 : 1; nsl = G / nlab; npc = (nC + 7) >> 3; npatch = ((nR + 3) >> 2) * npc;
        nfull = npatch; rem = 0;
        if constexpr (MASKED) { const int r = npatch % nlab; if (r > 0 && 2 * r <= nlab) { nfull = npatch - r; rem = r; npatch = nfull + 2 * r; } }
        pidx = bid / nsl; slot0 = bid % nsl; slot = slot0; if (pidx >= nlab) { pidx = npatch; } }
    int cRT, cCT;
    __device__ __forceinline__ bool next(AL& al, BL& bl) {
        while (pidx < npatch) {
            int pp = pidx, hcode = 0;
            if (MASKED && pidx >= nfull) { const int hp = pidx - nfull; pp = nfull + hp % rem; hcode = 1 + hp / rem; }
            while (slot < 32) { const int RT = (pp / npc) * 4 + (slot >> 3), CT = (pp % npc) * 8 + (slot & 7); slot += nsl;
                if (RT < nR && CT < nC) { cRT = RT | (hcode << 16); cCT = CT; mk.make_src(cRT, CT, al, bl); return true; } }
            pidx += nlab; slot = slot0; }
        return false; }
    __device__ __forceinline__ void make_ep(EP& ep) const { mk.make_ep(cRT, cCT, ep); } };

constexpr int KV_RS = 144, KT_BYTES = 64 * KV_RS;
constexpr int ATT_IMP_OFF = 8 * KT_BYTES;
constexpr int ATT_MASK_OFF = ATT_IMP_OFF + 64 * 64 * 4;
typedef float f32x16 __attribute__((ext_vector_type(16)));
struct GState32 { f32x16 o[2]; float m, l, nref; };
__device__ __forceinline__ float xchg32(float x) { const unsigned u = __builtin_bit_cast(unsigned, x); const auto r = __builtin_amdgcn_permlane32_swap(u, u, false, false);
    return __builtin_bit_cast(float, (threadIdx.x & 32) ? r[0] : r[1]); }

template <int MODE>
__device__ __forceinline__ void attn_block32(const LAS char* kt, const LAS char* vt, const int lane, const s16x8 (&qf)[4], GState32& st,
                                             const bool act, const int key0, const int lo, const int hi, LAS float* imp, const int tl, float& carry, const int jb) {
    const int c32 = lane & 31, h = lane >> 5;
    f32x16 s[2];
    const float cval = (MODE == 0) ? (act ? st.nref : -INFINITY) : 0.f;
    const f32x16 cin = {cval, cval, cval, cval, cval, cval, cval, cval, cval, cval, cval, cval, cval, cval, cval, cval};
#pragma unroll
    for (int k2 = 0; k2 < 2; ++k2) {
        s16x8 kf[4];
#pragma unroll
        for (int ds = 0; ds < 4; ++ds) kf[ds] = *(const LAS s16x8*)(kt + (32 * k2 + c32) * KV_RS + (16 * ds + 8 * h) * 2);
        s[k2] = __builtin_amdgcn_mfma_f32_32x32x16_bf16(kf[0], qf[0], cin, 0, 0, 0);
#pragma unroll
        for (int ds = 1; ds < 4; ++ds) s[k2] = __builtin_amdgcn_mfma_f32_32x32x16_bf16(kf[ds], qf[ds], s[k2], 0, 0, 0);
    }
    const bool needmask = !__all((lo <= key0) & (hi >= key0 + 63));
    if (needmask) {
#pragma unroll
        for (int k2 = 0; k2 < 2; ++k2)
#pragma unroll
            for (int i = 0; i < 16; ++i) { const int key = key0 + 32 * k2 + 8 * (i >> 2) + 4 * h + (i & 3); s[k2][i] = (key >= lo && key <= hi) ? s[k2][i] : -INFINITY; }
    }
    float mx = -INFINITY;
#pragma unroll
    for (int k2 = 0; k2 < 2; ++k2)
#pragma unroll
        for (int i = 0; i < 16; ++i) mx = fmaxf(mx, s[k2][i]);
    if (MODE == 0) {
        mx = fmaxf(mx, xchg32(mx));
        const bool slow = (mx > 8.f) || (st.m == -INFINITY && mx != -INFINITY);
        if (__any(slow)) {
            const float mnew = fmaxf(st.m, mx - st.nref);
            const float alpha = (mnew == -INFINITY) ? 1.0f : __builtin_amdgcn_exp2f(st.m - mnew);
            const float d = (mnew == -INFINITY) ? 0.f : mnew + st.nref;
#pragma unroll
            for (int k2 = 0; k2 < 2; ++k2)
#pragma unroll
                for (int i = 0; i < 16; ++i) s[k2][i] -= d;
            st.o[0] *= alpha; st.o[1] *= alpha; st.l *= alpha;
            st.m = mnew; st.nref = (mnew == -INFINITY) ? 0.f : -mnew;
        }
        float rs = 0.f;
#pragma unroll
        for (int k2 = 0; k2 < 2; ++k2)
#pragma unroll
            for (int i = 0; i < 16; ++i) { const float pv = __builtin_amdgcn_exp2f(s[k2][i]); s[k2][i] = pv; rs += pv; }
        rs += xchg32(rs); st.l += rs;
    } else {
    mx = act ? mx : -INFINITY;
    float msafe, scale = 1.0f;
    if (MODE == 2) { msafe = (st.m == -INFINITY) ? 0.f : st.m; scale = st.l; }
    else {
        mx = fmaxf(mx, xchg32(mx));
        const float mnew = fmaxf(st.m, mx);
        const float alpha = (mnew == -INFINITY) ? 1.0f : __builtin_amdgcn_exp2f(st.m - mnew);
        msafe = (mnew == -INFINITY) ? 0.f : mnew;
        st.m = mnew; st.l *= alpha;
    }
    msafe = act ? msafe : INFINITY;
    float rs = 0.f;
#pragma unroll
    for (int k2 = 0; k2 < 2; ++k2)
#pragma unroll
        for (int i = 0; i < 16; ++i) { const float pv = (MODE == 2) ? __builtin_amdgcn_exp2f(s[k2][i] - msafe) * scale : __builtin_amdgcn_exp2f(s[k2][i] - msafe); s[k2][i] = pv; rs += pv; }
    if (MODE != 2) { rs += xchg32(rs); st.l += rs; }
    }
    if (MODE == 2) {
#pragma unroll
        for (int k2 = 0; k2 < 2; ++k2)
#pragma unroll
            for (int ig = 0; ig < 4; ++ig) {
                const float prevreg = ig > 0 ? s[k2][4 * (ig > 0 ? ig - 1 : 0) + 3] : (k2 > 0 ? s[0][15] : carry);
                const float recv = xchg32(h ? prevreg : s[k2][4 * ig + 3]);
                float part = 32.f * (s[k2][4 * ig] + s[k2][4 * ig + 1] + s[k2][4 * ig + 2]) + 16.f * s[k2][4 * ig + 3] + 16.f * recv;
                part += __shfl_xor(part, 1); part += __shfl_xor(part, 2);
                if ((c32 & 3) == 0) imp[tl * 64 + 16 * jb + 8 * k2 + 2 * ig + h] = part;
            }
        carry = s[1][15];
    }
    if (MODE != 1) {
        const int blk = (lane >> 4) & 1, q = (lane & 15) >> 2, p = lane & 3;
#pragma unroll
        for (int k2 = 0; k2 < 2; ++k2)
#pragma unroll
            for (int sk = 0; sk < 2; ++sk) {
                const u32x4 w = {pack2(s[k2][8 * sk + 0], s[k2][8 * sk + 1]), pack2(s[k2][8 * sk + 2], s[k2][8 * sk + 3]), pack2(s[k2][8 * sk + 4], s[k2][8 * sk + 5]), pack2(s[k2][8 * sk + 6], s[k2][8 * sk + 7])};
                const s16x8 pf = __builtin_bit_cast(s16x8, w);
#pragma unroll
                for (int dt = 0; dt < 2; ++dt) { const int base = 32 * k2 + 16 * sk;
                    const s16x4 t0 = __builtin_amdgcn_ds_read_tr16_b64_v4i16((LAS s16x4*)(vt + (base + 4 * h + q) * KV_RS + (32 * dt + 16 * blk + 4 * p) * 2));
                    const s16x4 t1 = __builtin_amdgcn_ds_read_tr16_b64_v4i16((LAS s16x4*)(vt + (base + 8 + 4 * h + q) * KV_RS + (32 * dt + 16 * blk + 4 * p) * 2));
                    const s16x8 vf = {t0[0], t0[1], t0[2], t0[3], t1[0], t1[1], t1[2], t1[3]};
                    st.o[dt] = __builtin_amdgcn_mfma_f32_32x32x16_bf16(vf, pf, st.o[dt], 0, 0, 0); }
            }
    }
}

#define ATT_GLOAD(Kg, Vg, stg) do { const size_t _o = ((size_t)(stg) * 128 + (tid >> 3)) * 256 + g * 64 + (tid & 7) * 8; rk0 = *(const u32x4*)((Kg) + _o); rv0 = *(const u32x4*)((Vg) + _o); \
        rk1 = *(const u32x4*)((Kg) + _o + 64 * 256); rv1 = *(const u32x4*)((Vg) + _o + 64 * 256); __builtin_amdgcn_sched_barrier(0); } while (0)
#define ATT_SWRITE(stg) do { LAS char* _k = lds + ((stg) & 1) * 4 * KT_BYTES + (tid >> 3) * KV_RS + (tid & 7) * 16; *(LAS u32x4*)_k = rk0; *(LAS u32x4*)(_k + KT_BYTES) = rv0; \
        *(LAS u32x4*)(_k + 2 * KT_BYTES) = rk1; *(LAS u32x4*)(_k + 3 * KT_BYTES) = rv1; } while (0)
#define ATT_RUN(MODE, Kg, Vg, jlo, jhi, COND, ACT) do { const int _s0 = (jlo) >> 1, _s1 = (jhi) >> 1; \
        ATT_GLOAD(Kg, Vg, _s0); ATT_SWRITE(_s0); __syncthreads(); \
        for (int _s = _s0; _s <= _s1; ++_s) { \
            if (_s + 1 <= _s1) ATT_GLOAD(Kg, Vg, _s + 1); \
            _Pragma("unroll") for (int _q = 0; _q < 2; ++_q) { const int j = 2 * _s + _q; \
                if (j >= (jlo) && j <= (jhi) && (COND)) { act = (ACT); \
                    const LAS char* _kt = lds + (_s & 1) * 4 * KT_BYTES + _q * 2 * KT_BYTES; \
                    attn_block32<MODE>(_kt, _kt + KT_BYTES, lane, qf, st, act, 64 * j, lo, hi, imp, tl, carry, j); } } \
            if (_s + 1 <= _s1) ATT_SWRITE(_s + 1); \
            __syncthreads(); } } while (0)

__device__ __forceinline__ void nsa_unit32(LAS char* lds, const int unit, const bf16_t* QB, const bf16_t* KS, const bf16_t* VS, const bf16_t* KW, const bf16_t* VW,
                                           const bf16_t* KCB, const bf16_t* VCB, const float* GATEp, bf16_t* MIX) {
    const int tid = threadIdx.x, lane = tid & 63, wid = tid >> 6, c32 = lane & 31, h = lane >> 5;
    const int qt = unit >> 3, b = (unit >> 2) & 1, g = unit & 3;
    const int t0 = qt * 64;
    LAS float* imp = (LAS float*)(lds + ATT_IMP_OFF);
    LAS unsigned* lmask = (LAS unsigned*)(lds + ATT_MASK_OFF);
    const int tl = 8 * wid + (c32 >> 2), tpos = t0 + tl, hq = g * 4 + (c32 & 3);
    const size_t tt = (size_t)b * SEQ + tpos;
    s16x8 qf[4]; float gate[3];
#pragma unroll
    for (int ds = 0; ds < 4; ++ds) qf[ds] = *(const s16x8*)(QB + tt * 1024 + hq * 64 + 16 * ds + 8 * h);
    { const float* gl = GATEp + tt * 48 + hq * 3; gate[0] = gl[0]; gate[1] = gl[1]; gate[2] = gl[2]; }
    for (int i = tid; i < 64 * 64; i += 512) imp[i] = 0.f;
    f32x16 res[2];
    GState32 st; bool act; int lo, hi; float carry = 0.f;
    u32x4 rk0, rv0, rk1, rv1;
    const bf16_t* KCg = KCB + (size_t)b * 256 * 256; const bf16_t* VCg = VCB + (size_t)b * 256 * 256;
    const bf16_t* KSg = KS + (size_t)b * SEQ * 256; const bf16_t* VSg = VS + (size_t)b * SEQ * 256;
    const bf16_t* KWg = KW + (size_t)b * SEQ * 256; const bf16_t* VWg = VW + (size_t)b * SEQ * 256;
#define ST_RESET() do { st.m = -INFINITY; st.l = 0.f; st.nref = 0.f; _Pragma("unroll") for (int i_ = 0; i_ < 16; ++i_) { st.o[0][i_] = 0.f; st.o[1][i_] = 0.f; } } while (0)
    const int cmax_u = (t0 + 63 - 31) >> 4;
    const int ncb = cmax_u < 0 ? 0 : min(4, (cmax_u + 1) / 64 + 1);
    act = true; lo = 0; hi = tpos >= 31 ? ((tpos - 31) >> 4) : -1; ST_RESET();
    __syncthreads();
    if (ncb > 0) {
        ATT_RUN(1, KCg, VCg, 0, ncb - 1, true, true);
        st.l = st.l > 0.f ? 1.0f / st.l : 0.f;
        ATT_RUN(2, KCg, VCg, 0, ncb - 1, true, true);
    }
    res[0] = st.o[0] * gate[0]; res[1] = st.o[1] * gate[0];
    __syncthreads();
    for (int k = 0; k < 8; ++k) {
        const int tk = 8 * wid + k, j = lane;
        const float iv = imp[tk * 64 + j];
        const bool forced = (j == 0) || (j == qt) || (j == qt - 1), valid = j <= qt;
        const float sc = forced ? 1.0e4f : (valid ? iv : -1.0e4f);
        const unsigned ub = __float_as_uint(sc + 0.0f), key = (ub & 0x80000000u) ? ~ub : (ub | 0x80000000u);
        const unsigned long long K = ((unsigned long long)key << 32) | (unsigned)(63 - j);
        int rank = 0;
#pragma unroll
        for (int kk = 0; kk < 64; ++kk) { const unsigned long long O = ((unsigned long long)(unsigned)__builtin_amdgcn_readlane((int)key, kk) << 32) | (unsigned)(63 - kk); rank += (O > K) ? 1 : 0; }
        const unsigned long long m64 = __ballot(rank < 16 && valid);
        if (lane == 0) { lmask[tk * 2] = (unsigned)m64; lmask[tk * 2 + 1] = (unsigned)(m64 >> 32); }
    }
    __syncthreads();
    const unsigned long long msk = (unsigned long long)lmask[tl * 2] | ((unsigned long long)lmask[tl * 2 + 1] << 32);
    unsigned long long wunion;
    { unsigned ul = (unsigned)msk, uh = (unsigned)(msk >> 32);
#pragma unroll
      for (int o = 1; o < 64; o <<= 1) { ul |= __shfl_xor(ul, o); uh |= __shfl_xor(uh, o); }
      wunion = (unsigned long long)ul | ((unsigned long long)uh << 32); }
    lo = 0; hi = tpos; ST_RESET();
    ATT_RUN(0, KSg, VSg, 0, qt, (wunion >> j) & 1ull, (msk >> j) & 1ull);
    { const float il = gate[1] / fmaxf(st.l, 1e-30f); res[0] += st.o[0] * il; res[1] += st.o[1] * il; }
    act = true; lo = tpos - 511; hi = tpos; ST_RESET();
    const int jw0 = qt >= 8 ? qt - 8 : 0;
    ATT_RUN(0, KWg, VWg, jw0, qt, true, true);
    { const float il = gate[2] / fmaxf(st.l, 1e-30f);
      bf16_t* mp = MIX + tt * 2048 + 1024 + hq * 64 + 4 * h;
#pragma unroll
      for (int dt = 0; dt < 2; ++dt)
#pragma unroll
          for (int ig = 0; ig < 4; ++ig) { const int i0 = 4 * ig;
              const float r0 = res[dt][i0] + st.o[dt][i0] * il, r1 = res[dt][i0 + 1] + st.o[dt][i0 + 1] * il, r2 = res[dt][i0 + 2] + st.o[dt][i0 + 2] * il, r3 = res[dt][i0 + 3] + st.o[dt][i0 + 3] * il;
              *(uint2*)(mp + 32 * dt + 8 * ig) = make_uint2(pack2(r0, r1), pack2(r2, r3)); } }
#undef ST_RESET
}
#undef ATT_GLOAD
#undef ATT_SWRITE
#undef ATT_RUN


constexpr int SX_RS = 144, SX_H = 128 * SX_RS, SB_RS = 272, SB_BYTES = 128 * SB_RS;
constexpr int SSD_X_OFF = 0, SSD_B_OFF = 4 * SX_H, SSD_C_OFF = SSD_B_OFF + SB_BYTES, SSD_T_OFF = SSD_C_OFF + SB_BYTES;
static_assert(SSD_T_OFF + 4096 <= SSD_LDS, "ssd lds");

__device__ __forceinline__ u32x4 conv8_silu(const u32x4 (&tap)[4], const float* cw, const float* cb, const int chan, const int spos) {
    float acc[8];
    { const f32x4 b0 = *(const f32x4*)(cb + chan), b1 = *(const f32x4*)(cb + chan + 4); acc[0] = b0[0]; acc[1] = b0[1]; acc[2] = b0[2]; acc[3] = b0[3]; acc[4] = b1[0]; acc[5] = b1[1]; acc[6] = b1[2]; acc[7] = b1[3]; }
#pragma unroll
    for (int k = 0; k < 4; ++k) {
        const f32x4 w0 = *(const f32x4*)(cw + k * 2048 + chan), w1 = *(const f32x4*)(cw + k * 2048 + chan + 4);
        const float m = (spos - 3 + k >= 0) ? 1.0f : 0.0f;
#pragma unroll
        for (int e = 0; e < 4; ++e) { acc[2 * e] += m * (e < 2 ? w0[2 * e] : w1[2 * e - 4]) * __uint_as_float(tap[k][e] << 16); acc[2 * e + 1] += m * (e < 2 ? w0[2 * e + 1] : w1[2 * e - 3]) * __uint_as_float(tap[k][e] & 0xffff0000u); }
    }
    u32x4 o;
#pragma unroll
    for (int e = 0; e < 4; ++e) o[e] = pack2(acc[2 * e] * sigmoidf_(acc[2 * e]), acc[2 * e + 1] * sigmoidf_(acc[2 * e + 1]));
    return o;
}

template <bool WITH_C>
__device__ __forceinline__ void ssd_stage(LAS char* lds, const bf16_t* XBCR_, const float* cw, const float* cb, const float* DT, const float* a_log, const int b, const int c, const int grp) {
    const int tid = threadIdx.x;
    const size_t tt0 = (size_t)b * SEQ + c * 128;
    const int s0 = c * 128;
#define TAP_PTR(l_, k_, chan_) (XBCR_ + (size_t)((long)(tt0 + (l_)) - 3 + (k_) < 0 ? 0 : (long)(tt0 + (l_)) - 3 + (k_)) * 2048 + (chan_))
#pragma unroll 1
    for (int half = 0; half < 2; ++half) {
        u32x4 tp[4][4];
#pragma unroll
        for (int k4 = 0; k4 < 4; ++k4) { const int id = tid + 512 * (4 * half + k4), l = id >> 5, ch = id & 31;
#pragma unroll
            for (int k = 0; k < 4; ++k) tp[k4][k] = *(const u32x4*)TAP_PTR(l, k, grp * 256 + ch * 8); }
#pragma unroll
        for (int k4 = 0; k4 < 4; ++k4) { const int id = tid + 512 * (4 * half + k4), l = id >> 5, ch = id & 31, h = ch >> 3, pc = ch & 7;
            *(LAS u32x4*)(lds + SSD_X_OFF + h * SX_H + l * SX_RS + pc * 16) = conv8_silu(tp[k4], cw, cb, grp * 256 + ch * 8, s0 + l); }
    }
    {
        u32x4 tp[4][4];
#pragma unroll
        for (int k4 = 0; k4 < 4; ++k4) { const int id = tid + 512 * k4, l = id >> 4, ch = id & 15;
#pragma unroll
            for (int k = 0; k < 4; ++k) tp[k4][k] = *(const u32x4*)TAP_PTR(l, k, 1024 + grp * 128 + ch * 8); }
#pragma unroll
        for (int k4 = 0; k4 < 4; ++k4) { const int id = tid + 512 * k4, l = id >> 4, ch = id & 15;
            *(LAS u32x4*)(lds + SSD_B_OFF + l * SB_RS + ch * 16) = conv8_silu(tp[k4], cw, cb, 1024 + grp * 128 + ch * 8, s0 + l); }
    }
    if (WITH_C) {
        u32x4 tp[4][4];
#pragma unroll
        for (int k4 = 0; k4 < 4; ++k4) { const int id = tid + 512 * k4, l = id >> 4, ch = id & 15;
#pragma unroll
            for (int k = 0; k < 4; ++k) tp[k4][k] = *(const u32x4*)TAP_PTR(l, k, 1536 + grp * 128 + ch * 8); }
#pragma unroll
        for (int k4 = 0; k4 < 4; ++k4) { const int id = tid + 512 * k4, l = id >> 4, ch = id & 15;
            *(LAS u32x4*)(lds + SSD_C_OFF + l * SB_RS + ch * 16) = conv8_silu(tp[k4], cw, cb, 1536 + grp * 128 + ch * 8, s0 + l); }
    }
#undef TAP_PTR
    LAS float* dtl = (LAS float*)(lds + SSD_T_OFF); LAS float* acs = dtl + 512;
    const int h = tid >> 7, l = tid & 127;
    const float av = -expf(a_log[grp * 4 + h]);
    const float dtv = DT[(tt0 + l) * 16 + grp * 4 + h];
    dtl[tid] = dtv; acs[tid] = dtv * av;
    __syncthreads();
    float cs = acs[tid];
#pragma unroll
    for (int o = 1; o < 128; o <<= 1) { const float add = (l >= o) ? acs[tid - o] : 0.f; __syncthreads(); cs += add; acs[tid] = cs; __syncthreads(); }
}

__device__ __forceinline__ void ssd_states_item(LAS char* lds, const int item, const bf16_t* XBCB, const float* cw, const float* cb, const float* DT, const float* a_log, float* STATES, float* CHDEC) {
    const int tid = threadIdx.x, lane = tid & 63, wid = tid >> 6, c16 = lane & 15, fq = lane >> 4, q = c16 >> 2, pp = c16 & 3;
    const int grp = item & 3, c = (item >> 2) & 31, b = item >> 7;
    __syncthreads();
    ssd_stage<false>(lds, XBCB, cw, cb, DT, a_log, b, c, grp);
    LAS float* dtl = (LAS float*)(lds + SSD_T_OFF); LAS float* acs = dtl + 512;
#pragma unroll
    for (int k = 0; k < 8; ++k) { const int id = tid + 512 * k, l = id >> 5, ch = id & 31, h = ch >> 3, pc = ch & 7;
        const float w = __expf(acs[h * 128 + 127] - acs[h * 128 + l]) * dtl[h * 128 + l];
        LAS u32x4* pv = (LAS u32x4*)(lds + SSD_X_OFF + h * SX_H + l * SX_RS + pc * 16);
        u32x4 v = *pv;
#pragma unroll
        for (int e = 0; e < 4; ++e) { const float lo = __uint_as_float(v[e] << 16) * w, hi = __uint_as_float(v[e] & 0xffff0000u) * w; v[e] = pack2(lo, hi); }
        *pv = v; }
    if (tid < 4) CHDEC[((size_t)b * 32 + c) * 16 + grp * 4 + tid] = __expf(acs[tid * 128 + 127]);
    __syncthreads();
    s16x8 af[4];
#pragma unroll
    for (int ks = 0; ks < 4; ++ks) {
        const s16x4 t0 = __builtin_amdgcn_ds_read_tr16_b64_v4i16((LAS s16x4*)(lds + SSD_B_OFF + (32 * ks + 8 * fq + q) * SB_RS + (16 * wid + 4 * pp) * 2));
        const s16x4 t1 = __builtin_amdgcn_ds_read_tr16_b64_v4i16((LAS s16x4*)(lds + SSD_B_OFF + (32 * ks + 8 * fq + 4 + q) * SB_RS + (16 * wid + 4 * pp) * 2));
        af[ks] = (s16x8){t0[0], t0[1], t0[2], t0[3], t1[0], t1[1], t1[2], t1[3]};
    }
#pragma unroll
    for (int h = 0; h < 4; ++h) {
        float* sp = STATES + (((size_t)b * 32 + c) * 16 + grp * 4 + h) * 8192;
#pragma unroll
        for (int pt = 0; pt < 4; ++pt) {
            f32x4 acc = {0.f, 0.f, 0.f, 0.f};
#pragma unroll
            for (int ks = 0; ks < 4; ++ks) {
                const s16x4 t0 = __builtin_amdgcn_ds_read_tr16_b64_v4i16((LAS s16x4*)(lds + SSD_X_OFF + h * SX_H + (32 * ks + 8 * fq + q) * SX_RS + (16 * pt + 4 * pp) * 2));
                const s16x4 t1 = __builtin_amdgcn_ds_read_tr16_b64_v4i16((LAS s16x4*)(lds + SSD_X_OFF + h * SX_H + (32 * ks + 8 * fq + 4 + q) * SX_RS + (16 * pt + 4 * pp) * 2));
                const s16x8 bfr = {t0[0], t0[1], t0[2], t0[3], t1[0], t1[1], t1[2], t1[3]};
                acc = __builtin_amdgcn_mfma_f32_16x16x32_bf16(af[ks], bfr, acc, 0, 0, 0);
            }
            *(f32x4*)(sp + (size_t)(16 * pt + c16) * 128 + 16 * wid + 4 * fq) = acc;
        }
    }
}

__device__ __forceinline__ void ssd_out_item(LAS char* lds, const int item, const bf16_t* XBCB, const float* cw, const float* cb, const float* DT, const float* a_log, const float* d_skip, const float* nw,
                                             const bf16_t* PREV, const bf16_t* ZBp, float* YTMP, bf16_t* MIXO) {
    const int tid = threadIdx.x, lane = tid & 63, wid = tid >> 6, c16 = lane & 15, fq = lane >> 4, q = c16 >> 2, pp = c16 & 3;
    const int grp = item & 3, c = (item >> 2) & 31, b = item >> 7;
    __syncthreads();
    ssd_stage<true>(lds, XBCB, cw, cb, DT, a_log, b, c, grp);
    LAS float* dtl = (LAS float*)(lds + SSD_T_OFF); LAS float* acs = dtl + 512;
    const int lcol = 16 * wid + c16;
    const size_t tt = (size_t)b * SEQ + c * 128 + lcol;
    s16x8 cf[4];
#pragma unroll
    for (int ks = 0; ks < 4; ++ks) cf[ks] = *(const LAS s16x8*)(lds + SSD_C_OFF + lcol * SB_RS + (32 * ks + 8 * fq) * 2);
    f32x4 g[8];
#pragma unroll
    for (int mt = 0; mt < 8; ++mt) { g[mt] = (f32x4){0.f, 0.f, 0.f, 0.f};
        if (mt <= wid) {
#pragma unroll
            for (int ks = 0; ks < 4; ++ks) { const s16x8 bfr = *(const LAS s16x8*)(lds + SSD_B_OFF + (16 * mt + c16) * SB_RS + (32 * ks + 8 * fq) * 2);
                g[mt] = __builtin_amdgcn_mfma_f32_16x16x32_bf16(bfr, cf[ks], g[mt], 0, 0, 0); } } }
    float ss = 0.f;
#pragma unroll 1
    for (int h = 0; h < 4; ++h) {
        const int hh = grp * 4 + h;
        const float acs_l = acs[h * 128 + lcol];
        s16x8 pf[4];
#pragma unroll
        for (int ks = 0; ks < 4; ++ks) {
            float pv[2][4];
#pragma unroll
            for (int u = 0; u < 2; ++u) {
                const int s0 = 32 * ks + 16 * u + 4 * fq;
                const f32x4 av4 = *(const LAS f32x4*)(acs + h * 128 + s0), dv4 = *(const LAS f32x4*)(dtl + h * 128 + s0);
#pragma unroll
                for (int i = 0; i < 4; ++i) { const float e = __expf(fminf(acs_l - av4[i], 0.f)) * dv4[i]; pv[u][i] = (s0 + i <= lcol) ? g[2 * ks + u][i] * e : 0.f; }
            }
            const u32x4 w = {pack2(pv[0][0], pv[0][1]), pack2(pv[0][2], pv[0][3]), pack2(pv[1][0], pv[1][1]), pack2(pv[1][2], pv[1][3])};
            pf[ks] = __builtin_bit_cast(s16x8, w);
        }
        const float dsk = d_skip[hh], eal = __expf(acs_l);
        const bf16_t* prevp = PREV + (((size_t)b * 32 + c) * 16 + hh) * 8192;
        s16x8 pr[4][4]; f32x4 zz[4];
#pragma unroll
        for (int pt = 0; pt < 4; ++pt) {
#pragma unroll
            for (int ks = 0; ks < 4; ++ks) pr[pt][ks] = *(const s16x8*)(prevp + (size_t)(16 * pt + c16) * 128 + 32 * ks + 8 * fq);
            { const uint2 zr = *(const uint2*)(ZBp + tt * 1024 + hh * 64 + 16 * pt + 4 * fq); zz[pt] = (f32x4){__uint_as_float(zr.x << 16), __uint_as_float(zr.x & 0xffff0000u), __uint_as_float(zr.y << 16), __uint_as_float(zr.y & 0xffff0000u)}; }
        }
#pragma unroll
        for (int pt = 0; pt < 4; ++pt) {
            f32x4 yd = {0.f, 0.f, 0.f, 0.f}, yo = {0.f, 0.f, 0.f, 0.f};
#pragma unroll
            for (int ks = 0; ks < 4; ++ks) {
                const s16x4 t0 = __builtin_amdgcn_ds_read_tr16_b64_v4i16((LAS s16x4*)(lds + SSD_X_OFF + h * SX_H + (32 * ks + 4 * fq + q) * SX_RS + (16 * pt + 4 * pp) * 2));
                const s16x4 t1 = __builtin_amdgcn_ds_read_tr16_b64_v4i16((LAS s16x4*)(lds + SSD_X_OFF + h * SX_H + (32 * ks + 16 + 4 * fq + q) * SX_RS + (16 * pt + 4 * pp) * 2));
                const s16x8 xf = {t0[0], t0[1], t0[2], t0[3], t1[0], t1[1], t1[2], t1[3]};
                yd = __builtin_amdgcn_mfma_f32_16x16x32_bf16(xf, pf[ks], yd, 0, 0, 0);
                yo = __builtin_amdgcn_mfma_f32_16x16x32_bf16(pr[pt][ks], cf[ks], yo, 0, 0, 0);
            }
            const u32x2 xr = *(const LAS u32x2*)(lds + SSD_X_OFF + h * SX_H + lcol * SX_RS + (16 * pt + 4 * fq) * 2);
            const float xv[4] = {__uint_as_float(xr[0] << 16), __uint_as_float(xr[0] & 0xffff0000u), __uint_as_float(xr[1] << 16), __uint_as_float(xr[1] & 0xffff0000u)};
            const f32x4 z = zz[pt];
            f32x4 gvv;
#pragma unroll
            for (int i = 0; i < 4; ++i) { const float y = yd[i] + eal * yo[i] + dsk * xv[i]; gvv[i] = y * z[i] * sigmoidf_(z[i]); ss += gvv[i] * gvv[i]; }
            *(f32x4*)(YTMP + tt * 1024 + hh * 64 + 16 * pt + 4 * fq) = gvv;
        }
    }
    ss += __shfl_xor(ss, 16); ss += __shfl_xor(ss, 32);
    const float rs = rsqrtf(ss * (1.0f / 256.f) + NORM_EPS);
#pragma unroll 1
    for (int h = 0; h < 4; ++h) {
        f32x4 gq[4], wq[4];
#pragma unroll
        for (int pt = 0; pt < 4; ++pt) { const int ch = (grp * 4 + h) * 64 + 16 * pt + 4 * fq; wq[pt] = *(const f32x4*)(nw + ch); gq[pt] = *(const f32x4*)(YTMP + tt * 1024 + ch); }
#pragma unroll
        for (int pt = 0; pt < 4; ++pt) { const int ch = (grp * 4 + h) * 64 + 16 * pt + 4 * fq;
            *(uint2*)(MIXO + tt * 2048 + ch) = make_uint2(pack2(gq[pt][0] * rs * wq[pt][0], gq[pt][1] * rs * wq[pt][1]), pack2(gq[pt][2] * rs * wq[pt][2], gq[pt][3] * rs * wq[pt][3])); }
    }
}

struct Args {
    const float* in[23];
    float* out;
    unsigned char* ws;
    int ph_lo, ph_hi;
};

enum { PH_NORM1 = 0, PH_INPROJ, PH_SSD_CMP1, PH_GNORM_CMP2,
       PH_NSA,
       PH_OUTPROJ, PH_ROUTER, PH_SCATTER, PH_GATEUP, PH_DOWN, PH_FINAL, N_PHASES };

struct ARowsDense { static constexpr unsigned kstep = 128u; const bf16_t* base; size_t ld; int row0, nrows; const bf16_t* zrow; const void* wsbase;
    __device__ __forceinline__ const bf16_t* row(int r) const { const int g = row0 + r; return g < nrows ? base + (size_t)g * ld : zrow; } };
struct ARowsGather { static constexpr unsigned kstep = 128u; const bf16_t* base; size_t ld; const int* idx; const bf16_t* zrow; const void* wsbase; int nr;
    __device__ __forceinline__ const bf16_t* row(int r) const { const int g = r < nr ? idx[r] : -1; return g >= 0 ? base + (size_t)g * ld : zrow; } };
struct ARowsWindow { static constexpr unsigned kstep = 512u; const bf16_t* base; int row0; const bf16_t* zrow; const void* wsbase;
    __device__ __forceinline__ const bf16_t* row(int r) const { const int gr = row0 + r; if (gr >= CMP_ROWS) return zrow; const int g = gr & 3, n = (gr >> 2) % N_C, b = (gr >> 2) / N_C;
        return base + ((size_t)(b * SEQ + 16 * n)) * 256 + g * 64; } };
struct BColsDense { const float* base; int ldb; int col0, ncols;
    __device__ __forceinline__ int coloff(int n) const { const int c = col0 + n; return c < ncols ? c : ncols - 4; } };
struct BColsGateUp { const float* base; int ldb; int cn;
    __device__ __forceinline__ int coloff(int n) const { const int wc = n >> 7, nt = (n & 127) >> 4, w = n & 15; const int j = wc * 64 + (nt & 3) * 16 + w;
        return (nt < 4 ? 0 : DFF) + cn * 128 + j; } };

struct EpiStoreF32 { float* C; size_t ldc; int row0, col0, ncols;
    __device__ __forceinline__ void operator()(int r, int n, f32x4 v) const { const int c = col0 + n; if (c < ncols) *(f32x4*)(C + (size_t)(row0 + r) * ldc + c) = v; } };
struct EpiResidF32 { float* C; const float* X; size_t ldc; int row0, col0;
    __device__ __forceinline__ void operator()(int r, int n, f32x4 v) const { const size_t o = (size_t)(row0 + r) * ldc + col0 + n; const f32x4 x = *(const f32x4*)(X + o); *(f32x4*)(C + o) = v + x; } };
struct EpiSwiglu { bf16_t* O; const float* bias; int row0, cn;
    __device__ __forceinline__ void pair(int r, int j, f32x4 g, f32x4 u) const { const int c = cn * 128 + j; float o[4];
#pragma unroll
        for (int i = 0; i < 4; ++i) { float gv = g[i] + bias[c + i]; float uv = u[i] + bias[DFF + c + i]; gv = fminf(gv, 7.0f); uv = fminf(fmaxf(uv, -7.0f), 7.0f);
            const float glu = gv * sigmoidf_(1.702f * gv); o[i] = (uv + 1.0f) * glu; }
        *(uint2*)(O + (size_t)(row0 + r) * DFF + c) = make_uint2(pack2(o[0], o[1]), pack2(o[2], o[3])); } };
struct EpiBiasBf16 { bf16_t* O; const float* bias; int row0, col0;
    __device__ __forceinline__ void operator()(int r, int n, f32x4 v) const { const int c = col0 + n;
        *(uint2*)(O + (size_t)(row0 + r) * D + c) = make_uint2(pack2(v[0] + bias[c], v[1] + bias[c + 1]), pack2(v[2] + bias[c + 2], v[3] + bias[c + 3])); } };


struct EpiInProj { unsigned char* ws; const float* dt_bias; int row0, col0;
    __device__ __forceinline__ void operator()(int r, int n, f32x4 v) const {
        const int cb = __builtin_amdgcn_readfirstlane((col0 + n) & ~15);
        const int ci = (col0 + n) & 15;
        const size_t R = (size_t)(row0 + r); const int pos = (int)(R & (SEQ - 1));
        if (cb >= IN_PROJ) return;
        if (cb >= OFF_DT && cb < OFF_Q) { f32x4 o;
#pragma unroll
            for (int i = 0; i < 4; ++i) { const float x = v[i] + dt_bias[ci + i]; o[i] = x > 20.f ? x : log1pf(expf(x)); }
            *(f32x4*)((float*)(ws + WS_DT) + R * 16 + ci) = o; return; }
        if (cb >= OFF_GATE) { f32x4 o;
#pragma unroll
            for (int i = 0; i < 4; ++i) o[i] = sigmoidf_(v[i]);
            *(f32x4*)((float*)(ws + WS_GATE) + R * 48 + (cb - OFF_GATE) + ci) = o; return; }
        size_t boff; int ld, cc; bool rp = false; float scl = 1.0f;
        if (cb < OFF_XBC) { boff = WS_ZB; ld = 1024; cc = cb; }
        else if (cb < OFF_DT) { boff = WS_XBCR; ld = 2048; cc = cb - OFF_XBC; }
        else if (cb < OFF_KCMP) { boff = WS_QB; ld = 1024; cc = cb - OFF_Q; rp = true; scl = 0.125f * 1.4426950408889634f; }
        else if (cb < OFF_VCMP) { boff = WS_KCMP; ld = 256; cc = cb - OFF_KCMP; }
        else if (cb < OFF_KSLC) { boff = WS_VCMP; ld = 256; cc = cb - OFF_VCMP; }
        else if (cb < OFF_VSLC) { boff = WS_KS; ld = 256; cc = cb - OFF_KSLC; rp = true; }
        else if (cb < OFF_KWIN) { boff = WS_VS; ld = 256; cc = cb - OFF_VSLC; }
        else if (cb < OFF_VWIN) { boff = WS_KW; ld = 256; cc = cb - OFF_KWIN; rp = true; }
        else { boff = WS_VW; ld = 256; cc = cb - OFF_VWIN; }
        f32x4 o = v;
        if (rp && (cc & 63) == 0) {
            const float* rope = (const float*)(ws + WS_ROPE);
#pragma unroll
            for (int i = 0; i < 4; ++i) { const float pr = xchg32(v[i]); const int k = (ci & 7) + i; const float c = rope[pos * 8 + k], sn = rope[SEQ * 8 + pos * 8 + k];
                o[i] = (ci < 8) ? (v[i] * c - pr * sn) : (pr * sn + v[i] * c); }
        }
        *(uint2*)((bf16_t*)(ws + boff) + R * ld + cc + ci) = make_uint2(pack2(o[0] * scl, o[1] * scl), pack2(o[2] * scl, o[3] * scl));
    } };


__device__ __forceinline__ const bf16_t* zrow_of(unsigned char* ws) { return (const bf16_t*)((unsigned*)(ws + WS_CTL) + CW_ZROW); }
struct MkInProj { static constexpr bool MASKED = false; __device__ __forceinline__ int rows_valid(int) const { return 256; } typedef ARowsDense AL; typedef BColsDense BL; typedef EpiInProj EP; unsigned char* ws; const float* w; const float* dt_bias;
    __device__ __forceinline__ void make_src(int rt, int ct, AL& al, BL& bl) const { al = AL{(const bf16_t*)(ws + WS_XN), (size_t)D, rt * 256, T, zrow_of(ws), ws}; bl = BL{w, IN_PROJ, ct * 256, IN_PROJ}; }
    __device__ __forceinline__ void make_ep(int rt, int ct, EP& ep) const { ep = EP{ws, dt_bias, rt * 256, ct * 256}; } };
struct MkOutProj { static constexpr bool MASKED = false; __device__ __forceinline__ int rows_valid(int) const { return 256; } typedef ARowsDense AL; typedef BColsDense BL; typedef EpiResidF32 EP; unsigned char* ws; const float* w; const float* x;
    __device__ __forceinline__ void make_src(int rt, int ct, AL& al, BL& bl) const { al = AL{(const bf16_t*)(ws + WS_MIX), (size_t)2048, rt * 256, T, zrow_of(ws), ws}; bl = BL{w, D, ct * 256, D}; }
    __device__ __forceinline__ void make_ep(int rt, int ct, EP& ep) const { ep = EP{(float*)(ws + WS_X2), x, (size_t)D, rt * 256, ct * 256}; } };
constexpr int TT_OFF = GEMM_LDS;
__device__ __forceinline__ int moe_tile_table(LAS char* lds, const unsigned* cnt) {
    LAS int* tt = (LAS int*)(lds + TT_OFF); LAS int* tmp = tt + 480;
    const int tid = threadIdx.x;
    int ntiles = 0;
    for (int k = 0; k < NE; ++k) ntiles += (int)((cnt[k] + 255u) >> 8);
    if (tid < ntiles) { int e = 0, acc = 0, first = 0;
        for (int k = 0; k < NE; ++k) { const int nt = (int)((cnt[k] + 255u) >> 8); if (tid >= acc && tid < acc + nt) { e = k; first = acc; } acc += nt; }
        const int v = min(256, (int)cnt[e] - 256 * (tid - first));
        tmp[tid] = e; tmp[160 + tid] = v; }
    __syncthreads();
    if (tid < ntiles) { int nheavy = 0, hb = 0, lb = 0; const bool heavy = tmp[160 + tid] > 128;
        for (int k = 0; k < ntiles; ++k) { const bool hk = tmp[160 + k] > 128; nheavy += hk ? 1 : 0; if (k < tid) { hb += hk ? 1 : 0; lb += hk ? 0 : 1; } }
        const int slot = tid; (void)heavy; (void)hb; (void)lb; (void)nheavy;
        tt[slot] = tid; tt[160 + slot] = tmp[tid]; tt[320 + slot] = tmp[160 + tid]; }
    __syncthreads();
    return ntiles; }
__device__ __forceinline__ int moe_rows_valid(const LAS int* tt, int rtc) { const int v = tt[320 + (rtc & 0xffff)], hc = rtc >> 16; return hc == 0 ? v : min(128, max(0, v - (hc == 2 ? 128 : 0))); }
struct MkGateUp { static constexpr bool MASKED = true; typedef ARowsGather AL; typedef BColsGateUp BL; typedef EpiSwiglu EP; unsigned char* ws; const float* w; const float* bias; const LAS int* tt;
    __device__ __forceinline__ int rows_valid(int rtc) const { return moe_rows_valid(tt, rtc); }
    __device__ __forceinline__ void make_src(int rtc, int cn, AL& al, BL& bl) const { const int rt = rtc & 0xffff, hc = rtc >> 16, tile = __builtin_amdgcn_readfirstlane(tt[rt]), e = __builtin_amdgcn_readfirstlane(tt[160 + rt]);
        al = AL{(const bf16_t*)(ws + WS_XN), (size_t)D, (const int*)(ws + WS_ROWTOK) + tile * 256 + (hc == 2 ? 128 : 0), zrow_of(ws), ws, hc ? 128 : 256}; bl = BL{w + (size_t)e * D * 2 * DFF, 2 * DFF, cn}; }
    __device__ __forceinline__ void make_ep(int rtc, int cn, EP& ep) const { const int rt = rtc & 0xffff, hc = rtc >> 16, tile = __builtin_amdgcn_readfirstlane(tt[rt]), e = __builtin_amdgcn_readfirstlane(tt[160 + rt]);
        ep = EP{(bf16_t*)(ws + WS_ACT), bias + (size_t)e * 2 * DFF, tile * 256 + (hc == 2 ? 128 : 0), cn}; } };
struct MkDown { static constexpr bool MASKED = true; typedef ARowsDense AL; typedef BColsDense BL; typedef EpiBiasBf16 EP; unsigned char* ws; const float* w; const float* bias; const LAS int* tt;
    __device__ __forceinline__ int rows_valid(int rtc) const { return moe_rows_valid(tt, rtc); }
    __device__ __forceinline__ void make_src(int rtc, int ct, AL& al, BL& bl) const { const int rt = rtc & 0xffff, hc = rtc >> 16, tile = __builtin_amdgcn_readfirstlane(tt[rt]), e = __builtin_amdgcn_readfirstlane(tt[160 + rt]);
        const int r0 = tile * 256 + (hc == 2 ? 128 : 0);
        al = AL{(const bf16_t*)(ws + WS_ACT), (size_t)DFF, r0, hc ? r0 + 128 : MAX_ROWS, zrow_of(ws), ws}; bl = BL{w + (size_t)e * DFF * D, D, ct * 256, D}; }
    __device__ __forceinline__ void make_ep(int rtc, int ct, EP& ep) const { const int rt = rtc & 0xffff, hc = rtc >> 16, tile = __builtin_amdgcn_readfirstlane(tt[rt]), e = __builtin_amdgcn_readfirstlane(tt[160 + rt]);
        ep = EP{(bf16_t*)(ws + WS_Y), bias + (size_t)e * D, tile * 256 + (hc == 2 ? 128 : 0), ct * 256}; } };
struct ProvCmp1 { static constexpr bool SINGLE = true, MASKED = false; typedef ARowsWindow AL; typedef BColsDense BL; typedef EpiStoreF32 EP; unsigned char* ws; const float* w1; int u, G;
    int cu;
    __device__ __forceinline__ bool next(AL& al, BL& bl) { if (u >= 128) return false; const int kq = u >> 5, j = (u >> 4) & 1, rt = (u >> 1) & 7, ct = u & 1; cu = u; u += G;
        al = AL{(const bf16_t*)(ws + (j ? WS_VCMP : WS_KCMP)) + (size_t)kq * 8 * 256, rt * 256, zrow_of(ws), ws};
        bl = BL{w1 + (size_t)j * 2048 * CMP_HID + (size_t)kq * 512 * CMP_HID, CMP_HID, ct * 256, CMP_HID}; return true; }
    __device__ __forceinline__ void make_ep(EP& ep) const { const int kq = cu >> 5, j = (cu >> 4) & 1, rt = (cu >> 1) & 7, ct = cu & 1;
        ep = EP{(float*)(ws + WS_PART) + (size_t)(kq * 2 + j) * 2048 * CMP_HID, (size_t)CMP_HID, rt * 256, ct * 256, CMP_HID}; } };

__device__ __forceinline__ float rope_inv(int i) { return (float)exp(-(double)i * 0.125 * 13.122363377404328); }


__global__ void __launch_bounds__(512, 2) fwd(Args a) {
    extern __shared__ __attribute__((aligned(16))) unsigned char lds_raw[];
    LAS char* lds = (LAS char*)lds_raw;
    const int tid = threadIdx.x, lane = tid & 63, wid = __builtin_amdgcn_readfirstlane(tid >> 6);
    const int G = gridDim.x, bid = blockIdx.x;
    const int gtid = bid * 512 + tid, gthreads = G * 512;
    const int gwave = bid * 8 + wid, gwaves = G * 8;
    unsigned char* ws = a.ws;
    unsigned* ctl = (unsigned*)(ws + WS_CTL);
    volatile LAS unsigned* barw = (volatile LAS unsigned*)(lds + MAIN_LDS);
    if (tid == 0) { barw[0] = 0u; barw[1] = 0u; barw[2] = 0u; barw[3] = 0u; }
    __syncthreads();
    XcdBarrier bar; bar.bar = ctl; bar.x = 0; bar.st = barw;
    const bool multi = (a.ph_hi - a.ph_lo) > 1;
    int vbid = (G % 8 == 0) ? (bid & 7) * (G / 8) + (bid >> 3) : bid;
    if (multi) bar = xcd_barrier_post(ctl, barw);
#ifdef ONLY_PH
#define IN(k) ((k) == ONLY_PH)
#else
#define IN(k) (a.ph_lo <= (k) && (k) < a.ph_hi)
#endif
#define SEAM(k) do { if ((k) + 1 < a.ph_hi) xcd_barrier(bar); } while (0)

#define XN ((bf16_t*)(ws + WS_XN))
#define DT ((float*)(ws + WS_DT))
#define YSSD ((float*)(ws + WS_YSSD))
#define MIX ((bf16_t*)(ws + WS_MIX))
#define ROPE ((float*)(ws + WS_ROPE))
#define X2 ((float*)(ws + WS_X2))
#define TOPE ((int*)(ws + WS_TOPE))
#define TOPG ((float*)(ws + WS_TOPG))
#define SLOT ((int*)(ws + WS_SLOT))
#define POS ((int*)(ws + WS_POS))
#define ROWTOK ((int*)(ws + WS_ROWTOK))
#define ACT ((bf16_t*)(ws + WS_ACT))
#define YB ((bf16_t*)(ws + WS_Y))
#define STATES ((float*)(ws + WS_STATES))
#define PREV ((bf16_t*)(ws + WS_PREV))
#define CHDEC ((float*)(ws + WS_CHDEC))
#define QB ((bf16_t*)(ws + WS_QB))
#define KSb ((bf16_t*)(ws + WS_KS))
#define VSb ((bf16_t*)(ws + WS_VS))
#define KWb ((bf16_t*)(ws + WS_KW))
#define VWb ((bf16_t*)(ws + WS_VW))
#define KCB ((bf16_t*)(ws + WS_KCB))
#define VCB ((bf16_t*)(ws + WS_VCB))
#define XIN (a.in[0])
#define RW ((float*)(ws + WS_RW))
#define BCNT ((int*)(ws + WS_BCNT))
#define ZB ((bf16_t*)(ws + WS_ZB))
#define XBCR ((bf16_t*)(ws + WS_XBCR))
#define KCMPb ((bf16_t*)(ws + WS_KCMP))
#define VCMPb ((bf16_t*)(ws + WS_VCMP))
#define GATE ((float*)(ws + WS_GATE))
#define PEW ((float*)(ws + WS_PEW))
#define PEWP ((float*)(ws + WS_PEWP))
#define PART ((float*)(ws + WS_PART))
#define COUNT (ctl + CW_COUNT)
#define ZROW ((const bf16_t*)(ctl + CW_ZROW))
    if (IN(PH_NORM1)) {
        const float* w = a.in[1];
        for (int row = gwave; row < T; row += gwaves) {
            const float4* xr = (const float4*)(XIN + (size_t)row * D);
            float4 v[8]; float ss = 0.f;
#pragma unroll
            for (int i = 0; i < 8; ++i) { v[i] = xr[lane + 64 * i]; ss += v[i].x * v[i].x + v[i].y * v[i].y + v[i].z * v[i].z + v[i].w * v[i].w; }
            ss = wave_sum(ss);
            const float rstd = rsqrtf(ss * (1.0f / D) + NORM_EPS);
#pragma unroll
            for (int i = 0; i < 8; ++i) { const float4 wv = ((const float4*)w)[lane + 64 * i];
                *(uint2*)(XN + (size_t)row * D + 4 * (lane + 64 * i)) = make_uint2(pack2(v[i].x * rstd * wv.x, v[i].y * rstd * wv.y), pack2(v[i].z * rstd * wv.z, v[i].w * rstd * wv.w)); }
        }
        for (int i = gtid; i < SEQ * 8; i += gthreads) { const int pos = i >> 3, k = i & 7; const float ang = (float)pos * rope_inv(k); ROPE[i] = cosf(ang); ROPE[SEQ * 8 + i] = sinf(ang); }
        for (int i = gtid; i < MAX_ROWS; i += gthreads) ROWTOK[i] = -1;
        for (int i = gtid; i < 2 * 2 * 256; i += gthreads) { const int d = i & 255, b = (i >> 8) & 1, j = i >> 9; (j ? VCB : KCB)[((size_t)b * 256 + 255) * 256 + d] = 0; }
        for (int i = gtid; i < 2048 * 32; i += gthreads) { const int ii = i & 3, e = (i >> 2) & 31, kk = i >> 7, k = 4 * kk + ii; RW[i] = a.in[15][k] * a.in[16][k * NE + e]; }
        for (int i = gtid; i < 32 * 2 * CMP_HID; i += gthreads) {
            const int col = i & (CMP_HID - 1), j = (i >> 9) & 1, kc = i >> 10; const float* pe = a.in[9] + j * 2048 + kc * 64; const float* w1 = a.in[10] + ((size_t)j * 2048 + kc * 64) * CMP_HID + col;
            float acc = 0.f;
#pragma unroll 8
            for (int k = 0; k < 64; ++k) acc += pe[k] * w1[(size_t)k * CMP_HID];
            PEWP[i] = acc;
        }
        SEAM(PH_NORM1);
    }

    if (IN(PH_INPROJ)) {
        for (int i = gtid; i < 2 * CMP_HID; i += gthreads) { float acc = 0.f;
#pragma unroll 8
            for (int kc = 0; kc < 32; ++kc) acc += PEWP[kc * 1024 + i]; PEW[i] = acc; }
        if (multi && a.ph_lo <= PH_NORM1) {
            if (tid == 0) { unsigned base = 0u;
#pragma unroll
                for (unsigned j = 0; j < 16; ++j) { const unsigned c = xb_ld(&ctl[XB_XCNT(j)]); base += (j < bar.x) ? c : 0u; }
                barw[3] = base + barw[2]; }
            __syncthreads();
            vbid = __builtin_amdgcn_readfirstlane((int)barw[3]);
            if (vbid < 0 || vbid >= G) vbid = bid;
        }
        { PatchProv<MkInProj> P; P.mk = MkInProj{ws, a.in[2], a.in[5]}; P.init(T / 256, (IN_PROJ + 255) / 256, G, vbid); gemm_stream<false>(lds, P, D); }
        SEAM(PH_INPROJ);
    }

    if (IN(PH_SSD_CMP1)) {
        const int GW = G;
        {
            for (int u0 = bid; u0 < 128; u0 += GW) { ProvCmp1 P{ws, a.in[10], u0, 1 << 20, 0}; gemm_stream<false>(lds, P, 512); }
            for (int it = (bid + GW - (128 % GW)) % GW; it < 256; it += GW) ssd_states_item(lds, it, XBCR, a.in[3], a.in[4], DT, a.in[6], STATES, CHDEC);
        }
        SEAM(PH_SSD_CMP1);
    }

    if (IN(PH_GNORM_CMP2)) {
        const float* nw = a.in[8];
        for (int i = gtid; i < 2 * 16 * 64 * 32; i += gthreads) {
            const int n4 = i & 31, p = (i >> 5) & 63, h = (i >> 11) & 15, b = i >> 15;
            f32x4 run = {0.f, 0.f, 0.f, 0.f};
#pragma unroll 1
            for (int c0 = 0; c0 < 32; c0 += 16) {
                f32x4 sv[16]; float dec[16];
#pragma unroll
                for (int q = 0; q < 16; ++q) { const size_t base = (((size_t)b * 32 + c0 + q) * 16 + h) * 8192 + p * 128 + n4 * 4; sv[q] = *(const f32x4*)(STATES + base); dec[q] = CHDEC[((size_t)b * 32 + c0 + q) * 16 + h]; }
#pragma unroll
                for (int q = 0; q < 16; ++q) { const size_t base = (((size_t)b * 32 + c0 + q) * 16 + h) * 8192 + p * 128 + n4 * 4;
                    *(uint2*)(PREV + base) = make_uint2(pack2(run[0], run[1]), pack2(run[2], run[3])); run = run * dec[q] + sv[q]; }
            }
        }
        const float* w2 = a.in[12]; const float* b2 = a.in[13]; const float* b1 = a.in[11];
        for (int it = gwave; it < 2 * CMP_ROWS; it += gwaves) {
            const int row = it % CMP_ROWS, j = it / CMP_ROWS, d = lane;
            const float* wj = w2 + (size_t)j * CMP_HID * 64;
            float s0 = b2[j * 64 + d];
            for (int k0 = 0; k0 < CMP_HID; k0 += 64) {
                float hx = b1[j * CMP_HID + k0 + lane] + PEW[j * CMP_HID + k0 + lane];
#pragma unroll
                for (int q = 0; q < 4; ++q) hx += PART[((size_t)(q * 2 + j) * 2048 + row) * CMP_HID + k0 + lane];
                const float u = 0.7978845608028654f * (hx + 0.044715f * hx * hx * hx);
                const float hv = bf2f(f2bf(0.5f * hx * (1.0f + tanhf(u))));
#pragma unroll
                for (int kk = 0; kk < 64; ++kk) s0 += __builtin_bit_cast(float, __builtin_amdgcn_readlane(__builtin_bit_cast(int, hv), kk)) * wj[(k0 + kk) * 64 + d];
            }
            float o = s0;
            if (j == 0) { const float sp = __shfl(s0, (d < 8) ? d + 8 : ((d < 16) ? d - 8 : d));
                if (d < 16) { const int n = (row >> 2) % N_C, pos = 16 * n + 31, k = d & 7; const float c = ROPE[pos * 8 + k], sn = ROPE[SEQ * 8 + pos * 8 + k];
                    o = (d < 8) ? (s0 * c - sp * sn) : (sp * sn + s0 * c); } }
            { const int g4 = row & 3, n = (row >> 2) % N_C, bb = (row >> 2) / N_C; (j ? VCB : KCB)[((size_t)bb * 256 + n) * 256 + g4 * 64 + d] = f2bf(o); }
        }
        SEAM(PH_GNORM_CMP2);
    }

    if (IN(PH_NSA)) {
        bf16_t* MIXO = MIX;
        for (int k = bid; k < 512; k += G) { const int rnd = k / G; const int u = (rnd & 1) ? ((511 - (k - G * rnd) - G * (rnd - 1)) ^ 7) : k;
            if (u >= 0 && u < 512) nsa_unit32(lds, (G == 256) ? u : k, QB, KSb, VSb, KWb, VWb, KCB, VCB, GATE, MIXO); }
        for (int it = bid; it < 256; it += G) ssd_out_item(lds, it, XBCR, a.in[3], a.in[4], DT, a.in[6], a.in[7], a.in[8], PREV, ZB, YSSD, MIXO);
        SEAM(PH_NSA);
    }

    if (IN(PH_OUTPROJ)) {
        { PatchProv<MkOutProj> P; P.mk = MkOutProj{ws, a.in[14], a.in[0]}; P.init(T / 256, D / 256, G, vbid); gemm_stream<false>(lds, P, 2048); }
        SEAM(PH_OUTPROJ);
    }

    if (IN(PH_ROUTER)) {
        const float* nwp = a.in[15]; const float* br = a.in[17];
        LAS float* part = (LAS float*)lds;
        LAS float* ssq = part + 8 * 512;
        LAS float* rsl = ssq + 128;
        LAS int* lcnt = (LAS int*)(rsl + 32);
        if (tid < 32) lcnt[tid] = 0;
        __syncthreads();
        const int r16 = lane & 15, kq = lane >> 4;
        for (int tp = bid; tp < T / 32; tp += G) {
            const int wt = wid >> 2, wk = wid & 3, tile = 2 * tp + wt;
            const int row = tile * 16 + r16;
            f32x4 acc0 = {0.f, 0.f, 0.f, 0.f}, acc1 = {0.f, 0.f, 0.f, 0.f}; float ssp = 0.f;
            const float* xr = X2 + (size_t)row * D + 512 * wk + 4 * kq;
            const float* rwp = RW + ((size_t)(128 * wk + kq) * 32 + r16) * 4;
#pragma unroll 8
            for (int j = 0; j < 32; ++j) {
                const f32x4 av = *(const f32x4*)(xr + 16 * j);
                const f32x4 b0 = *(const f32x4*)(rwp + (size_t)j * 4 * 128), b1 = *(const f32x4*)(rwp + (size_t)j * 4 * 128 + 64);
                ssp += av[0] * av[0] + av[1] * av[1] + av[2] * av[2] + av[3] * av[3];
#pragma unroll
                for (int i = 0; i < 4; ++i) { acc0 = __builtin_amdgcn_mfma_f32_16x16x4f32(av[i], b0[i], acc0, 0, 0, 0); acc1 = __builtin_amdgcn_mfma_f32_16x16x4f32(av[i], b1[i], acc1, 0, 0, 0); }
            }
            ssp += __shfl_xor(ssp, 16); ssp += __shfl_xor(ssp, 32);
            if (kq == 0) ssq[wid * 16 + r16] = ssp;
#pragma unroll
            for (int i = 0; i < 4; ++i) { part[wid * 512 + (4 * kq + i) * 32 + r16] = acc0[i]; part[wid * 512 + (4 * kq + i) * 32 + 16 + r16] = acc1[i]; }
            __syncthreads();
#pragma unroll
            for (int rep = 0; rep < 2; ++rep) {
                const int idx = tid + 512 * rep, ts = idx >> 9, rr = (idx >> 5) & 15, e = idx & 31, grow = (2 * tp + ts) * 16 + rr;
                float lg = 0.f, ss = 0.f;
#pragma unroll
                for (int w = 0; w < 4; ++w) { lg += part[(4 * ts + w) * 512 + rr * 32 + e]; ss += ssq[(4 * ts + w) * 16 + rr]; }
                const float rstd = rsqrtf(ss * (1.0f / D) + NORM_EPS);
                const float mine = lg * rstd + br[e];
                int rank = 0;
#pragma unroll
                for (int k = 0; k < NE; ++k) { const float o = __shfl(mine, (lane & 32) + k); rank += (o > mine || (o == mine && k < e)) ? 1 : 0; }
                const bool sel = rank < 4;
                float mx = sel ? mine : -INFINITY;
#pragma unroll
                for (int o = 16; o > 0; o >>= 1) mx = fmaxf(mx, __shfl_xor(mx, o));
                const float ex = sel ? __expf(mine - mx) : 0.f;
                float den = ex;
#pragma unroll
                for (int o = 16; o > 0; o >>= 1) den += __shfl_xor(den, o);
                if (sel) { const int slot = atomicAdd((int*)&lcnt[e], 1); const int o = grow * 4 + rank; TOPE[o] = e; TOPG[o] = ex / den; SLOT[o] = slot; }
                if (e == 0) rsl[ts * 16 + rr] = rstd;
            }
            __syncthreads();
            if (tid < 32) { BCNT[tp * 32 + tid] = lcnt[tid]; lcnt[tid] = 0; }
            { const f32x4 wv = *(const f32x4*)(nwp + 4 * tid);
#pragma unroll 1
              for (int half = 0; half < 4; ++half) {
                f32x4 vv[8];
#pragma unroll
                for (int it = 0; it < 8; ++it) vv[it] = *(const f32x4*)(X2 + (size_t)(tp * 32 + half * 8 + it) * D + 4 * tid);
#pragma unroll
                for (int it = 0; it < 8; ++it) { const float rs = rsl[half * 8 + it]; const f32x4 v = vv[it];
                    *(uint2*)(XN + (size_t)(tp * 32 + half * 8 + it) * D + 4 * tid) = make_uint2(pack2(v[0] * rs * wv[0], v[1] * rs * wv[1]), pack2(v[2] * rs * wv[2], v[3] * rs * wv[3])); }
              } }
            __syncthreads();
        }
        SEAM(PH_ROUTER);
    }

    if (IN(PH_SCATTER)) {
        LAS int* red = (LAS int*)lds;
        for (int cb = bid; cb < 64; cb += G) {
            const int tp0 = 4 * cb, e = tid & 31, c = tid >> 5;
            int sb = 0, stt = 0;
#pragma unroll 4
            for (int q = 0; q < 16; ++q) { const int tpq = 16 * c + q; const int v = BCNT[tpq * 32 + e]; stt += v; sb += (tpq < tp0) ? v : 0; }
            red[c * 32 + e] = sb; red[512 + c * 32 + e] = stt;
            __syncthreads();
            if (tid < 32) { int b0 = 0, tt_ = 0;
#pragma unroll
                for (int q = 0; q < 16; ++q) { b0 += red[q * 32 + tid]; tt_ += red[512 + q * 32 + tid]; }
                red[1024 + tid] = b0; red[1056 + tid] = tt_; if (cb == 0) COUNT[tid] = (unsigned)tt_; }
            __syncthreads();
            { const int i = cb * 512 + tid, ei = TOPE[i], tp = i >> 7;
              int base = red[1024 + ei];
              for (int q = tp0; q < tp; ++q) base += BCNT[q * 32 + ei];
              int off = 0;
              for (int k = 0; k < ei; ++k) off += (red[1056 + k] + 255) >> 8;
              const int pos = off * 256 + base + SLOT[i];
              ROWTOK[pos] = i >> 2; POS[i] = pos; }
            __syncthreads();
        }
        SEAM(PH_SCATTER);
    }

    if (IN(PH_GATEUP)) {
        const int ntiles = moe_tile_table(lds, COUNT);
        { PatchProv<MkGateUp> P; P.mk = MkGateUp{ws, a.in[18], a.in[19], (const LAS int*)(lds + TT_OFF)}; P.init(ntiles, 16, G, vbid); gemm_stream<true>(lds, P, D); }
        SEAM(PH_GATEUP);
    }
    if (IN(PH_DOWN)) {
        const int ntiles = moe_tile_table(lds, COUNT);
        { PatchProv<MkDown> P; P.mk = MkDown{ws, a.in[20], a.in[21], (const LAS int*)(lds + TT_OFF)}; P.init(ntiles, 8, G, vbid); gemm_stream<false>(lds, P, DFF); }
        SEAM(PH_DOWN);
    }

    if (IN(PH_FINAL)) {
        const float* fw = a.in[22];
        for (int row = gwave; row < T; row += gwaves) {
            const float4* xr = (const float4*)(X2 + (size_t)row * D);
            float4 v[8];
#pragma unroll
            for (int i = 0; i < 8; ++i) v[i] = xr[lane + 64 * i];
#pragma unroll
            for (int k = 0; k < 4; ++k) { const float gk = TOPG[row * 4 + k]; const bf16_t* yr = YB + (size_t)POS[row * 4 + k] * D;
#pragma unroll
                for (int i = 0; i < 8; ++i) { const uint2 y = *(const uint2*)(yr + 4 * (lane + 64 * i));
                    v[i].x += gk * bf2f((bf16_t)(y.x & 0xffffu)); v[i].y += gk * bf2f((bf16_t)(y.x >> 16)); v[i].z += gk * bf2f((bf16_t)(y.y & 0xffffu)); v[i].w += gk * bf2f((bf16_t)(y.y >> 16)); } }
            float ss = 0.f;
#pragma unroll
            for (int i = 0; i < 8; ++i) ss += v[i].x * v[i].x + v[i].y * v[i].y + v[i].z * v[i].z + v[i].w * v[i].w;
            ss = wave_sum(ss);
            float rstd = rsqrtf(ss * (1.0f / D) + NORM_EPS);
#pragma unroll
            for (int i = 0; i < 8; ++i) { const float4 wv = ((const float4*)fw)[lane + 64 * i];
                ((float4*)(a.out + (size_t)row * D))[lane + 64 * i] = make_float4(v[i].x * rstd * wv.x, v[i].y * rstd * wv.y, v[i].z * rstd * wv.z, v[i].w * rstd * wv.w); }
        }
    }
#undef IN
#undef SEAM
}

extern "C" void kernel_launch(void* const* d_in, const int* in_sizes, int n_in, void* d_out, int out_size, void* d_ws, size_t ws_size, hipStream_t stream) {
    static int grid = 0;
    if (grid == 0) {
        if (n_in != 23 || out_size != T * D || ws_size < WS_END) { fprintf(stderr, "kernel_launch: unexpected shapes (n_in %d, out %d, ws %zu < %zu)\n", n_in, out_size, ws_size, (size_t)WS_END); grid = -1; return; }
        int dev = 0, cus = 0, per_cu = 0;
        if (hipGetDevice(&dev) != hipSuccess || hipDeviceGetAttribute(&cus, hipDeviceAttributeMultiprocessorCount, dev) != hipSuccess) { grid = -1; return; }
        if (hipFuncSetAttribute((const void*)fwd, hipFuncAttributeMaxDynamicSharedMemorySize, LDS_BYTES) != hipSuccess) { fprintf(stderr, "kernel_launch: hipFuncSetAttribute failed\n"); grid = -1; return; }
        if (hipOccupancyMaxActiveBlocksPerMultiprocessor(&per_cu, (const void*)fwd, 512, LDS_BYTES) != hipSuccess || per_cu < 1) { fprintf(stderr, "kernel_launch: occupancy query says %d\n", per_cu); per_cu = 1; }
        (void)hipGetLastError();
        grid = cus;
    }
    if (grid < 0) return;
    (void)hipMemsetAsync((char*)d_ws + WS_CTL, 0, CTL_BYTES, stream);
    Args a{};
    for (int i = 0; i < 23; ++i) a.in[i] = (const float*)d_in[i];
    a.out = (float*)d_out; a.ws = (unsigned char*)d_ws;
#if N_LAUNCH_MODE == 1
    a.ph_lo = 0; a.ph_hi = N_PHASES;
    hipLaunchKernelGGL(fwd, dim3(grid), dim3(512), LDS_BYTES, stream, a);
#else
    for (int ph = 0; ph < N_PHASES; ++ph) { a.ph_lo = ph; a.ph_hi = ph + 1; hipLaunchKernelGGL(fwd, dim3(grid), dim3(512), LDS_BYTES, stream, a); }
#endif
}
```

```cpp
#include <hip/hip_runtime.h>
#include <stdint.h>
#include <stdio.h>

#ifndef N_LAUNCH_MODE
#define N_LAUNCH_MODE 1
#endif

typedef unsigned short bf16_t;
typedef short s16x4 __attribute__((ext_vector_type(4)));
typedef short s16x8 __attribute__((ext_vector_type(8)));
typedef float f32x4 __attribute__((ext_vector_type(4)));
typedef unsigned u32x4 __attribute__((ext_vector_type(4)));
typedef unsigned u32x2 __attribute__((ext_vector_type(2)));
#define LAS __attribute__((address_space(3)))

constexpr int D = 2048, BATCH = 2, SEQ = 4096, T = BATCH * SEQ;
constexpr int SSM_H = 16, SSM_N = 128;
constexpr int NSA_H = 16, DH = 64;
constexpr int CMP_HID = 512;
constexpr int N_C = 255, N_SEL = 64;
constexpr int IN_PROJ = 5696;
constexpr int OFF_Z = 0, OFF_XBC = 1024, OFF_DT = 3072, OFF_Q = 3088, OFF_KCMP = 4112, OFF_VCMP = 4368, OFF_KSLC = 4624,
              OFF_VSLC = 4880, OFF_KWIN = 5136, OFF_VWIN = 5392, OFF_GATE = 5648;
constexpr int NE = 32, DFF = 2048;
constexpr float NORM_EPS = 1e-5f;
constexpr int CMP_ROWS = BATCH * N_C * 4;
constexpr int MAX_TILES = 160, MAX_ROWS = MAX_TILES * 256;

constexpr size_t AL(size_t x) { return (x + 255) & ~(size_t)255; }
constexpr size_t WS_CTL = 0;
constexpr size_t CTL_BYTES = 32768;
constexpr size_t WS_XN = WS_CTL + CTL_BYTES;
constexpr size_t WS_PROJ = WS_XN + AL((size_t)T * D * 2);
constexpr size_t WS_ZB = WS_PROJ;
constexpr size_t WS_XBCR = WS_ZB + AL((size_t)T * 1024 * 2);
constexpr size_t WS_KCMP = WS_XBCR + AL((size_t)T * 2048 * 2);
constexpr size_t WS_VCMP = WS_KCMP + AL((size_t)T * 256 * 2);
constexpr size_t WS_GATE = WS_VCMP + AL((size_t)T * 256 * 2);
constexpr size_t WS_PEW = WS_GATE + AL((size_t)T * 48 * 4);
constexpr size_t WS_PEWP = WS_PEW + 4096;
static_assert(WS_PEWP + 32 * 1024 * 4 <= WS_PROJ + AL((size_t)T * IN_PROJ * 4), "in-proj outputs fit the old PROJ region");
constexpr size_t WS_XBC = WS_PROJ + AL((size_t)T * IN_PROJ * 4);
constexpr size_t WS_DT = WS_XBC + AL((size_t)T * 2048 * 4);
constexpr size_t WS_YSSD = WS_DT + AL((size_t)T * 16 * 4);
constexpr size_t WS_MIX = WS_YSSD + AL((size_t)T * 1024 * 4);
constexpr size_t WS_ROPE = WS_MIX + AL((size_t)T * 2048 * 2);
constexpr size_t WS_BLK = WS_ROPE + AL((size_t)SEQ * 16 * 4);
constexpr size_t WS_H1 = WS_BLK + AL((size_t)2 * 2048 * 2048 * 2);
constexpr size_t WS_KC = WS_H1 + AL((size_t)2 * 2048 * 512 * 2);
constexpr size_t WS_VC = WS_KC + AL((size_t)2048 * 64 * 4);
constexpr size_t WS_PCMP = WS_VC + AL((size_t)2048 * 64 * 4);
constexpr size_t WS_OCMP = WS_PCMP + AL((size_t)T * 16 * 256 * 4);
constexpr size_t WS_SEL = WS_OCMP + AL((size_t)T * 1024 * 4);
constexpr size_t WS_X2 = WS_SEL + AL((size_t)T * 4 * 8);
constexpr size_t WS_TOPE = WS_X2 + AL((size_t)T * D * 4);
constexpr size_t WS_TOPG = WS_TOPE + AL((size_t)T * 4 * 4);
constexpr size_t WS_SLOT = WS_TOPG + AL((size_t)T * 4 * 4);
constexpr size_t WS_POS = WS_SLOT + AL((size_t)T * 4 * 4);
constexpr size_t WS_ROWTOK = WS_POS + AL((size_t)T * 4 * 4);
constexpr size_t WS_BCNT = WS_ROWTOK + AL((size_t)MAX_ROWS * 4);
constexpr size_t WS_ACT = WS_BCNT + AL((size_t)256 * 32 * 4);
constexpr size_t WS_Y = WS_ACT + AL((size_t)MAX_ROWS * DFF * 2);
constexpr size_t WS_QB = WS_Y + AL((size_t)MAX_ROWS * D * 2);
constexpr size_t WS_KS = WS_QB + AL((size_t)T * 1024 * 2);
constexpr size_t WS_VS = WS_KS + AL((size_t)T * 256 * 2);
constexpr size_t WS_KW = WS_VS + AL((size_t)T * 256 * 2);
constexpr size_t WS_VW = WS_KW + AL((size_t)T * 256 * 2);
constexpr size_t WS_KCB = WS_VW + AL((size_t)T * 256 * 2);
constexpr size_t WS_VCB = WS_KCB + AL((size_t)2 * 256 * 256 * 2);
constexpr size_t WS_XBCB = WS_VCB + AL((size_t)2 * 256 * 256 * 2);
constexpr size_t WS_STATES = WS_XBCB + AL((size_t)T * 2048 * 2);
constexpr size_t WS_PREV = WS_STATES + AL((size_t)2 * 32 * 16 * 64 * 128 * 4);
constexpr size_t WS_CHDEC = WS_PREV + AL((size_t)2 * 32 * 16 * 64 * 128 * 2);
constexpr size_t WS_PART = WS_CHDEC + AL((size_t)2 * 32 * 16 * 4);
constexpr size_t WS_RW = WS_PART + AL((size_t)4 * 2 * 2048 * 512 * 4);
constexpr size_t WS_CHK = WS_RW + AL((size_t)2048 * 32 * 4);
constexpr size_t WS_END = WS_CHK + AL((size_t)T * 2048 * 4);

constexpr int CW_COUNT = 4096;
constexpr int CW_ZROW = 5120;
constexpr int CW_CHK = 4160;

#define XB_TMO      128
#define XB_XCNT(j)  (256  + 64 * (j))
#define XB_XSUB(j)  (1280 + 64 * (j))
#define XB_XGEN(j)  (2304 + 64 * (j))
#define XB_TOP      3328
#define XB_TOPGEN   3392
#define XCD_BAR_WORDS 3456
#define XB_SPIN_CAP (1u << 18)

__device__ __forceinline__ unsigned xb_ld(unsigned* p)              { return __hip_atomic_load(p, __ATOMIC_RELAXED, __HIP_MEMORY_SCOPE_AGENT); }
__device__ __forceinline__ unsigned xb_add(unsigned* p, unsigned v) { return __hip_atomic_fetch_add(p, v, __ATOMIC_RELAXED, __HIP_MEMORY_SCOPE_AGENT); }
__device__ __forceinline__ unsigned xb_xcc_id() { return (unsigned)__builtin_amdgcn_s_getreg((3 << 11) | 20) & 0xFu; }
#define XB_SPIN(cond, bar) do { unsigned _sp = 0; while (cond) { __builtin_amdgcn_s_sleep(1); \
    if ((++_sp & 255u) == 0u) { if (xb_ld(&(bar)[XB_TMO])) break; if (_sp > XB_SPIN_CAP) { atomicAdd(&(bar)[XB_TMO], 1u); break; } } } } while (0)

struct XcdBarrier { unsigned* bar; unsigned x; volatile LAS unsigned* st; };

__device__ __forceinline__ XcdBarrier xcd_barrier_post(unsigned* bar, volatile LAS unsigned* st) {
    XcdBarrier b; b.bar = bar; b.x = xb_xcc_id(); b.st = st;
    if (threadIdx.x == 0) st[2] = xb_add(&bar[XB_XCNT(b.x)], 1u);
    return b;
}
__device__ __forceinline__ void xcd_barrier_complete(unsigned* bar, unsigned x, unsigned& nloc, unsigned& nx) {
    const unsigned G = gridDim.x * gridDim.y * gridDim.z;
    unsigned sum, cnt, mine, sp = 0u;
    for (;;) {
        sum = 0u; cnt = 0u; mine = 0u;
#pragma unroll
        for (unsigned j = 0; j < 16; ++j) { const unsigned c = xb_ld(&bar[XB_XCNT(j)]); sum += c; cnt += (c > 0u) ? 1u : 0u; mine = (j == x) ? c : mine; }
        if (sum == G) break;
        __builtin_amdgcn_s_sleep(1);
        if ((++sp & 255u) == 0u) { if (xb_ld(&bar[XB_TMO])) break; if (sp > XB_SPIN_CAP) { atomicAdd(&bar[XB_TMO], 1u); break; } }
    }
    nloc = mine > 0u ? mine : 1u; nx = cnt > 0u ? cnt : 1u;
}
__device__ __forceinline__ void xcd_barrier(const XcdBarrier& b) {
    asm volatile("s_waitcnt vmcnt(0)" ::: "memory");
    __syncthreads();
    if (threadIdx.x == 0) {
        unsigned* bar = b.bar;
        __builtin_amdgcn_s_waitcnt(0);
        unsigned nloc = b.st[0], nx = b.st[1];
        if (nloc == 0u) { xcd_barrier_complete(bar, b.x, nloc, nx); b.st[0] = nloc; b.st[1] = nx; }
        const unsigned old = xb_add(&bar[XB_XSUB(b.x)], 1u);
        const unsigned gen = old / nloc;
        if (old + 1u == (gen + 1u) * nloc) {
            __builtin_amdgcn_fence(__ATOMIC_RELEASE, "agent");
            asm volatile("s_waitcnt vmcnt(0)" ::: "memory");
            const unsigned og = xb_add(&bar[XB_TOP], 1u);
            const unsigned tg = og / nx;
            if (og + 1u == (tg + 1u) * nx) xb_add(&bar[XB_TOPGEN], 1u);
            else XB_SPIN(xb_ld(&bar[XB_TOPGEN]) == tg, bar);
            __builtin_amdgcn_fence(__ATOMIC_ACQUIRE, "agent");
            xb_add(&bar[XB_XGEN(b.x)], 1u);
            asm volatile("s_waitcnt vmcnt(0)" ::: "memory");
        } else {
            XB_SPIN(xb_ld(&bar[XB_XGEN(b.x)]) == gen, bar);
            __builtin_amdgcn_fence(__ATOMIC_ACQUIRE, "agent");
            asm volatile("s_waitcnt vmcnt(0)" ::: "memory");
        }
    }
    __syncthreads();
}

__device__ __forceinline__ bf16_t f2bf(float f) { unsigned u = __float_as_uint(f); u += 0x7FFFu + ((u >> 16) & 1u); return (bf16_t)(u >> 16); }
__device__ __forceinline__ float bf2f(bf16_t b) { return __uint_as_float(((unsigned)b) << 16); }
typedef __bf16 bf16x2_t __attribute__((ext_vector_type(2)));
typedef float f32x2_t __attribute__((ext_vector_type(2)));
__device__ __forceinline__ unsigned pack2(float lo, float hi) { const f32x2_t v = {lo, hi}; return __builtin_bit_cast(unsigned, __builtin_convertvector(v, bf16x2_t)); }
__device__ __forceinline__ float wave_sum(float v) {
#pragma unroll
    for (int o = 32; o > 0; o >>= 1) v += __shfl_xor(v, o);
    return v;
}
__device__ __forceinline__ float xmax16(float x) { const unsigned u = __builtin_bit_cast(unsigned, x); const auto r = __builtin_amdgcn_permlane16_swap(u, u, false, false); return fmaxf(__builtin_bit_cast(float, r[0]), __builtin_bit_cast(float, r[1])); }
__device__ __forceinline__ float xmax32(float x) { const unsigned u = __builtin_bit_cast(unsigned, x); const auto r = __builtin_amdgcn_permlane32_swap(u, u, false, false); return fmaxf(__builtin_bit_cast(float, r[0]), __builtin_bit_cast(float, r[1])); }
__device__ __forceinline__ float xsum16(float x) { const unsigned u = __builtin_bit_cast(unsigned, x); const auto r = __builtin_amdgcn_permlane16_swap(u, u, false, false); return __builtin_bit_cast(float, r[0]) + __builtin_bit_cast(float, r[1]); }
__device__ __forceinline__ float xsum32(float x) { const unsigned u = __builtin_bit_cast(unsigned, x); const auto r = __builtin_amdgcn_permlane32_swap(u, u, false, false); return __builtin_bit_cast(float, r[0]) + __builtin_bit_cast(float, r[1]); }
__device__ __forceinline__ float sigmoidf_(float x) { return 1.0f / (1.0f + __expf(-x)); }

constexpr int B_RS = 544, A_ST = 256 * 128, B_ST = 64 * B_RS, STAGE = A_ST + B_ST;
constexpr int GEMM_LDS = 2 * STAGE;
constexpr int SSD_LDS = 147456;
constexpr int MAIN_LDS = SSD_LDS > GEMM_LDS ? SSD_LDS : GEMM_LDS;
constexpr int LDS_BYTES = MAIN_LDS + 64;

template <bool PAIRED, class Prov>
__device__ __forceinline__ void gemm_stream(LAS char* lds, Prov& P, const int K) {
    typedef typename Prov::AL ALd; typedef typename Prov::BL BLd; typedef typename Prov::EP EPt;
    ALd al; BLd bl; EPt ep;
    if (!P.next(al, bl)) return;
    P.make_ep(ep);
    const int tid = threadIdx.x, lane = tid & 63, wid = __builtin_amdgcn_readfirstlane(tid >> 6);
    const int wr = wid >> 1, wc = wid & 1, fr = lane & 15, fq = lane >> 4;
    int nvalid_next = 256;
    bool wave_on = true;
    if constexpr (Prov::MASKED) { nvalid_next = __builtin_amdgcn_readfirstlane(P.rows_valid()); wave_on = wr * 64 < nvalid_next; }
    const char* abase = (const char*)al.wsbase;
    unsigned aoff[4];
    const int bk0 = tid >> 6;
    unsigned ldb4, boff;
    __amdgpu_buffer_rsrc_t rsb;
    const __amdgpu_buffer_rsrc_t rsa = __builtin_amdgcn_make_buffer_rsrc((void*)abase, 0, 0x7fffffff, 0x00020000);
#define SET_SRC(al_, bl_) do { \
        _Pragma("unroll") for (int j = 0; j < 4; ++j) aoff[j] = (unsigned)((const char*)((al_).row(32 * wid + 8 * j + (lane >> 3)) + ((lane & 7) ^ (lane >> 3)) * 8) - abase); \
        rsb = __builtin_amdgcn_make_buffer_rsrc((void*)(bl_).base, 0, 0x7fffffff, 0x00020000); \
        ldb4 = (unsigned)(bl_).ldb * 4u; boff = (unsigned)(bl_).coloff(4 * (tid & 63)) * 4u + (unsigned)(tid >> 6) * ldb4; } while (0)
    SET_SRC(al, bl);
    unsigned atile = 0u, btile = 0u;
    u32x4 ra[4]; float4 rb[8];
#define LD_CHUNK(c) do { if ((c) < 8) { const u32x4 t_ = __builtin_amdgcn_raw_buffer_load_b128(rsb, (int)boff, (int)(btile + (unsigned)(8 * ((c) & 7)) * ldb4), 0); rb[(c) & 7] = __builtin_bit_cast(float4, t_); } \
        else ra[(c) & 3] = __builtin_amdgcn_raw_buffer_load_b128(rsa, (int)aoff[(c) & 3], (int)atile, 0); } while (0)
#define WR_CHUNK(c, buf) do { if ((c) < 8) *(LAS u32x2*)(lds + (buf) * STAGE + A_ST + bw_off + ((((c) & 7) & 1) * 4 + (((c) & 7) >> 1) * 16) * B_RS) = (u32x2){pack2(rb[(c) & 7].x, rb[(c) & 7].y), pack2(rb[(c) & 7].z, rb[(c) & 7].w)}; \
        else *(LAS u32x4*)(lds + (buf) * STAGE + (4 * wid + ((c) & 3)) * 1024 + lane * 16) = ra[(c) & 3]; } while (0)
#define ADVANCE() do { atile += ALd::kstep; btile += 64u * ldb4; } while (0)
    f32x4 acc[4][8];
    const int nk = K / 64;
    const int a_off0 = (wr * 64 + fr) * 128 + ((fq ^ (fr & 7)) * 16);
    const int br_off = A_ST + (((fq & 1) * 4 + (fq >> 1) * 16 + ((lane & 15) >> 2)) * B_RS) + (wc * 128 + 4 * (lane & 3)) * 2;
    const int bw_off = ((bk0 & 3) + ((bk0 >> 2) << 3)) * B_RS + (tid & 63) * 8;
#pragma unroll
    for (int c = 0; c < 12; ++c) LD_CHUNK(c);
    ADVANCE();
#pragma unroll
    for (int c = 0; c < 12; ++c) { WR_CHUNK(c, 0); LD_CHUNK(c); }
    int ldt = 1;
    if (2 < nk) { ADVANCE(); ldt = 2; }
    __syncthreads();
    for (;;) {
#pragma unroll
        for (int m = 0; m < 4; ++m)
#pragma unroll
            for (int n = 0; n < 8; ++n) acc[m][n] = (f32x4){0.f, 0.f, 0.f, 0.f};
        bool has_next = false;
        if constexpr (Prov::MASKED) { if (!wave_on) {
            for (int kt = 0; kt < nk; ++kt) {
                if (kt == nk - 2) { ALd aln; BLd bln; has_next = P.next(aln, bln);
                    if (has_next) { SET_SRC(aln, bln); atile = 0u; btile = 0u; ldt = 0; nvalid_next = __builtin_amdgcn_readfirstlane(P.rows_valid()); } }
                const int buf = kt & 1;
#pragma unroll
                for (int st = 0; st < 12; ++st) { WR_CHUNK(st, buf ^ 1); LD_CHUNK(st); }
                if (ldt + 1 < nk) { ADVANCE(); ++ldt; }
                __syncthreads();
            }
        } }
        if (!Prov::MASKED || wave_on)
        for (int kt = 0; kt < nk; ++kt) {
            if constexpr (!Prov::SINGLE) { if (kt == nk - 2) { ALd aln; BLd bln; has_next = P.next(aln, bln);
                if (has_next) { SET_SRC(aln, bln); atile = 0u; btile = 0u; ldt = 0; if constexpr (Prov::MASKED) nvalid_next = __builtin_amdgcn_readfirstlane(P.rows_valid()); } } }
            const int buf = kt & 1;
            LAS char* sbase = lds + buf * STAGE;
            s16x8 af[4]; s16x4 tq[4][2];
#define RD_B(slot, st_) do { tq[slot][0] = __builtin_amdgcn_ds_read_tr16_b64_v4i16((LAS s16x4*)(sbase + br_off + ((st_) >> 3) * 32 * B_RS + ((st_) & 7) * 32)); \
                             tq[slot][1] = __builtin_amdgcn_ds_read_tr16_b64_v4i16((LAS s16x4*)(sbase + br_off + ((st_) >> 3) * 32 * B_RS + ((st_) & 7) * 32 + 8 * B_RS)); } while (0)
#pragma unroll
            for (int m = 0; m < 4; ++m) af[m] = *(const LAS s16x8*)(sbase + a_off0 + m * 16 * 128);
            RD_B(0, 0); RD_B(1, 1); RD_B(2, 2);
            __builtin_amdgcn_sched_barrier(0);
#pragma unroll
            for (int st = 0; st < 16; ++st) {
                const int n = st & 7;
                if (st + 3 < 16) RD_B((st + 3) & 3, st + 3);
                const s16x8 bfr = {tq[st & 3][0][0], tq[st & 3][0][1], tq[st & 3][0][2], tq[st & 3][0][3], tq[st & 3][1][0], tq[st & 3][1][1], tq[st & 3][1][2], tq[st & 3][1][3]};
#pragma unroll
                for (int m = 0; m < 4; ++m) acc[m][n] = __builtin_amdgcn_mfma_f32_16x16x32_bf16(bfr, af[m], acc[m][n], 0, 0, 0);
                if (st == 7) {
#pragma unroll
                    for (int m = 0; m < 4; ++m) af[m] = *(const LAS s16x8*)(sbase + (a_off0 ^ 64) + m * 16 * 128);
                }
                if (st < 12) { WR_CHUNK(st, buf ^ 1); LD_CHUNK(st); }
                if (st & 1) __builtin_amdgcn_sched_barrier(0);
            }
#undef RD_B
            if (ldt + 1 < nk) { ADVANCE(); ++ldt; }
            __syncthreads();
        }
        if (!Prov::MASKED || wave_on)
#pragma unroll
        for (int m = 0; m < 4; ++m) {
            const int r = wr * 64 + m * 16 + fr;
            if constexpr (PAIRED) {
                ep.pair4(r, wc * 64 + 4 * fq, acc[m]);
            } else if constexpr (EPt::ROW8) { ep.row8(r, wc * 128 + 4 * fq, acc[m]);
            } else {
#pragma unroll
                for (int n = 0; n < 8; ++n) ep(r, wc * 128 + n * 16 + 4 * fq, acc[m][n]);
            }
        }
        if (!has_next) break;
        P.make_ep(ep);
        if constexpr (Prov::MASKED) wave_on = wr * 64 < nvalid_next;
    }
#undef LD_CHUNK
#undef WR_CHUNK
#undef ADVANCE
#undef SET_SRC
}

template <class Maker> struct PatchProv {
    static constexpr bool SINGLE = false, MASKED = Maker::MASKED;
    __device__ __forceinline__ int rows_valid() const { return mk.rows_valid(cRT); }
    typedef typename Maker::AL AL; typedef typename Maker::BL BL; typedef typename Maker::EP EP;
    Maker mk; int nR, nC, npc, npatch, nlab, nsl, pidx, slot, slot0, nfull, rem;
    __device__ __forceinline__ void init(int nR_, int nC_, int G, int bid) { nR = nR_; nC = nC_; nlab = (G % 8 == 0) ? 8 : 1; nsl = G / nlab; npc = (nC + 7) >> 3; npatch = ((nR + 3) >> 2) * npc;
        nfull = npatch; rem = 0;
        if constexpr (MASKED) { const int r = npatch % nlab; if (r > 0 && 2 * r <= nlab) { nfull = npatch - r; rem = r; npatch = nfull + 2 * r; } }
        pidx = bid / nsl; slot0 = bid % nsl; slot = slot0; if (pidx >= nlab) { pidx = npatch; } }
    int cRT, cCT;
    __device__ __forceinline__ bool next(AL& al, BL& bl) {
        while (pidx < npatch) {
            int pp = pidx, hcode = 0;
            if (MASKED && pidx >= nfull) { const int hp = pidx - nfull; pp = nfull + hp % rem; hcode = 1 + hp / rem; }
            while (slot < 32) { const int RT = (pp / npc) * 4 + (slot >> 3), CT = (pp % npc) * 8 + (slot & 7); slot += nsl;
                if (RT < nR && CT < nC) { cRT = RT | (hcode << 16); cCT = CT; mk.make_src(cRT, CT, al, bl); return true; } }
            pidx += nlab; slot = slot0; }
        return false; }
    __device__ __forceinline__ void make_ep(EP& ep) const { mk.make_ep(cRT, cCT, ep); } };

constexpr int KV_RS = 144, KT_BYTES = 64 * KV_RS;
constexpr int ATT_IMP_OFF = 8 * KT_BYTES;
constexpr int ATT_MASK_OFF = ATT_IMP_OFF + 64 * 64 * 4;
typedef float f32x16 __attribute__((ext_vector_type(16)));
struct GState32 { f32x16 o[2]; float m, l, nref; };
__device__ __forceinline__ float xchg32(float x) { const unsigned u = __builtin_bit_cast(unsigned, x); const auto r = __builtin_amdgcn_permlane32_swap(u, u, false, false);
    return __builtin_bit_cast(float, (threadIdx.x & 32) ? r[0] : r[1]); }

template <int MODE>
__device__ __forceinline__ void attn_block32(const LAS char* kt, const LAS char* vt, const int lane, const s16x8 (&qf)[4], GState32& st,
                                             const bool act, const int key0, const int lo, const int hi, LAS float* imp, const int tl, float& carry, const int jb) {
    const int c32 = lane & 31, h = lane >> 5;
    f32x16 s[2];
    const float cval = (MODE == 0) ? (act ? st.nref : -INFINITY) : 0.f;
    const f32x16 cin = {cval, cval, cval, cval, cval, cval, cval, cval, cval, cval, cval, cval, cval, cval, cval, cval};
#pragma unroll
    for (int k2 = 0; k2 < 2; ++k2) {
        s16x8 kf[4];
#pragma unroll
        for (int ds = 0; ds < 4; ++ds) kf[ds] = *(const LAS s16x8*)(kt + (32 * k2 + c32) * KV_RS + (16 * ds + 8 * h) * 2);
        s[k2] = __builtin_amdgcn_mfma_f32_32x32x16_bf16(kf[0], qf[0], cin, 0, 0, 0);
#pragma unroll
        for (int ds = 1; ds < 4; ++ds) s[k2] = __builtin_amdgcn_mfma_f32_32x32x16_bf16(kf[ds], qf[ds], s[k2], 0, 0, 0);
    }
    const bool needmask = !__all((lo <= key0) & (hi >= key0 + 63));
    if (needmask) {
#pragma unroll
        for (int k2 = 0; k2 < 2; ++k2)
#pragma unroll
            for (int i = 0; i < 16; ++i) { const int key = key0 + 32 * k2 + 8 * (i >> 2) + 4 * h + (i & 3); s[k2][i] = (key >= lo && key <= hi) ? s[k2][i] : -INFINITY; }
    }
    float mx = -INFINITY;
#pragma unroll
    for (int k2 = 0; k2 < 2; ++k2)
#pragma unroll
        for (int i = 0; i < 16; ++i) mx = fmaxf(mx, s[k2][i]);
    if (MODE == 0) {
        mx = fmaxf(mx, xchg32(mx));
        const bool slow = (mx > 8.f) || (st.m == -INFINITY && mx != -INFINITY);
        if (__any(slow)) {
            const float mnew = fmaxf(st.m, mx - st.nref);
            const float alpha = (mnew == -INFINITY) ? 1.0f : __builtin_amdgcn_exp2f(st.m - mnew);
            const float d = (mnew == -INFINITY) ? 0.f : mnew + st.nref;
#pragma unroll
            for (int k2 = 0; k2 < 2; ++k2)
#pragma unroll
                for (int i = 0; i < 16; ++i) s[k2][i] -= d;
            st.o[0] *= alpha; st.o[1] *= alpha; st.l *= alpha;
            st.m = mnew; st.nref = (mnew == -INFINITY) ? 0.f : -mnew;
        }
        float rs = 0.f;
#pragma unroll
        for (int k2 = 0; k2 < 2; ++k2)
#pragma unroll
            for (int i = 0; i < 16; ++i) { const float pv = __builtin_amdgcn_exp2f(s[k2][i]); s[k2][i] = pv; rs += pv; }
        rs += xchg32(rs); st.l += rs;
    } else {
    mx = act ? mx : -INFINITY;
    float msafe, scale = 1.0f;
    if (MODE == 2) { msafe = (st.m == -INFINITY) ? 0.f : st.m; scale = st.l; }
    else {
        mx = fmaxf(mx, xchg32(mx));
        const float mnew = fmaxf(st.m, mx);
        const float alpha = (mnew == -INFINITY) ? 1.0f : __builtin_amdgcn_exp2f(st.m - mnew);
        msafe = (mnew == -INFINITY) ? 0.f : mnew;
        st.m = mnew; st.l *= alpha;
    }
    msafe = act ? msafe : INFINITY;
    float rs = 0.f;
#pragma unroll
    for (int k2 = 0; k2 < 2; ++k2)
#pragma unroll
        for (int i = 0; i < 16; ++i) { const float pv = (MODE == 2) ? __builtin_amdgcn_exp2f(s[k2][i] - msafe) * scale : __builtin_amdgcn_exp2f(s[k2][i] - msafe); s[k2][i] = pv; rs += pv; }
    if (MODE != 2) { rs += xchg32(rs); st.l += rs; }
    }
    if (MODE == 2) {
#pragma unroll
        for (int k2 = 0; k2 < 2; ++k2)
#pragma unroll
            for (int ig = 0; ig < 4; ++ig) {
                const float prevreg = ig > 0 ? s[k2][4 * (ig > 0 ? ig - 1 : 0) + 3] : (k2 > 0 ? s[0][15] : carry);
                const float recv = xchg32(h ? prevreg : s[k2][4 * ig + 3]);
                float part = 32.f * (s[k2][4 * ig] + s[k2][4 * ig + 1] + s[k2][4 * ig + 2]) + 16.f * s[k2][4 * ig + 3] + 16.f * recv;
                part += __shfl_xor(part, 1); part += __shfl_xor(part, 2);
                if ((c32 & 3) == 0) imp[tl * 64 + 16 * jb + 8 * k2 + 2 * ig + h] = part;
            }
        carry = s[1][15];
    }
    if (MODE != 1) {
        const int blk = (lane >> 4) & 1, q = (lane & 15) >> 2, p = lane & 3;
#pragma unroll
        for (int k2 = 0; k2 < 2; ++k2)
#pragma unroll
            for (int sk = 0; sk < 2; ++sk) {
                const u32x4 w = {pack2(s[k2][8 * sk + 0], s[k2][8 * sk + 1]), pack2(s[k2][8 * sk + 2], s[k2][8 * sk + 3]), pack2(s[k2][8 * sk + 4], s[k2][8 * sk + 5]), pack2(s[k2][8 * sk + 6], s[k2][8 * sk + 7])};
                const s16x8 pf = __builtin_bit_cast(s16x8, w);
#pragma unroll
                for (int dt = 0; dt < 2; ++dt) { const int base = 32 * k2 + 16 * sk;
                    const s16x4 t0 = __builtin_amdgcn_ds_read_tr16_b64_v4i16((LAS s16x4*)(vt + (base + 4 * h + q) * KV_RS + (32 * dt + 16 * blk + 4 * p) * 2));
                    const s16x4 t1 = __builtin_amdgcn_ds_read_tr16_b64_v4i16((LAS s16x4*)(vt + (base + 8 + 4 * h + q) * KV_RS + (32 * dt + 16 * blk + 4 * p) * 2));
                    const s16x8 vf = {t0[0], t0[1], t0[2], t0[3], t1[0], t1[1], t1[2], t1[3]};
                    st.o[dt] = __builtin_amdgcn_mfma_f32_32x32x16_bf16(vf, pf, st.o[dt], 0, 0, 0); }
            }
    }
}

#define ATT_GLOAD(Kg, Vg, stg) do { const size_t _o = ((size_t)(stg) * 128 + (tid >> 3)) * 256 + g * 64 + (tid & 7) * 8; rk0 = *(const u32x4*)((Kg) + _o); rv0 = *(const u32x4*)((Vg) + _o); \
        rk1 = *(const u32x4*)((Kg) + _o + 64 * 256); rv1 = *(const u32x4*)((Vg) + _o + 64 * 256); __builtin_amdgcn_sched_barrier(0); } while (0)
#define ATT_SWRITE(stg) do { LAS char* _k = lds + ((stg) & 1) * 4 * KT_BYTES + (tid >> 3) * KV_RS + (tid & 7) * 16; *(LAS u32x4*)_k = rk0; *(LAS u32x4*)(_k + KT_BYTES) = rv0; \
        *(LAS u32x4*)(_k + 2 * KT_BYTES) = rk1; *(LAS u32x4*)(_k + 3 * KT_BYTES) = rv1; } while (0)
#define ATT_RUN(MODE, Kg, Vg, jlo, jhi, COND, ACT) do { const int _s0 = (jlo) >> 1, _s1 = (jhi) >> 1; \
        ATT_GLOAD(Kg, Vg, _s0); ATT_SWRITE(_s0); __syncthreads(); \
        for (int _s = _s0; _s <= _s1; ++_s) { \
            if (_s + 1 <= _s1) ATT_GLOAD(Kg, Vg, _s + 1); \
            _Pragma("unroll") for (int _q = 0; _q < 2; ++_q) { const int j = 2 * _s + _q; \
                if (j >= (jlo) && j <= (jhi) && (COND)) { act = (ACT); \
                    const LAS char* _kt = lds + (_s & 1) * 4 * KT_BYTES + _q * 2 * KT_BYTES; \
                    attn_block32<MODE>(_kt, _kt + KT_BYTES, lane, qf, st, act, 64 * j, lo, hi, imp, tl, carry, j); } } \
            if (_s + 1 <= _s1) ATT_SWRITE(_s + 1); \
            __syncthreads(); } } while (0)

__device__ __forceinline__ void nsa_unit32(LAS char* lds, const int unit, const bf16_t* QB, const bf16_t* KS, const bf16_t* VS, const bf16_t* KW, const bf16_t* VW,
                                           const bf16_t* KCB, const bf16_t* VCB, const float* GATEp, bf16_t* MIX) {
    const int tid = threadIdx.x, lane = tid & 63, wid = tid >> 6, c32 = lane & 31, h = lane >> 5;
    const int qt = unit >> 3, b = (unit >> 2) & 1, g = unit & 3;
    const int t0 = qt * 64;
    LAS float* imp = (LAS float*)(lds + ATT_IMP_OFF);
    LAS unsigned* lmask = (LAS unsigned*)(lds + ATT_MASK_OFF);
    const int tl = 8 * wid + (c32 >> 2), tpos = t0 + tl, hq = g * 4 + (c32 & 3);
    const size_t tt = (size_t)b * SEQ + tpos;
    s16x8 qf[4]; float gate[3];
#pragma unroll
    for (int ds = 0; ds < 4; ++ds) qf[ds] = *(const s16x8*)(QB + tt * 1024 + hq * 64 + 16 * ds + 8 * h);
    { const float* gl = GATEp + tt * 48 + hq * 3; gate[0] = gl[0]; gate[1] = gl[1]; gate[2] = gl[2]; }
    for (int i = tid; i < 64 * 64; i += 512) imp[i] = 0.f;
    f32x16 res[2];
    GState32 st; bool act; int lo, hi; float carry = 0.f;
    u32x4 rk0, rv0, rk1, rv1;
    const bf16_t* KCg = KCB + (size_t)b * 256 * 256; const bf16_t* VCg = VCB + (size_t)b * 256 * 256;
    const bf16_t* KSg = KS + (size_t)b * SEQ * 256; const bf16_t* VSg = VS + (size_t)b * SEQ * 256;
    const bf16_t* KWg = KW + (size_t)b * SEQ * 256; const bf16_t* VWg = VW + (size_t)b * SEQ * 256;
#define ST_RESET() do { st.m = -INFINITY; st.l = 0.f; st.nref = 0.f; _Pragma("unroll") for (int i_ = 0; i_ < 16; ++i_) { st.o[0][i_] = 0.f; st.o[1][i_] = 0.f; } } while (0)
    const int cmax_u = (t0 + 63 - 31) >> 4;
    const int ncb = cmax_u < 0 ? 0 : min(4, (cmax_u + 1) / 64 + 1);
    act = true; lo = 0; hi = tpos >= 31 ? ((tpos - 31) >> 4) : -1; ST_RESET();
    __syncthreads();
    if (ncb > 0) {
        ATT_RUN(1, KCg, VCg, 0, ncb - 1, true, true);
        st.l = st.l > 0.f ? 1.0f / st.l : 0.f;
        ATT_RUN(2, KCg, VCg, 0, ncb - 1, true, true);
    }
    res[0] = st.o[0] * gate[0]; res[1] = st.o[1] * gate[0];
    __syncthreads();
    for (int k = 0; k < 8; ++k) {
        const int tk = 8 * wid + k, j = lane;
        const float iv = imp[tk * 64 + j];
        const bool forced = (j == 0) || (j == qt) || (j == qt - 1), valid = j <= qt;
        const float sc = forced ? 1.0e4f : (valid ? iv : -1.0e4f);
        const unsigned ub = __float_as_uint(sc + 0.0f), key = (ub & 0x80000000u) ? ~ub : (ub | 0x80000000u);
        const unsigned long long K = ((unsigned long long)key << 32) | (unsigned)(63 - j);
        int rank = 0;
#pragma unroll
        for (int kk = 0; kk < 64; ++kk) { const unsigned long long O = ((unsigned long long)(unsigned)__builtin_amdgcn_readlane((int)key, kk) << 32) | (unsigned)(63 - kk); rank += (O > K) ? 1 : 0; }
        const unsigned long long m64 = __ballot(rank < 16 && valid);
        if (lane == 0) { lmask[tk * 2] = (unsigned)m64; lmask[tk * 2 + 1] = (unsigned)(m64 >> 32); }
    }
    __syncthreads();
    const unsigned long long msk = (unsigned long long)lmask[tl * 2] | ((unsigned long long)lmask[tl * 2 + 1] << 32);
    unsigned long long wunion;
    { unsigned ul = (unsigned)msk, uh = (unsigned)(msk >> 32);
#pragma unroll
      for (int o = 1; o < 64; o <<= 1) { ul |= __shfl_xor(ul, o); uh |= __shfl_xor(uh, o); }
      wunion = (unsigned long long)ul | ((unsigned long long)uh << 32); }
    lo = 0; hi = tpos; ST_RESET();
    ATT_RUN(0, KSg, VSg, 0, qt, (wunion >> j) & 1ull, (msk >> j) & 1ull);
    { const float il = gate[1] / fmaxf(st.l, 1e-30f); res[0] += st.o[0] * il; res[1] += st.o[1] * il; }
    act = true; lo = tpos - 511; hi = tpos; ST_RESET();
    const int jw0 = qt >= 8 ? qt - 8 : 0;
    ATT_RUN(0, KWg, VWg, jw0, qt, true, true);
    { const float il = gate[2] / fmaxf(st.l, 1e-30f);
      bf16_t* mp = MIX + tt * 2048 + 1024 + hq * 64 + 4 * h;
#pragma unroll
      for (int dt = 0; dt < 2; ++dt)
#pragma unroll
          for (int ig = 0; ig < 4; ++ig) { const int i0 = 4 * ig;
              const float r0 = res[dt][i0] + st.o[dt][i0] * il, r1 = res[dt][i0 + 1] + st.o[dt][i0 + 1] * il, r2 = res[dt][i0 + 2] + st.o[dt][i0 + 2] * il, r3 = res[dt][i0 + 3] + st.o[dt][i0 + 3] * il;
              *(uint2*)(mp + 32 * dt + 8 * ig) = make_uint2(pack2(r0, r1), pack2(r2, r3)); } }
#undef ST_RESET
}
#undef ATT_GLOAD
#undef ATT_SWRITE
#undef ATT_RUN


constexpr int SX_RS = 144, SX_H = 128 * SX_RS, SB_RS = 272, SB_BYTES = 128 * SB_RS;
constexpr int SSD_X_OFF = 0, SSD_B_OFF = 4 * SX_H, SSD_C_OFF = SSD_B_OFF + SB_BYTES, SSD_T_OFF = SSD_C_OFF + SB_BYTES;
static_assert(SSD_T_OFF + 4096 <= SSD_LDS, "ssd lds");

__device__ __forceinline__ u32x4 conv8_silu(const u32x4 (&tap)[4], const float* cw, const float* cb, const int chan, const int spos) {
    float acc[8];
    { const f32x4 b0 = *(const f32x4*)(cb + chan), b1 = *(const f32x4*)(cb + chan + 4); acc[0] = b0[0]; acc[1] = b0[1]; acc[2] = b0[2]; acc[3] = b0[3]; acc[4] = b1[0]; acc[5] = b1[1]; acc[6] = b1[2]; acc[7] = b1[3]; }
#pragma unroll
    for (int k = 0; k < 4; ++k) {
        const f32x4 w0 = *(const f32x4*)(cw + k * 2048 + chan), w1 = *(const f32x4*)(cw + k * 2048 + chan + 4);
        const float m = (spos - 3 + k >= 0) ? 1.0f : 0.0f;
#pragma unroll
        for (int e = 0; e < 4; ++e) { acc[2 * e] += m * (e < 2 ? w0[2 * e] : w1[2 * e - 4]) * __uint_as_float(tap[k][e] << 16); acc[2 * e + 1] += m * (e < 2 ? w0[2 * e + 1] : w1[2 * e - 3]) * __uint_as_float(tap[k][e] & 0xffff0000u); }
    }
    u32x4 o;
#pragma unroll
    for (int e = 0; e < 4; ++e) o[e] = pack2(acc[2 * e] * sigmoidf_(acc[2 * e]), acc[2 * e + 1] * sigmoidf_(acc[2 * e + 1]));
    return o;
}

template <bool WITH_C>
__device__ __forceinline__ void ssd_stage(LAS char* lds, const bf16_t* XBCR_, const float* cw, const float* cb, const float* DT, const float* a_log, const int b, const int c, const int grp) {
    const int tid = threadIdx.x;
    const size_t tt0 = (size_t)b * SEQ + c * 128;
    const int s0 = c * 128;
#define TAP_PTR(l_, k_, chan_) (XBCR_ + (size_t)((long)(tt0 + (l_)) - 3 + (k_) < 0 ? 0 : (long)(tt0 + (l_)) - 3 + (k_)) * 2048 + (chan_))
#pragma unroll 1
    for (int half = 0; half < 2; ++half) {
        u32x4 tp[4][4];
#pragma unroll
        for (int k4 = 0; k4 < 4; ++k4) { const int id = tid + 512 * (4 * half + k4), l = id >> 5, ch = id & 31;
#pragma unroll
            for (int k = 0; k < 4; ++k) tp[k4][k] = *(const u32x4*)TAP_PTR(l, k, grp * 256 + ch * 8); }
#pragma unroll
        for (int k4 = 0; k4 < 4; ++k4) { const int id = tid + 512 * (4 * half + k4), l = id >> 5, ch = id & 31, h = ch >> 3, pc = ch & 7;
            *(LAS u32x4*)(lds + SSD_X_OFF + h * SX_H + l * SX_RS + pc * 16) = conv8_silu(tp[k4], cw, cb, grp * 256 + ch * 8, s0 + l); }
    }
    {
        u32x4 tp[4][4];
#pragma unroll
        for (int k4 = 0; k4 < 4; ++k4) { const int id = tid + 512 * k4, l = id >> 4, ch = id & 15;
#pragma unroll
            for (int k = 0; k < 4; ++k) tp[k4][k] = *(const u32x4*)TAP_PTR(l, k, 1024 + grp * 128 + ch * 8); }
#pragma unroll
        for (int k4 = 0; k4 < 4; ++k4) { const int id = tid + 512 * k4, l = id >> 4, ch = id & 15;
            *(LAS u32x4*)(lds + SSD_B_OFF + l * SB_RS + ch * 16) = conv8_silu(tp[k4], cw, cb, 1024 + grp * 128 + ch * 8, s0 + l); }
    }
    if (WITH_C) {
        u32x4 tp[4][4];
#pragma unroll
        for (int k4 = 0; k4 < 4; ++k4) { const int id = tid + 512 * k4, l = id >> 4, ch = id & 15;
#pragma unroll
            for (int k = 0; k < 4; ++k) tp[k4][k] = *(const u32x4*)TAP_PTR(l, k, 1536 + grp * 128 + ch * 8); }
#pragma unroll
        for (int k4 = 0; k4 < 4; ++k4) { const int id = tid + 512 * k4, l = id >> 4, ch = id & 15;
            *(LAS u32x4*)(lds + SSD_C_OFF + l * SB_RS + ch * 16) = conv8_silu(tp[k4], cw, cb, 1536 + grp * 128 + ch * 8, s0 + l); }
    }
#undef TAP_PTR
    LAS float* dtl = (LAS float*)(lds + SSD_T_OFF); LAS float* acs = dtl + 512;
    const int h = tid >> 7, l = tid & 127;
    const float av = -expf(a_log[grp * 4 + h]);
    const float dtv = DT[(tt0 + l) * 16 + grp * 4 + h];
    dtl[tid] = dtv; acs[tid] = dtv * av;
    __syncthreads();
    float cs = acs[tid];
#pragma unroll
    for (int o = 1; o < 128; o <<= 1) { const float add = (l >= o) ? acs[tid - o] : 0.f; __syncthreads(); cs += add; acs[tid] = cs; __syncthreads(); }
}

__device__ __forceinline__ void ssd_states_item(LAS char* lds, const int item, const bf16_t* XBCB, const float* cw, const float* cb, const float* DT, const float* a_log, float* STATES, float* CHDEC) {
    const int tid = threadIdx.x, lane = tid & 63, wid = tid >> 6, c16 = lane & 15, fq = lane >> 4, q = c16 >> 2, pp = c16 & 3;
    const int grp = item & 3, c = (item >> 2) & 31, b = item >> 7;
    __syncthreads();
    ssd_stage<false>(lds, XBCB, cw, cb, DT, a_log, b, c, grp);
    LAS float* dtl = (LAS float*)(lds + SSD_T_OFF); LAS float* acs = dtl + 512;
#pragma unroll
    for (int k = 0; k < 8; ++k) { const int id = tid + 512 * k, l = id >> 5, ch = id & 31, h = ch >> 3, pc = ch & 7;
        const float w = __expf(acs[h * 128 + 127] - acs[h * 128 + l]) * dtl[h * 128 + l];
        LAS u32x4* pv = (LAS u32x4*)(lds + SSD_X_OFF + h * SX_H + l * SX_RS + pc * 16);
        u32x4 v = *pv;
#pragma unroll
        for (int e = 0; e < 4; ++e) { const float lo = __uint_as_float(v[e] << 16) * w, hi = __uint_as_float(v[e] & 0xffff0000u) * w; v[e] = pack2(lo, hi); }
        *pv = v; }
    if (tid < 4) CHDEC[((size_t)b * 32 + c) * 16 + grp * 4 + tid] = __expf(acs[tid * 128 + 127]);
    __syncthreads();
    s16x8 af[4];
#pragma unroll
    for (int ks = 0; ks < 4; ++ks) {
        const s16x4 t0 = __builtin_amdgcn_ds_read_tr16_b64_v4i16((LAS s16x4*)(lds + SSD_B_OFF + (32 * ks + 8 * fq + q) * SB_RS + (16 * wid + 4 * pp) * 2));
        const s16x4 t1 = __builtin_amdgcn_ds_read_tr16_b64_v4i16((LAS s16x4*)(lds + SSD_B_OFF + (32 * ks + 8 * fq + 4 + q) * SB_RS + (16 * wid + 4 * pp) * 2));
        af[ks] = (s16x8){t0[0], t0[1], t0[2], t0[3], t1[0], t1[1], t1[2], t1[3]};
    }
#pragma unroll
    for (int h = 0; h < 4; ++h) {
        float* sp = STATES + (((size_t)b * 32 + c) * 16 + grp * 4 + h) * 8192;
#pragma unroll
        for (int pt = 0; pt < 4; ++pt) {
            f32x4 acc = {0.f, 0.f, 0.f, 0.f};
#pragma unroll
            for (int ks = 0; ks < 4; ++ks) {
                const s16x4 t0 = __builtin_amdgcn_ds_read_tr16_b64_v4i16((LAS s16x4*)(lds + SSD_X_OFF + h * SX_H + (32 * ks + 8 * fq + q) * SX_RS + (16 * pt + 4 * pp) * 2));
                const s16x4 t1 = __builtin_amdgcn_ds_read_tr16_b64_v4i16((LAS s16x4*)(lds + SSD_X_OFF + h * SX_H + (32 * ks + 8 * fq + 4 + q) * SX_RS + (16 * pt + 4 * pp) * 2));
                const s16x8 bfr = {t0[0], t0[1], t0[2], t0[3], t1[0], t1[1], t1[2], t1[3]};
                acc = __builtin_amdgcn_mfma_f32_16x16x32_bf16(af[ks], bfr, acc, 0, 0, 0);
            }
            *(f32x4*)(sp + (size_t)(16 * pt + c16) * 128 + 16 * wid + 4 * fq) = acc;
        }
    }
}

__device__ __forceinline__ void ssd_out_item(LAS char* lds, const int item, const bf16_t* XBCB, const float* cw, const float* cb, const float* DT, const float* a_log, const float* d_skip, const float* nw,
                                             const bf16_t* PREV, const bf16_t* ZBp, float* YTMP, bf16_t* MIXO) {
    const int tid = threadIdx.x, lane = tid & 63, wid = tid >> 6, c16 = lane & 15, fq = lane >> 4, q = c16 >> 2, pp = c16 & 3;
    const int grp = item & 3, c = (item >> 2) & 31, b = item >> 7;
    __syncthreads();
    ssd_stage<true>(lds, XBCB, cw, cb, DT, a_log, b, c, grp);
    LAS float* dtl = (LAS float*)(lds + SSD_T_OFF); LAS float* acs = dtl + 512;
    const int lcol = 16 * wid + c16;
    const size_t tt = (size_t)b * SEQ + c * 128 + lcol;
    s16x8 cf[4];
#pragma unroll
    for (int ks = 0; ks < 4; ++ks) cf[ks] = *(const LAS s16x8*)(lds + SSD_C_OFF + lcol * SB_RS + (32 * ks + 8 * fq) * 2);
    f32x4 g[8];
#pragma unroll
    for (int mt = 0; mt < 8; ++mt) { g[mt] = (f32x4){0.f, 0.f, 0.f, 0.f};
        if (mt <= wid) {
#pragma unroll
            for (int ks = 0; ks < 4; ++ks) { const s16x8 bfr = *(const LAS s16x8*)(lds + SSD_B_OFF + (16 * mt + c16) * SB_RS + (32 * ks + 8 * fq) * 2);
                g[mt] = __builtin_amdgcn_mfma_f32_16x16x32_bf16(bfr, cf[ks], g[mt], 0, 0, 0); } } }
    float ss = 0.f;
#pragma unroll 1
    for (int h = 0; h < 4; ++h) {
        const int hh = grp * 4 + h;
        const float acs_l = acs[h * 128 + lcol];
        s16x8 pf[4];
#pragma unroll
        for (int ks = 0; ks < 4; ++ks) {
            float pv[2][4];
#pragma unroll
            for (int u = 0; u < 2; ++u) {
                const int s0 = 32 * ks + 16 * u + 4 * fq;
                const f32x4 av4 = *(const LAS f32x4*)(acs + h * 128 + s0), dv4 = *(const LAS f32x4*)(dtl + h * 128 + s0);
#pragma unroll
                for (int i = 0; i < 4; ++i) { const float e = __expf(fminf(acs_l - av4[i], 0.f)) * dv4[i]; pv[u][i] = (s0 + i <= lcol) ? g[2 * ks + u][i] * e : 0.f; }
            }
            const u32x4 w = {pack2(pv[0][0], pv[0][1]), pack2(pv[0][2], pv[0][3]), pack2(pv[1][0], pv[1][1]), pack2(pv[1][2], pv[1][3])};
            pf[ks] = __builtin_bit_cast(s16x8, w);
        }
        const float dsk = d_skip[hh], eal = __expf(acs_l);
        const bf16_t* prevp = PREV + (((size_t)b * 32 + c) * 16 + hh) * 8192;
        s16x8 pr[4][4]; f32x4 zz[4];
#pragma unroll
        for (int pt = 0; pt < 4; ++pt) {
#pragma unroll
            for (int ks = 0; ks < 4; ++ks) pr[pt][ks] = *(const s16x8*)(prevp + (size_t)(16 * pt + c16) * 128 + 32 * ks + 8 * fq);
            { const uint2 zr = *(const uint2*)(ZBp + tt * 1024 + hh * 64 + 16 * pt + 4 * fq); zz[pt] = (f32x4){__uint_as_float(zr.x << 16), __uint_as_float(zr.x & 0xffff0000u), __uint_as_float(zr.y << 16), __uint_as_float(zr.y & 0xffff0000u)}; }
        }
#pragma unroll
        for (int pt = 0; pt < 4; ++pt) {
            f32x4 yd = {0.f, 0.f, 0.f, 0.f}, yo = {0.f, 0.f, 0.f, 0.f};
#pragma unroll
            for (int ks = 0; ks < 4; ++ks) {
                const s16x4 t0 = __builtin_amdgcn_ds_read_tr16_b64_v4i16((LAS s16x4*)(lds + SSD_X_OFF + h * SX_H + (32 * ks + 4 * fq + q) * SX_RS + (16 * pt + 4 * pp) * 2));
                const s16x4 t1 = __builtin_amdgcn_ds_read_tr16_b64_v4i16((LAS s16x4*)(lds + SSD_X_OFF + h * SX_H + (32 * ks + 16 + 4 * fq + q) * SX_RS + (16 * pt + 4 * pp) * 2));
                const s16x8 xf = {t0[0], t0[1], t0[2], t0[3], t1[0], t1[1], t1[2], t1[3]};
                yd = __builtin_amdgcn_mfma_f32_16x16x32_bf16(xf, pf[ks], yd, 0, 0, 0);
                yo = __builtin_amdgcn_mfma_f32_16x16x32_bf16(pr[pt][ks], cf[ks], yo, 0, 0, 0);
            }
            const u32x2 xr = *(const LAS u32x2*)(lds + SSD_X_OFF + h * SX_H + lcol * SX_RS + (16 * pt + 4 * fq) * 2);
            const float xv[4] = {__uint_as_float(xr[0] << 16), __uint_as_float(xr[0] & 0xffff0000u), __uint_as_float(xr[1] << 16), __uint_as_float(xr[1] & 0xffff0000u)};
            const f32x4 z = zz[pt];
            f32x4 gvv;
#pragma unroll
            for (int i = 0; i < 4; ++i) { const float y = yd[i] + eal * yo[i] + dsk * xv[i]; gvv[i] = y * z[i] * sigmoidf_(z[i]); ss += gvv[i] * gvv[i]; }
            *(f32x4*)(YTMP + tt * 1024 + hh * 64 + 16 * pt + 4 * fq) = gvv;
        }
    }
    ss += __shfl_xor(ss, 16); ss += __shfl_xor(ss, 32);
    const float rs = rsqrtf(ss * (1.0f / 256.f) + NORM_EPS);
#pragma unroll 1
    for (int h = 0; h < 4; ++h) {
        f32x4 gq[4], wq[4];
#pragma unroll
        for (int pt = 0; pt < 4; ++pt) { const int ch = (grp * 4 + h) * 64 + 16 * pt + 4 * fq; wq[pt] = *(const f32x4*)(nw + ch); gq[pt] = *(const f32x4*)(YTMP + tt * 1024 + ch); }
#pragma unroll
        for (int pt = 0; pt < 4; ++pt) { const int ch = (grp * 4 + h) * 64 + 16 * pt + 4 * fq;
            *(uint2*)(MIXO + tt * 2048 + ch) = make_uint2(pack2(gq[pt][0] * rs * wq[pt][0], gq[pt][1] * rs * wq[pt][1]), pack2(gq[pt][2] * rs * wq[pt][2], gq[pt][3] * rs * wq[pt][3])); }
    }
}

struct Args {
    const float* in[23];
    float* out;
    unsigned char* ws;
    int ph_lo, ph_hi;
};

enum { PH_NORM1 = 0, PH_INPROJ, PH_SSD_CMP1, PH_GNORM_CMP2,
       PH_NSA,
       PH_OUTPROJ, PH_ROUTER, PH_SCATTER, PH_GATEUP, PH_DOWN, PH_FINAL, N_PHASES };

struct ARowsDense { static constexpr unsigned kstep = 128u; const bf16_t* base; size_t ld; int row0, nrows; const bf16_t* zrow; const void* wsbase;
    __device__ __forceinline__ const bf16_t* row(int r) const { const int g = row0 + r; return g < nrows ? base + (size_t)g * ld : zrow; } };
struct ARowsGather { static constexpr unsigned kstep = 128u; const bf16_t* base; size_t ld; const int* idx; const bf16_t* zrow; const void* wsbase; int nr;
    __device__ __forceinline__ const bf16_t* row(int r) const { const int g = r < nr ? idx[r] : -1; return g >= 0 ? base + (size_t)g * ld : zrow; } };
struct ARowsWindow { static constexpr unsigned kstep = 512u; const bf16_t* base; int row0; const bf16_t* zrow; const void* wsbase;
    __device__ __forceinline__ const bf16_t* row(int r) const { const int gr = row0 + r; if (gr >= CMP_ROWS) return zrow; const int g = gr & 3, n = (gr >> 2) % N_C, b = (gr >> 2) / N_C;
        return base + ((size_t)(b * SEQ + 16 * n)) * 256 + g * 64; } };
struct BColsDense { const float* base; int ldb; int col0, ncols;
    __device__ __forceinline__ int coloff(int n) const { const int c = col0 + n; return c < ncols ? c : ncols - 4; } };
struct BColsGateUp { const float* base; int ldb; int cn;
    __device__ __forceinline__ int coloff(int n) const { const int wc = n >> 7, nt = (n & 127) >> 4, w = n & 15; const int j = wc * 64 + (nt & 3) * 16 + w;
        return (nt < 4 ? 0 : DFF) + cn * 128 + j; } };

struct EpiStoreF32 { static constexpr bool ROW8 = false; float* C; size_t ldc; int row0, col0, ncols;
    __device__ __forceinline__ void operator()(int r, int n, f32x4 v) const { const int c = col0 + n; if (c < ncols) *(f32x4*)(C + (size_t)(row0 + r) * ldc + c) = v; } };
struct EpiResidF32 { static constexpr bool ROW8 = true; float* C; const float* X; size_t ldc; int row0, col0;
    __device__ __forceinline__ void row8(int r, int n0, const f32x4 (&v)[8]) const { const size_t o = (size_t)(row0 + r) * ldc + col0 + n0; f32x4 x[8];
#pragma unroll
        for (int n = 0; n < 8; ++n) x[n] = *(const f32x4*)(X + o + 16 * n);
#pragma unroll
        for (int n = 0; n < 8; ++n) *(f32x4*)(C + o + 16 * n) = v[n] + x[n]; } };
struct EpiSwiglu { static constexpr bool ROW8 = false; bf16_t* O; const float* bias; int row0, cn;
    __device__ __forceinline__ void pair4(int r, int j0, const f32x4 (&a)[8]) const { const int c0 = cn * 128 + j0; f32x4 bg[4], bu[4];
#pragma unroll
        for (int n = 0; n < 4; ++n) { bg[n] = *(const f32x4*)(bias + c0 + 16 * n); bu[n] = *(const f32x4*)(bias + DFF + c0 + 16 * n); }
#pragma unroll
        for (int n = 0; n < 4; ++n) { float o[4];
#pragma unroll
            for (int i = 0; i < 4; ++i) { float gv = a[n][i] + bg[n][i]; float uv = a[n + 4][i] + bu[n][i]; gv = fminf(gv, 7.0f); uv = fminf(fmaxf(uv, -7.0f), 7.0f);
                const float glu = gv * sigmoidf_(1.702f * gv); o[i] = (uv + 1.0f) * glu; }
            *(uint2*)(O + (size_t)(row0 + r) * DFF + c0 + 16 * n) = make_uint2(pack2(o[0], o[1]), pack2(o[2], o[3])); } } };
struct EpiBiasBf16 { static constexpr bool ROW8 = true; bf16_t* O; const float* bias; int row0, col0;
    __device__ __forceinline__ void row8(int r, int n0, const f32x4 (&v)[8]) const { const int c = col0 + n0; f32x4 bz[8];
#pragma unroll
        for (int n = 0; n < 8; ++n) bz[n] = *(const f32x4*)(bias + c + 16 * n);
#pragma unroll
        for (int n = 0; n < 8; ++n) { const f32x4 t = v[n] + bz[n]; *(uint2*)(O + (size_t)(row0 + r) * D + c + 16 * n) = make_uint2(pack2(t[0], t[1]), pack2(t[2], t[3])); } } };


struct EpiInProj { static constexpr bool ROW8 = false; unsigned char* ws; const float* dt_bias; int row0, col0;
    __device__ __forceinline__ void operator()(int r, int n, f32x4 v) const {
        const int cb = __builtin_amdgcn_readfirstlane((col0 + n) & ~15);
        const int ci = (col0 + n) & 15;
        const size_t R = (size_t)(row0 + r); const int pos = (int)(R & (SEQ - 1));
        if (cb >= IN_PROJ) return;
        if (cb >= OFF_DT && cb < OFF_Q) { f32x4 o;
#pragma unroll
            for (int i = 0; i < 4; ++i) { const float x = v[i] + dt_bias[ci + i]; o[i] = x > 20.f ? x : log1pf(expf(x)); }
            *(f32x4*)((float*)(ws + WS_DT) + R * 16 + ci) = o; return; }
        if (cb >= OFF_GATE) { f32x4 o;
#pragma unroll
            for (int i = 0; i < 4; ++i) o[i] = sigmoidf_(v[i]);
            *(f32x4*)((float*)(ws + WS_GATE) + R * 48 + (cb - OFF_GATE) + ci) = o; return; }
        size_t boff; int ld, cc; bool rp = false; float scl = 1.0f;
        if (cb < OFF_XBC) { boff = WS_ZB; ld = 1024; cc = cb; }
        else if (cb < OFF_DT) { boff = WS_XBCR; ld = 2048; cc = cb - OFF_XBC; }
        else if (cb < OFF_KCMP) { boff = WS_QB; ld = 1024; cc = cb - OFF_Q; rp = true; scl = 0.125f * 1.4426950408889634f; }
        else if (cb < OFF_VCMP) { boff = WS_KCMP; ld = 256; cc = cb - OFF_KCMP; }
        else if (cb < OFF_KSLC) { boff = WS_VCMP; ld = 256; cc = cb - OFF_VCMP; }
        else if (cb < OFF_VSLC) { boff = WS_KS; ld = 256; cc = cb - OFF_KSLC; rp = true; }
        else if (cb < OFF_KWIN) { boff = WS_VS; ld = 256; cc = cb - OFF_VSLC; }
        else if (cb < OFF_VWIN) { boff = WS_KW; ld = 256; cc = cb - OFF_KWIN; rp = true; }
        else { boff = WS_VW; ld = 256; cc = cb - OFF_VWIN; }
        f32x4 o = v;
        if (rp && (cc & 63) == 0) {
            const float* rope = (const float*)(ws + WS_ROPE);
#pragma unroll
            for (int i = 0; i < 4; ++i) { const float pr = xchg32(v[i]); const int k = (ci & 7) + i; const float c = rope[pos * 8 + k], sn = rope[SEQ * 8 + pos * 8 + k];
                o[i] = (ci < 8) ? (v[i] * c - pr * sn) : (pr * sn + v[i] * c); }
        }
        *(uint2*)((bf16_t*)(ws + boff) + R * ld + cc + ci) = make_uint2(pack2(o[0] * scl, o[1] * scl), pack2(o[2] * scl, o[3] * scl));
    } };


__device__ __forceinline__ const bf16_t* zrow_of(unsigned char* ws) { return (const bf16_t*)((unsigned*)(ws + WS_CTL) + CW_ZROW); }
struct MkInProj { static constexpr bool MASKED = false; __device__ __forceinline__ int rows_valid(int) const { return 256; } typedef ARowsDense AL; typedef BColsDense BL; typedef EpiInProj EP; unsigned char* ws; const float* w; const float* dt_bias;
    __device__ __forceinline__ void make_src(int rt, int ct, AL& al, BL& bl) const { al = AL{(const bf16_t*)(ws + WS_XN), (size_t)D, rt * 256, T, zrow_of(ws), ws}; bl = BL{w, IN_PROJ, ct * 256, IN_PROJ}; }
    __device__ __forceinline__ void make_ep(int rt, int ct, EP& ep) const { ep = EP{ws, dt_bias, rt * 256, ct * 256}; } };
struct MkOutProj { static constexpr bool MASKED = false; __device__ __forceinline__ int rows_valid(int) const { return 256; } typedef ARowsDense AL; typedef BColsDense BL; typedef EpiResidF32 EP; unsigned char* ws; const float* w; const float* x;
    __device__ __forceinline__ void make_src(int rt, int ct, AL& al, BL& bl) const { al = AL{(const bf16_t*)(ws + WS_MIX), (size_t)2048, rt * 256, T, zrow_of(ws), ws}; bl = BL{w, D, ct * 256, D}; }
    __device__ __forceinline__ void make_ep(int rt, int ct, EP& ep) const { ep = EP{(float*)(ws + WS_X2), x, (size_t)D, rt * 256, ct * 256}; } };
constexpr int TT_OFF = GEMM_LDS;
__device__ __forceinline__ int moe_tile_table(LAS char* lds, const unsigned* cnt) {
    LAS int* tt = (LAS int*)(lds + TT_OFF); LAS int* tmp = tt + 480;
    const int tid = threadIdx.x;
    int ntiles = 0;
    for (int k = 0; k < NE; ++k) ntiles += (int)((cnt[k] + 255u) >> 8);
    if (tid < ntiles) { int e = 0, acc = 0, first = 0;
        for (int k = 0; k < NE; ++k) { const int nt = (int)((cnt[k] + 255u) >> 8); if (tid >= acc && tid < acc + nt) { e = k; first = acc; } acc += nt; }
        const int v = min(256, (int)cnt[e] - 256 * (tid - first));
        tmp[tid] = e; tmp[160 + tid] = v; }
    __syncthreads();
    if (tid < ntiles) { int nheavy = 0, hb = 0, lb = 0; const bool heavy = tmp[160 + tid] > 128;
        for (int k = 0; k < ntiles; ++k) { const bool hk = tmp[160 + k] > 128; nheavy += hk ? 1 : 0; if (k < tid) { hb += hk ? 1 : 0; lb += hk ? 0 : 1; } }
        const int slot = tid; (void)heavy; (void)hb; (void)lb; (void)nheavy;
        tt[slot] = tid; tt[160 + slot] = tmp[tid]; tt[320 + slot] = tmp[160 + tid]; }
    __syncthreads();
    return ntiles; }
__device__ __forceinline__ int moe_rows_valid(const LAS int* tt, int rtc) { const int v = tt[320 + (rtc & 0xffff)], hc = rtc >> 16; return hc == 0 ? v : min(128, max(0, v - (hc == 2 ? 128 : 0))); }
struct MkGateUp { static constexpr bool MASKED = true; typedef ARowsGather AL; typedef BColsGateUp BL; typedef EpiSwiglu EP; unsigned char* ws; const float* w; const float* bias; const LAS int* tt;
    __device__ __forceinline__ int rows_valid(int rtc) const { return moe_rows_valid(tt, rtc); }
    __device__ __forceinline__ void make_src(int rtc, int cn, AL& al, BL& bl) const { const int rt = rtc & 0xffff, hc = rtc >> 16, tile = __builtin_amdgcn_readfirstlane(tt[rt]), e = __builtin_amdgcn_readfirstlane(tt[160 + rt]);
        al = AL{(const bf16_t*)(ws + WS_XN), (size_t)D, (const int*)(ws + WS_ROWTOK) + tile * 256 + (hc == 2 ? 128 : 0), zrow_of(ws), ws, hc ? 128 : 256}; bl = BL{w + (size_t)e * D * 2 * DFF, 2 * DFF, cn}; }
    __device__ __forceinline__ void make_ep(int rtc, int cn, EP& ep) const { const int rt = rtc & 0xffff, hc = rtc >> 16, tile = __builtin_amdgcn_readfirstlane(tt[rt]), e = __builtin_amdgcn_readfirstlane(tt[160 + rt]);
        ep = EP{(bf16_t*)(ws + WS_ACT), bias + (size_t)e * 2 * DFF, tile * 256 + (hc == 2 ? 128 : 0), cn}; } };
struct MkDown { static constexpr bool MASKED = true; typedef ARowsDense AL; typedef BColsDense BL; typedef EpiBiasBf16 EP; unsigned char* ws; const float* w; const float* bias; const LAS int* tt;
    __device__ __forceinline__ int rows_valid(int rtc) const { return moe_rows_valid(tt, rtc); }
    __device__ __forceinline__ void make_src(int rtc, int ct, AL& al, BL& bl) const { const int rt = rtc & 0xffff, hc = rtc >> 16, tile = __builtin_amdgcn_readfirstlane(tt[rt]), e = __builtin_amdgcn_readfirstlane(tt[160 + rt]);
        const int r0 = tile * 256 + (hc == 2 ? 128 : 0);
        al = AL{(const bf16_t*)(ws + WS_ACT), (size_t)DFF, r0, hc ? r0 + 128 : MAX_ROWS, zrow_of(ws), ws}; bl = BL{w + (size_t)e * DFF * D, D, ct * 256, D}; }
    __device__ __forceinline__ void make_ep(int rtc, int ct, EP& ep) const { const int rt = rtc & 0xffff, hc = rtc >> 16, tile = __builtin_amdgcn_readfirstlane(tt[rt]), e = __builtin_amdgcn_readfirstlane(tt[160 + rt]);
        ep = EP{(bf16_t*)(ws + WS_Y), bias + (size_t)e * D, tile * 256 + (hc == 2 ? 128 : 0), ct * 256}; } };
struct ProvCmp1 { static constexpr bool SINGLE = true, MASKED = false; typedef ARowsWindow AL; typedef BColsDense BL; typedef EpiStoreF32 EP; unsigned char* ws; const float* w1; int u, G;
    int cu;
    __device__ __forceinline__ bool next(AL& al, BL& bl) { if (u >= 128) return false; const int kq = u >> 5, j = (u >> 4) & 1, rt = (u >> 1) & 7, ct = u & 1; cu = u; u += G;
        al = AL{(const bf16_t*)(ws + (j ? WS_VCMP : WS_KCMP)) + (size_t)kq * 8 * 256, rt * 256, zrow_of(ws), ws};
        bl = BL{w1 + (size_t)j * 2048 * CMP_HID + (size_t)kq * 512 * CMP_HID, CMP_HID, ct * 256, CMP_HID}; return true; }
    __device__ __forceinline__ void make_ep(EP& ep) const { const int kq = cu >> 5, j = (cu >> 4) & 1, rt = (cu >> 1) & 7, ct = cu & 1;
        ep = EP{(float*)(ws + WS_PART) + (size_t)(kq * 2 + j) * 2048 * CMP_HID, (size_t)CMP_HID, rt * 256, ct * 256, CMP_HID}; } };

__device__ __forceinline__ float rope_inv(int i) { return (float)exp(-(double)i * 0.125 * 13.122363377404328); }


__global__ void __launch_bounds__(512, 2) fwd(Args a) {
    extern __shared__ __attribute__((aligned(16))) unsigned char lds_raw[];
    LAS char* lds = (LAS char*)lds_raw;
    const int tid = threadIdx.x, lane = tid & 63, wid = __builtin_amdgcn_readfirstlane(tid >> 6);
    const int G = gridDim.x, bid = blockIdx.x;
    const int gtid = bid * 512 + tid, gthreads = G * 512;
    const int gwave = bid * 8 + wid, gwaves = G * 8;
    unsigned char* ws = a.ws;
    unsigned* ctl = (unsigned*)(ws + WS_CTL);
    volatile LAS unsigned* barw = (volatile LAS unsigned*)(lds + MAIN_LDS);
    if (tid == 0) { barw[0] = 0u; barw[1] = 0u; barw[2] = 0u; barw[3] = 0u; }
    __syncthreads();
    XcdBarrier bar; bar.bar = ctl; bar.x = 0; bar.st = barw;
    const bool multi = (a.ph_hi - a.ph_lo) > 1;
    int vbid = (G % 8 == 0) ? (bid & 7) * (G / 8) + (bid >> 3) : bid;
    if (multi) bar = xcd_barrier_post(ctl, barw);
#ifdef ONLY_PH
#define IN(k) ((k) == ONLY_PH)
#else
#define IN(k) (a.ph_lo <= (k) && (k) < a.ph_hi)
#endif
#define SEAM(k) do { if ((k) + 1 < a.ph_hi) xcd_barrier(bar); } while (0)

#define XN ((bf16_t*)(ws + WS_XN))
#define DT ((float*)(ws + WS_DT))
#define YSSD ((float*)(ws + WS_YSSD))
#define MIX ((bf16_t*)(ws + WS_MIX))
#define ROPE ((float*)(ws + WS_ROPE))
#define X2 ((float*)(ws + WS_X2))
#define TOPE ((int*)(ws + WS_TOPE))
#define TOPG ((float*)(ws + WS_TOPG))
#define SLOT ((int*)(ws + WS_SLOT))
#define POS ((int*)(ws + WS_POS))
#define ROWTOK ((int*)(ws + WS_ROWTOK))
#define ACT ((bf16_t*)(ws + WS_ACT))
#define YB ((bf16_t*)(ws + WS_Y))
#define STATES ((float*)(ws + WS_STATES))
#define PREV ((bf16_t*)(ws + WS_PREV))
#define CHDEC ((float*)(ws + WS_CHDEC))
#define QB ((bf16_t*)(ws + WS_QB))
#define KSb ((bf16_t*)(ws + WS_KS))
#define VSb ((bf16_t*)(ws + WS_VS))
#define KWb ((bf16_t*)(ws + WS_KW))
#define VWb ((bf16_t*)(ws + WS_VW))
#define KCB ((bf16_t*)(ws + WS_KCB))
#define VCB ((bf16_t*)(ws + WS_VCB))
#define XIN (a.in[0])
#define RW ((float*)(ws + WS_RW))
#define BCNT ((int*)(ws + WS_BCNT))
#define ZB ((bf16_t*)(ws + WS_ZB))
#define XBCR ((bf16_t*)(ws + WS_XBCR))
#define KCMPb ((bf16_t*)(ws + WS_KCMP))
#define VCMPb ((bf16_t*)(ws + WS_VCMP))
#define GATE ((float*)(ws + WS_GATE))
#define PEW ((float*)(ws + WS_PEW))
#define PEWP ((float*)(ws + WS_PEWP))
#define PART ((float*)(ws + WS_PART))
#define COUNT (ctl + CW_COUNT)
#define ZROW ((const bf16_t*)(ctl + CW_ZROW))
    if (IN(PH_NORM1)) {
        const float* w = a.in[1];
        for (int row = gwave; row < T; row += gwaves) {
            const float4* xr = (const float4*)(XIN + (size_t)row * D);
            float4 v[8], wg[8]; float ss = 0.f;
#pragma unroll
            for (int i = 0; i < 8; ++i) { v[i] = xr[lane + 64 * i]; wg[i] = ((const float4*)w)[lane + 64 * i]; }
#pragma unroll
            for (int i = 0; i < 8; ++i) ss += v[i].x * v[i].x + v[i].y * v[i].y + v[i].z * v[i].z + v[i].w * v[i].w;
            ss = wave_sum(ss);
            const float rstd = rsqrtf(ss * (1.0f / D) + NORM_EPS);
#pragma unroll
            for (int i = 0; i < 8; ++i) { const float4 wv = wg[i];
                *(uint2*)(XN + (size_t)row * D + 4 * (lane + 64 * i)) = make_uint2(pack2(v[i].x * rstd * wv.x, v[i].y * rstd * wv.y), pack2(v[i].z * rstd * wv.z, v[i].w * rstd * wv.w)); }
        }
        for (int i = gtid; i < SEQ * 8; i += gthreads) { const int pos = i >> 3, k = i & 7; const float ang = (float)pos * rope_inv(k); ROPE[i] = cosf(ang); ROPE[SEQ * 8 + i] = sinf(ang); }
        for (int i = gtid; i < MAX_ROWS; i += gthreads) ROWTOK[i] = -1;
        for (int i = gtid; i < 2 * 2 * 256; i += gthreads) { const int d = i & 255, b = (i >> 8) & 1, j = i >> 9; (j ? VCB : KCB)[((size_t)b * 256 + 255) * 256 + d] = 0; }
        for (int i = gtid; i < 2048 * 32; i += gthreads) { const int ii = i & 3, e = (i >> 2) & 31, kk = i >> 7, k = 4 * kk + ii; RW[i] = a.in[15][k] * a.in[16][k * NE + e]; }
        for (int i = gtid; i < 32 * 2 * CMP_HID; i += gthreads) {
            const int col = i & (CMP_HID - 1), j = (i >> 9) & 1, kc = i >> 10; const float* pe = a.in[9] + j * 2048 + kc * 64; const float* w1 = a.in[10] + ((size_t)j * 2048 + kc * 64) * CMP_HID + col;
            float acc = 0.f;
#pragma unroll 8
            for (int k = 0; k < 64; ++k) acc += pe[k] * w1[(size_t)k * CMP_HID];
            PEWP[i] = acc;
        }
        SEAM(PH_NORM1);
    }

    if (IN(PH_INPROJ)) {
        for (int i = gtid; i < 2 * CMP_HID; i += gthreads) { float acc = 0.f;
#pragma unroll 8
            for (int kc = 0; kc < 32; ++kc) acc += PEWP[kc * 1024 + i]; PEW[i] = acc; }
        if (multi && a.ph_lo <= PH_NORM1) {
            if (tid == 0) { unsigned base = 0u;
#pragma unroll
                for (unsigned j = 0; j < 16; ++j) { const unsigned c = xb_ld(&ctl[XB_XCNT(j)]); base += (j < bar.x) ? c : 0u; }
                barw[3] = base + barw[2]; }
            __syncthreads();
            vbid = __builtin_amdgcn_readfirstlane((int)barw[3]);
            if (vbid < 0 || vbid >= G) vbid = bid;
        }
        { PatchProv<MkInProj> P; P.mk = MkInProj{ws, a.in[2], a.in[5]}; P.init(T / 256, (IN_PROJ + 255) / 256, G, vbid); gemm_stream<false>(lds, P, D); }
        SEAM(PH_INPROJ);
    }

    if (IN(PH_SSD_CMP1)) {
        const int GW = G;
        {
            for (int u0 = bid; u0 < 128; u0 += GW) { ProvCmp1 P{ws, a.in[10], u0, 1 << 20, 0}; gemm_stream<false>(lds, P, 512); }
            for (int it = (bid + GW - (128 % GW)) % GW; it < 256; it += GW) ssd_states_item(lds, it, XBCR, a.in[3], a.in[4], DT, a.in[6], STATES, CHDEC);
        }
        SEAM(PH_SSD_CMP1);
    }

    if (IN(PH_GNORM_CMP2)) {
        const float* nw = a.in[8];
        for (int i = gtid; i < 2 * 16 * 64 * 32; i += gthreads) {
            const int n4 = i & 31, p = (i >> 5) & 63, h = (i >> 11) & 15, b = i >> 15;
            f32x4 run = {0.f, 0.f, 0.f, 0.f};
#pragma unroll 1
            for (int c0 = 0; c0 < 32; c0 += 16) {
                f32x4 sv[16]; float dec[16];
#pragma unroll
                for (int q = 0; q < 16; ++q) { const size_t base = (((size_t)b * 32 + c0 + q) * 16 + h) * 8192 + p * 128 + n4 * 4; sv[q] = *(const f32x4*)(STATES + base); dec[q] = CHDEC[((size_t)b * 32 + c0 + q) * 16 + h]; }
#pragma unroll
                for (int q = 0; q < 16; ++q) { const size_t base = (((size_t)b * 32 + c0 + q) * 16 + h) * 8192 + p * 128 + n4 * 4;
                    *(uint2*)(PREV + base) = make_uint2(pack2(run[0], run[1]), pack2(run[2], run[3])); run = run * dec[q] + sv[q]; }
            }
        }
        const float* w2 = a.in[12]; const float* b2 = a.in[13]; const float* b1 = a.in[11];
        for (int it = gwave; it < 2 * CMP_ROWS; it += gwaves) {
            const int row = it % CMP_ROWS, j = it / CMP_ROWS, d = lane;
            const float* wj = w2 + (size_t)j * CMP_HID * 64;
            float s0 = b2[j * 64 + d];
            for (int k0 = 0; k0 < CMP_HID; k0 += 64) {
                float hx = b1[j * CMP_HID + k0 + lane] + PEW[j * CMP_HID + k0 + lane];
#pragma unroll
                for (int q = 0; q < 4; ++q) hx += PART[((size_t)(q * 2 + j) * 2048 + row) * CMP_HID + k0 + lane];
                const float u = 0.7978845608028654f * (hx + 0.044715f * hx * hx * hx);
                const float hv = bf2f(f2bf(0.5f * hx * (1.0f + tanhf(u))));
#pragma unroll
                for (int kk = 0; kk < 64; ++kk) s0 += __builtin_bit_cast(float, __builtin_amdgcn_readlane(__builtin_bit_cast(int, hv), kk)) * wj[(k0 + kk) * 64 + d];
            }
            float o = s0;
            if (j == 0) { const float sp = __shfl(s0, (d < 8) ? d + 8 : ((d < 16) ? d - 8 : d));
                if (d < 16) { const int n = (row >> 2) % N_C, pos = 16 * n + 31, k = d & 7; const float c = ROPE[pos * 8 + k], sn = ROPE[SEQ * 8 + pos * 8 + k];
                    o = (d < 8) ? (s0 * c - sp * sn) : (sp * sn + s0 * c); } }
            { const int g4 = row & 3, n = (row >> 2) % N_C, bb = (row >> 2) / N_C; (j ? VCB : KCB)[((size_t)bb * 256 + n) * 256 + g4 * 64 + d] = f2bf(o); }
        }
        SEAM(PH_GNORM_CMP2);
    }

    if (IN(PH_NSA)) {
        bf16_t* MIXO = MIX;
        for (int k = bid; k < 512; k += G) { const int rnd = k / G; const int u = (rnd & 1) ? ((511 - (k - G * rnd) - G * (rnd - 1)) ^ 7) : k;
            if (u >= 0 && u < 512) nsa_unit32(lds, (G == 256) ? u : k, QB, KSb, VSb, KWb, VWb, KCB, VCB, GATE, MIXO); }
        for (int it = bid; it < 256; it += G) ssd_out_item(lds, it, XBCR, a.in[3], a.in[4], DT, a.in[6], a.in[7], a.in[8], PREV, ZB, YSSD, MIXO);
        SEAM(PH_NSA);
    }

    if (IN(PH_OUTPROJ)) {
        { PatchProv<MkOutProj> P; P.mk = MkOutProj{ws, a.in[14], a.in[0]}; P.init(T / 256, D / 256, G, vbid); gemm_stream<false>(lds, P, 2048); }
        SEAM(PH_OUTPROJ);
    }

    if (IN(PH_ROUTER)) {
        const float* nwp = a.in[15]; const float* br = a.in[17];
        LAS float* part = (LAS float*)lds;
        LAS float* ssq = part + 8 * 512;
        LAS float* rsl = ssq + 128;
        LAS int* lcnt = (LAS int*)(rsl + 32);
        if (tid < 32) lcnt[tid] = 0;
        __syncthreads();
        const int r16 = lane & 15, kq = lane >> 4;
        for (int tp = bid; tp < T / 32; tp += G) {
            const int wt = wid >> 2, wk = wid & 3, tile = 2 * tp + wt;
            const int row = tile * 16 + r16;
            f32x4 acc0 = {0.f, 0.f, 0.f, 0.f}, acc1 = {0.f, 0.f, 0.f, 0.f}; float ssp = 0.f;
            const float* xr = X2 + (size_t)row * D + 512 * wk + 4 * kq;
            const float* rwp = RW + ((size_t)(128 * wk + kq) * 32 + r16) * 4;
#pragma unroll 8
            for (int j = 0; j < 32; ++j) {
                const f32x4 av = *(const f32x4*)(xr + 16 * j);
                const f32x4 b0 = *(const f32x4*)(rwp + (size_t)j * 4 * 128), b1 = *(const f32x4*)(rwp + (size_t)j * 4 * 128 + 64);
                ssp += av[0] * av[0] + av[1] * av[1] + av[2] * av[2] + av[3] * av[3];
#pragma unroll
                for (int i = 0; i < 4; ++i) { acc0 = __builtin_amdgcn_mfma_f32_16x16x4f32(av[i], b0[i], acc0, 0, 0, 0); acc1 = __builtin_amdgcn_mfma_f32_16x16x4f32(av[i], b1[i], acc1, 0, 0, 0); }
            }
            ssp += __shfl_xor(ssp, 16); ssp += __shfl_xor(ssp, 32);
            if (kq == 0) ssq[wid * 16 + r16] = ssp;
#pragma unroll
            for (int i = 0; i < 4; ++i) { part[wid * 512 + (4 * kq + i) * 32 + r16] = acc0[i]; part[wid * 512 + (4 * kq + i) * 32 + 16 + r16] = acc1[i]; }
            __syncthreads();
#pragma unroll
            for (int rep = 0; rep < 2; ++rep) {
                const int idx = tid + 512 * rep, ts = idx >> 9, rr = (idx >> 5) & 15, e = idx & 31, grow = (2 * tp + ts) * 16 + rr;
                float lg = 0.f, ss = 0.f;
#pragma unroll
                for (int w = 0; w < 4; ++w) { lg += part[(4 * ts + w) * 512 + rr * 32 + e]; ss += ssq[(4 * ts + w) * 16 + rr]; }
                const float rstd = rsqrtf(ss * (1.0f / D) + NORM_EPS);
                const float mine = lg * rstd + br[e];
                int rank = 0;
#pragma unroll
                for (int k = 0; k < NE; ++k) { const float o = __shfl(mine, (lane & 32) + k); rank += (o > mine || (o == mine && k < e)) ? 1 : 0; }
                const bool sel = rank < 4;
                float mx = sel ? mine : -INFINITY;
#pragma unroll
                for (int o = 16; o > 0; o >>= 1) mx = fmaxf(mx, __shfl_xor(mx, o));
                const float ex = sel ? __expf(mine - mx) : 0.f;
                float den = ex;
#pragma unroll
                for (int o = 16; o > 0; o >>= 1) den += __shfl_xor(den, o);
                if (sel) { const int slot = atomicAdd((int*)&lcnt[e], 1); const int o = grow * 4 + rank; TOPE[o] = e; TOPG[o] = ex / den; SLOT[o] = slot; }
                if (e == 0) rsl[ts * 16 + rr] = rstd;
            }
            __syncthreads();
            if (tid < 32) { BCNT[tp * 32 + tid] = lcnt[tid]; lcnt[tid] = 0; }
            { const f32x4 wv = *(const f32x4*)(nwp + 4 * tid);
#pragma unroll 1
              for (int half = 0; half < 4; ++half) {
                f32x4 vv[8];
#pragma unroll
                for (int it = 0; it < 8; ++it) vv[it] = *(const f32x4*)(X2 + (size_t)(tp * 32 + half * 8 + it) * D + 4 * tid);
#pragma unroll
                for (int it = 0; it < 8; ++it) { const float rs = rsl[half * 8 + it]; const f32x4 v = vv[it];
                    *(uint2*)(XN + (size_t)(tp * 32 + half * 8 + it) * D + 4 * tid) = make_uint2(pack2(v[0] * rs * wv[0], v[1] * rs * wv[1]), pack2(v[2] * rs * wv[2], v[3] * rs * wv[3])); }
              } }
            __syncthreads();
        }
        SEAM(PH_ROUTER);
    }

    if (IN(PH_SCATTER)) {
        LAS int* red = (LAS int*)lds;
        for (int cb = bid; cb < 64; cb += G) {
            const int tp0 = 4 * cb, e = tid & 31, c = tid >> 5;
            int sb = 0, stt = 0;
#pragma unroll 4
            for (int q = 0; q < 16; ++q) { const int tpq = 16 * c + q; const int v = BCNT[tpq * 32 + e]; stt += v; sb += (tpq < tp0) ? v : 0; }
            red[c * 32 + e] = sb; red[512 + c * 32 + e] = stt;
            __syncthreads();
            if (tid < 32) { int b0 = 0, tt_ = 0;
#pragma unroll
                for (int q = 0; q < 16; ++q) { b0 += red[q * 32 + tid]; tt_ += red[512 + q * 32 + tid]; }
                red[1024 + tid] = b0; red[1056 + tid] = tt_; if (cb == 0) COUNT[tid] = (unsigned)tt_; }
            __syncthreads();
            { const int i = cb * 512 + tid, ei = TOPE[i], tp = i >> 7;
              int base = red[1024 + ei];
              for (int q = tp0; q < tp; ++q) base += BCNT[q * 32 + ei];
              int off = 0;
              for (int k = 0; k < ei; ++k) off += (red[1056 + k] + 255) >> 8;
              const int pos = off * 256 + base + SLOT[i];
              ROWTOK[pos] = i >> 2; POS[i] = pos; }
            __syncthreads();
        }
        SEAM(PH_SCATTER);
    }

    if (IN(PH_GATEUP)) {
        const int ntiles = moe_tile_table(lds, COUNT);
        { PatchProv<MkGateUp> P; P.mk = MkGateUp{ws, a.in[18], a.in[19], (const LAS int*)(lds + TT_OFF)}; P.init(ntiles, 16, G, vbid); gemm_stream<true>(lds, P, D); }
        SEAM(PH_GATEUP);
    }
    if (IN(PH_DOWN)) {
        const int ntiles = moe_tile_table(lds, COUNT);
        { PatchProv<MkDown> P; P.mk = MkDown{ws, a.in[20], a.in[21], (const LAS int*)(lds + TT_OFF)}; P.init(ntiles, 8, G, vbid); gemm_stream<false>(lds, P, DFF); }
        SEAM(PH_DOWN);
    }

    if (IN(PH_FINAL)) {
        const float* fw = a.in[22];
        for (int row = gwave; row < T; row += gwaves) {
            const float4* xr = (const float4*)(X2 + (size_t)row * D);
            float4 v[8], wg[8]; float gks[4]; int ps[4];
#pragma unroll
            for (int k = 0; k < 4; ++k) { gks[k] = TOPG[row * 4 + k]; ps[k] = POS[row * 4 + k]; }
#pragma unroll
            for (int i = 0; i < 8; ++i) { v[i] = xr[lane + 64 * i]; wg[i] = ((const float4*)fw)[lane + 64 * i]; }
#pragma unroll
            for (int k = 0; k < 4; ++k) { const float gk = gks[k]; const bf16_t* yr = YB + (size_t)ps[k] * D;
#pragma unroll
                for (int i = 0; i < 8; ++i) { const uint2 y = *(const uint2*)(yr + 4 * (lane + 64 * i));
                    v[i].x += gk * bf2f((bf16_t)(y.x & 0xffffu)); v[i].y += gk * bf2f((bf16_t)(y.x >> 16)); v[i].z += gk * bf2f((bf16_t)(y.y & 0xffffu)); v[i].w += gk * bf2f((bf16_t)(y.y >> 16)); } }
            float ss = 0.f;
#pragma unroll
            for (int i = 0; i < 8; ++i) ss += v[i].x * v[i].x + v[i].y * v[i].y + v[i].z * v[i].z + v[i].w * v[i].w;
            ss = wave_sum(ss);
            float rstd = rsqrtf(ss * (1.0f / D) + NORM_EPS);
#pragma unroll
            for (int i = 0; i < 8; ++i) { const float4 wv = wg[i];
                ((float4*)(a.out + (size_t)row * D))[lane + 64 * i] = make_float4(v[i].x * rstd * wv.x, v[i].y * rstd * wv.y, v[i].z * rstd * wv.z, v[i].w * rstd * wv.w); }
        }
    }
#undef IN
#undef SEAM
}

extern "C" void kernel_launch(void* const* d_in, const int* in_sizes, int n_in, void* d_out, int out_size, void* d_ws, size_t ws_size, hipStream_t stream) {
    static int grid = 0;
    if (grid == 0) {
        if (n_in != 23 || out_size != T * D || ws_size < WS_END) { fprintf(stderr, "kernel_launch: unexpected shapes (n_in %d, out %d, ws %zu < %zu)\n", n_in, out_size, ws_size, (size_t)WS_END); grid = -1; return; }
        int dev = 0, cus = 0, per_cu = 0;
        if (hipGetDevice(&dev) != hipSuccess || hipDeviceGetAttribute(&cus, hipDeviceAttributeMultiprocessorCount, dev) != hipSuccess) { grid = -1; return; }
        if (hipFuncSetAttribute((const void*)fwd, hipFuncAttributeMaxDynamicSharedMemorySize, LDS_BYTES) != hipSuccess) { fprintf(stderr, "kernel_launch: hipFuncSetAttribute failed\n"); grid = -1; return; }
        if (hipOccupancyMaxActiveBlocksPerMultiprocessor(&per_cu, (const void*)fwd, 512, LDS_BYTES) != hipSuccess || per_cu < 1) { fprintf(stderr, "kernel_launch: occupancy query says %d\n", per_cu); per_cu = 1; }
        (void)hipGetLastError();
        grid = cus;
    }
    if (grid < 0) return;
    (void)hipMemsetAsync((char*)d_ws + WS_CTL, 0, CTL_BYTES, stream);
    Args a{};
    for (int i = 0; i < 23; ++i) a.in[i] = (const float*)d_in[i];
    a.out = (float*)d_out; a.ws = (unsigned char*)d_ws;
#if N_LAUNCH_MODE == 1
    a.ph_lo = 0; a.ph_hi = N_PHASES;
    hipLaunchKernelGGL(fwd, dim3(grid), dim3(512), LDS_BYTES, stream, a);
#else
    for (int ph = 0; ph < N_PHASES; ++ph) { a.ph_lo = ph; a.ph_hi = ph + 1; hipLaunchKernelGGL(fwd, dim3(grid), dim3(512), LDS_BYTES, stream, a); }
#endif
}
```

```cpp
#include <hip/hip_runtime.h>
#include <stdint.h>
#include <stdio.h>

#ifndef N_LAUNCH_MODE
#define N_LAUNCH_MODE 1
#endif

typedef unsigned short bf16_t;
typedef short s16x4 __attribute__((ext_vector_type(4)));
typedef short s16x8 __attribute__((ext_vector_type(8)));
typedef float f32x4 __attribute__((ext_vector_type(4)));
typedef unsigned u32x4 __attribute__((ext_vector_type(4)));
typedef unsigned u32x2 __attribute__((ext_vector_type(2)));
#define LAS __attribute__((address_space(3)))

constexpr int D = 2048, BATCH = 2, SEQ = 4096, T = BATCH * SEQ;
constexpr int SSM_H = 16, SSM_N = 128;
constexpr int NSA_H = 16, DH = 64;
constexpr int CMP_HID = 512;
constexpr int N_C = 255, N_SEL = 64;
constexpr int IN_PROJ = 5696;
constexpr int OFF_Z = 0, OFF_XBC = 1024, OFF_DT = 3072, OFF_Q = 3088, OFF_KCMP = 4112, OFF_VCMP = 4368, OFF_KSLC = 4624,
              OFF_VSLC = 4880, OFF_KWIN = 5136, OFF_VWIN = 5392, OFF_GATE = 5648;
constexpr int NE = 32, DFF = 2048;
constexpr float NORM_EPS = 1e-5f;
constexpr int CMP_ROWS = BATCH * N_C * 4;
constexpr int MAX_TILES = 160, MAX_ROWS = MAX_TILES * 256;

constexpr size_t AL(size_t x) { return (x + 255) & ~(size_t)255; }
constexpr size_t WS_CTL = 0;
constexpr size_t CTL_BYTES = 32768;
constexpr size_t WS_XN = WS_CTL + CTL_BYTES;
constexpr size_t WS_PROJ = WS_XN + AL((size_t)T * D * 2);
constexpr size_t WS_ZB = WS_PROJ;
constexpr size_t WS_XBCR = WS_ZB + AL((size_t)T * 1024 * 2);
constexpr size_t WS_KCMP = WS_XBCR + AL((size_t)T * 2048 * 2);
constexpr size_t WS_VCMP = WS_KCMP + AL((size_t)T * 256 * 2);
constexpr size_t WS_GATE = WS_VCMP + AL((size_t)T * 256 * 2);
constexpr size_t WS_PEW = WS_GATE + AL((size_t)T * 48 * 4);
constexpr size_t WS_PEWP = WS_PEW + 4096;
static_assert(WS_PEWP + 32 * 1024 * 4 <= WS_PROJ + AL((size_t)T * IN_PROJ * 4), "in-proj outputs fit the old PROJ region");
constexpr size_t WS_XBC = WS_PROJ + AL((size_t)T * IN_PROJ * 4);
constexpr size_t WS_DT = WS_XBC + AL((size_t)T * 2048 * 4);
constexpr size_t WS_YSSD = WS_DT + AL((size_t)T * 16 * 4);
constexpr size_t WS_MIX = WS_YSSD + AL((size_t)T * 1024 * 4);
constexpr size_t WS_ROPE = WS_MIX + AL((size_t)T * 2048 * 2);
constexpr size_t WS_BLK = WS_ROPE + AL((size_t)SEQ * 16 * 4);
constexpr size_t WS_H1 = WS_BLK + AL((size_t)2 * 2048 * 2048 * 2);
constexpr size_t WS_KC = WS_H1 + AL((size_t)2 * 2048 * 512 * 2);
constexpr size_t WS_VC = WS_KC + AL((size_t)2048 * 64 * 4);
constexpr size_t WS_PCMP = WS_VC + AL((size_t)2048 * 64 * 4);
constexpr size_t WS_OCMP = WS_PCMP + AL((size_t)T * 16 * 256 * 4);
constexpr size_t WS_SEL = WS_OCMP + AL((size_t)T * 1024 * 4);
constexpr size_t WS_X2 = WS_SEL + AL((size_t)T * 4 * 8);
constexpr size_t WS_TOPE = WS_X2 + AL((size_t)T * D * 4);
constexpr size_t WS_TOPG = WS_TOPE + AL((size_t)T * 4 * 4);
constexpr size_t WS_SLOT = WS_TOPG + AL((size_t)T * 4 * 4);
constexpr size_t WS_POS = WS_SLOT + AL((size_t)T * 4 * 4);
constexpr size_t WS_ROWTOK = WS_POS + AL((size_t)T * 4 * 4);
constexpr size_t WS_BCNT = WS_ROWTOK + AL((size_t)MAX_ROWS * 4);
constexpr size_t WS_ACT = WS_BCNT + AL((size_t)256 * 32 * 4);
constexpr size_t WS_Y = WS_ACT + AL((size_t)MAX_ROWS * DFF * 2);
constexpr size_t WS_QB = WS_Y + AL((size_t)MAX_ROWS * D * 2);
constexpr size_t WS_KS = WS_QB + AL((size_t)T * 1024 * 2);
constexpr size_t WS_VS = WS_KS + AL((size_t)T * 256 * 2);
constexpr size_t WS_KW = WS_VS + AL((size_t)T * 256 * 2);
constexpr size_t WS_VW = WS_KW + AL((size_t)T * 256 * 2);
constexpr size_t WS_KCB = WS_VW + AL((size_t)T * 256 * 2);
constexpr size_t WS_VCB = WS_KCB + AL((size_t)2 * 256 * 256 * 2);
constexpr size_t WS_XBCB = WS_VCB + AL((size_t)2 * 256 * 256 * 2);
constexpr size_t WS_STATES = WS_XBCB + AL((size_t)T * 2048 * 2);
constexpr size_t WS_PREV = WS_STATES + AL((size_t)2 * 32 * 16 * 64 * 128 * 4);
constexpr size_t WS_CHDEC = WS_PREV + AL((size_t)2 * 32 * 16 * 64 * 128 * 2);
constexpr size_t WS_PART = WS_CHDEC + AL((size_t)2 * 32 * 16 * 4);
constexpr size_t WS_RW = WS_PART + AL((size_t)4 * 2 * 2048 * 512 * 4);
constexpr size_t WS_CHK = WS_RW + AL((size_t)2048 * 32 * 4);
constexpr size_t WS_END = WS_CHK + AL((size_t)T * 2048 * 4);

constexpr int CW_COUNT = 4096;
constexpr int CW_ZROW = 5120;
constexpr int CW_CHK = 4160;

#define XB_TMO      128
#define XB_XCNT(j)  (256  + 64 * (j))
#define XB_XSUB(j)  (1280 + 64 * (j))
#define XB_XGEN(j)  (2304 + 64 * (j))
#define XB_TOP      3328
#define XB_TOPGEN   3392
#define XCD_BAR_WORDS 3456
#define XB_SPIN_CAP (1u << 18)

__device__ __forceinline__ unsigned xb_ld(unsigned* p)              { return __hip_atomic_load(p, __ATOMIC_RELAXED, __HIP_MEMORY_SCOPE_AGENT); }
__device__ __forceinline__ unsigned xb_add(unsigned* p, unsigned v) { return __hip_atomic_fetch_add(p, v, __ATOMIC_RELAXED, __HIP_MEMORY_SCOPE_AGENT); }
__device__ __forceinline__ unsigned xb_xcc_id() { return (unsigned)__builtin_amdgcn_s_getreg((3 << 11) | 20) & 0xFu; }
#define XB_SPIN(cond, bar) do { unsigned _sp = 0; while (cond) { __builtin_amdgcn_s_sleep(1); \
    if ((++_sp & 255u) == 0u) { if (xb_ld(&(bar)[XB_TMO])) break; if (_sp > XB_SPIN_CAP) { atomicAdd(&(bar)[XB_TMO], 1u); break; } } } } while (0)

struct XcdBarrier { unsigned* bar; unsigned x; volatile LAS unsigned* st; };

__device__ __forceinline__ XcdBarrier xcd_barrier_post(unsigned* bar, volatile LAS unsigned* st) {
    XcdBarrier b; b.bar = bar; b.x = xb_xcc_id(); b.st = st;
    if (threadIdx.x == 0) st[2] = xb_add(&bar[XB_XCNT(b.x)], 1u);
    return b;
}
__device__ __forceinline__ void xcd_barrier_complete(unsigned* bar, unsigned x, unsigned& nloc, unsigned& nx) {
    const unsigned G = gridDim.x * gridDim.y * gridDim.z;
    unsigned sum, cnt, mine, sp = 0u;
    for (;;) {
        sum = 0u; cnt = 0u; mine = 0u;
#pragma unroll
        for (unsigned j = 0; j < 16; ++j) { const unsigned c = xb_ld(&bar[XB_XCNT(j)]); sum += c; cnt += (c > 0u) ? 1u : 0u; mine = (j == x) ? c : mine; }
        if (sum == G) break;
        __builtin_amdgcn_s_sleep(1);
        if ((++sp & 255u) == 0u) { if (xb_ld(&bar[XB_TMO])) break; if (sp > XB_SPIN_CAP) { atomicAdd(&bar[XB_TMO], 1u); break; } }
    }
    nloc = mine > 0u ? mine : 1u; nx = cnt > 0u ? cnt : 1u;
}
__device__ __forceinline__ void xcd_barrier(const XcdBarrier& b) {
    asm volatile("s_waitcnt vmcnt(0)" ::: "memory");
    __syncthreads();
    if (threadIdx.x == 0) {
        unsigned* bar = b.bar;
        __builtin_amdgcn_s_waitcnt(0);
        unsigned nloc = b.st[0], nx = b.st[1];
        if (nloc == 0u) { xcd_barrier_complete(bar, b.x, nloc, nx); b.st[0] = nloc; b.st[1] = nx; }
        const unsigned old = xb_add(&bar[XB_XSUB(b.x)], 1u);
        const unsigned gen = old / nloc;
        if (old + 1u == (gen + 1u) * nloc) {
            __builtin_amdgcn_fence(__ATOMIC_RELEASE, "agent");
            asm volatile("s_waitcnt vmcnt(0)" ::: "memory");
            const unsigned og = xb_add(&bar[XB_TOP], 1u);
            const unsigned tg = og / nx;
            if (og + 1u == (tg + 1u) * nx) xb_add(&bar[XB_TOPGEN], 1u);
            else XB_SPIN(xb_ld(&bar[XB_TOPGEN]) == tg, bar);
            __builtin_amdgcn_fence(__ATOMIC_ACQUIRE, "agent");
            xb_add(&bar[XB_XGEN(b.x)], 1u);
            asm volatile("s_waitcnt vmcnt(0)" ::: "memory");
        } else {
            XB_SPIN(xb_ld(&bar[XB_XGEN(b.x)]) == gen, bar);
            __builtin_amdgcn_fence(__ATOMIC_ACQUIRE, "agent");
            asm volatile("s_waitcnt vmcnt(0)" ::: "memory");
        }
    }
    __syncthreads();
}

__device__ __forceinline__ bf16_t f2bf(float f) { unsigned u = __float_as_uint(f); u += 0x7FFFu + ((u >> 16) & 1u); return (bf16_t)(u >> 16); }
__device__ __forceinline__ float bf2f(bf16_t b) { return __uint_as_float(((unsigned)b) << 16); }
typedef __bf16 bf16x2_t __attribute__((ext_vector_type(2)));
typedef float f32x2_t __attribute__((ext_vector_type(2)));
__device__ __forceinline__ unsigned pack2(float lo, float hi) { const f32x2_t v = {lo, hi}; return __builtin_bit_cast(unsigned, __builtin_convertvector(v, bf16x2_t)); }
__device__ __forceinline__ float wave_sum(float v) {
#pragma unroll
    for (int o = 32; o > 0; o >>= 1) v += __shfl_xor(v, o);
    return v;
}
__device__ __forceinline__ float xmax16(float x) { const unsigned u = __builtin_bit_cast(unsigned, x); const auto r = __builtin_amdgcn_permlane16_swap(u, u, false, false); return fmaxf(__builtin_bit_cast(float, r[0]), __builtin_bit_cast(float, r[1])); }
__device__ __forceinline__ float xmax32(float x) { const unsigned u = __builtin_bit_cast(unsigned, x); const auto r = __builtin_amdgcn_permlane32_swap(u, u, false, false); return fmaxf(__builtin_bit_cast(float, r[0]), __builtin_bit_cast(float, r[1])); }
__device__ __forceinline__ float xsum16(float x) { const unsigned u = __builtin_bit_cast(unsigned, x); const auto r = __builtin_amdgcn_permlane16_swap(u, u, false, false); return __builtin_bit_cast(float, r[0]) + __builtin_bit_cast(float, r[1]); }
__device__ __forceinline__ float xsum32(float x) { const unsigned u = __builtin_bit_cast(unsigned, x); const auto r = __builtin_amdgcn_permlane32_swap(u, u, false, false); return __builtin_bit_cast(float, r[0]) + __builtin_bit_cast(float, r[1]); }
__device__ __forceinline__ float sigmoidf_(float x) { return __builtin_amdgcn_rcpf(1.0f + __expf(-x)); }

constexpr int B_RS = 544, A_ST = 256 * 128, B_ST = 64 * B_RS, STAGE = A_ST + B_ST;
constexpr int GEMM_LDS = 2 * STAGE;
constexpr int SSD_LDS = 147456;
constexpr int MAIN_LDS = SSD_LDS > GEMM_LDS ? SSD_LDS : GEMM_LDS;
constexpr int LDS_BYTES = MAIN_LDS + 64;

template <bool PAIRED, class Prov>
__device__ __forceinline__ void gemm_stream(LAS char* lds, Prov& P, const int K) {
    typedef typename Prov::AL ALd; typedef typename Prov::BL BLd; typedef typename Prov::EP EPt;
    ALd al; BLd bl; EPt ep;
    if (!P.next(al, bl)) return;
    P.make_ep(ep);
    const int tid = threadIdx.x, lane = tid & 63, wid = __builtin_amdgcn_readfirstlane(tid >> 6);
    const int wr = wid >> 1, wc = wid & 1, fr = lane & 15, fq = lane >> 4;
    int nvalid_next = 256;
    bool wave_on = true;
    if constexpr (Prov::MASKED) { nvalid_next = __builtin_amdgcn_readfirstlane(P.rows_valid()); wave_on = wr * 64 < nvalid_next; }
    const char* abase = (const char*)al.wsbase;
    unsigned aoff[4];
    const int bk0 = tid >> 6;
    unsigned ldb4, boff;
    __amdgpu_buffer_rsrc_t rsb;
    const __amdgpu_buffer_rsrc_t rsa = __builtin_amdgcn_make_buffer_rsrc((void*)abase, 0, 0x7fffffff, 0x00020000);
#define SET_SRC(al_, bl_) do { \
        _Pragma("unroll") for (int j = 0; j < 4; ++j) aoff[j] = (unsigned)((const char*)((al_).row(32 * wid + 8 * j + (lane >> 3)) + ((lane & 7) ^ (lane >> 3)) * 8) - abase); \
        rsb = __builtin_amdgcn_make_buffer_rsrc((void*)(bl_).base, 0, 0x7fffffff, 0x00020000); \
        ldb4 = (unsigned)(bl_).ldb * 4u; boff = (unsigned)(bl_).coloff(4 * (tid & 63)) * 4u + (unsigned)(tid >> 6) * ldb4; } while (0)
    SET_SRC(al, bl);
    unsigned atile = 0u, btile = 0u;
    u32x4 ra[4]; float4 rb[8];
#define LD_CHUNK(c) do { if ((c) < 8) { const u32x4 t_ = __builtin_amdgcn_raw_buffer_load_b128(rsb, (int)boff, (int)(btile + (unsigned)(8 * ((c) & 7)) * ldb4), 0); rb[(c) & 7] = __builtin_bit_cast(float4, t_); } \
        else ra[(c) & 3] = __builtin_amdgcn_raw_buffer_load_b128(rsa, (int)aoff[(c) & 3], (int)atile, 0); } while (0)
#define WR_CHUNK(c, buf) do { if ((c) < 8) *(LAS u32x2*)(lds + (buf) * STAGE + A_ST + bw_off + ((((c) & 7) & 1) * 4 + (((c) & 7) >> 1) * 16) * B_RS) = (u32x2){pack2(rb[(c) & 7].x, rb[(c) & 7].y), pack2(rb[(c) & 7].z, rb[(c) & 7].w)}; \
        else *(LAS u32x4*)(lds + (buf) * STAGE + (4 * wid + ((c) & 3)) * 1024 + lane * 16) = ra[(c) & 3]; } while (0)
#define ADVANCE() do { atile += ALd::kstep; btile += 64u * ldb4; } while (0)
    f32x4 acc[4][8];
    const int nk = K / 64;
    const int a_off0 = (wr * 64 + fr) * 128 + ((fq ^ (fr & 7)) * 16);
    const int br_off = A_ST + (((fq & 1) * 4 + (fq >> 1) * 16 + ((lane & 15) >> 2)) * B_RS) + (wc * 128 + 4 * (lane & 3)) * 2;
    const int bw_off = ((bk0 & 3) + ((bk0 >> 2) << 3)) * B_RS + (tid & 63) * 8;
#pragma unroll
    for (int c = 0; c < 12; ++c) LD_CHUNK(c);
    ADVANCE();
#pragma unroll
    for (int c = 0; c < 12; ++c) { WR_CHUNK(c, 0); LD_CHUNK(c); }
    int ldt = 1;
    if (2 < nk) { ADVANCE(); ldt = 2; }
    __syncthreads();
    for (;;) {
#pragma unroll
        for (int m = 0; m < 4; ++m)
#pragma unroll
            for (int n = 0; n < 8; ++n) acc[m][n] = (f32x4){0.f, 0.f, 0.f, 0.f};
        bool has_next = false;
        if constexpr (Prov::MASKED) { if (!wave_on) {
            for (int kt = 0; kt < nk; ++kt) {
                if (kt == nk - 2) { ALd aln; BLd bln; has_next = P.next(aln, bln);
                    if (has_next) { SET_SRC(aln, bln); atile = 0u; btile = 0u; ldt = 0; nvalid_next = __builtin_amdgcn_readfirstlane(P.rows_valid()); } }
                const int buf = kt & 1;
#pragma unroll
                for (int st = 0; st < 12; ++st) { WR_CHUNK(st, buf ^ 1); LD_CHUNK(st); }
                if (ldt + 1 < nk) { ADVANCE(); ++ldt; }
                __syncthreads();
            }
        } }
        if (!Prov::MASKED || wave_on)
        for (int kt = 0; kt < nk; ++kt) {
            if constexpr (!Prov::SINGLE) { if (kt == nk - 2) { ALd aln; BLd bln; has_next = P.next(aln, bln);
                if (has_next) { SET_SRC(aln, bln); atile = 0u; btile = 0u; ldt = 0; if constexpr (Prov::MASKED) nvalid_next = __builtin_amdgcn_readfirstlane(P.rows_valid()); } } }
            const int buf = kt & 1;
            LAS char* sbase = lds + buf * STAGE;
            s16x8 af[4]; s16x4 tq[4][2];
#define RD_B(slot, st_) do { tq[slot][0] = __builtin_amdgcn_ds_read_tr16_b64_v4i16((LAS s16x4*)(sbase + br_off + ((st_) >> 3) * 32 * B_RS + ((st_) & 7) * 32)); \
                             tq[slot][1] = __builtin_amdgcn_ds_read_tr16_b64_v4i16((LAS s16x4*)(sbase + br_off + ((st_) >> 3) * 32 * B_RS + ((st_) & 7) * 32 + 8 * B_RS)); } while (0)
#pragma unroll
            for (int m = 0; m < 4; ++m) af[m] = *(const LAS s16x8*)(sbase + a_off0 + m * 16 * 128);
            RD_B(0, 0); RD_B(1, 1); RD_B(2, 2);
            __builtin_amdgcn_sched_barrier(0);
#pragma unroll
            for (int st = 0; st < 16; ++st) {
                const int n = st & 7;
                if (st + 3 < 16) RD_B((st + 3) & 3, st + 3);
                const s16x8 bfr = {tq[st & 3][0][0], tq[st & 3][0][1], tq[st & 3][0][2], tq[st & 3][0][3], tq[st & 3][1][0], tq[st & 3][1][1], tq[st & 3][1][2], tq[st & 3][1][3]};
#pragma unroll
                for (int m = 0; m < 4; ++m) acc[m][n] = __builtin_amdgcn_mfma_f32_16x16x32_bf16(bfr, af[m], acc[m][n], 0, 0, 0);
                if (st == 7) {
#pragma unroll
                    for (int m = 0; m < 4; ++m) af[m] = *(const LAS s16x8*)(sbase + (a_off0 ^ 64) + m * 16 * 128);
                }
                if (st < 12) { WR_CHUNK(st, buf ^ 1); LD_CHUNK(st); }
                if (st & 1) __builtin_amdgcn_sched_barrier(0);
            }
#undef RD_B
            if (ldt + 1 < nk) { ADVANCE(); ++ldt; }
            __syncthreads();
        }
        if (!Prov::MASKED || wave_on)
#pragma unroll
        for (int m = 0; m < 4; ++m) {
            const int r = wr * 64 + m * 16 + fr;
            if constexpr (PAIRED) {
                ep.pair4(r, wc * 64 + 4 * fq, acc[m]);
            } else if constexpr (EPt::ROW8) { ep.row8(r, wc * 128 + 4 * fq, acc[m]);
            } else {
#pragma unroll
                for (int n = 0; n < 8; ++n) ep(r, wc * 128 + n * 16 + 4 * fq, acc[m][n]);
            }
        }
        if (!has_next) break;
        P.make_ep(ep);
        if constexpr (Prov::MASKED) wave_on = wr * 64 < nvalid_next;
    }
#undef LD_CHUNK
#undef WR_CHUNK
#undef ADVANCE
#undef SET_SRC
}

template <class Maker> struct PatchProv {
    static constexpr bool SINGLE = false, MASKED = Maker::MASKED;
    __device__ __forceinline__ int rows_valid() const { return mk.rows_valid(cRT); }
    typedef typename Maker::AL AL; typedef typename Maker::BL BL; typedef typename Maker::EP EP;
    Maker mk; int nR, nC, npc, npatch, nlab, nsl, pidx, slot, slot0, nfull, rem;
    __device__ __forceinline__ void init(int nR_, int nC_, int G, int bid) { nR = nR_; nC = nC_; nlab = (G % 8 == 0) ? 8 : 1; nsl = G / nlab; npc = (nC + 7) >> 3; npatch = ((nR + 3) >> 2) * npc;
        nfull = npatch; rem = 0;
        if constexpr (MASKED) { const int r = npatch % nlab; if (r > 0 && 2 * r <= nlab) { nfull = npatch - r; rem = r; npatch = nfull + 2 * r; } }
        pidx = bid / nsl; slot0 = bid % nsl; slot = slot0; if (pidx >= nlab) { pidx = npatch; } }
    int cRT, cCT;
    __device__ __forceinline__ bool next(AL& al, BL& bl) {
        while (pidx < npatch) {
            int pp = pidx, hcode = 0;
            if (MASKED && pidx >= nfull) { const int hp = pidx - nfull; pp = nfull + hp % rem; hcode = 1 + hp / rem; }
            while (slot < 32) { const int RT = (pp / npc) * 4 + (slot >> 3), CT = (pp % npc) * 8 + (slot & 7); slot += nsl;
                if (RT < nR && CT < nC) { cRT = RT | (hcode << 16); cCT = CT; mk.make_src(cRT, CT, al, bl); return true; } }
            pidx += nlab; slot = slot0; }
        return false; }
    __device__ __forceinline__ void make_ep(EP& ep) const { mk.make_ep(cRT, cCT, ep); } };

constexpr int KV_RS = 144, KT_BYTES = 64 * KV_RS;
constexpr int ATT_IMP_OFF = 8 * KT_BYTES;
constexpr int ATT_MASK_OFF = ATT_IMP_OFF + 64 * 64 * 4;
typedef float f32x16 __attribute__((ext_vector_type(16)));
struct GState32 { f32x16 o[2]; float m, l, nref; };
__device__ __forceinline__ float xchg32(float x) { const unsigned u = __builtin_bit_cast(unsigned, x); const auto r = __builtin_amdgcn_permlane32_swap(u, u, false, false);
    return __builtin_bit_cast(float, (threadIdx.x & 32) ? r[0] : r[1]); }

template <int MODE>
__device__ __forceinline__ void attn_block32(const LAS char* kt, const LAS char* vt, const int lane, const s16x8 (&qf)[4], GState32& st,
                                             const bool act, const int key0, const int lo, const int hi, LAS float* imp, const int tl, float& carry, const int jb) {
    const int c32 = lane & 31, h = lane >> 5;
    f32x16 s[2];
    const float cval = (MODE == 0) ? (act ? st.nref : -INFINITY) : 0.f;
    const f32x16 cin = {cval, cval, cval, cval, cval, cval, cval, cval, cval, cval, cval, cval, cval, cval, cval, cval};
#pragma unroll
    for (int k2 = 0; k2 < 2; ++k2) {
        s16x8 kf[4];
#pragma unroll
        for (int ds = 0; ds < 4; ++ds) kf[ds] = *(const LAS s16x8*)(kt + (32 * k2 + c32) * KV_RS + (16 * ds + 8 * h) * 2);
        s[k2] = __builtin_amdgcn_mfma_f32_32x32x16_bf16(kf[0], qf[0], cin, 0, 0, 0);
#pragma unroll
        for (int ds = 1; ds < 4; ++ds) s[k2] = __builtin_amdgcn_mfma_f32_32x32x16_bf16(kf[ds], qf[ds], s[k2], 0, 0, 0);
    }
    const bool needmask = !__all((lo <= key0) & (hi >= key0 + 63));
    if (needmask) {
#pragma unroll
        for (int k2 = 0; k2 < 2; ++k2)
#pragma unroll
            for (int i = 0; i < 16; ++i) { const int key = key0 + 32 * k2 + 8 * (i >> 2) + 4 * h + (i & 3); s[k2][i] = (key >= lo && key <= hi) ? s[k2][i] : -INFINITY; }
    }
    float mx = -INFINITY;
#pragma unroll
    for (int k2 = 0; k2 < 2; ++k2)
#pragma unroll
        for (int i = 0; i < 16; ++i) mx = fmaxf(mx, s[k2][i]);
    if (MODE == 0) {
        mx = fmaxf(mx, xchg32(mx));
        const bool slow = (mx > 8.f) || (st.m == -INFINITY && mx != -INFINITY);
        if (__any(slow)) {
            const float mnew = fmaxf(st.m, mx - st.nref);
            const float alpha = (mnew == -INFINITY) ? 1.0f : __builtin_amdgcn_exp2f(st.m - mnew);
            const float d = (mnew == -INFINITY) ? 0.f : mnew + st.nref;
#pragma unroll
            for (int k2 = 0; k2 < 2; ++k2)
#pragma unroll
                for (int i = 0; i < 16; ++i) s[k2][i] -= d;
            st.o[0] *= alpha; st.o[1] *= alpha; st.l *= alpha;
            st.m = mnew; st.nref = (mnew == -INFINITY) ? 0.f : -mnew;
        }
        float rs = 0.f;
#pragma unroll
        for (int k2 = 0; k2 < 2; ++k2)
#pragma unroll
            for (int i = 0; i < 16; ++i) { const float pv = __builtin_amdgcn_exp2f(s[k2][i]); s[k2][i] = pv; rs += pv; }
        rs += xchg32(rs); st.l += rs;
    } else {
    mx = act ? mx : -INFINITY;
    float msafe, scale = 1.0f;
    if (MODE == 2) { msafe = (st.m == -INFINITY) ? 0.f : st.m; scale = st.l; }
    else {
        mx = fmaxf(mx, xchg32(mx));
        const float mnew = fmaxf(st.m, mx);
        const float alpha = (mnew == -INFINITY) ? 1.0f : __builtin_amdgcn_exp2f(st.m - mnew);
        msafe = (mnew == -INFINITY) ? 0.f : mnew;
        st.m = mnew; st.l *= alpha;
    }
    msafe = act ? msafe : INFINITY;
    float rs = 0.f;
#pragma unroll
    for (int k2 = 0; k2 < 2; ++k2)
#pragma unroll
        for (int i = 0; i < 16; ++i) { const float pv = (MODE == 2) ? __builtin_amdgcn_exp2f(s[k2][i] - msafe) * scale : __builtin_amdgcn_exp2f(s[k2][i] - msafe); s[k2][i] = pv; rs += pv; }
    if (MODE != 2) { rs += xchg32(rs); st.l += rs; }
    }
    if (MODE == 2) {
#pragma unroll
        for (int k2 = 0; k2 < 2; ++k2)
#pragma unroll
            for (int ig = 0; ig < 4; ++ig) {
                const float prevreg = ig > 0 ? s[k2][4 * (ig > 0 ? ig - 1 : 0) + 3] : (k2 > 0 ? s[0][15] : carry);
                const float recv = xchg32(h ? prevreg : s[k2][4 * ig + 3]);
                float part = 32.f * (s[k2][4 * ig] + s[k2][4 * ig + 1] + s[k2][4 * ig + 2]) + 16.f * s[k2][4 * ig + 3] + 16.f * recv;
                part += __shfl_xor(part, 1); part += __shfl_xor(part, 2);
                if ((c32 & 3) == 0) imp[tl * 64 + 16 * jb + 8 * k2 + 2 * ig + h] = part;
            }
        carry = s[1][15];
    }
    if (MODE != 1) {
        const int blk = (lane >> 4) & 1, q = (lane & 15) >> 2, p = lane & 3;
#pragma unroll
        for (int k2 = 0; k2 < 2; ++k2)
#pragma unroll
            for (int sk = 0; sk < 2; ++sk) {
                const u32x4 w = {pack2(s[k2][8 * sk + 0], s[k2][8 * sk + 1]), pack2(s[k2][8 * sk + 2], s[k2][8 * sk + 3]), pack2(s[k2][8 * sk + 4], s[k2][8 * sk + 5]), pack2(s[k2][8 * sk + 6], s[k2][8 * sk + 7])};
                const s16x8 pf = __builtin_bit_cast(s16x8, w);
#pragma unroll
                for (int dt = 0; dt < 2; ++dt) { const int base = 32 * k2 + 16 * sk;
                    const s16x4 t0 = __builtin_amdgcn_ds_read_tr16_b64_v4i16((LAS s16x4*)(vt + (base + 4 * h + q) * KV_RS + (32 * dt + 16 * blk + 4 * p) * 2));
                    const s16x4 t1 = __builtin_amdgcn_ds_read_tr16_b64_v4i16((LAS s16x4*)(vt + (base + 8 + 4 * h + q) * KV_RS + (32 * dt + 16 * blk + 4 * p) * 2));
                    const s16x8 vf = {t0[0], t0[1], t0[2], t0[3], t1[0], t1[1], t1[2], t1[3]};
                    st.o[dt] = __builtin_amdgcn_mfma_f32_32x32x16_bf16(vf, pf, st.o[dt], 0, 0, 0); }
            }
    }
}

#define ATT_GLOAD(Kg, Vg, stg) do { const size_t _o = ((size_t)(stg) * 128 + (tid >> 3)) * 256 + g * 64 + (tid & 7) * 8; rk0 = *(const u32x4*)((Kg) + _o); rv0 = *(const u32x4*)((Vg) + _o); \
        rk1 = *(const u32x4*)((Kg) + _o + 64 * 256); rv1 = *(const u32x4*)((Vg) + _o + 64 * 256); __builtin_amdgcn_sched_barrier(0); } while (0)
#define ATT_SWRITE(stg) do { LAS char* _k = lds + ((stg) & 1) * 4 * KT_BYTES + (tid >> 3) * KV_RS + (tid & 7) * 16; *(LAS u32x4*)_k = rk0; *(LAS u32x4*)(_k + KT_BYTES) = rv0; \
        *(LAS u32x4*)(_k + 2 * KT_BYTES) = rk1; *(LAS u32x4*)(_k + 3 * KT_BYTES) = rv1; } while (0)
#define ATT_RUN(MODE, Kg, Vg, jlo, jhi, COND, ACT) do { const int _s0 = (jlo) >> 1, _s1 = (jhi) >> 1; \
        ATT_GLOAD(Kg, Vg, _s0); ATT_SWRITE(_s0); __syncthreads(); \
        for (int _s = _s0; _s <= _s1; ++_s) { \
            if (_s + 1 <= _s1) ATT_GLOAD(Kg, Vg, _s + 1); \
            _Pragma("unroll") for (int _q = 0; _q < 2; ++_q) { const int j = 2 * _s + _q; \
                if (j >= (jlo) && j <= (jhi) && (COND)) { act = (ACT); \
                    const LAS char* _kt = lds + (_s & 1) * 4 * KT_BYTES + _q * 2 * KT_BYTES; \
                    attn_block32<MODE>(_kt, _kt + KT_BYTES, lane, qf, st, act, 64 * j, lo, hi, imp, tl, carry, j); } } \
            if (_s + 1 <= _s1) ATT_SWRITE(_s + 1); \
            __syncthreads(); } } while (0)

__device__ __forceinline__ void nsa_unit32(LAS char* lds, const int unit, const bf16_t* QB, const bf16_t* KS, const bf16_t* VS, const bf16_t* KW, const bf16_t* VW,
                                           const bf16_t* KCB, const bf16_t* VCB, const float* GATEp, bf16_t* MIX) {
    const int tid = threadIdx.x, lane = tid & 63, wid = tid >> 6, c32 = lane & 31, h = lane >> 5;
    const int qt = unit >> 3, b = (unit >> 2) & 1, g = unit & 3;
    const int t0 = qt * 64;
    LAS float* imp = (LAS float*)(lds + ATT_IMP_OFF);
    LAS unsigned* lmask = (LAS unsigned*)(lds + ATT_MASK_OFF);
    const int tl = 8 * wid + (c32 >> 2), tpos = t0 + tl, hq = g * 4 + (c32 & 3);
    const size_t tt = (size_t)b * SEQ + tpos;
    s16x8 qf[4]; float gate[3];
#pragma unroll
    for (int ds = 0; ds < 4; ++ds) qf[ds] = *(const s16x8*)(QB + tt * 1024 + hq * 64 + 16 * ds + 8 * h);
    { const float* gl = GATEp + tt * 48 + hq * 3; gate[0] = gl[0]; gate[1] = gl[1]; gate[2] = gl[2]; }
    for (int i = tid; i < 64 * 64; i += 512) imp[i] = 0.f;
    f32x16 res[2];
    GState32 st; bool act; int lo, hi; float carry = 0.f;
    u32x4 rk0, rv0, rk1, rv1;
    const bf16_t* KCg = KCB + (size_t)b * 256 * 256; const bf16_t* VCg = VCB + (size_t)b * 256 * 256;
    const bf16_t* KSg = KS + (size_t)b * SEQ * 256; const bf16_t* VSg = VS + (size_t)b * SEQ * 256;
    const bf16_t* KWg = KW + (size_t)b * SEQ * 256; const bf16_t* VWg = VW + (size_t)b * SEQ * 256;
#define ST_RESET() do { st.m = -INFINITY; st.l = 0.f; st.nref = 0.f; _Pragma("unroll") for (int i_ = 0; i_ < 16; ++i_) { st.o[0][i_] = 0.f; st.o[1][i_] = 0.f; } } while (0)
    const int cmax_u = (t0 + 63 - 31) >> 4;
    const int ncb = cmax_u < 0 ? 0 : min(4, (cmax_u + 1) / 64 + 1);
    act = true; lo = 0; hi = tpos >= 31 ? ((tpos - 31) >> 4) : -1; ST_RESET();
    __syncthreads();
    if (ncb > 0) {
        ATT_RUN(1, KCg, VCg, 0, ncb - 1, true, true);
        st.l = st.l > 0.f ? 1.0f / st.l : 0.f;
        ATT_RUN(2, KCg, VCg, 0, ncb - 1, true, true);
    }
    res[0] = st.o[0] * gate[0]; res[1] = st.o[1] * gate[0];
    __syncthreads();
    for (int k = 0; k < 8; ++k) {
        const int tk = 8 * wid + k, j = lane;
        const float iv = imp[tk * 64 + j];
        const bool forced = (j == 0) || (j == qt) || (j == qt - 1), valid = j <= qt;
        const float sc = forced ? 1.0e4f : (valid ? iv : -1.0e4f);
        const unsigned ub = __float_as_uint(sc + 0.0f), key = (ub & 0x80000000u) ? ~ub : (ub | 0x80000000u);
        const unsigned long long K = ((unsigned long long)key << 32) | (unsigned)(63 - j);
        int rank = 0;
#pragma unroll
        for (int kk = 0; kk < 64; ++kk) { const unsigned long long O = ((unsigned long long)(unsigned)__builtin_amdgcn_readlane((int)key, kk) << 32) | (unsigned)(63 - kk); rank += (O > K) ? 1 : 0; }
        const unsigned long long m64 = __ballot(rank < 16 && valid);
        if (lane == 0) { lmask[tk * 2] = (unsigned)m64; lmask[tk * 2 + 1] = (unsigned)(m64 >> 32); }
    }
    __syncthreads();
    const unsigned long long msk = (unsigned long long)lmask[tl * 2] | ((unsigned long long)lmask[tl * 2 + 1] << 32);
    unsigned long long wunion;
    { unsigned ul = (unsigned)msk, uh = (unsigned)(msk >> 32);
#pragma unroll
      for (int o = 1; o < 64; o <<= 1) { ul |= __shfl_xor(ul, o); uh |= __shfl_xor(uh, o); }
      wunion = (unsigned long long)ul | ((unsigned long long)uh << 32); }
    lo = 0; hi = tpos; ST_RESET();
    ATT_RUN(0, KSg, VSg, 0, qt, (wunion >> j) & 1ull, (msk >> j) & 1ull);
    { const float il = gate[1] / fmaxf(st.l, 1e-30f); res[0] += st.o[0] * il; res[1] += st.o[1] * il; }
    act = true; lo = tpos - 511; hi = tpos; ST_RESET();
    const int jw0 = qt >= 8 ? qt - 8 : 0;
    ATT_RUN(0, KWg, VWg, jw0, qt, true, true);
    { const float il = gate[2] / fmaxf(st.l, 1e-30f);
      bf16_t* mp = MIX + tt * 2048 + 1024 + hq * 64 + 4 * h;
#pragma unroll
      for (int dt = 0; dt < 2; ++dt)
#pragma unroll
          for (int ig = 0; ig < 4; ++ig) { const int i0 = 4 * ig;
              const float r0 = res[dt][i0] + st.o[dt][i0] * il, r1 = res[dt][i0 + 1] + st.o[dt][i0 + 1] * il, r2 = res[dt][i0 + 2] + st.o[dt][i0 + 2] * il, r3 = res[dt][i0 + 3] + st.o[dt][i0 + 3] * il;
              *(uint2*)(mp + 32 * dt + 8 * ig) = make_uint2(pack2(r0, r1), pack2(r2, r3)); } }
#undef ST_RESET
}
#undef ATT_GLOAD
#undef ATT_SWRITE
#undef ATT_RUN


constexpr int SX_RS = 144, SX_H = 128 * SX_RS, SB_RS = 272, SB_BYTES = 128 * SB_RS;
constexpr int SSD_X_OFF = 0, SSD_B_OFF = 4 * SX_H, SSD_C_OFF = SSD_B_OFF + SB_BYTES, SSD_T_OFF = SSD_C_OFF + SB_BYTES;
static_assert(SSD_T_OFF + 4096 <= SSD_LDS, "ssd lds");

__device__ __forceinline__ u32x4 conv8_silu(const u32x4 (&tap)[4], const float* cw, const float* cb, const int chan, const int spos) {
    float acc[8];
    { const f32x4 b0 = *(const f32x4*)(cb + chan), b1 = *(const f32x4*)(cb + chan + 4); acc[0] = b0[0]; acc[1] = b0[1]; acc[2] = b0[2]; acc[3] = b0[3]; acc[4] = b1[0]; acc[5] = b1[1]; acc[6] = b1[2]; acc[7] = b1[3]; }
#pragma unroll
    for (int k = 0; k < 4; ++k) {
        const f32x4 w0 = *(const f32x4*)(cw + k * 2048 + chan), w1 = *(const f32x4*)(cw + k * 2048 + chan + 4);
        const float m = (spos - 3 + k >= 0) ? 1.0f : 0.0f;
#pragma unroll
        for (int e = 0; e < 4; ++e) { acc[2 * e] += m * (e < 2 ? w0[2 * e] : w1[2 * e - 4]) * __uint_as_float(tap[k][e] << 16); acc[2 * e + 1] += m * (e < 2 ? w0[2 * e + 1] : w1[2 * e - 3]) * __uint_as_float(tap[k][e] & 0xffff0000u); }
    }
    u32x4 o;
#pragma unroll
    for (int e = 0; e < 4; ++e) o[e] = pack2(acc[2 * e] * sigmoidf_(acc[2 * e]), acc[2 * e + 1] * sigmoidf_(acc[2 * e + 1]));
    return o;
}

template <bool WITH_C>
__device__ __forceinline__ void ssd_stage(LAS char* lds, const bf16_t* XBCR_, const float* cw, const float* cb, const float* DT, const float* a_log, const int b, const int c, const int grp) {
    const int tid = threadIdx.x;
    const size_t tt0 = (size_t)b * SEQ + c * 128;
    const int s0 = c * 128;
#define TAP_PTR(l_, k_, chan_) (XBCR_ + (size_t)((long)(tt0 + (l_)) - 3 + (k_) < 0 ? 0 : (long)(tt0 + (l_)) - 3 + (k_)) * 2048 + (chan_))
#pragma unroll 1
    for (int half = 0; half < 2; ++half) {
        u32x4 tp[4][4];
#pragma unroll
        for (int k4 = 0; k4 < 4; ++k4) { const int id = tid + 512 * (4 * half + k4), l = id >> 5, ch = id & 31;
#pragma unroll
            for (int k = 0; k < 4; ++k) tp[k4][k] = *(const u32x4*)TAP_PTR(l, k, grp * 256 + ch * 8); }
#pragma unroll
        for (int k4 = 0; k4 < 4; ++k4) { const int id = tid + 512 * (4 * half + k4), l = id >> 5, ch = id & 31, h = ch >> 3, pc = ch & 7;
            *(LAS u32x4*)(lds + SSD_X_OFF + h * SX_H + l * SX_RS + pc * 16) = conv8_silu(tp[k4], cw, cb, grp * 256 + ch * 8, s0 + l); }
    }
    {
        u32x4 tp[4][4];
#pragma unroll
        for (int k4 = 0; k4 < 4; ++k4) { const int id = tid + 512 * k4, l = id >> 4, ch = id & 15;
#pragma unroll
            for (int k = 0; k < 4; ++k) tp[k4][k] = *(const u32x4*)TAP_PTR(l, k, 1024 + grp * 128 + ch * 8); }
#pragma unroll
        for (int k4 = 0; k4 < 4; ++k4) { const int id = tid + 512 * k4, l = id >> 4, ch = id & 15;
            *(LAS u32x4*)(lds + SSD_B_OFF + l * SB_RS + ch * 16) = conv8_silu(tp[k4], cw, cb, 1024 + grp * 128 + ch * 8, s0 + l); }
    }
    if (WITH_C) {
        u32x4 tp[4][4];
#pragma unroll
        for (int k4 = 0; k4 < 4; ++k4) { const int id = tid + 512 * k4, l = id >> 4, ch = id & 15;
#pragma unroll
            for (int k = 0; k < 4; ++k) tp[k4][k] = *(const u32x4*)TAP_PTR(l, k, 1536 + grp * 128 + ch * 8); }
#pragma unroll
        for (int k4 = 0; k4 < 4; ++k4) { const int id = tid + 512 * k4, l = id >> 4, ch = id & 15;
            *(LAS u32x4*)(lds + SSD_C_OFF + l * SB_RS + ch * 16) = conv8_silu(tp[k4], cw, cb, 1536 + grp * 128 + ch * 8, s0 + l); }
    }
#undef TAP_PTR
    LAS float* dtl = (LAS float*)(lds + SSD_T_OFF); LAS float* acs = dtl + 512;
    const int h = tid >> 7, l = tid & 127;
    const float av = -expf(a_log[grp * 4 + h]);
    const float dtv = DT[(tt0 + l) * 16 + grp * 4 + h];
    dtl[tid] = dtv; acs[tid] = dtv * av;
    __syncthreads();
    float cs = acs[tid];
#pragma unroll
    for (int o = 1; o < 128; o <<= 1) { const float add = (l >= o) ? acs[tid - o] : 0.f; __syncthreads(); cs += add; acs[tid] = cs; __syncthreads(); }
}

__device__ __forceinline__ void ssd_states_item(LAS char* lds, const int item, const bf16_t* XBCB, const float* cw, const float* cb, const float* DT, const float* a_log, float* STATES, float* CHDEC) {
    const int tid = threadIdx.x, lane = tid & 63, wid = tid >> 6, c16 = lane & 15, fq = lane >> 4, q = c16 >> 2, pp = c16 & 3;
    const int grp = item & 3, c = (item >> 2) & 31, b = item >> 7;
    __syncthreads();
    ssd_stage<false>(lds, XBCB, cw, cb, DT, a_log, b, c, grp);
    LAS float* dtl = (LAS float*)(lds + SSD_T_OFF); LAS float* acs = dtl + 512;
#pragma unroll
    for (int k = 0; k < 8; ++k) { const int id = tid + 512 * k, l = id >> 5, ch = id & 31, h = ch >> 3, pc = ch & 7;
        const float w = __expf(acs[h * 128 + 127] - acs[h * 128 + l]) * dtl[h * 128 + l];
        LAS u32x4* pv = (LAS u32x4*)(lds + SSD_X_OFF + h * SX_H + l * SX_RS + pc * 16);
        u32x4 v = *pv;
#pragma unroll
        for (int e = 0; e < 4; ++e) { const float lo = __uint_as_float(v[e] << 16) * w, hi = __uint_as_float(v[e] & 0xffff0000u) * w; v[e] = pack2(lo, hi); }
        *pv = v; }
    if (tid < 4) CHDEC[((size_t)b * 32 + c) * 16 + grp * 4 + tid] = __expf(acs[tid * 128 + 127]);
    __syncthreads();
    s16x8 af[4];
#pragma unroll
    for (int ks = 0; ks < 4; ++ks) {
        const s16x4 t0 = __builtin_amdgcn_ds_read_tr16_b64_v4i16((LAS s16x4*)(lds + SSD_B_OFF + (32 * ks + 8 * fq + q) * SB_RS + (16 * wid + 4 * pp) * 2));
        const s16x4 t1 = __builtin_amdgcn_ds_read_tr16_b64_v4i16((LAS s16x4*)(lds + SSD_B_OFF + (32 * ks + 8 * fq + 4 + q) * SB_RS + (16 * wid + 4 * pp) * 2));
        af[ks] = (s16x8){t0[0], t0[1], t0[2], t0[3], t1[0], t1[1], t1[2], t1[3]};
    }
#pragma unroll
    for (int h = 0; h < 4; ++h) {
        float* sp = STATES + (((size_t)b * 32 + c) * 16 + grp * 4 + h) * 8192;
#pragma unroll
        for (int pt = 0; pt < 4; ++pt) {
            f32x4 acc = {0.f, 0.f, 0.f, 0.f};
#pragma unroll
            for (int ks = 0; ks < 4; ++ks) {
                const s16x4 t0 = __builtin_amdgcn_ds_read_tr16_b64_v4i16((LAS s16x4*)(lds + SSD_X_OFF + h * SX_H + (32 * ks + 8 * fq + q) * SX_RS + (16 * pt + 4 * pp) * 2));
                const s16x4 t1 = __builtin_amdgcn_ds_read_tr16_b64_v4i16((LAS s16x4*)(lds + SSD_X_OFF + h * SX_H + (32 * ks + 8 * fq + 4 + q) * SX_RS + (16 * pt + 4 * pp) * 2));
                const s16x8 bfr = {t0[0], t0[1], t0[2], t0[3], t1[0], t1[1], t1[2], t1[3]};
                acc = __builtin_amdgcn_mfma_f32_16x16x32_bf16(af[ks], bfr, acc, 0, 0, 0);
            }
            *(f32x4*)(sp + (size_t)(16 * pt + c16) * 128 + 16 * wid + 4 * fq) = acc;
        }
    }
}

__device__ __forceinline__ void ssd_out_item(LAS char* lds, const int item, const bf16_t* XBCB, const float* cw, const float* cb, const float* DT, const float* a_log, const float* d_skip, const float* nw,
                                             const bf16_t* PREV, const bf16_t* ZBp, float* YTMP, bf16_t* MIXO) {
    const int tid = threadIdx.x, lane = tid & 63, wid = tid >> 6, c16 = lane & 15, fq = lane >> 4, q = c16 >> 2, pp = c16 & 3;
    const int grp = item & 3, c = (item >> 2) & 31, b = item >> 7;
    __syncthreads();
    ssd_stage<true>(lds, XBCB, cw, cb, DT, a_log, b, c, grp);
    LAS float* dtl = (LAS float*)(lds + SSD_T_OFF); LAS float* acs = dtl + 512;
    const int lcol = 16 * wid + c16;
    const size_t tt = (size_t)b * SEQ + c * 128 + lcol;
    s16x8 cf[4];
#pragma unroll
    for (int ks = 0; ks < 4; ++ks) cf[ks] = *(const LAS s16x8*)(lds + SSD_C_OFF + lcol * SB_RS + (32 * ks + 8 * fq) * 2);
    f32x4 g[8];
#pragma unroll
    for (int mt = 0; mt < 8; ++mt) { g[mt] = (f32x4){0.f, 0.f, 0.f, 0.f};
        if (mt <= wid) {
#pragma unroll
            for (int ks = 0; ks < 4; ++ks) { const s16x8 bfr = *(const LAS s16x8*)(lds + SSD_B_OFF + (16 * mt + c16) * SB_RS + (32 * ks + 8 * fq) * 2);
                g[mt] = __builtin_amdgcn_mfma_f32_16x16x32_bf16(bfr, cf[ks], g[mt], 0, 0, 0); } } }
    float ss = 0.f;
#pragma unroll 1
    for (int h = 0; h < 4; ++h) {
        const int hh = grp * 4 + h;
        const float acs_l = acs[h * 128 + lcol];
        s16x8 pf[4];
#pragma unroll
        for (int ks = 0; ks < 4; ++ks) {
            float pv[2][4];
#pragma unroll
            for (int u = 0; u < 2; ++u) {
                const int s0 = 32 * ks + 16 * u + 4 * fq;
                const f32x4 av4 = *(const LAS f32x4*)(acs + h * 128 + s0), dv4 = *(const LAS f32x4*)(dtl + h * 128 + s0);
#pragma unroll
                for (int i = 0; i < 4; ++i) { const float e = __expf(fminf(acs_l - av4[i], 0.f)) * dv4[i]; pv[u][i] = (s0 + i <= lcol) ? g[2 * ks + u][i] * e : 0.f; }
            }
            const u32x4 w = {pack2(pv[0][0], pv[0][1]), pack2(pv[0][2], pv[0][3]), pack2(pv[1][0], pv[1][1]), pack2(pv[1][2], pv[1][3])};
            pf[ks] = __builtin_bit_cast(s16x8, w);
        }
        const float dsk = d_skip[hh], eal = __expf(acs_l);
        const bf16_t* prevp = PREV + (((size_t)b * 32 + c) * 16 + hh) * 8192;
        s16x8 pr[4][4]; f32x4 zz[4];
#pragma unroll
        for (int pt = 0; pt < 4; ++pt) {
#pragma unroll
            for (int ks = 0; ks < 4; ++ks) pr[pt][ks] = *(const s16x8*)(prevp + (size_t)(16 * pt + c16) * 128 + 32 * ks + 8 * fq);
            { const uint2 zr = *(const uint2*)(ZBp + tt * 1024 + hh * 64 + 16 * pt + 4 * fq); zz[pt] = (f32x4){__uint_as_float(zr.x << 16), __uint_as_float(zr.x & 0xffff0000u), __uint_as_float(zr.y << 16), __uint_as_float(zr.y & 0xffff0000u)}; }
        }
#pragma unroll
        for (int pt = 0; pt < 4; ++pt) {
            f32x4 yd = {0.f, 0.f, 0.f, 0.f}, yo = {0.f, 0.f, 0.f, 0.f};
#pragma unroll
            for (int ks = 0; ks < 4; ++ks) {
                const s16x4 t0 = __builtin_amdgcn_ds_read_tr16_b64_v4i16((LAS s16x4*)(lds + SSD_X_OFF + h * SX_H + (32 * ks + 4 * fq + q) * SX_RS + (16 * pt + 4 * pp) * 2));
                const s16x4 t1 = __builtin_amdgcn_ds_read_tr16_b64_v4i16((LAS s16x4*)(lds + SSD_X_OFF + h * SX_H + (32 * ks + 16 + 4 * fq + q) * SX_RS + (16 * pt + 4 * pp) * 2));
                const s16x8 xf = {t0[0], t0[1], t0[2], t0[3], t1[0], t1[1], t1[2], t1[3]};
                yd = __builtin_amdgcn_mfma_f32_16x16x32_bf16(xf, pf[ks], yd, 0, 0, 0);
                yo = __builtin_amdgcn_mfma_f32_16x16x32_bf16(pr[pt][ks], cf[ks], yo, 0, 0, 0);
            }
            const u32x2 xr = *(const LAS u32x2*)(lds + SSD_X_OFF + h * SX_H + lcol * SX_RS + (16 * pt + 4 * fq) * 2);
            const float xv[4] = {__uint_as_float(xr[0] << 16), __uint_as_float(xr[0] & 0xffff0000u), __uint_as_float(xr[1] << 16), __uint_as_float(xr[1] & 0xffff0000u)};
            const f32x4 z = zz[pt];
            f32x4 gvv;
#pragma unroll
            for (int i = 0; i < 4; ++i) { const float y = yd[i] + eal * yo[i] + dsk * xv[i]; gvv[i] = y * z[i] * sigmoidf_(z[i]); ss += gvv[i] * gvv[i]; }
            *(f32x4*)(YTMP + tt * 1024 + hh * 64 + 16 * pt + 4 * fq) = gvv;
        }
    }
    ss += __shfl_xor(ss, 16); ss += __shfl_xor(ss, 32);
    const float rs = rsqrtf(ss * (1.0f / 256.f) + NORM_EPS);
#pragma unroll 1
    for (int h = 0; h < 4; ++h) {
        f32x4 gq[4], wq[4];
#pragma unroll
        for (int pt = 0; pt < 4; ++pt) { const int ch = (grp * 4 + h) * 64 + 16 * pt + 4 * fq; wq[pt] = *(const f32x4*)(nw + ch); gq[pt] = *(const f32x4*)(YTMP + tt * 1024 + ch); }
#pragma unroll
        for (int pt = 0; pt < 4; ++pt) { const int ch = (grp * 4 + h) * 64 + 16 * pt + 4 * fq;
            *(uint2*)(MIXO + tt * 2048 + ch) = make_uint2(pack2(gq[pt][0] * rs * wq[pt][0], gq[pt][1] * rs * wq[pt][1]), pack2(gq[pt][2] * rs * wq[pt][2], gq[pt][3] * rs * wq[pt][3])); }
    }
}

struct Args {
    const float* in[23];
    float* out;
    unsigned char* ws;
    int ph_lo, ph_hi;
};

enum { PH_NORM1 = 0, PH_INPROJ, PH_SSD_CMP1, PH_GNORM_CMP2,
       PH_NSA,
       PH_OUTPROJ, PH_ROUTER, PH_SCATTER, PH_GATEUP, PH_DOWN, PH_FINAL, N_PHASES };

struct ARowsDense { static constexpr unsigned kstep = 128u; const bf16_t* base; size_t ld; int row0, nrows; const bf16_t* zrow; const void* wsbase;
    __device__ __forceinline__ const bf16_t* row(int r) const { const int g = row0 + r; return g < nrows ? base + (size_t)g * ld : zrow; } };
struct ARowsGather { static constexpr unsigned kstep = 128u; const bf16_t* base; size_t ld; const int* idx; const bf16_t* zrow; const void* wsbase; int nr;
    __device__ __forceinline__ const bf16_t* row(int r) const { const int g = r < nr ? idx[r] : -1; return g >= 0 ? base + (size_t)g * ld : zrow; } };
struct ARowsWindow { static constexpr unsigned kstep = 512u; const bf16_t* base; int row0; const bf16_t* zrow; const void* wsbase;
    __device__ __forceinline__ const bf16_t* row(int r) const { const int gr = row0 + r; if (gr >= CMP_ROWS) return zrow; const int g = gr & 3, n = (gr >> 2) % N_C, b = (gr >> 2) / N_C;
        return base + ((size_t)(b * SEQ + 16 * n)) * 256 + g * 64; } };
struct BColsDense { const float* base; int ldb; int col0, ncols;
    __device__ __forceinline__ int coloff(int n) const { const int c = col0 + n; return c < ncols ? c : ncols - 4; } };
struct BColsGateUp { const float* base; int ldb; int cn;
    __device__ __forceinline__ int coloff(int n) const { const int wc = n >> 7, nt = (n & 127) >> 4, w = n & 15; const int j = wc * 64 + (nt & 3) * 16 + w;
        return (nt < 4 ? 0 : DFF) + cn * 128 + j; } };

struct EpiStoreF32 { static constexpr bool ROW8 = false; float* C; size_t ldc; int row0, col0, ncols;
    __device__ __forceinline__ void operator()(int r, int n, f32x4 v) const { const int c = col0 + n; if (c < ncols) *(f32x4*)(C + (size_t)(row0 + r) * ldc + c) = v; } };
struct EpiResidF32 { static constexpr bool ROW8 = true; float* C; const float* X; size_t ldc; int row0, col0;
    __device__ __forceinline__ void row8(int r, int n0, const f32x4 (&v)[8]) const { const size_t o = (size_t)(row0 + r) * ldc + col0 + n0; f32x4 x[8];
#pragma unroll
        for (int n = 0; n < 8; ++n) x[n] = *(const f32x4*)(X + o + 16 * n);
#pragma unroll
        for (int n = 0; n < 8; ++n) *(f32x4*)(C + o + 16 * n) = v[n] + x[n]; } };
struct EpiSwiglu { static constexpr bool ROW8 = false; bf16_t* O; const float* bias; int row0, cn;
    __device__ __forceinline__ void pair4(int r, int j0, const f32x4 (&a)[8]) const { const int c0 = cn * 128 + j0; f32x4 bg[4], bu[4];
#pragma unroll
        for (int n = 0; n < 4; ++n) { bg[n] = *(const f32x4*)(bias + c0 + 16 * n); bu[n] = *(const f32x4*)(bias + DFF + c0 + 16 * n); }
#pragma unroll
        for (int n = 0; n < 4; ++n) { float o[4];
#pragma unroll
            for (int i = 0; i < 4; ++i) { float gv = a[n][i] + bg[n][i]; float uv = a[n + 4][i] + bu[n][i]; gv = fminf(gv, 7.0f); uv = fminf(fmaxf(uv, -7.0f), 7.0f);
                const float glu = gv * sigmoidf_(1.702f * gv); o[i] = (uv + 1.0f) * glu; }
            *(uint2*)(O + (size_t)(row0 + r) * DFF + c0 + 16 * n) = make_uint2(pack2(o[0], o[1]), pack2(o[2], o[3])); } } };
struct EpiBiasBf16 { static constexpr bool ROW8 = true; bf16_t* O; const float* bias; int row0, col0;
    __device__ __forceinline__ void row8(int r, int n0, const f32x4 (&v)[8]) const { const int c = col0 + n0; f32x4 bz[8];
#pragma unroll
        for (int n = 0; n < 8; ++n) bz[n] = *(const f32x4*)(bias + c + 16 * n);
#pragma unroll
        for (int n = 0; n < 8; ++n) { const f32x4 t = v[n] + bz[n]; *(uint2*)(O + (size_t)(row0 + r) * D + c + 16 * n) = make_uint2(pack2(t[0], t[1]), pack2(t[2], t[3])); } } };


struct EpiInProj { static constexpr bool ROW8 = false; unsigned char* ws; const float* dt_bias; int row0, col0;
    __device__ __forceinline__ void operator()(int r, int n, f32x4 v) const {
        const int cb = __builtin_amdgcn_readfirstlane((col0 + n) & ~15);
        const int ci = (col0 + n) & 15;
        const size_t R = (size_t)(row0 + r); const int pos = (int)(R & (SEQ - 1));
        if (cb >= IN_PROJ) return;
        if (cb >= OFF_DT && cb < OFF_Q) { f32x4 o;
#pragma unroll
            for (int i = 0; i < 4; ++i) { const float x = v[i] + dt_bias[ci + i]; o[i] = x > 20.f ? x : log1pf(expf(x)); }
            *(f32x4*)((float*)(ws + WS_DT) + R * 16 + ci) = o; return; }
        if (cb >= OFF_GATE) { f32x4 o;
#pragma unroll
            for (int i = 0; i < 4; ++i) o[i] = sigmoidf_(v[i]);
            *(f32x4*)((float*)(ws + WS_GATE) + R * 48 + (cb - OFF_GATE) + ci) = o; return; }
        size_t boff; int ld, cc; bool rp = false; float scl = 1.0f;
        if (cb < OFF_XBC) { boff = WS_ZB; ld = 1024; cc = cb; }
        else if (cb < OFF_DT) { boff = WS_XBCR; ld = 2048; cc = cb - OFF_XBC; }
        else if (cb < OFF_KCMP) { boff = WS_QB; ld = 1024; cc = cb - OFF_Q; rp = true; scl = 0.125f * 1.4426950408889634f; }
        else if (cb < OFF_VCMP) { boff = WS_KCMP; ld = 256; cc = cb - OFF_KCMP; }
        else if (cb < OFF_KSLC) { boff = WS_VCMP; ld = 256; cc = cb - OFF_VCMP; }
        else if (cb < OFF_VSLC) { boff = WS_KS; ld = 256; cc = cb - OFF_KSLC; rp = true; }
        else if (cb < OFF_KWIN) { boff = WS_VS; ld = 256; cc = cb - OFF_VSLC; }
        else if (cb < OFF_VWIN) { boff = WS_KW; ld = 256; cc = cb - OFF_KWIN; rp = true; }
        else { boff = WS_VW; ld = 256; cc = cb - OFF_VWIN; }
        f32x4 o = v;
        if (rp && (cc & 63) == 0) {
            const float* rope = (const float*)(ws + WS_ROPE);
#pragma unroll
            for (int i = 0; i < 4; ++i) { const float pr = xchg32(v[i]); const int k = (ci & 7) + i; const float c = rope[pos * 8 + k], sn = rope[SEQ * 8 + pos * 8 + k];
                o[i] = (ci < 8) ? (v[i] * c - pr * sn) : (pr * sn + v[i] * c); }
        }
        *(uint2*)((bf16_t*)(ws + boff) + R * ld + cc + ci) = make_uint2(pack2(o[0] * scl, o[1] * scl), pack2(o[2] * scl, o[3] * scl));
    } };


__device__ __forceinline__ const bf16_t* zrow_of(unsigned char* ws) { return (const bf16_t*)((unsigned*)(ws + WS_CTL) + CW_ZROW); }
struct MkInProj { static constexpr bool MASKED = false; __device__ __forceinline__ int rows_valid(int) const { return 256; } typedef ARowsDense AL; typedef BColsDense BL; typedef EpiInProj EP; unsigned char* ws; const float* w; const float* dt_bias;
    __device__ __forceinline__ void make_src(int rt, int ct, AL& al, BL& bl) const { al = AL{(const bf16_t*)(ws + WS_XN), (size_t)D, rt * 256, T, zrow_of(ws), ws}; bl = BL{w, IN_PROJ, ct * 256, IN_PROJ}; }
    __device__ __forceinline__ void make_ep(int rt, int ct, EP& ep) const { ep = EP{ws, dt_bias, rt * 256, ct * 256}; } };
struct MkOutProj { static constexpr bool MASKED = false; __device__ __forceinline__ int rows_valid(int) const { return 256; } typedef ARowsDense AL; typedef BColsDense BL; typedef EpiResidF32 EP; unsigned char* ws; const float* w; const float* x;
    __device__ __forceinline__ void make_src(int rt, int ct, AL& al, BL& bl) const { al = AL{(const bf16_t*)(ws + WS_MIX), (size_t)2048, rt * 256, T, zrow_of(ws), ws}; bl = BL{w, D, ct * 256, D}; }
    __device__ __forceinline__ void make_ep(int rt, int ct, EP& ep) const { ep = EP{(float*)(ws + WS_X2), x, (size_t)D, rt * 256, ct * 256}; } };
constexpr int TT_OFF = GEMM_LDS;
__device__ __forceinline__ int moe_tile_table(LAS char* lds, const unsigned* cnt) {
    LAS int* tt = (LAS int*)(lds + TT_OFF); LAS int* tmp = tt + 480;
    const int tid = threadIdx.x;
    int ntiles = 0;
    for (int k = 0; k < NE; ++k) ntiles += (int)((cnt[k] + 255u) >> 8);
    if (tid < ntiles) { int e = 0, acc = 0, first = 0;
        for (int k = 0; k < NE; ++k) { const int nt = (int)((cnt[k] + 255u) >> 8); if (tid >= acc && tid < acc + nt) { e = k; first = acc; } acc += nt; }
        const int v = min(256, (int)cnt[e] - 256 * (tid - first));
        tmp[tid] = e; tmp[160 + tid] = v; }
    __syncthreads();
    if (tid < ntiles) { int nheavy = 0, hb = 0, lb = 0; const bool heavy = tmp[160 + tid] > 128;
        for (int k = 0; k < ntiles; ++k) { const bool hk = tmp[160 + k] > 128; nheavy += hk ? 1 : 0; if (k < tid) { hb += hk ? 1 : 0; lb += hk ? 0 : 1; } }
        const int slot = tid; (void)heavy; (void)hb; (void)lb; (void)nheavy;
        tt[slot] = tid; tt[160 + slot] = tmp[tid]; tt[320 + slot] = tmp[160 + tid]; }
    __syncthreads();
    return ntiles; }
__device__ __forceinline__ int moe_rows_valid(const LAS int* tt, int rtc) { const int v = tt[320 + (rtc & 0xffff)], hc = rtc >> 16; return hc == 0 ? v : min(128, max(0, v - (hc == 2 ? 128 : 0))); }
struct MkGateUp { static constexpr bool MASKED = true; typedef ARowsGather AL; typedef BColsGateUp BL; typedef EpiSwiglu EP; unsigned char* ws; const float* w; const float* bias; const LAS int* tt;
    __device__ __forceinline__ int rows_valid(int rtc) const { return moe_rows_valid(tt, rtc); }
    __device__ __forceinline__ void make_src(int rtc, int cn, AL& al, BL& bl) const { const int rt = rtc & 0xffff, hc = rtc >> 16, tile = __builtin_amdgcn_readfirstlane(tt[rt]), e = __builtin_amdgcn_readfirstlane(tt[160 + rt]);
        al = AL{(const bf16_t*)(ws + WS_XN), (size_t)D, (const int*)(ws + WS_ROWTOK) + tile * 256 + (hc == 2 ? 128 : 0), zrow_of(ws), ws, hc ? 128 : 256}; bl = BL{w + (size_t)e * D * 2 * DFF, 2 * DFF, cn}; }
    __device__ __forceinline__ void make_ep(int rtc, int cn, EP& ep) const { const int rt = rtc & 0xffff, hc = rtc >> 16, tile = __builtin_amdgcn_readfirstlane(tt[rt]), e = __builtin_amdgcn_readfirstlane(tt[160 + rt]);
        ep = EP{(bf16_t*)(ws + WS_ACT), bias + (size_t)e * 2 * DFF, tile * 256 + (hc == 2 ? 128 : 0), cn}; } };
struct MkDown { static constexpr bool MASKED = true; typedef ARowsDense AL; typedef BColsDense BL; typedef EpiBiasBf16 EP; unsigned char* ws; const float* w; const float* bias; const LAS int* tt;
    __device__ __forceinline__ int rows_valid(int rtc) const { return moe_rows_valid(tt, rtc); }
    __device__ __forceinline__ void make_src(int rtc, int ct, AL& al, BL& bl) const { const int rt = rtc & 0xffff, hc = rtc >> 16, tile = __builtin_amdgcn_readfirstlane(tt[rt]), e = __builtin_amdgcn_readfirstlane(tt[160 + rt]);
        const int r0 = tile * 256 + (hc == 2 ? 128 : 0);
        al = AL{(const bf16_t*)(ws + WS_ACT), (size_t)DFF, r0, hc ? r0 + 128 : MAX_ROWS, zrow_of(ws), ws}; bl = BL{w + (size_t)e * DFF * D, D, ct * 256, D}; }
    __device__ __forceinline__ void make_ep(int rtc, int ct, EP& ep) const { const int rt = rtc & 0xffff, hc = rtc >> 16, tile = __builtin_amdgcn_readfirstlane(tt[rt]), e = __builtin_amdgcn_readfirstlane(tt[160 + rt]);
        ep = EP{(bf16_t*)(ws + WS_Y), bias + (size_t)e * D, tile * 256 + (hc == 2 ? 128 : 0), ct * 256}; } };
struct ProvCmp1 { static constexpr bool SINGLE = true, MASKED = false; typedef ARowsWindow AL; typedef BColsDense BL; typedef EpiStoreF32 EP; unsigned char* ws; const float* w1; int u, G;
    int cu;
    __device__ __forceinline__ bool next(AL& al, BL& bl) { if (u >= 128) return false; const int kq = u >> 5, j = (u >> 4) & 1, rt = (u >> 1) & 7, ct = u & 1; cu = u; u += G;
        al = AL{(const bf16_t*)(ws + (j ? WS_VCMP : WS_KCMP)) + (size_t)kq * 8 * 256, rt * 256, zrow_of(ws), ws};
        bl = BL{w1 + (size_t)j * 2048 * CMP_HID + (size_t)kq * 512 * CMP_HID, CMP_HID, ct * 256, CMP_HID}; return true; }
    __device__ __forceinline__ void make_ep(EP& ep) const { const int kq = cu >> 5, j = (cu >> 4) & 1, rt = (cu >> 1) & 7, ct = cu & 1;
        ep = EP{(float*)(ws + WS_PART) + (size_t)(kq * 2 + j) * 2048 * CMP_HID, (size_t)CMP_HID, rt * 256, ct * 256, CMP_HID}; } };

__device__ __forceinline__ float rope_inv(int i) { return (float)exp(-(double)i * 0.125 * 13.122363377404328); }


__global__ void __launch_bounds__(512, 2) fwd(Args a) {
    extern __shared__ __attribute__((aligned(16))) unsigned char lds_raw[];
    LAS char* lds = (LAS char*)lds_raw;
    const int tid = threadIdx.x, lane = tid & 63, wid = __builtin_amdgcn_readfirstlane(tid >> 6);
    const int G = gridDim.x, bid = blockIdx.x;
    const int gtid = bid * 512 + tid, gthreads = G * 512;
    const int gwave = bid * 8 + wid, gwaves = G * 8;
    unsigned char* ws = a.ws;
    unsigned* ctl = (unsigned*)(ws + WS_CTL);
    volatile LAS unsigned* barw = (volatile LAS unsigned*)(lds + MAIN_LDS);
    if (tid == 0) { barw[0] = 0u; barw[1] = 0u; barw[2] = 0u; barw[3] = 0u; }
    __syncthreads();
    XcdBarrier bar; bar.bar = ctl; bar.x = 0; bar.st = barw;
    const bool multi = (a.ph_hi - a.ph_lo) > 1;
    int vbid = (G % 8 == 0) ? (bid & 7) * (G / 8) + (bid >> 3) : bid;
    if (multi) bar = xcd_barrier_post(ctl, barw);
#ifdef ONLY_PH
#define IN(k) ((k) == ONLY_PH)
#else
#define IN(k) (a.ph_lo <= (k) && (k) < a.ph_hi)
#endif
#define SEAM(k) do { if ((k) + 1 < a.ph_hi) xcd_barrier(bar); } while (0)

#define XN ((bf16_t*)(ws + WS_XN))
#define DT ((float*)(ws + WS_DT))
#define YSSD ((float*)(ws + WS_YSSD))
#define MIX ((bf16_t*)(ws + WS_MIX))
#define ROPE ((float*)(ws + WS_ROPE))
#define X2 ((float*)(ws + WS_X2))
#define TOPE ((int*)(ws + WS_TOPE))
#define TOPG ((float*)(ws + WS_TOPG))
#define SLOT ((int*)(ws + WS_SLOT))
#define POS ((int*)(ws + WS_POS))
#define ROWTOK ((int*)(ws + WS_ROWTOK))
#define ACT ((bf16_t*)(ws + WS_ACT))
#define YB ((bf16_t*)(ws + WS_Y))
#define STATES ((float*)(ws + WS_STATES))
#define PREV ((bf16_t*)(ws + WS_PREV))
#define CHDEC ((float*)(ws + WS_CHDEC))
#define QB ((bf16_t*)(ws + WS_QB))
#define KSb ((bf16_t*)(ws + WS_KS))
#define VSb ((bf16_t*)(ws + WS_VS))
#define KWb ((bf16_t*)(ws + WS_KW))
#define VWb ((bf16_t*)(ws + WS_VW))
#define KCB ((bf16_t*)(ws + WS_KCB))
#define VCB ((bf16_t*)(ws + WS_VCB))
#define XIN (a.in[0])
#define RW ((float*)(ws + WS_RW))
#define BCNT ((int*)(ws + WS_BCNT))
#define ZB ((bf16_t*)(ws + WS_ZB))
#define XBCR ((bf16_t*)(ws + WS_XBCR))
#define KCMPb ((bf16_t*)(ws + WS_KCMP))
#define VCMPb ((bf16_t*)(ws + WS_VCMP))
#define GATE ((float*)(ws + WS_GATE))
#define PEW ((float*)(ws + WS_PEW))
#define PEWP ((float*)(ws + WS_PEWP))
#define PART ((float*)(ws + WS_PART))
#define COUNT (ctl + CW_COUNT)
#define ZROW ((const bf16_t*)(ctl + CW_ZROW))
    if (IN(PH_NORM1)) {
        const float* w = a.in[1];
        for (int row = gwave; row < T; row += gwaves) {
            const float4* xr = (const float4*)(XIN + (size_t)row * D);
            float4 v[8], wg[8]; float ss = 0.f;
#pragma unroll
            for (int i = 0; i < 8; ++i) { v[i] = xr[lane + 64 * i]; wg[i] = ((const float4*)w)[lane + 64 * i]; }
#pragma unroll
            for (int i = 0; i < 8; ++i) ss += v[i].x * v[i].x + v[i].y * v[i].y + v[i].z * v[i].z + v[i].w * v[i].w;
            ss = wave_sum(ss);
            const float rstd = rsqrtf(ss * (1.0f / D) + NORM_EPS);
#pragma unroll
            for (int i = 0; i < 8; ++i) { const float4 wv = wg[i];
                *(uint2*)(XN + (size_t)row * D + 4 * (lane + 64 * i)) = make_uint2(pack2(v[i].x * rstd * wv.x, v[i].y * rstd * wv.y), pack2(v[i].z * rstd * wv.z, v[i].w * rstd * wv.w)); }
        }
        for (int i = gtid; i < SEQ * 8; i += gthreads) { const int pos = i >> 3, k = i & 7; const float ang = (float)pos * rope_inv(k); ROPE[i] = cosf(ang); ROPE[SEQ * 8 + i] = sinf(ang); }
        for (int i = gtid; i < MAX_ROWS; i += gthreads) ROWTOK[i] = -1;
        for (int i = gtid; i < 2 * 2 * 256; i += gthreads) { const int d = i & 255, b = (i >> 8) & 1, j = i >> 9; (j ? VCB : KCB)[((size_t)b * 256 + 255) * 256 + d] = 0; }
        for (int i = gtid; i < 2048 * 32; i += gthreads) { const int ii = i & 3, e = (i >> 2) & 31, kk = i >> 7, k = 4 * kk + ii; RW[i] = a.in[15][k] * a.in[16][k * NE + e]; }
        for (int i = gtid; i < 32 * 2 * CMP_HID; i += gthreads) {
            const int col = i & (CMP_HID - 1), j = (i >> 9) & 1, kc = i >> 10; const float* pe = a.in[9] + j * 2048 + kc * 64; const float* w1 = a.in[10] + ((size_t)j * 2048 + kc * 64) * CMP_HID + col;
            float acc = 0.f;
#pragma unroll 8
            for (int k = 0; k < 64; ++k) acc += pe[k] * w1[(size_t)k * CMP_HID];
            PEWP[i] = acc;
        }
        SEAM(PH_NORM1);
    }

    if (IN(PH_INPROJ)) {
        for (int i = gtid; i < 2 * CMP_HID; i += gthreads) { float acc = 0.f;
#pragma unroll 8
            for (int kc = 0; kc < 32; ++kc) acc += PEWP[kc * 1024 + i]; PEW[i] = acc; }
        if (multi && a.ph_lo <= PH_NORM1) {
            if (tid == 0) { unsigned base = 0u;
#pragma unroll
                for (unsigned j = 0; j < 16; ++j) { const unsigned c = xb_ld(&ctl[XB_XCNT(j)]); base += (j < bar.x) ? c : 0u; }
                barw[3] = base + barw[2]; }
            __syncthreads();
            vbid = __builtin_amdgcn_readfirstlane((int)barw[3]);
            if (vbid < 0 || vbid >= G) vbid = bid;
        }
        { PatchProv<MkInProj> P; P.mk = MkInProj{ws, a.in[2], a.in[5]}; P.init(T / 256, (IN_PROJ + 255) / 256, G, vbid); gemm_stream<false>(lds, P, D); }
        SEAM(PH_INPROJ);
    }

    if (IN(PH_SSD_CMP1)) {
        const int GW = G;
        {
            for (int u0 = bid; u0 < 128; u0 += GW) { ProvCmp1 P{ws, a.in[10], u0, 1 << 20, 0}; gemm_stream<false>(lds, P, 512); }
            for (int it = (bid + GW - (128 % GW)) % GW; it < 256; it += GW) ssd_states_item(lds, it, XBCR, a.in[3], a.in[4], DT, a.in[6], STATES, CHDEC);
        }
        SEAM(PH_SSD_CMP1);
    }

    if (IN(PH_GNORM_CMP2)) {
        const float* nw = a.in[8];
        for (int i = gtid; i < 2 * 16 * 64 * 32; i += gthreads) {
            const int n4 = i & 31, p = (i >> 5) & 63, h = (i >> 11) & 15, b = i >> 15;
            f32x4 run = {0.f, 0.f, 0.f, 0.f};
#pragma unroll 1
            for (int c0 = 0; c0 < 32; c0 += 16) {
                f32x4 sv[16]; float dec[16];
#pragma unroll
                for (int q = 0; q < 16; ++q) { const size_t base = (((size_t)b * 32 + c0 + q) * 16 + h) * 8192 + p * 128 + n4 * 4; sv[q] = *(const f32x4*)(STATES + base); dec[q] = CHDEC[((size_t)b * 32 + c0 + q) * 16 + h]; }
#pragma unroll
                for (int q = 0; q < 16; ++q) { const size_t base = (((size_t)b * 32 + c0 + q) * 16 + h) * 8192 + p * 128 + n4 * 4;
                    *(uint2*)(PREV + base) = make_uint2(pack2(run[0], run[1]), pack2(run[2], run[3])); run = run * dec[q] + sv[q]; }
            }
        }
        const float* w2 = a.in[12]; const float* b2 = a.in[13]; const float* b1 = a.in[11];
        for (int it = gwave; it < 2 * CMP_ROWS; it += gwaves) {
            const int row = it % CMP_ROWS, j = it / CMP_ROWS, d = lane;
            const float* wj = w2 + (size_t)j * CMP_HID * 64;
            float s0 = b2[j * 64 + d];
            for (int k0 = 0; k0 < CMP_HID; k0 += 64) {
                float hx = b1[j * CMP_HID + k0 + lane] + PEW[j * CMP_HID + k0 + lane];
#pragma unroll
                for (int q = 0; q < 4; ++q) hx += PART[((size_t)(q * 2 + j) * 2048 + row) * CMP_HID + k0 + lane];
                const float u = 0.7978845608028654f * (hx + 0.044715f * hx * hx * hx);
                const float hv = bf2f(f2bf(0.5f * hx * (1.0f + tanhf(u))));
#pragma unroll
                for (int kk = 0; kk < 64; ++kk) s0 += __builtin_bit_cast(float, __builtin_amdgcn_readlane(__builtin_bit_cast(int, hv), kk)) * wj[(k0 + kk) * 64 + d];
            }
            float o = s0;
            if (j == 0) { const float sp = __shfl(s0, (d < 8) ? d + 8 : ((d < 16) ? d - 8 : d));
                if (d < 16) { const int n = (row >> 2) % N_C, pos = 16 * n + 31, k = d & 7; const float c = ROPE[pos * 8 + k], sn = ROPE[SEQ * 8 + pos * 8 + k];
                    o = (d < 8) ? (s0 * c - sp * sn) : (sp * sn + s0 * c); } }
            { const int g4 = row & 3, n = (row >> 2) % N_C, bb = (row >> 2) / N_C; (j ? VCB : KCB)[((size_t)bb * 256 + n) * 256 + g4 * 64 + d] = f2bf(o); }
        }
        SEAM(PH_GNORM_CMP2);
    }

    if (IN(PH_NSA)) {
        bf16_t* MIXO = MIX;
        for (int k = bid; k < 512; k += G) { const int rnd = k / G; const int u = (rnd & 1) ? ((511 - (k - G * rnd) - G * (rnd - 1)) ^ 7) : k;
            if (u >= 0 && u < 512) nsa_unit32(lds, (G == 256) ? u : k, QB, KSb, VSb, KWb, VWb, KCB, VCB, GATE, MIXO); }
        for (int it = bid; it < 256; it += G) ssd_out_item(lds, it, XBCR, a.in[3], a.in[4], DT, a.in[6], a.in[7], a.in[8], PREV, ZB, YSSD, MIXO);
        SEAM(PH_NSA);
    }

    if (IN(PH_OUTPROJ)) {
        { PatchProv<MkOutProj> P; P.mk = MkOutProj{ws, a.in[14], a.in[0]}; P.init(T / 256, D / 256, G, vbid); gemm_stream<false>(lds, P, 2048); }
        SEAM(PH_OUTPROJ);
    }

    if (IN(PH_ROUTER)) {
        const float* nwp = a.in[15]; const float* br = a.in[17];
        LAS float* part = (LAS float*)lds;
        LAS float* ssq = part + 8 * 512;
        LAS float* rsl = ssq + 128;
        LAS int* lcnt = (LAS int*)(rsl + 32);
        if (tid < 32) lcnt[tid] = 0;
        __syncthreads();
        const int r16 = lane & 15, kq = lane >> 4;
        for (int tp = bid; tp < T / 32; tp += G) {
            const int wt = wid >> 2, wk = wid & 3, tile = 2 * tp + wt;
            const int row = tile * 16 + r16;
            f32x4 acc0 = {0.f, 0.f, 0.f, 0.f}, acc1 = {0.f, 0.f, 0.f, 0.f}; float ssp = 0.f;
            const float* xr = X2 + (size_t)row * D + 512 * wk + 4 * kq;
            const float* rwp = RW + ((size_t)(128 * wk + kq) * 32 + r16) * 4;
#pragma unroll 8
            for (int j = 0; j < 32; ++j) {
                const f32x4 av = *(const f32x4*)(xr + 16 * j);
                const f32x4 b0 = *(const f32x4*)(rwp + (size_t)j * 4 * 128), b1 = *(const f32x4*)(rwp + (size_t)j * 4 * 128 + 64);
                ssp += av[0] * av[0] + av[1] * av[1] + av[2] * av[2] + av[3] * av[3];
#pragma unroll
                for (int i = 0; i < 4; ++i) { acc0 = __builtin_amdgcn_mfma_f32_16x16x4f32(av[i], b0[i], acc0, 0, 0, 0); acc1 = __builtin_amdgcn_mfma_f32_16x16x4f32(av[i], b1[i], acc1, 0, 0, 0); }
            }
            ssp += __shfl_xor(ssp, 16); ssp += __shfl_xor(ssp, 32);
            if (kq == 0) ssq[wid * 16 + r16] = ssp;
#pragma unroll
            for (int i = 0; i < 4; ++i) { part[wid * 512 + (4 * kq + i) * 32 + r16] = acc0[i]; part[wid * 512 + (4 * kq + i) * 32 + 16 + r16] = acc1[i]; }
            __syncthreads();
#pragma unroll
            for (int rep = 0; rep < 2; ++rep) {
                const int idx = tid + 512 * rep, ts = idx >> 9, rr = (idx >> 5) & 15, e = idx & 31, grow = (2 * tp + ts) * 16 + rr;
                float lg = 0.f, ss = 0.f;
#pragma unroll
                for (int w = 0; w < 4; ++w) { lg += part[(4 * ts + w) * 512 + rr * 32 + e]; ss += ssq[(4 * ts + w) * 16 + rr]; }
                const float rstd = rsqrtf(ss * (1.0f / D) + NORM_EPS);
                const float mine = lg * rstd + br[e];
                int rank = 0;
#pragma unroll
                for (int k = 0; k < NE; ++k) { const float o = __shfl(mine, (lane & 32) + k); rank += (o > mine || (o == mine && k < e)) ? 1 : 0; }
                const bool sel = rank < 4;
                float mx = sel ? mine : -INFINITY;
#pragma unroll
                for (int o = 16; o > 0; o >>= 1) mx = fmaxf(mx, __shfl_xor(mx, o));
                const float ex = sel ? __expf(mine - mx) : 0.f;
                float den = ex;
#pragma unroll
                for (int o = 16; o > 0; o >>= 1) den += __shfl_xor(den, o);
                if (sel) { const int slot = atomicAdd((int*)&lcnt[e], 1); const int o = grow * 4 + rank; TOPE[o] = e; TOPG[o] = ex / den; SLOT[o] = slot; }
                if (e == 0) rsl[ts * 16 + rr] = rstd;
            }
            __syncthreads();
            if (tid < 32) { BCNT[tp * 32 + tid] = lcnt[tid]; lcnt[tid] = 0; }
            { const f32x4 wv = *(const f32x4*)(nwp + 4 * tid);
#pragma unroll 1
              for (int half = 0; half < 4; ++half) {
                f32x4 vv[8];
#pragma unroll
                for (int it = 0; it < 8; ++it) vv[it] = *(const f32x4*)(X2 + (size_t)(tp * 32 + half * 8 + it) * D + 4 * tid);
#pragma unroll
                for (int it = 0; it < 8; ++it) { const float rs = rsl[half * 8 + it]; const f32x4 v = vv[it];
                    *(uint2*)(XN + (size_t)(tp * 32 + half * 8 + it) * D + 4 * tid) = make_uint2(pack2(v[0] * rs * wv[0], v[1] * rs * wv[1]), pack2(v[2] * rs * wv[2], v[3] * rs * wv[3])); }
              } }
            __syncthreads();
        }
        SEAM(PH_ROUTER);
    }

    if (IN(PH_SCATTER)) {
        LAS int* red = (LAS int*)lds;
        for (int cb = bid; cb < 64; cb += G) {
            const int tp0 = 4 * cb, e = tid & 31, c = tid >> 5;
            int sb = 0, stt = 0;
#pragma unroll 4
            for (int q = 0; q < 16; ++q) { const int tpq = 16 * c + q; const int v = BCNT[tpq * 32 + e]; stt += v; sb += (tpq < tp0) ? v : 0; }
            red[c * 32 + e] = sb; red[512 + c * 32 + e] = stt;
            __syncthreads();
            if (tid < 32) { int b0 = 0, tt_ = 0;
#pragma unroll
                for (int q = 0; q < 16; ++q) { b0 += red[q * 32 + tid]; tt_ += red[512 + q * 32 + tid]; }
                red[1024 + tid] = b0; red[1056 + tid] = tt_; if (cb == 0) COUNT[tid] = (unsigned)tt_; }
            __syncthreads();
            { const int i = cb * 512 + tid, ei = TOPE[i], tp = i >> 7;
              int base = red[1024 + ei];
              for (int q = tp0; q < tp; ++q) base += BCNT[q * 32 + ei];
              int off = 0;
              for (int k = 0; k < ei; ++k) off += (red[1056 + k] + 255) >> 8;
              const int pos = off * 256 + base + SLOT[i];
              ROWTOK[pos] = i >> 2; POS[i] = pos; }
            __syncthreads();
        }
        SEAM(PH_SCATTER);
    }

    if (IN(PH_GATEUP)) {
        const int ntiles = moe_tile_table(lds, COUNT);
        { PatchProv<MkGateUp> P; P.mk = MkGateUp{ws, a.in[18], a.in[19], (const LAS int*)(lds + TT_OFF)}; P.init(ntiles, 16, G, vbid); gemm_stream<true>(lds, P, D); }
        SEAM(PH_GATEUP);
    }
    if (IN(PH_DOWN)) {
        const int ntiles = moe_tile_table(lds, COUNT);
        { PatchProv<MkDown> P; P.mk = MkDown{ws, a.in[20], a.in[21], (const LAS int*)(lds + TT_OFF)}; P.init(ntiles, 8, G, vbid); gemm_stream<false>(lds, P, DFF); }
        SEAM(PH_DOWN);
    }

    if (IN(PH_FINAL)) {
        const float* fw = a.in[22];
        for (int row = gwave; row < T; row += gwaves) {
            const float4* xr = (const float4*)(X2 + (size_t)row * D);
            float4 v[8], wg[8]; float gks[4]; int ps[4];
#pragma unroll
            for (int k = 0; k < 4; ++k) { gks[k] = TOPG[row * 4 + k]; ps[k] = POS[row * 4 + k]; }
#pragma unroll
            for (int i = 0; i < 8; ++i) { v[i] = xr[lane + 64 * i]; wg[i] = ((const float4*)fw)[lane + 64 * i]; }
#pragma unroll
            for (int k = 0; k < 4; ++k) { const float gk = gks[k]; const bf16_t* yr = YB + (size_t)ps[k] * D;
#pragma unroll
                for (int i = 0; i < 8; ++i) { const uint2 y = *(const uint2*)(yr + 4 * (lane + 64 * i));
                    v[i].x += gk * bf2f((bf16_t)(y.x & 0xffffu)); v[i].y += gk * bf2f((bf16_t)(y.x >> 16)); v[i].z += gk * bf2f((bf16_t)(y.y & 0xffffu)); v[i].w += gk * bf2f((bf16_t)(y.y >> 16)); } }
            float ss = 0.f;
#pragma unroll
            for (int i = 0; i < 8; ++i) ss += v[i].x * v[i].x + v[i].y * v[i].y + v[i].z * v[i].z + v[i].w * v[i].w;
            ss = wave_sum(ss);
            float rstd = rsqrtf(ss * (1.0f / D) + NORM_EPS);
#pragma unroll
            for (int i = 0; i < 8; ++i) { const float4 wv = wg[i];
                ((float4*)(a.out + (size_t)row * D))[lane + 64 * i] = make_float4(v[i].x * rstd * wv.x, v[i].y * rstd * wv.y, v[i].z * rstd * wv.z, v[i].w * rstd * wv.w); }
        }
    }
#undef IN
#undef SEAM
}

extern "C" void kernel_launch(void* const* d_in, const int* in_sizes, int n_in, void* d_out, int out_size, void* d_ws, size_t ws_size, hipStream_t stream) {
    static int grid = 0;
    if (grid == 0) {
        if (n_in != 23 || out_size != T * D || ws_size < WS_END) { fprintf(stderr, "kernel_launch: unexpected shapes (n_in %d, out %d, ws %zu < %zu)\n", n_in, out_size, ws_size, (size_t)WS_END); grid = -1; return; }
        int dev = 0, cus = 0, per_cu = 0;
        if (hipGetDevice(&dev) != hipSuccess || hipDeviceGetAttribute(&cus, hipDeviceAttributeMultiprocessorCount, dev) != hipSuccess) { grid = -1; return; }
        if (hipFuncSetAttribute((const void*)fwd, hipFuncAttributeMaxDynamicSharedMemorySize, LDS_BYTES) != hipSuccess) { fprintf(stderr, "kernel_launch: hipFuncSetAttribute failed\n"); grid = -1; return; }
        if (hipOccupancyMaxActiveBlocksPerMultiprocessor(&per_cu, (const void*)fwd, 512, LDS_BYTES) != hipSuccess || per_cu < 1) { fprintf(stderr, "kernel_launch: occupancy query says %d\n", per_cu); per_cu = 1; }
        (void)hipGetLastError();
        grid = cus;
    }
    if (grid < 0) return;
    (void)hipMemsetAsync((char*)d_ws + WS_CTL, 0, CTL_BYTES, stream);
    Args a{};
    for (int i = 0; i < 23; ++i) a.in[i] = (const float*)d_in[i];
    a.out = (float*)d_out; a.ws = (unsigned char*)d_ws;
#if N_LAUNCH_MODE == 1
    a.ph_lo = 0; a.ph_hi = N_PHASES;
    hipLaunchKernelGGL(fwd, dim3(grid), dim3(512), LDS_BYTES, stream, a);
#else
    for (int ph = 0; ph < N_PHASES; ++ph) { a.ph_lo = ph; a.ph_hi = ph + 1; hipLaunchKernelGGL(fwd, dim3(grid), dim3(512), LDS_BYTES, stream, a); }
#endif
}
```

```cpp
#include <hip/hip_runtime.h>
#include <stdint.h>
#include <stdio.h>

#ifndef N_LAUNCH_MODE
#define N_LAUNCH_MODE 1
#endif

typedef unsigned short bf16_t;
typedef short s16x4 __attribute__((ext_vector_type(4)));
typedef short s16x8 __attribute__((ext_vector_type(8)));
typedef float f32x4 __attribute__((ext_vector_type(4)));
typedef unsigned u32x4 __attribute__((ext_vector_type(4)));
typedef unsigned u32x2 __attribute__((ext_vector_type(2)));
#define LAS __attribute__((address_space(3)))

constexpr int D = 2048, BATCH = 2, SEQ = 4096, T = BATCH * SEQ;
constexpr int SSM_H = 16, SSM_N = 128;
constexpr int NSA_H = 16, DH = 64;
constexpr int CMP_HID = 512;
constexpr int N_C = 255, N_SEL = 64;
constexpr int IN_PROJ = 5696;
constexpr int OFF_Z = 0, OFF_XBC = 1024, OFF_DT = 3072, OFF_Q = 3088, OFF_KCMP = 4112, OFF_VCMP = 4368, OFF_KSLC = 4624,
              OFF_VSLC = 4880, OFF_KWIN = 5136, OFF_VWIN = 5392, OFF_GATE = 5648;
constexpr int NE = 32, DFF = 2048;
constexpr float NORM_EPS = 1e-5f;
constexpr int CMP_ROWS = BATCH * N_C * 4;
constexpr int MAX_TILES = 160, MAX_ROWS = MAX_TILES * 256;

constexpr size_t AL(size_t x) { return (x + 255) & ~(size_t)255; }
constexpr size_t WS_CTL = 0;
constexpr size_t CTL_BYTES = 32768;
constexpr size_t WS_XN = WS_CTL + CTL_BYTES;
constexpr size_t WS_PROJ = WS_XN + AL((size_t)T * D * 2);
constexpr size_t WS_ZB = WS_PROJ;
constexpr size_t WS_XBCR = WS_ZB + AL((size_t)T * 1024 * 2);
constexpr size_t WS_KCMP = WS_XBCR + AL((size_t)T * 2048 * 2);
constexpr size_t WS_VCMP = WS_KCMP + AL((size_t)T * 256 * 2);
constexpr size_t WS_GATE = WS_VCMP + AL((size_t)T * 256 * 2);
constexpr size_t WS_PEW = WS_GATE + AL((size_t)T * 48 * 4);
constexpr size_t WS_PEWP = WS_PEW + 4096;
static_assert(WS_PEWP + 32 * 1024 * 4 <= WS_PROJ + AL((size_t)T * IN_PROJ * 4), "in-proj outputs fit the old PROJ region");
constexpr size_t WS_XBC = WS_PROJ + AL((size_t)T * IN_PROJ * 4);
constexpr size_t WS_DT = WS_XBC + AL((size_t)T * 2048 * 4);
constexpr size_t WS_YSSD = WS_DT + AL((size_t)T * 16 * 4);
constexpr size_t WS_MIX = WS_YSSD + AL((size_t)T * 1024 * 4);
constexpr size_t WS_ROPE = WS_MIX + AL((size_t)T * 2048 * 2);
constexpr size_t WS_BLK = WS_ROPE + AL((size_t)SEQ * 16 * 4);
constexpr size_t WS_H1 = WS_BLK + AL((size_t)2 * 2048 * 2048 * 2);
constexpr size_t WS_KC = WS_H1 + AL((size_t)2 * 2048 * 512 * 2);
constexpr size_t WS_VC = WS_KC + AL((size_t)2048 * 64 * 4);
constexpr size_t WS_PCMP = WS_VC + AL((size_t)2048 * 64 * 4);
constexpr size_t WS_OCMP = WS_PCMP + AL((size_t)T * 16 * 256 * 4);
constexpr size_t WS_SEL = WS_OCMP + AL((size_t)T * 1024 * 4);
constexpr size_t WS_X2 = WS_SEL + AL((size_t)T * 4 * 8);
constexpr size_t WS_TOPE = WS_X2 + AL((size_t)T * D * 4);
constexpr size_t WS_TOPG = WS_TOPE + AL((size_t)T * 4 * 4);
constexpr size_t WS_SLOT = WS_TOPG + AL((size_t)T * 4 * 4);
constexpr size_t WS_POS = WS_SLOT + AL((size_t)T * 4 * 4);
constexpr size_t WS_ROWTOK = WS_POS + AL((size_t)T * 4 * 4);
constexpr size_t WS_BCNT = WS_ROWTOK + AL((size_t)MAX_ROWS * 4);
constexpr size_t WS_ACT = WS_BCNT + AL((size_t)256 * 32 * 4);
constexpr size_t WS_Y = WS_ACT + AL((size_t)MAX_ROWS * DFF * 2);
constexpr size_t WS_QB = WS_Y + AL((size_t)MAX_ROWS * D * 2);
constexpr size_t WS_KS = WS_QB + AL((size_t)T * 1024 * 2);
constexpr size_t WS_VS = WS_KS + AL((size_t)T * 256 * 2);
constexpr size_t WS_KW = WS_VS + AL((size_t)T * 256 * 2);
constexpr size_t WS_VW = WS_KW + AL((size_t)T * 256 * 2);
constexpr size_t WS_KCB = WS_VW + AL((size_t)T * 256 * 2);
constexpr size_t WS_VCB = WS_KCB + AL((size_t)2 * 256 * 256 * 2);
constexpr size_t WS_XBCB = WS_VCB + AL((size_t)2 * 256 * 256 * 2);
constexpr size_t WS_STATES = WS_XBCB + AL((size_t)T * 2048 * 2);
constexpr size_t WS_PREV = WS_STATES + AL((size_t)2 * 32 * 16 * 64 * 128 * 4);
constexpr size_t WS_CHDEC = WS_PREV + AL((size_t)2 * 32 * 16 * 64 * 128 * 2);
constexpr size_t WS_PART = WS_CHDEC + AL((size_t)2 * 32 * 16 * 4);
constexpr size_t WS_RW = WS_PART + AL((size_t)4 * 2 * 2048 * 512 * 4);
constexpr size_t WS_CHK = WS_RW + AL((size_t)2048 * 32 * 4);
constexpr size_t WS_END = WS_CHK + AL((size_t)T * 2048 * 4);

constexpr int CW_COUNT = 4096;
constexpr int CW_ZROW = 5120;
constexpr int CW_CHK = 4160;

#define XB_TMO      128
#define XB_XCNT(j)  (256  + 64 * (j))
#define XB_XSUB(j)  (1280 + 64 * (j))
#define XB_XGEN(j)  (2304 + 64 * (j))
#define XB_TOP      3328
#define XB_TOPGEN   3392
#define XCD_BAR_WORDS 3456
#define XB_SPIN_CAP (1u << 18)

__device__ __forceinline__ unsigned xb_ld(unsigned* p)              { return __hip_atomic_load(p, __ATOMIC_RELAXED, __HIP_MEMORY_SCOPE_AGENT); }
__device__ __forceinline__ unsigned xb_add(unsigned* p, unsigned v) { return __hip_atomic_fetch_add(p, v, __ATOMIC_RELAXED, __HIP_MEMORY_SCOPE_AGENT); }
__device__ __forceinline__ unsigned xb_xcc_id() { return (unsigned)__builtin_amdgcn_s_getreg((3 << 11) | 20) & 0xFu; }
#define XB_SPIN(cond, bar) do { unsigned _sp = 0; while (cond) { __builtin_amdgcn_s_sleep(1); \
    if ((++_sp & 255u) == 0u) { if (xb_ld(&(bar)[XB_TMO])) break; if (_sp > XB_SPIN_CAP) { atomicAdd(&(bar)[XB_TMO], 1u); break; } } } } while (0)

struct XcdBarrier { unsigned* bar; unsigned x; volatile LAS unsigned* st; };

__device__ __forceinline__ XcdBarrier xcd_barrier_post(unsigned* bar, volatile LAS unsigned* st) {
    XcdBarrier b; b.bar = bar; b.x = xb_xcc_id(); b.st = st;
    if (threadIdx.x == 0) st[2] = xb_add(&bar[XB_XCNT(b.x)], 1u);
    return b;
}
__device__ __forceinline__ void xcd_barrier_complete(unsigned* bar, unsigned x, unsigned& nloc, unsigned& nx) {
    const unsigned G = gridDim.x * gridDim.y * gridDim.z;
    unsigned sum, cnt, mine, sp = 0u;
    for (;;) {
        sum = 0u; cnt = 0u; mine = 0u;
#pragma unroll
        for (unsigned j = 0; j < 16; ++j) { const unsigned c = xb_ld(&bar[XB_XCNT(j)]); sum += c; cnt += (c > 0u) ? 1u : 0u; mine = (j == x) ? c : mine; }
        if (sum == G) break;
        __builtin_amdgcn_s_sleep(1);
        if ((++sp & 255u) == 0u) { if (xb_ld(&bar[XB_TMO])) break; if (sp > XB_SPIN_CAP) { atomicAdd(&bar[XB_TMO], 1u); break; } }
    }
    nloc = mine > 0u ? mine : 1u; nx = cnt > 0u ? cnt : 1u;
}
__device__ __forceinline__ void xcd_barrier(const XcdBarrier& b) {
    asm volatile("s_waitcnt vmcnt(0)" ::: "memory");
    __syncthreads();
    if (threadIdx.x == 0) {
        unsigned* bar = b.bar;
        __builtin_amdgcn_s_waitcnt(0);
        unsigned nloc = b.st[0], nx = b.st[1];
        if (nloc == 0u) { xcd_barrier_complete(bar, b.x, nloc, nx); b.st[0] = nloc; b.st[1] = nx; }
        const unsigned old = xb_add(&bar[XB_XSUB(b.x)], 1u);
        const unsigned gen = old / nloc;
        if (old + 1u == (gen + 1u) * nloc) {
            __builtin_amdgcn_fence(__ATOMIC_RELEASE, "agent");
            asm volatile("s_waitcnt vmcnt(0)" ::: "memory");
            const unsigned og = xb_add(&bar[XB_TOP], 1u);
            const unsigned tg = og / nx;
            if (og + 1u == (tg + 1u) * nx) xb_add(&bar[XB_TOPGEN], 1u);
            else XB_SPIN(xb_ld(&bar[XB_TOPGEN]) == tg, bar);
            __builtin_amdgcn_fence(__ATOMIC_ACQUIRE, "agent");
            xb_add(&bar[XB_XGEN(b.x)], 1u);
            asm volatile("s_waitcnt vmcnt(0)" ::: "memory");
        } else {
            XB_SPIN(xb_ld(&bar[XB_XGEN(b.x)]) == gen, bar);
            __builtin_amdgcn_fence(__ATOMIC_ACQUIRE, "agent");
            asm volatile("s_waitcnt vmcnt(0)" ::: "memory");
        }
    }
    __syncthreads();
}

__device__ __forceinline__ bf16_t f2bf(float f) { unsigned u = __float_as_uint(f); u += 0x7FFFu + ((u >> 16) & 1u); return (bf16_t)(u >> 16); }
__device__ __forceinline__ float bf2f(bf16_t b) { return __uint_as_float(((unsigned)b) << 16); }
typedef __bf16 bf16x2_t __attribute__((ext_vector_type(2)));
typedef float f32x2_t __attribute__((ext_vector_type(2)));
__device__ __forceinline__ unsigned pack2(float lo, float hi) { const f32x2_t v = {lo, hi}; return __builtin_bit_cast(unsigned, __builtin_convertvector(v, bf16x2_t)); }
__device__ __forceinline__ float wave_sum(float v) {
#pragma unroll
    for (int o = 32; o > 0; o >>= 1) v += __shfl_xor(v, o);
    return v;
}
__device__ __forceinline__ float xmax16(float x) { const unsigned u = __builtin_bit_cast(unsigned, x); const auto r = __builtin_amdgcn_permlane16_swap(u, u, false, false); return fmaxf(__builtin_bit_cast(float, r[0]), __builtin_bit_cast(float, r[1])); }
__device__ __forceinline__ float xmax32(float x) { const unsigned u = __builtin_bit_cast(unsigned, x); const auto r = __builtin_amdgcn_permlane32_swap(u, u, false, false); return fmaxf(__builtin_bit_cast(float, r[0]), __builtin_bit_cast(float, r[1])); }
__device__ __forceinline__ float xsum16(float x) { const unsigned u = __builtin_bit_cast(unsigned, x); const auto r = __builtin_amdgcn_permlane16_swap(u, u, false, false); return __builtin_bit_cast(float, r[0]) + __builtin_bit_cast(float, r[1]); }
__device__ __forceinline__ float xsum32(float x) { const unsigned u = __builtin_bit_cast(unsigned, x); const auto r = __builtin_amdgcn_permlane32_swap(u, u, false, false); return __builtin_bit_cast(float, r[0]) + __builtin_bit_cast(float, r[1]); }
__device__ __forceinline__ float sigmoidf_(float x) { return __builtin_amdgcn_rcpf(1.0f + __expf(-x)); }

constexpr int B_RS = 544, A_ST = 256 * 128, B_ST = 64 * B_RS, STAGE = A_ST + B_ST;
constexpr int GEMM_LDS = 2 * STAGE;
constexpr int SSD_LDS = 147456;
constexpr int MAIN_LDS = SSD_LDS > GEMM_LDS ? SSD_LDS : GEMM_LDS;
constexpr int LDS_BYTES = MAIN_LDS + 64;

template <bool PAIRED, class Prov>
__device__ __forceinline__ void gemm_stream(LAS char* lds, Prov& P, const int K) {
    typedef typename Prov::AL ALd; typedef typename Prov::BL BLd; typedef typename Prov::EP EPt;
    ALd al; BLd bl; EPt ep;
    if (!P.next(al, bl)) return;
    P.make_ep(ep);
    const int tid = threadIdx.x, lane = tid & 63, wid = __builtin_amdgcn_readfirstlane(tid >> 6);
    const int wr = wid >> 1, wc = wid & 1, fr = lane & 15, fq = lane >> 4;
    int nvalid_next = 256;
    bool wave_on = true;
    if constexpr (Prov::MASKED) { nvalid_next = __builtin_amdgcn_readfirstlane(P.rows_valid()); wave_on = wr * 64 < nvalid_next; }
    const char* abase = (const char*)al.wsbase;
    unsigned aoff[4];
    const int bk0 = tid >> 6;
    unsigned ldb4, boff;
    __amdgpu_buffer_rsrc_t rsb;
    const __amdgpu_buffer_rsrc_t rsa = __builtin_amdgcn_make_buffer_rsrc((void*)abase, 0, 0x7fffffff, 0x00020000);
#define SET_SRC(al_, bl_) do { \
        _Pragma("unroll") for (int j = 0; j < 4; ++j) aoff[j] = (unsigned)((const char*)((al_).row(32 * wid + 8 * j + (lane >> 3)) + ((lane & 7) ^ (lane >> 3)) * 8) - abase); \
        rsb = __builtin_amdgcn_make_buffer_rsrc((void*)(bl_).base, 0, 0x7fffffff, 0x00020000); \
        ldb4 = (unsigned)(bl_).ldb * 4u; boff = (unsigned)(bl_).coloff(4 * (tid & 63)) * 4u + (unsigned)(tid >> 6) * ldb4; } while (0)
    SET_SRC(al, bl);
    unsigned atile = 0u, btile = 0u;
    u32x4 ra[4]; float4 rb[8];
#define LD_CHUNK(c) do { if ((c) < 8) { const u32x4 t_ = __builtin_amdgcn_raw_buffer_load_b128(rsb, (int)boff, (int)(btile + (unsigned)(8 * ((c) & 7)) * ldb4), 0); rb[(c) & 7] = __builtin_bit_cast(float4, t_); } \
        else ra[(c) & 3] = __builtin_amdgcn_raw_buffer_load_b128(rsa, (int)aoff[(c) & 3], (int)atile, 0); } while (0)
#define WR_CHUNK(c, buf) do { if ((c) < 8) *(LAS u32x2*)(lds + (buf) * STAGE + A_ST + bw_off + ((((c) & 7) & 1) * 4 + (((c) & 7) >> 1) * 16) * B_RS) = (u32x2){pack2(rb[(c) & 7].x, rb[(c) & 7].y), pack2(rb[(c) & 7].z, rb[(c) & 7].w)}; \
        else *(LAS u32x4*)(lds + (buf) * STAGE + (4 * wid + ((c) & 3)) * 1024 + lane * 16) = ra[(c) & 3]; } while (0)
#define ADVANCE() do { atile += ALd::kstep; btile += 64u * ldb4; } while (0)
    f32x4 acc[4][8];
    const int nk = K / 64;
    const int a_off0 = (wr * 64 + fr) * 128 + ((fq ^ (fr & 7)) * 16);
    const int br_off = A_ST + (((fq & 1) * 4 + (fq >> 1) * 16 + ((lane & 15) >> 2)) * B_RS) + (wc * 128 + 4 * (lane & 3)) * 2;
    const int bw_off = ((bk0 & 3) + ((bk0 >> 2) << 3)) * B_RS + (tid & 63) * 8;
#pragma unroll
    for (int c = 0; c < 12; ++c) LD_CHUNK(c);
    ADVANCE();
#pragma unroll
    for (int c = 0; c < 12; ++c) { WR_CHUNK(c, 0); LD_CHUNK(c); }
    int ldt = 1;
    if (2 < nk) { ADVANCE(); ldt = 2; }
    __syncthreads();
    for (;;) {
#pragma unroll
        for (int m = 0; m < 4; ++m)
#pragma unroll
            for (int n = 0; n < 8; ++n) acc[m][n] = (f32x4){0.f, 0.f, 0.f, 0.f};
        bool has_next = false;
        if constexpr (Prov::MASKED) { if (!wave_on) {
            for (int kt = 0; kt < nk; ++kt) {
                if (kt == nk - 2) { ALd aln; BLd bln; has_next = P.next(aln, bln);
                    if (has_next) { SET_SRC(aln, bln); atile = 0u; btile = 0u; ldt = 0; nvalid_next = __builtin_amdgcn_readfirstlane(P.rows_valid()); } }
                const int buf = kt & 1;
#pragma unroll
                for (int st = 0; st < 12; ++st) { WR_CHUNK(st, buf ^ 1); LD_CHUNK(st); }
                if (ldt + 1 < nk) { ADVANCE(); ++ldt; }
                __syncthreads();
            }
        } }
        if (!Prov::MASKED || wave_on)
        for (int kt = 0; kt < nk; ++kt) {
            if constexpr (!Prov::SINGLE) { if (kt == nk - 2) { ALd aln; BLd bln; has_next = P.next(aln, bln);
                if (has_next) { SET_SRC(aln, bln); atile = 0u; btile = 0u; ldt = 0; if constexpr (Prov::MASKED) nvalid_next = __builtin_amdgcn_readfirstlane(P.rows_valid()); } } }
            const int buf = kt & 1;
            LAS char* sbase = lds + buf * STAGE;
            s16x8 af[4]; s16x4 tq[4][2];
#define RD_B(slot, st_) do { tq[slot][0] = __builtin_amdgcn_ds_read_tr16_b64_v4i16((LAS s16x4*)(sbase + br_off + ((st_) >> 3) * 32 * B_RS + ((st_) & 7) * 32)); \
                             tq[slot][1] = __builtin_amdgcn_ds_read_tr16_b64_v4i16((LAS s16x4*)(sbase + br_off + ((st_) >> 3) * 32 * B_RS + ((st_) & 7) * 32 + 8 * B_RS)); } while (0)
#pragma unroll
            for (int m = 0; m < 4; ++m) af[m] = *(const LAS s16x8*)(sbase + a_off0 + m * 16 * 128);
            RD_B(0, 0); RD_B(1, 1); RD_B(2, 2);
            __builtin_amdgcn_sched_barrier(0);
#pragma unroll
            for (int st = 0; st < 16; ++st) {
                const int n = st & 7;
                if (st + 3 < 16) RD_B((st + 3) & 3, st + 3);
                const s16x8 bfr = {tq[st & 3][0][0], tq[st & 3][0][1], tq[st & 3][0][2], tq[st & 3][0][3], tq[st & 3][1][0], tq[st & 3][1][1], tq[st & 3][1][2], tq[st & 3][1][3]};
#pragma unroll
                for (int m = 0; m < 4; ++m) acc[m][n] = __builtin_amdgcn_mfma_f32_16x16x32_bf16(bfr, af[m], acc[m][n], 0, 0, 0);
                if (st == 7) {
#pragma unroll
                    for (int m = 0; m < 4; ++m) af[m] = *(const LAS s16x8*)(sbase + (a_off0 ^ 64) + m * 16 * 128);
                }
                if (st < 12) { WR_CHUNK(st, buf ^ 1); LD_CHUNK(st); }
                if (st & 1) __builtin_amdgcn_sched_barrier(0);
            }
#undef RD_B
            if (ldt + 1 < nk) { ADVANCE(); ++ldt; }
            __syncthreads();
        }
        if (!Prov::MASKED || wave_on)
#pragma unroll
        for (int m = 0; m < 4; ++m) {
            const int r = wr * 64 + m * 16 + fr;
            if constexpr (PAIRED) {
                ep.pair4(r, wc * 64 + 4 * fq, acc[m]);
            } else if constexpr (EPt::ROW8) { ep.row8(r, wc * 128 + 4 * fq, acc[m]);
            } else {
#pragma unroll
                for (int n = 0; n < 8; ++n) ep(r, wc * 128 + n * 16 + 4 * fq, acc[m][n]);
            }
        }
        if (!has_next) break;
        P.make_ep(ep);
        if constexpr (Prov::MASKED) wave_on = wr * 64 < nvalid_next;
    }
#undef LD_CHUNK
#undef WR_CHUNK
#undef ADVANCE
#undef SET_SRC
}

template <class Maker> struct PatchProv {
    static constexpr bool SINGLE = false, MASKED = Maker::MASKED;
    __device__ __forceinline__ int rows_valid() const { return mk.rows_valid(cRT); }
    typedef typename Maker::AL AL; typedef typename Maker::BL BL; typedef typename Maker::EP EP;
    Maker mk; int nR, nC, npc, npatch, nlab, nsl, pidx, slot, slot0, nfull, rem;
    __device__ __forceinline__ void init(int nR_, int nC_, int G, int bid) { nR = nR_; nC = nC_; nlab = (G % 8 == 0) ? 8 : 1; nsl = G / nlab; npc = (nC + 7) >> 3; npatch = ((nR + 3) >> 2) * npc;
        nfull = npatch; rem = 0;
        if constexpr (MASKED) { const int r = npatch % nlab; if (r > 0 && 2 * r <= nlab) { nfull = npatch - r; rem = r; npatch = nfull + 2 * r; } }
        pidx = bid / nsl; slot0 = bid % nsl; slot = slot0; if (pidx >= nlab) { pidx = npatch; } }
    int cRT, cCT;
    __device__ __forceinline__ bool next(AL& al, BL& bl) {
        while (pidx < npatch) {
            int pp = pidx, hcode = 0;
            if (MASKED && pidx >= nfull) { const int hp = pidx - nfull; pp = nfull + hp % rem; hcode = 1 + hp / rem; }
            while (slot < 32) { const int RT = (pp / npc) * 4 + (slot >> 3), CT = (pp % npc) * 8 + (slot & 7); slot += nsl;
                if (RT < nR && CT < nC) { cRT = RT | (hcode << 16); cCT = CT; mk.make_src(cRT, CT, al, bl); return true; } }
            pidx += nlab; slot = slot0; }
        return false; }
    __device__ __forceinline__ void make_ep(EP& ep) const { mk.make_ep(cRT, cCT, ep); } };

constexpr int KV_RS = 144, KT_BYTES = 64 * KV_RS;
constexpr int ATT_IMP_OFF = 8 * KT_BYTES;
constexpr int ATT_MASK_OFF = ATT_IMP_OFF + 64 * 64 * 4;
typedef float f32x16 __attribute__((ext_vector_type(16)));
struct GState32 { f32x16 o[2]; float m, l, nref; };
__device__ __forceinline__ float xchg32(float x) { const unsigned u = __builtin_bit_cast(unsigned, x); const auto r = __builtin_amdgcn_permlane32_swap(u, u, false, false);
    return __builtin_bit_cast(float, (threadIdx.x & 32) ? r[0] : r[1]); }

template <int MODE>
__device__ __forceinline__ void attn_block32(const LAS char* kt, const LAS char* vt, const int lane, const s16x8 (&qf)[4], GState32& st,
                                             const bool act, const int key0, const int lo, const int hi, LAS float* imp, const int tl, float& carry, const int jb) {
    const int c32 = lane & 31, h = lane >> 5;
    f32x16 s[2];
    const float cval = (MODE == 0) ? (act ? st.nref : -INFINITY) : 0.f;
    const f32x16 cin = {cval, cval, cval, cval, cval, cval, cval, cval, cval, cval, cval, cval, cval, cval, cval, cval};
#pragma unroll
    for (int k2 = 0; k2 < 2; ++k2) {
        s16x8 kf[4];
#pragma unroll
        for (int ds = 0; ds < 4; ++ds) kf[ds] = *(const LAS s16x8*)(kt + (32 * k2 + c32) * KV_RS + (16 * ds + 8 * h) * 2);
        s[k2] = __builtin_amdgcn_mfma_f32_32x32x16_bf16(kf[0], qf[0], cin, 0, 0, 0);
#pragma unroll
        for (int ds = 1; ds < 4; ++ds) s[k2] = __builtin_amdgcn_mfma_f32_32x32x16_bf16(kf[ds], qf[ds], s[k2], 0, 0, 0);
    }
    const bool needmask = !__all((lo <= key0) & (hi >= key0 + 63));
    if (needmask) {
#pragma unroll
        for (int k2 = 0; k2 < 2; ++k2)
#pragma unroll
            for (int i = 0; i < 16; ++i) { const int key = key0 + 32 * k2 + 8 * (i >> 2) + 4 * h + (i & 3); s[k2][i] = (key >= lo && key <= hi) ? s[k2][i] : -INFINITY; }
    }
    float mx = -INFINITY;
#pragma unroll
    for (int k2 = 0; k2 < 2; ++k2)
#pragma unroll
        for (int i = 0; i < 16; ++i) mx = fmaxf(mx, s[k2][i]);
    if (MODE == 0) {
        mx = fmaxf(mx, xchg32(mx));
        const bool slow = (mx > 8.f) || (st.m == -INFINITY && mx != -INFINITY);
        if (__any(slow)) {
            const float mnew = fmaxf(st.m, mx - st.nref);
            const float alpha = (mnew == -INFINITY) ? 1.0f : __builtin_amdgcn_exp2f(st.m - mnew);
            const float d = (mnew == -INFINITY) ? 0.f : mnew + st.nref;
#pragma unroll
            for (int k2 = 0; k2 < 2; ++k2)
#pragma unroll
                for (int i = 0; i < 16; ++i) s[k2][i] -= d;
            st.o[0] *= alpha; st.o[1] *= alpha; st.l *= alpha;
            st.m = mnew; st.nref = (mnew == -INFINITY) ? 0.f : -mnew;
        }
        float rs = 0.f;
#pragma unroll
        for (int k2 = 0; k2 < 2; ++k2)
#pragma unroll
            for (int i = 0; i < 16; ++i) { const float pv = __builtin_amdgcn_exp2f(s[k2][i]); s[k2][i] = pv; rs += pv; }
        rs += xchg32(rs); st.l += rs;
    } else {
    mx = act ? mx : -INFINITY;
    float msafe, scale = 1.0f;
    if (MODE == 2) { msafe = (st.m == -INFINITY) ? 0.f : st.m; scale = st.l; }
    else {
        mx = fmaxf(mx, xchg32(mx));
        const float mnew = fmaxf(st.m, mx);
        const float alpha = (mnew == -INFINITY) ? 1.0f : __builtin_amdgcn_exp2f(st.m - mnew);
        msafe = (mnew == -INFINITY) ? 0.f : mnew;
        st.m = mnew; st.l *= alpha;
    }
    msafe = act ? msafe : INFINITY;
    float rs = 0.f;
#pragma unroll
    for (int k2 = 0; k2 < 2; ++k2)
#pragma unroll
        for (int i = 0; i < 16; ++i) { const float pv = (MODE == 2) ? __builtin_amdgcn_exp2f(s[k2][i] - msafe) * scale : __builtin_amdgcn_exp2f(s[k2][i] - msafe); s[k2][i] = pv; rs += pv; }
    if (MODE != 2) { rs += xchg32(rs); st.l += rs; }
    }
    if (MODE == 2) {
#pragma unroll
        for (int k2 = 0; k2 < 2; ++k2)
#pragma unroll
            for (int ig = 0; ig < 4; ++ig) {
                const float prevreg = ig > 0 ? s[k2][4 * (ig > 0 ? ig - 1 : 0) + 3] : (k2 > 0 ? s[0][15] : carry);
                const float recv = xchg32(h ? prevreg : s[k2][4 * ig + 3]);
                float part = 32.f * (s[k2][4 * ig] + s[k2][4 * ig + 1] + s[k2][4 * ig + 2]) + 16.f * s[k2][4 * ig + 3] + 16.f * recv;
                part += __shfl_xor(part, 1); part += __shfl_xor(part, 2);
                if ((c32 & 3) == 0) imp[tl * 64 + 16 * jb + 8 * k2 + 2 * ig + h] = part;
            }
        carry = s[1][15];
    }
    if (MODE != 1) {
        const int blk = (lane >> 4) & 1, q = (lane & 15) >> 2, p = lane & 3;
#pragma unroll
        for (int k2 = 0; k2 < 2; ++k2)
#pragma unroll
            for (int sk = 0; sk < 2; ++sk) {
                const u32x4 w = {pack2(s[k2][8 * sk + 0], s[k2][8 * sk + 1]), pack2(s[k2][8 * sk + 2], s[k2][8 * sk + 3]), pack2(s[k2][8 * sk + 4], s[k2][8 * sk + 5]), pack2(s[k2][8 * sk + 6], s[k2][8 * sk + 7])};
                const s16x8 pf = __builtin_bit_cast(s16x8, w);
#pragma unroll
                for (int dt = 0; dt < 2; ++dt) { const int base = 32 * k2 + 16 * sk;
                    const s16x4 t0 = __builtin_amdgcn_ds_read_tr16_b64_v4i16((LAS s16x4*)(vt + (base + 4 * h + q) * KV_RS + (32 * dt + 16 * blk + 4 * p) * 2));
                    const s16x4 t1 = __builtin_amdgcn_ds_read_tr16_b64_v4i16((LAS s16x4*)(vt + (base + 8 + 4 * h + q) * KV_RS + (32 * dt + 16 * blk + 4 * p) * 2));
                    const s16x8 vf = {t0[0], t0[1], t0[2], t0[3], t1[0], t1[1], t1[2], t1[3]};
                    st.o[dt] = __builtin_amdgcn_mfma_f32_32x32x16_bf16(vf, pf, st.o[dt], 0, 0, 0); }
            }
    }
}

#define ATT_GLOAD(Kg, Vg, stg) do { const size_t _o = ((size_t)(stg) * 128 + (tid >> 3)) * 256 + g * 64 + (tid & 7) * 8; rk0 = *(const u32x4*)((Kg) + _o); rv0 = *(const u32x4*)((Vg) + _o); \
        rk1 = *(const u32x4*)((Kg) + _o + 64 * 256); rv1 = *(const u32x4*)((Vg) + _o + 64 * 256); __builtin_amdgcn_sched_barrier(0); } while (0)
#define ATT_SWRITE(stg) do { LAS char* _k = lds + ((stg) & 1) * 4 * KT_BYTES + (tid >> 3) * KV_RS + (tid & 7) * 16; *(LAS u32x4*)_k = rk0; *(LAS u32x4*)(_k + KT_BYTES) = rv0; \
        *(LAS u32x4*)(_k + 2 * KT_BYTES) = rk1; *(LAS u32x4*)(_k + 3 * KT_BYTES) = rv1; } while (0)
#define ATT_RUN(MODE, Kg, Vg, jlo, jhi, COND, ACT) do { const int _s0 = (jlo) >> 1, _s1 = (jhi) >> 1; \
        ATT_GLOAD(Kg, Vg, _s0); ATT_SWRITE(_s0); __syncthreads(); \
        for (int _s = _s0; _s <= _s1; ++_s) { \
            if (_s + 1 <= _s1) ATT_GLOAD(Kg, Vg, _s + 1); \
            _Pragma("unroll") for (int _q = 0; _q < 2; ++_q) { const int j = 2 * _s + _q; \
                if (j >= (jlo) && j <= (jhi) && (COND)) { act = (ACT); \
                    const LAS char* _kt = lds + (_s & 1) * 4 * KT_BYTES + _q * 2 * KT_BYTES; \
                    attn_block32<MODE>(_kt, _kt + KT_BYTES, lane, qf, st, act, 64 * j, lo, hi, imp, tl, carry, j); } } \
            if (_s + 1 <= _s1) ATT_SWRITE(_s + 1); \
            __syncthreads(); } } while (0)

__device__ __forceinline__ void nsa_unit32(LAS char* lds, const int unit, const bf16_t* QB, const bf16_t* KS, const bf16_t* VS, const bf16_t* KW, const bf16_t* VW,
                                           const bf16_t* KCB, const bf16_t* VCB, const float* GATEp, bf16_t* MIX) {
    const int tid = threadIdx.x, lane = tid & 63, wid = tid >> 6, c32 = lane & 31, h = lane >> 5;
    const int qt = unit >> 3, b = (unit >> 2) & 1, g = unit & 3;
    const int t0 = qt * 64;
    LAS float* imp = (LAS float*)(lds + ATT_IMP_OFF);
    LAS unsigned* lmask = (LAS unsigned*)(lds + ATT_MASK_OFF);
    const int tl = 8 * wid + (c32 >> 2), tpos = t0 + tl, hq = g * 4 + (c32 & 3);
    const size_t tt = (size_t)b * SEQ + tpos;
    s16x8 qf[4]; float gate[3];
#pragma unroll
    for (int ds = 0; ds < 4; ++ds) qf[ds] = *(const s16x8*)(QB + tt * 1024 + hq * 64 + 16 * ds + 8 * h);
    { const float* gl = GATEp + tt * 48 + hq * 3; gate[0] = gl[0]; gate[1] = gl[1]; gate[2] = gl[2]; }
    for (int i = tid; i < 64 * 64; i += 512) imp[i] = 0.f;
    f32x16 res[2];
    GState32 st; bool act; int lo, hi; float carry = 0.f;
    u32x4 rk0, rv0, rk1, rv1;
    const bf16_t* KCg = KCB + (size_t)b * 256 * 256; const bf16_t* VCg = VCB + (size_t)b * 256 * 256;
    const bf16_t* KSg = KS + (size_t)b * SEQ * 256; const bf16_t* VSg = VS + (size_t)b * SEQ * 256;
    const bf16_t* KWg = KW + (size_t)b * SEQ * 256; const bf16_t* VWg = VW + (size_t)b * SEQ * 256;
#define ST_RESET() do { st.m = -INFINITY; st.l = 0.f; st.nref = 0.f; _Pragma("unroll") for (int i_ = 0; i_ < 16; ++i_) { st.o[0][i_] = 0.f; st.o[1][i_] = 0.f; } } while (0)
    const int cmax_u = (t0 + 63 - 31) >> 4;
    const int ncb = cmax_u < 0 ? 0 : min(4, (cmax_u + 1) / 64 + 1);
    act = true; lo = 0; hi = tpos >= 31 ? ((tpos - 31) >> 4) : -1; ST_RESET();
    __syncthreads();
    if (ncb > 0) {
        ATT_RUN(1, KCg, VCg, 0, ncb - 1, true, true);
        st.l = st.l > 0.f ? 1.0f / st.l : 0.f;
        ATT_RUN(2, KCg, VCg, 0, ncb - 1, true, true);
    }
    res[0] = st.o[0] * gate[0]; res[1] = st.o[1] * gate[0];
    __syncthreads();
    for (int k = 0; k < 8; ++k) {
        const int tk = 8 * wid + k, j = lane;
        const float iv = imp[tk * 64 + j];
        const bool forced = (j == 0) || (j == qt) || (j == qt - 1), valid = j <= qt;
        const float sc = forced ? 1.0e4f : (valid ? iv : -1.0e4f);
        const unsigned ub = __float_as_uint(sc + 0.0f), key = (ub & 0x80000000u) ? ~ub : (ub | 0x80000000u);
        const unsigned long long K = ((unsigned long long)key << 32) | (unsigned)(63 - j);
        int rank = 0;
#pragma unroll
        for (int kk = 0; kk < 64; ++kk) { const unsigned long long O = ((unsigned long long)(unsigned)__builtin_amdgcn_readlane((int)key, kk) << 32) | (unsigned)(63 - kk); rank += (O > K) ? 1 : 0; }
        const unsigned long long m64 = __ballot(rank < 16 && valid);
        if (lane == 0) { lmask[tk * 2] = (unsigned)m64; lmask[tk * 2 + 1] = (unsigned)(m64 >> 32); }
    }
    __syncthreads();
    const unsigned long long msk = (unsigned long long)lmask[tl * 2] | ((unsigned long long)lmask[tl * 2 + 1] << 32);
    unsigned long long wunion;
    { unsigned ul = (unsigned)msk, uh = (unsigned)(msk >> 32);
#pragma unroll
      for (int o = 1; o < 64; o <<= 1) { ul |= __shfl_xor(ul, o); uh |= __shfl_xor(uh, o); }
      wunion = (unsigned long long)ul | ((unsigned long long)uh << 32); }
    lo = 0; hi = tpos; ST_RESET();
    ATT_RUN(0, KSg, VSg, 0, qt, (wunion >> j) & 1ull, (msk >> j) & 1ull);
    { const float il = gate[1] / fmaxf(st.l, 1e-30f); res[0] += st.o[0] * il; res[1] += st.o[1] * il; }
    act = true; lo = tpos - 511; hi = tpos; ST_RESET();
    const int jw0 = qt >= 8 ? qt - 8 : 0;
    ATT_RUN(0, KWg, VWg, jw0, qt, true, true);
    { const float il = gate[2] / fmaxf(st.l, 1e-30f);
      bf16_t* mp = MIX + tt * 2048 + 1024 + hq * 64 + 4 * h;
#pragma unroll
      for (int dt = 0; dt < 2; ++dt)
#pragma unroll
          for (int ig = 0; ig < 4; ++ig) { const int i0 = 4 * ig;
              const float r0 = res[dt][i0] + st.o[dt][i0] * il, r1 = res[dt][i0 + 1] + st.o[dt][i0 + 1] * il, r2 = res[dt][i0 + 2] + st.o[dt][i0 + 2] * il, r3 = res[dt][i0 + 3] + st.o[dt][i0 + 3] * il;
              *(uint2*)(mp + 32 * dt + 8 * ig) = make_uint2(pack2(r0, r1), pack2(r2, r3)); } }
#undef ST_RESET
}
#undef ATT_GLOAD
#undef ATT_SWRITE
#undef ATT_RUN


constexpr int SX_RS = 144, SX_H = 128 * SX_RS, SB_RS = 272, SB_BYTES = 128 * SB_RS;
constexpr int SSD_X_OFF = 0, SSD_B_OFF = 4 * SX_H, SSD_C_OFF = SSD_B_OFF + SB_BYTES, SSD_T_OFF = SSD_C_OFF + SB_BYTES;
static_assert(SSD_T_OFF + 4096 <= SSD_LDS, "ssd lds");

__device__ __forceinline__ u32x4 conv8_silu(const u32x4 (&tap)[4], const float* cw, const float* cb, const int chan, const int spos) {
    float acc[8];
    { const f32x4 b0 = *(const f32x4*)(cb + chan), b1 = *(const f32x4*)(cb + chan + 4); acc[0] = b0[0]; acc[1] = b0[1]; acc[2] = b0[2]; acc[3] = b0[3]; acc[4] = b1[0]; acc[5] = b1[1]; acc[6] = b1[2]; acc[7] = b1[3]; }
#pragma unroll
    for (int k = 0; k < 4; ++k) {
        const f32x4 w0 = *(const f32x4*)(cw + k * 2048 + chan), w1 = *(const f32x4*)(cw + k * 2048 + chan + 4);
        const float m = (spos - 3 + k >= 0) ? 1.0f : 0.0f;
#pragma unroll
        for (int e = 0; e < 4; ++e) { acc[2 * e] += m * (e < 2 ? w0[2 * e] : w1[2 * e - 4]) * __uint_as_float(tap[k][e] << 16); acc[2 * e + 1] += m * (e < 2 ? w0[2 * e + 1] : w1[2 * e - 3]) * __uint_as_float(tap[k][e] & 0xffff0000u); }
    }
    u32x4 o;
#pragma unroll
    for (int e = 0; e < 4; ++e) o[e] = pack2(acc[2 * e] * sigmoidf_(acc[2 * e]), acc[2 * e + 1] * sigmoidf_(acc[2 * e + 1]));
    return o;
}

template <bool WITH_C>
__device__ __forceinline__ void ssd_stage(LAS char* lds, const bf16_t* XBCR_, const float* cw, const float* cb, const float* DT, const float* a_log, const int b, const int c, const int grp) {
    const int tid = threadIdx.x;
    const size_t tt0 = (size_t)b * SEQ + c * 128;
    const int s0 = c * 128;
#define TAP_PTR(l_, k_, chan_) (XBCR_ + (size_t)((long)(tt0 + (l_)) - 3 + (k_) < 0 ? 0 : (long)(tt0 + (l_)) - 3 + (k_)) * 2048 + (chan_))
#pragma unroll 1
    for (int half = 0; half < 2; ++half) {
        u32x4 tp[4][4];
#pragma unroll
        for (int k4 = 0; k4 < 4; ++k4) { const int id = tid + 512 * (4 * half + k4), l = id >> 5, ch = id & 31;
#pragma unroll
            for (int k = 0; k < 4; ++k) tp[k4][k] = *(const u32x4*)TAP_PTR(l, k, grp * 256 + ch * 8); }
#pragma unroll
        for (int k4 = 0; k4 < 4; ++k4) { const int id = tid + 512 * (4 * half + k4), l = id >> 5, ch = id & 31, h = ch >> 3, pc = ch & 7;
            *(LAS u32x4*)(lds + SSD_X_OFF + h * SX_H + l * SX_RS + pc * 16) = conv8_silu(tp[k4], cw, cb, grp * 256 + ch * 8, s0 + l); }
    }
    {
        u32x4 tp[4][4];
#pragma unroll
        for (int k4 = 0; k4 < 4; ++k4) { const int id = tid + 512 * k4, l = id >> 4, ch = id & 15;
#pragma unroll
            for (int k = 0; k < 4; ++k) tp[k4][k] = *(const u32x4*)TAP_PTR(l, k, 1024 + grp * 128 + ch * 8); }
#pragma unroll
        for (int k4 = 0; k4 < 4; ++k4) { const int id = tid + 512 * k4, l = id >> 4, ch = id & 15;
            *(LAS u32x4*)(lds + SSD_B_OFF + l * SB_RS + ch * 16) = conv8_silu(tp[k4], cw, cb, 1024 + grp * 128 + ch * 8, s0 + l); }
    }
    if (WITH_C) {
        u32x4 tp[4][4];
#pragma unroll
        for (int k4 = 0; k4 < 4; ++k4) { const int id = tid + 512 * k4, l = id >> 4, ch = id & 15;
#pragma unroll
            for (int k = 0; k < 4; ++k) tp[k4][k] = *(const u32x4*)TAP_PTR(l, k, 1536 + grp * 128 + ch * 8); }
#pragma unroll
        for (int k4 = 0; k4 < 4; ++k4) { const int id = tid + 512 * k4, l = id >> 4, ch = id & 15;
            *(LAS u32x4*)(lds + SSD_C_OFF + l * SB_RS + ch * 16) = conv8_silu(tp[k4], cw, cb, 1536 + grp * 128 + ch * 8, s0 + l); }
    }
#undef TAP_PTR
    LAS float* dtl = (LAS float*)(lds + SSD_T_OFF); LAS float* acs = dtl + 512;
    const int h = tid >> 7, l = tid & 127;
    const float av = -expf(a_log[grp * 4 + h]);
    const float dtv = DT[(tt0 + l) * 16 + grp * 4 + h];
    float cs = dtv * av;
    const int lane = tid & 63, wid = tid >> 6;
#pragma unroll
    for (int o = 1; o < 64; o <<= 1) { const float t = __shfl_up(cs, o); cs += (lane >= o) ? t : 0.f; }
    LAS float* wtot = (LAS float*)(lds + MAIN_LDS + 32);
    if (lane == 63) wtot[wid] = cs;
    __syncthreads();
    if (wid & 1) cs += wtot[wid - 1];
    dtl[tid] = dtv; acs[tid] = cs;
    __syncthreads();
}

__device__ __forceinline__ void ssd_states_item(LAS char* lds, const int item, const bf16_t* XBCB, const float* cw, const float* cb, const float* DT, const float* a_log, float* STATES, float* CHDEC) {
    const int tid = threadIdx.x, lane = tid & 63, wid = tid >> 6, c16 = lane & 15, fq = lane >> 4, q = c16 >> 2, pp = c16 & 3;
    const int grp = item & 3, c = (item >> 2) & 31, b = item >> 7;
    __syncthreads();
    ssd_stage<false>(lds, XBCB, cw, cb, DT, a_log, b, c, grp);
    LAS float* dtl = (LAS float*)(lds + SSD_T_OFF); LAS float* acs = dtl + 512;
#pragma unroll
    for (int k = 0; k < 8; ++k) { const int id = tid + 512 * k, l = id >> 5, ch = id & 31, h = ch >> 3, pc = ch & 7;
        const float w = __expf(acs[h * 128 + 127] - acs[h * 128 + l]) * dtl[h * 128 + l];
        LAS u32x4* pv = (LAS u32x4*)(lds + SSD_X_OFF + h * SX_H + l * SX_RS + pc * 16);
        u32x4 v = *pv;
#pragma unroll
        for (int e = 0; e < 4; ++e) { const float lo = __uint_as_float(v[e] << 16) * w, hi = __uint_as_float(v[e] & 0xffff0000u) * w; v[e] = pack2(lo, hi); }
        *pv = v; }
    if (tid < 4) CHDEC[((size_t)b * 32 + c) * 16 + grp * 4 + tid] = __expf(acs[tid * 128 + 127]);
    __syncthreads();
    s16x8 af[4];
#pragma unroll
    for (int ks = 0; ks < 4; ++ks) {
        const s16x4 t0 = __builtin_amdgcn_ds_read_tr16_b64_v4i16((LAS s16x4*)(lds + SSD_B_OFF + (32 * ks + 8 * fq + q) * SB_RS + (16 * wid + 4 * pp) * 2));
        const s16x4 t1 = __builtin_amdgcn_ds_read_tr16_b64_v4i16((LAS s16x4*)(lds + SSD_B_OFF + (32 * ks + 8 * fq + 4 + q) * SB_RS + (16 * wid + 4 * pp) * 2));
        af[ks] = (s16x8){t0[0], t0[1], t0[2], t0[3], t1[0], t1[1], t1[2], t1[3]};
    }
#pragma unroll
    for (int h = 0; h < 4; ++h) {
        float* sp = STATES + (((size_t)b * 32 + c) * 16 + grp * 4 + h) * 8192;
#pragma unroll
        for (int pt = 0; pt < 4; ++pt) {
            f32x4 acc = {0.f, 0.f, 0.f, 0.f};
#pragma unroll
            for (int ks = 0; ks < 4; ++ks) {
                const s16x4 t0 = __builtin_amdgcn_ds_read_tr16_b64_v4i16((LAS s16x4*)(lds + SSD_X_OFF + h * SX_H + (32 * ks + 8 * fq + q) * SX_RS + (16 * pt + 4 * pp) * 2));
                const s16x4 t1 = __builtin_amdgcn_ds_read_tr16_b64_v4i16((LAS s16x4*)(lds + SSD_X_OFF + h * SX_H + (32 * ks + 8 * fq + 4 + q) * SX_RS + (16 * pt + 4 * pp) * 2));
                const s16x8 bfr = {t0[0], t0[1], t0[2], t0[3], t1[0], t1[1], t1[2], t1[3]};
                acc = __builtin_amdgcn_mfma_f32_16x16x32_bf16(af[ks], bfr, acc, 0, 0, 0);
            }
            *(f32x4*)(sp + (size_t)(16 * pt + c16) * 128 + 16 * wid + 4 * fq) = acc;
        }
    }
}

__device__ __forceinline__ void ssd_out_item(LAS char* lds, const int item, const bf16_t* XBCB, const float* cw, const float* cb, const float* DT, const float* a_log, const float* d_skip, const float* nw,
                                             const bf16_t* PREV, const bf16_t* ZBp, float* YTMP, bf16_t* MIXO) {
    const int tid = threadIdx.x, lane = tid & 63, wid = tid >> 6, c16 = lane & 15, fq = lane >> 4, q = c16 >> 2, pp = c16 & 3;
    const int grp = item & 3, c = (item >> 2) & 31, b = item >> 7;
    __syncthreads();
    ssd_stage<true>(lds, XBCB, cw, cb, DT, a_log, b, c, grp);
    LAS float* dtl = (LAS float*)(lds + SSD_T_OFF); LAS float* acs = dtl + 512;
    const int lcol = 16 * wid + c16;
    const size_t tt = (size_t)b * SEQ + c * 128 + lcol;
    s16x8 cf[4];
#pragma unroll
    for (int ks = 0; ks < 4; ++ks) cf[ks] = *(const LAS s16x8*)(lds + SSD_C_OFF + lcol * SB_RS + (32 * ks + 8 * fq) * 2);
    f32x4 g[8];
#pragma unroll
    for (int mt = 0; mt < 8; ++mt) { g[mt] = (f32x4){0.f, 0.f, 0.f, 0.f};
        if (mt <= wid) {
#pragma unroll
            for (int ks = 0; ks < 4; ++ks) { const s16x8 bfr = *(const LAS s16x8*)(lds + SSD_B_OFF + (16 * mt + c16) * SB_RS + (32 * ks + 8 * fq) * 2);
                g[mt] = __builtin_amdgcn_mfma_f32_16x16x32_bf16(bfr, cf[ks], g[mt], 0, 0, 0); } } }
    const bf16_t* prev0 = PREV + (((size_t)b * 32 + c) * 16 + grp * 4) * 8192;
    const int prow = tid >> 3, pch = tid & 7;
    u32x4 rp0, rp1; uint2 zr[4];
#define PREV_LOAD(h_) do { const bf16_t* _p = prev0 + (size_t)(h_) * 8192 + prow * 128 + pch * 16; rp0 = *(const u32x4*)_p; rp1 = *(const u32x4*)(_p + 8); } while (0)
#define PREV_WRITE(h_) do { LAS char* _d = lds + SSD_B_OFF + ((h_) & 1) * 64 * SB_RS + prow * SB_RS + pch * 32; *(LAS u32x4*)_d = rp0; *(LAS u32x4*)(_d + 16) = rp1; } while (0)
#define Z_LOAD(h_) do { _Pragma("unroll") for (int pt = 0; pt < 4; ++pt) zr[pt] = *(const uint2*)(ZBp + tt * 1024 + (grp * 4 + (h_)) * 64 + 16 * pt + 4 * fq); } while (0)
    PREV_LOAD(0); Z_LOAD(0);
    __syncthreads();
    PREV_WRITE(0); PREV_LOAD(1);
    __syncthreads();
    float ss = 0.f;
#pragma unroll 1
    for (int h = 0; h < 4; ++h) {
        const int hh = grp * 4 + h;
        const float acs_l = acs[h * 128 + lcol];
        s16x8 pf[4];
#pragma unroll
        for (int ks = 0; ks < 4; ++ks) {
            float pv[2][4];
#pragma unroll
            for (int u = 0; u < 2; ++u) {
                const int s0 = 32 * ks + 16 * u + 4 * fq;
                const f32x4 av4 = *(const LAS f32x4*)(acs + h * 128 + s0), dv4 = *(const LAS f32x4*)(dtl + h * 128 + s0);
#pragma unroll
                for (int i = 0; i < 4; ++i) { const float e = __expf(fminf(acs_l - av4[i], 0.f)) * dv4[i]; pv[u][i] = (s0 + i <= lcol) ? g[2 * ks + u][i] * e : 0.f; }
            }
            const u32x4 w = {pack2(pv[0][0], pv[0][1]), pack2(pv[0][2], pv[0][3]), pack2(pv[1][0], pv[1][1]), pack2(pv[1][2], pv[1][3])};
            pf[ks] = __builtin_bit_cast(s16x8, w);
        }
        const float dsk = d_skip[hh], eal = __expf(acs_l);
        f32x4 zz[4];
#pragma unroll
        for (int pt = 0; pt < 4; ++pt) zz[pt] = (f32x4){__uint_as_float(zr[pt].x << 16), __uint_as_float(zr[pt].x & 0xffff0000u), __uint_as_float(zr[pt].y << 16), __uint_as_float(zr[pt].y & 0xffff0000u)};
        if (h + 1 < 4) Z_LOAD(h + 1);
        const LAS char* pbuf = lds + SSD_B_OFF + (h & 1) * 64 * SB_RS;
#pragma unroll
        for (int pt = 0; pt < 4; ++pt) {
            f32x4 yd = {0.f, 0.f, 0.f, 0.f}, yo = {0.f, 0.f, 0.f, 0.f};
#pragma unroll
            for (int ks = 0; ks < 4; ++ks) {
                const s16x4 t0 = __builtin_amdgcn_ds_read_tr16_b64_v4i16((LAS s16x4*)(lds + SSD_X_OFF + h * SX_H + (32 * ks + 4 * fq + q) * SX_RS + (16 * pt + 4 * pp) * 2));
                const s16x4 t1 = __builtin_amdgcn_ds_read_tr16_b64_v4i16((LAS s16x4*)(lds + SSD_X_OFF + h * SX_H + (32 * ks + 16 + 4 * fq + q) * SX_RS + (16 * pt + 4 * pp) * 2));
                const s16x8 xf = {t0[0], t0[1], t0[2], t0[3], t1[0], t1[1], t1[2], t1[3]};
                const s16x8 prf = *(const LAS s16x8*)(pbuf + (16 * pt + c16) * SB_RS + (32 * ks + 8 * fq) * 2);
                yd = __builtin_amdgcn_mfma_f32_16x16x32_bf16(xf, pf[ks], yd, 0, 0, 0);
                yo = __builtin_amdgcn_mfma_f32_16x16x32_bf16(prf, cf[ks], yo, 0, 0, 0);
            }
            const u32x2 xr = *(const LAS u32x2*)(lds + SSD_X_OFF + h * SX_H + lcol * SX_RS + (16 * pt + 4 * fq) * 2);
            const float xv[4] = {__uint_as_float(xr[0] << 16), __uint_as_float(xr[0] & 0xffff0000u), __uint_as_float(xr[1] << 16), __uint_as_float(xr[1] & 0xffff0000u)};
            const f32x4 z = zz[pt];
            f32x4 gvv;
#pragma unroll
            for (int i = 0; i < 4; ++i) { const float y = yd[i] + eal * yo[i] + dsk * xv[i]; gvv[i] = y * z[i] * sigmoidf_(z[i]); ss += gvv[i] * gvv[i]; }
            *(f32x4*)(YTMP + tt * 1024 + hh * 64 + 16 * pt + 4 * fq) = gvv;
        }
        if (h + 1 < 4) { PREV_WRITE(h + 1); if (h + 2 < 4) PREV_LOAD(h + 2); __syncthreads(); }
    }
#undef PREV_LOAD
#undef PREV_WRITE
#undef Z_LOAD
    ss += __shfl_xor(ss, 16); ss += __shfl_xor(ss, 32);
    const float rs = rsqrtf(ss * (1.0f / 256.f) + NORM_EPS);
    f32x4 gq[4][4], wq[4][4];
#pragma unroll
    for (int h = 0; h < 4; ++h)
#pragma unroll
        for (int pt = 0; pt < 4; ++pt) { const int ch = (grp * 4 + h) * 64 + 16 * pt + 4 * fq; wq[h][pt] = *(const f32x4*)(nw + ch); gq[h][pt] = *(const f32x4*)(YTMP + tt * 1024 + ch); }
#pragma unroll
    for (int h = 0; h < 4; ++h)
#pragma unroll
        for (int pt = 0; pt < 4; ++pt) { const int ch = (grp * 4 + h) * 64 + 16 * pt + 4 * fq; const f32x4 gv = gq[h][pt], w4 = wq[h][pt];
            *(uint2*)(MIXO + tt * 2048 + ch) = make_uint2(pack2(gv[0] * rs * w4[0], gv[1] * rs * w4[1]), pack2(gv[2] * rs * w4[2], gv[3] * rs * w4[3])); }
}

struct Args {
    const float* in[23];
    float* out;
    unsigned char* ws;
    int ph_lo, ph_hi;
};

enum { PH_NORM1 = 0, PH_INPROJ, PH_SSD_CMP1, PH_GNORM_CMP2,
       PH_NSA,
       PH_OUTPROJ, PH_ROUTER, PH_SCATTER, PH_GATEUP, PH_DOWN, PH_FINAL, N_PHASES };

struct ARowsDense { static constexpr unsigned kstep = 128u; const bf16_t* base; size_t ld; int row0, nrows; const bf16_t* zrow; const void* wsbase;
    __device__ __forceinline__ const bf16_t* row(int r) const { const int g = row0 + r; return g < nrows ? base + (size_t)g * ld : zrow; } };
struct ARowsGather { static constexpr unsigned kstep = 128u; const bf16_t* base; size_t ld; const int* idx; const bf16_t* zrow; const void* wsbase; int nr;
    __device__ __forceinline__ const bf16_t* row(int r) const { const int g = r < nr ? idx[r] : -1; return g >= 0 ? base + (size_t)g * ld : zrow; } };
struct ARowsWindow { static constexpr unsigned kstep = 512u; const bf16_t* base; int row0; const bf16_t* zrow; const void* wsbase;
    __device__ __forceinline__ const bf16_t* row(int r) const { const int gr = row0 + r; if (gr >= CMP_ROWS) return zrow; const int g = gr & 3, n = (gr >> 2) % N_C, b = (gr >> 2) / N_C;
        return base + ((size_t)(b * SEQ + 16 * n)) * 256 + g * 64; } };
struct BColsDense { const float* base; int ldb; int col0, ncols;
    __device__ __forceinline__ int coloff(int n) const { const int c = col0 + n; return c < ncols ? c : ncols - 4; } };
struct BColsGateUp { const float* base; int ldb; int cn;
    __device__ __forceinline__ int coloff(int n) const { const int wc = n >> 7, nt = (n & 127) >> 4, w = n & 15; const int j = wc * 64 + (nt & 3) * 16 + w;
        return (nt < 4 ? 0 : DFF) + cn * 128 + j; } };

struct EpiStoreF32 { static constexpr bool ROW8 = false; float* C; size_t ldc; int row0, col0, ncols;
    __device__ __forceinline__ void operator()(int r, int n, f32x4 v) const { const int c = col0 + n; if (c < ncols) *(f32x4*)(C + (size_t)(row0 + r) * ldc + c) = v; } };
struct EpiResidF32 { static constexpr bool ROW8 = true; float* C; const float* X; size_t ldc; int row0, col0;
    __device__ __forceinline__ void row8(int r, int n0, const f32x4 (&v)[8]) const { const size_t o = (size_t)(row0 + r) * ldc + col0 + n0; f32x4 x[8];
#pragma unroll
        for (int n = 0; n < 8; ++n) x[n] = *(const f32x4*)(X + o + 16 * n);
#pragma unroll
        for (int n = 0; n < 8; ++n) *(f32x4*)(C + o + 16 * n) = v[n] + x[n]; } };
struct EpiSwiglu { static constexpr bool ROW8 = false; bf16_t* O; const float* bias; int row0, cn;
    __device__ __forceinline__ void pair4(int r, int j0, const f32x4 (&a)[8]) const { const int c0 = cn * 128 + j0; f32x4 bg[4], bu[4];
#pragma unroll
        for (int n = 0; n < 4; ++n) { bg[n] = *(const f32x4*)(bias + c0 + 16 * n); bu[n] = *(const f32x4*)(bias + DFF + c0 + 16 * n); }
#pragma unroll
        for (int n = 0; n < 4; ++n) { float o[4];
#pragma unroll
            for (int i = 0; i < 4; ++i) { float gv = a[n][i] + bg[n][i]; float uv = a[n + 4][i] + bu[n][i]; gv = fminf(gv, 7.0f); uv = fminf(fmaxf(uv, -7.0f), 7.0f);
                const float glu = gv * sigmoidf_(1.702f * gv); o[i] = (uv + 1.0f) * glu; }
            *(uint2*)(O + (size_t)(row0 + r) * DFF + c0 + 16 * n) = make_uint2(pack2(o[0], o[1]), pack2(o[2], o[3])); } } };
struct EpiBiasBf16 { static constexpr bool ROW8 = true; bf16_t* O; const float* bias; int row0, col0;
    __device__ __forceinline__ void row8(int r, int n0, const f32x4 (&v)[8]) const { const int c = col0 + n0; f32x4 bz[8];
#pragma unroll
        for (int n = 0; n < 8; ++n) bz[n] = *(const f32x4*)(bias + c + 16 * n);
#pragma unroll
        for (int n = 0; n < 8; ++n) { const f32x4 t = v[n] + bz[n]; *(uint2*)(O + (size_t)(row0 + r) * D + c + 16 * n) = make_uint2(pack2(t[0], t[1]), pack2(t[2], t[3])); } } };


struct EpiInProj { static constexpr bool ROW8 = false; unsigned char* ws; const float* dt_bias; int row0, col0;
    __device__ __forceinline__ void operator()(int r, int n, f32x4 v) const {
        const int cb = __builtin_amdgcn_readfirstlane((col0 + n) & ~15);
        const int ci = (col0 + n) & 15;
        const size_t R = (size_t)(row0 + r); const int pos = (int)(R & (SEQ - 1));
        if (cb >= IN_PROJ) return;
        if (cb >= OFF_DT && cb < OFF_Q) { f32x4 o;
#pragma unroll
            for (int i = 0; i < 4; ++i) { const float x = v[i] + dt_bias[ci + i]; o[i] = x > 20.f ? x : log1pf(expf(x)); }
            *(f32x4*)((float*)(ws + WS_DT) + R * 16 + ci) = o; return; }
        if (cb >= OFF_GATE) { f32x4 o;
#pragma unroll
            for (int i = 0; i < 4; ++i) o[i] = sigmoidf_(v[i]);
            *(f32x4*)((float*)(ws + WS_GATE) + R * 48 + (cb - OFF_GATE) + ci) = o; return; }
        size_t boff; int ld, cc; bool rp = false; float scl = 1.0f;
        if (cb < OFF_XBC) { boff = WS_ZB; ld = 1024; cc = cb; }
        else if (cb < OFF_DT) { boff = WS_XBCR; ld = 2048; cc = cb - OFF_XBC; }
        else if (cb < OFF_KCMP) { boff = WS_QB; ld = 1024; cc = cb - OFF_Q; rp = true; scl = 0.125f * 1.4426950408889634f; }
        else if (cb < OFF_VCMP) { boff = WS_KCMP; ld = 256; cc = cb - OFF_KCMP; }
        else if (cb < OFF_KSLC) { boff = WS_VCMP; ld = 256; cc = cb - OFF_VCMP; }
        else if (cb < OFF_VSLC) { boff = WS_KS; ld = 256; cc = cb - OFF_KSLC; rp = true; }
        else if (cb < OFF_KWIN) { boff = WS_VS; ld = 256; cc = cb - OFF_VSLC; }
        else if (cb < OFF_VWIN) { boff = WS_KW; ld = 256; cc = cb - OFF_KWIN; rp = true; }
        else { boff = WS_VW; ld = 256; cc = cb - OFF_VWIN; }
        f32x4 o = v;
        if (rp && (cc & 63) == 0) {
            const float* rope = (const float*)(ws + WS_ROPE);
#pragma unroll
            for (int i = 0; i < 4; ++i) { const float pr = xchg32(v[i]); const int k = (ci & 7) + i; const float c = rope[pos * 8 + k], sn = rope[SEQ * 8 + pos * 8 + k];
                o[i] = (ci < 8) ? (v[i] * c - pr * sn) : (pr * sn + v[i] * c); }
        }
        *(uint2*)((bf16_t*)(ws + boff) + R * ld + cc + ci) = make_uint2(pack2(o[0] * scl, o[1] * scl), pack2(o[2] * scl, o[3] * scl));
    } };


__device__ __forceinline__ const bf16_t* zrow_of(unsigned char* ws) { return (const bf16_t*)((unsigned*)(ws + WS_CTL) + CW_ZROW); }
struct MkInProj { static constexpr bool MASKED = false; __device__ __forceinline__ int rows_valid(int) const { return 256; } typedef ARowsDense AL; typedef BColsDense BL; typedef EpiInProj EP; unsigned char* ws; const float* w; const float* dt_bias;
    __device__ __forceinline__ void make_src(int rt, int ct, AL& al, BL& bl) const { al = AL{(const bf16_t*)(ws + WS_XN), (size_t)D, rt * 256, T, zrow_of(ws), ws}; bl = BL{w, IN_PROJ, ct * 256, IN_PROJ}; }
    __device__ __forceinline__ void make_ep(int rt, int ct, EP& ep) const { ep = EP{ws, dt_bias, rt * 256, ct * 256}; } };
struct MkOutProj { static constexpr bool MASKED = false; __device__ __forceinline__ int rows_valid(int) const { return 256; } typedef ARowsDense AL; typedef BColsDense BL; typedef EpiResidF32 EP; unsigned char* ws; const float* w; const float* x;
    __device__ __forceinline__ void make_src(int rt, int ct, AL& al, BL& bl) const { al = AL{(const bf16_t*)(ws + WS_MIX), (size_t)2048, rt * 256, T, zrow_of(ws), ws}; bl = BL{w, D, ct * 256, D}; }
    __device__ __forceinline__ void make_ep(int rt, int ct, EP& ep) const { ep = EP{(float*)(ws + WS_X2), x, (size_t)D, rt * 256, ct * 256}; } };
constexpr int TT_OFF = GEMM_LDS;
__device__ __forceinline__ int moe_tile_table(LAS char* lds, const unsigned* cnt) {
    LAS int* tt = (LAS int*)(lds + TT_OFF); LAS int* tmp = tt + 480;
    const int tid = threadIdx.x;
    int ntiles = 0;
    for (int k = 0; k < NE; ++k) ntiles += (int)((cnt[k] + 255u) >> 8);
    if (tid < ntiles) { int e = 0, acc = 0, first = 0;
        for (int k = 0; k < NE; ++k) { const int nt = (int)((cnt[k] + 255u) >> 8); if (tid >= acc && tid < acc + nt) { e = k; first = acc; } acc += nt; }
        const int v = min(256, (int)cnt[e] - 256 * (tid - first));
        tmp[tid] = e; tmp[160 + tid] = v; }
    __syncthreads();
    if (tid < ntiles) { int nheavy = 0, hb = 0, lb = 0; const bool heavy = tmp[160 + tid] > 128;
        for (int k = 0; k < ntiles; ++k) { const bool hk = tmp[160 + k] > 128; nheavy += hk ? 1 : 0; if (k < tid) { hb += hk ? 1 : 0; lb += hk ? 0 : 1; } }
        const int slot = tid; (void)heavy; (void)hb; (void)lb; (void)nheavy;
        tt[slot] = tid; tt[160 + slot] = tmp[tid]; tt[320 + slot] = tmp[160 + tid]; }
    __syncthreads();
    return ntiles; }
__device__ __forceinline__ int moe_rows_valid(const LAS int* tt, int rtc) { const int v = tt[320 + (rtc & 0xffff)], hc = rtc >> 16; return hc == 0 ? v : min(128, max(0, v - (hc == 2 ? 128 : 0))); }
struct MkGateUp { static constexpr bool MASKED = true; typedef ARowsGather AL; typedef BColsGateUp BL; typedef EpiSwiglu EP; unsigned char* ws; const float* w; const float* bias; const LAS int* tt;
    __device__ __forceinline__ int rows_valid(int rtc) const { return moe_rows_valid(tt, rtc); }
    __device__ __forceinline__ void make_src(int rtc, int cn, AL& al, BL& bl) const { const int rt = rtc & 0xffff, hc = rtc >> 16, tile = __builtin_amdgcn_readfirstlane(tt[rt]), e = __builtin_amdgcn_readfirstlane(tt[160 + rt]);
        al = AL{(const bf16_t*)(ws + WS_XN), (size_t)D, (const int*)(ws + WS_ROWTOK) + tile * 256 + (hc == 2 ? 128 : 0), zrow_of(ws), ws, hc ? 128 : 256}; bl = BL{w + (size_t)e * D * 2 * DFF, 2 * DFF, cn}; }
    __device__ __forceinline__ void make_ep(int rtc, int cn, EP& ep) const { const int rt = rtc & 0xffff, hc = rtc >> 16, tile = __builtin_amdgcn_readfirstlane(tt[rt]), e = __builtin_amdgcn_readfirstlane(tt[160 + rt]);
        ep = EP{(bf16_t*)(ws + WS_ACT), bias + (size_t)e * 2 * DFF, tile * 256 + (hc == 2 ? 128 : 0), cn}; } };
struct MkDown { static constexpr bool MASKED = true; typedef ARowsDense AL; typedef BColsDense BL; typedef EpiBiasBf16 EP; unsigned char* ws; const float* w; const float* bias; const LAS int* tt;
    __device__ __forceinline__ int rows_valid(int rtc) const { return moe_rows_valid(tt, rtc); }
    __device__ __forceinline__ void make_src(int rtc, int ct, AL& al, BL& bl) const { const int rt = rtc & 0xffff, hc = rtc >> 16, tile = __builtin_amdgcn_readfirstlane(tt[rt]), e = __builtin_amdgcn_readfirstlane(tt[160 + rt]);
        const int r0 = tile * 256 + (hc == 2 ? 128 : 0);
        al = AL{(const bf16_t*)(ws + WS_ACT), (size_t)DFF, r0, hc ? r0 + 128 : MAX_ROWS, zrow_of(ws), ws}; bl = BL{w + (size_t)e * DFF * D, D, ct * 256, D}; }
    __device__ __forceinline__ void make_ep(int rtc, int ct, EP& ep) const { const int rt = rtc & 0xffff, hc = rtc >> 16, tile = __builtin_amdgcn_readfirstlane(tt[rt]), e = __builtin_amdgcn_readfirstlane(tt[160 + rt]);
        ep = EP{(bf16_t*)(ws + WS_Y), bias + (size_t)e * D, tile * 256 + (hc == 2 ? 128 : 0), ct * 256}; } };
struct ProvCmp1 { static constexpr bool SINGLE = true, MASKED = false; typedef ARowsWindow AL; typedef BColsDense BL; typedef EpiStoreF32 EP; unsigned char* ws; const float* w1; int u, G;
    int cu;
    __device__ __forceinline__ bool next(AL& al, BL& bl) { if (u >= 128) return false; const int kq = u >> 5, j = (u >> 4) & 1, rt = (u >> 1) & 7, ct = u & 1; cu = u; u += G;
        al = AL{(const bf16_t*)(ws + (j ? WS_VCMP : WS_KCMP)) + (size_t)kq * 8 * 256, rt * 256, zrow_of(ws), ws};
        bl = BL{w1 + (size_t)j * 2048 * CMP_HID + (size_t)kq * 512 * CMP_HID, CMP_HID, ct * 256, CMP_HID}; return true; }
    __device__ __forceinline__ void make_ep(EP& ep) const { const int kq = cu >> 5, j = (cu >> 4) & 1, rt = (cu >> 1) & 7, ct = cu & 1;
        ep = EP{(float*)(ws + WS_PART) + (size_t)(kq * 2 + j) * 2048 * CMP_HID, (size_t)CMP_HID, rt * 256, ct * 256, CMP_HID}; } };

__device__ __forceinline__ float rope_inv(int i) { return (float)exp(-(double)i * 0.125 * 13.122363377404328); }


__global__ void __launch_bounds__(512, 2) fwd(Args a) {
    extern __shared__ __attribute__((aligned(16))) unsigned char lds_raw[];
    LAS char* lds = (LAS char*)lds_raw;
    const int tid = threadIdx.x, lane = tid & 63, wid = __builtin_amdgcn_readfirstlane(tid >> 6);
    const int G = gridDim.x, bid = blockIdx.x;
    const int gtid = bid * 512 + tid, gthreads = G * 512;
    const int gwave = bid * 8 + wid, gwaves = G * 8;
    unsigned char* ws = a.ws;
    unsigned* ctl = (unsigned*)(ws + WS_CTL);
    volatile LAS unsigned* barw = (volatile LAS unsigned*)(lds + MAIN_LDS);
    if (tid == 0) { barw[0] = 0u; barw[1] = 0u; barw[2] = 0u; barw[3] = 0u; }
    __syncthreads();
    XcdBarrier bar; bar.bar = ctl; bar.x = 0; bar.st = barw;
    const bool multi = (a.ph_hi - a.ph_lo) > 1;
    int vbid = (G % 8 == 0) ? (bid & 7) * (G / 8) + (bid >> 3) : bid;
    if (multi) bar = xcd_barrier_post(ctl, barw);
#ifdef ONLY_PH
#define IN(k) ((k) == ONLY_PH)
#else
#define IN(k) (a.ph_lo <= (k) && (k) < a.ph_hi)
#endif
#define SEAM(k) do { if ((k) + 1 < a.ph_hi) xcd_barrier(bar); } while (0)

#define XN ((bf16_t*)(ws + WS_XN))
#define DT ((float*)(ws + WS_DT))
#define YSSD ((float*)(ws + WS_YSSD))
#define MIX ((bf16_t*)(ws + WS_MIX))
#define ROPE ((float*)(ws + WS_ROPE))
#define X2 ((float*)(ws + WS_X2))
#define TOPE ((int*)(ws + WS_TOPE))
#define TOPG ((float*)(ws + WS_TOPG))
#define SLOT ((int*)(ws + WS_SLOT))
#define POS ((int*)(ws + WS_POS))
#define ROWTOK ((int*)(ws + WS_ROWTOK))
#define ACT ((bf16_t*)(ws + WS_ACT))
#define YB ((bf16_t*)(ws + WS_Y))
#define STATES ((float*)(ws + WS_STATES))
#define PREV ((bf16_t*)(ws + WS_PREV))
#define CHDEC ((float*)(ws + WS_CHDEC))
#define QB ((bf16_t*)(ws + WS_QB))
#define KSb ((bf16_t*)(ws + WS_KS))
#define VSb ((bf16_t*)(ws + WS_VS))
#define KWb ((bf16_t*)(ws + WS_KW))
#define VWb ((bf16_t*)(ws + WS_VW))
#define KCB ((bf16_t*)(ws + WS_KCB))
#define VCB ((bf16_t*)(ws + WS_VCB))
#define XIN (a.in[0])
#define RW ((float*)(ws + WS_RW))
#define BCNT ((int*)(ws + WS_BCNT))
#define ZB ((bf16_t*)(ws + WS_ZB))
#define XBCR ((bf16_t*)(ws + WS_XBCR))
#define KCMPb ((bf16_t*)(ws + WS_KCMP))
#define VCMPb ((bf16_t*)(ws + WS_VCMP))
#define GATE ((float*)(ws + WS_GATE))
#define PEW ((float*)(ws + WS_PEW))
#define PEWP ((float*)(ws + WS_PEWP))
#define PART ((float*)(ws + WS_PART))
#define COUNT (ctl + CW_COUNT)
#define ZROW ((const bf16_t*)(ctl + CW_ZROW))
    if (IN(PH_NORM1)) {
        const float* w = a.in[1];
        for (int row = gwave; row < T; row += gwaves) {
            const float4* xr = (const float4*)(XIN + (size_t)row * D);
            float4 v[8], wg[8]; float ss = 0.f;
#pragma unroll
            for (int i = 0; i < 8; ++i) { v[i] = xr[lane + 64 * i]; wg[i] = ((const float4*)w)[lane + 64 * i]; }
#pragma unroll
            for (int i = 0; i < 8; ++i) ss += v[i].x * v[i].x + v[i].y * v[i].y + v[i].z * v[i].z + v[i].w * v[i].w;
            ss = wave_sum(ss);
            const float rstd = rsqrtf(ss * (1.0f / D) + NORM_EPS);
#pragma unroll
            for (int i = 0; i < 8; ++i) { const float4 wv = wg[i];
                *(uint2*)(XN + (size_t)row * D + 4 * (lane + 64 * i)) = make_uint2(pack2(v[i].x * rstd * wv.x, v[i].y * rstd * wv.y), pack2(v[i].z * rstd * wv.z, v[i].w * rstd * wv.w)); }
        }
        for (int i = gtid; i < SEQ * 8; i += gthreads) { const int pos = i >> 3, k = i & 7; const float ang = (float)pos * rope_inv(k); ROPE[i] = cosf(ang); ROPE[SEQ * 8 + i] = sinf(ang); }
        for (int i = gtid; i < MAX_ROWS; i += gthreads) ROWTOK[i] = -1;
        for (int i = gtid; i < 2 * 2 * 256; i += gthreads) { const int d = i & 255, b = (i >> 8) & 1, j = i >> 9; (j ? VCB : KCB)[((size_t)b * 256 + 255) * 256 + d] = 0; }
        for (int i = gtid; i < 2048 * 32; i += gthreads) { const int ii = i & 3, e = (i >> 2) & 31, kk = i >> 7, k = 4 * kk + ii; RW[i] = a.in[15][k] * a.in[16][k * NE + e]; }
        for (int i = gtid; i < 32 * 2 * CMP_HID; i += gthreads) {
            const int col = i & (CMP_HID - 1), j = (i >> 9) & 1, kc = i >> 10; const float* pe = a.in[9] + j * 2048 + kc * 64; const float* w1 = a.in[10] + ((size_t)j * 2048 + kc * 64) * CMP_HID + col;
            float acc = 0.f;
#pragma unroll 8
            for (int k = 0; k < 64; ++k) acc += pe[k] * w1[(size_t)k * CMP_HID];
            PEWP[i] = acc;
        }
        SEAM(PH_NORM1);
    }

    if (IN(PH_INPROJ)) {
        for (int i = gtid; i < 2 * CMP_HID; i += gthreads) { float acc = 0.f;
#pragma unroll 8
            for (int kc = 0; kc < 32; ++kc) acc += PEWP[kc * 1024 + i]; PEW[i] = acc; }
        if (multi && a.ph_lo <= PH_NORM1) {
            if (tid == 0) { unsigned base = 0u;
#pragma unroll
                for (unsigned j = 0; j < 16; ++j) { const unsigned c = xb_ld(&ctl[XB_XCNT(j)]); base += (j < bar.x) ? c : 0u; }
                barw[3] = base + barw[2]; }
            __syncthreads();
            vbid = __builtin_amdgcn_readfirstlane((int)barw[3]);
            if (vbid < 0 || vbid >= G) vbid = bid;
        }
        { PatchProv<MkInProj> P; P.mk = MkInProj{ws, a.in[2], a.in[5]}; P.init(T / 256, (IN_PROJ + 255) / 256, G, vbid); gemm_stream<false>(lds, P, D); }
        SEAM(PH_INPROJ);
    }

    if (IN(PH_SSD_CMP1)) {
        const int GW = G;
        {
            if (GW >= 256) {
                if (bid < 128) { ProvCmp1 P{ws, a.in[10], bid, 1 << 20, 0}; gemm_stream<false>(lds, P, 512); }
                else for (int it = bid - 128; it < 256; it += GW - 128) ssd_states_item(lds, it, XBCR, a.in[3], a.in[4], DT, a.in[6], STATES, CHDEC);
            } else {
            for (int u0 = bid; u0 < 128; u0 += GW) { ProvCmp1 P{ws, a.in[10], u0, 1 << 20, 0}; gemm_stream<false>(lds, P, 512); }
            for (int it = (bid + GW - (128 % GW)) % GW; it < 256; it += GW) ssd_states_item(lds, it, XBCR, a.in[3], a.in[4], DT, a.in[6], STATES, CHDEC);
            }
        }
        SEAM(PH_SSD_CMP1);
    }

    if (IN(PH_GNORM_CMP2)) {
        const float* nw = a.in[8];
        for (int i = (tid < 256 ? bid * 256 + tid : 1 << 30); i < 2 * 16 * 64 * 32; i += G * 256) {
            const int n4 = i & 31, p = (i >> 5) & 63, h = (i >> 11) & 15, b = i >> 15;
            f32x4 run = {0.f, 0.f, 0.f, 0.f};
#pragma unroll 1
            for (int c0 = 0; c0 < 32; c0 += 16) {
                f32x4 sv[16]; float dec[16];
#pragma unroll
                for (int q = 0; q < 16; ++q) { const size_t base = (((size_t)b * 32 + c0 + q) * 16 + h) * 8192 + p * 128 + n4 * 4; sv[q] = *(const f32x4*)(STATES + base); dec[q] = CHDEC[((size_t)b * 32 + c0 + q) * 16 + h]; }
#pragma unroll
                for (int q = 0; q < 16; ++q) { const size_t base = (((size_t)b * 32 + c0 + q) * 16 + h) * 8192 + p * 128 + n4 * 4;
                    *(uint2*)(PREV + base) = make_uint2(pack2(run[0], run[1]), pack2(run[2], run[3])); run = run * dec[q] + sv[q]; }
            }
        }
        const float* w2 = a.in[12]; const float* b2 = a.in[13]; const float* b1 = a.in[11];
        for (int it = gwave; it < 2 * CMP_ROWS; it += gwaves) {
            const int row = it % CMP_ROWS, j = it / CMP_ROWS, d = lane;
            const float* wj = w2 + (size_t)j * CMP_HID * 64;
            float s0 = b2[j * 64 + d];
            for (int k0 = 0; k0 < CMP_HID; k0 += 64) {
                float hx = b1[j * CMP_HID + k0 + lane] + PEW[j * CMP_HID + k0 + lane];
#pragma unroll
                for (int q = 0; q < 4; ++q) hx += PART[((size_t)(q * 2 + j) * 2048 + row) * CMP_HID + k0 + lane];
                const float u = 0.7978845608028654f * (hx + 0.044715f * hx * hx * hx);
                const float hv = bf2f(f2bf(0.5f * hx * (1.0f + tanhf(u))));
#pragma unroll
                for (int kk = 0; kk < 64; ++kk) s0 += __builtin_bit_cast(float, __builtin_amdgcn_readlane(__builtin_bit_cast(int, hv), kk)) * wj[(k0 + kk) * 64 + d];
            }
            float o = s0;
            if (j == 0) { const float sp = __shfl(s0, (d < 8) ? d + 8 : ((d < 16) ? d - 8 : d));
                if (d < 16) { const int n = (row >> 2) % N_C, pos = 16 * n + 31, k = d & 7; const float c = ROPE[pos * 8 + k], sn = ROPE[SEQ * 8 + pos * 8 + k];
                    o = (d < 8) ? (s0 * c - sp * sn) : (sp * sn + s0 * c); } }
            { const int g4 = row & 3, n = (row >> 2) % N_C, bb = (row >> 2) / N_C; (j ? VCB : KCB)[((size_t)bb * 256 + n) * 256 + g4 * 64 + d] = f2bf(o); }
        }
        SEAM(PH_GNORM_CMP2);
    }

    if (IN(PH_NSA)) {
        bf16_t* MIXO = MIX;
        for (int k = bid; k < 512; k += G) { const int rnd = k / G; const int u = (rnd & 1) ? ((511 - (k - G * rnd) - G * (rnd - 1)) ^ 7) : k;
            if (u >= 0 && u < 512) nsa_unit32(lds, (G == 256) ? u : k, QB, KSb, VSb, KWb, VWb, KCB, VCB, GATE, MIXO); }
        for (int it = bid; it < 256; it += G) ssd_out_item(lds, it, XBCR, a.in[3], a.in[4], DT, a.in[6], a.in[7], a.in[8], PREV, ZB, YSSD, MIXO);
        SEAM(PH_NSA);
    }

    if (IN(PH_OUTPROJ)) {
        { PatchProv<MkOutProj> P; P.mk = MkOutProj{ws, a.in[14], a.in[0]}; P.init(T / 256, D / 256, G, vbid); gemm_stream<false>(lds, P, 2048); }
        SEAM(PH_OUTPROJ);
    }

    if (IN(PH_ROUTER)) {
        const float* nwp = a.in[15]; const float* br = a.in[17];
        LAS float* part = (LAS float*)lds;
        LAS float* ssq = part + 8 * 512;
        LAS float* rsl = ssq + 128;
        LAS int* lcnt = (LAS int*)(rsl + 32);
        if (tid < 32) lcnt[tid] = 0;
        __syncthreads();
        const int r16 = lane & 15, kq = lane >> 4;
        for (int tp = bid; tp < T / 32; tp += G) {
            const int wt = wid >> 2, wk = wid & 3, tile = 2 * tp + wt;
            const int row = tile * 16 + r16;
            f32x4 acc0 = {0.f, 0.f, 0.f, 0.f}, acc1 = {0.f, 0.f, 0.f, 0.f}; float ssp = 0.f;
            const float* xr = X2 + (size_t)row * D + 512 * wk + 4 * kq;
            const float* rwp = RW + ((size_t)(128 * wk + kq) * 32 + r16) * 4;
#pragma unroll 8
            for (int j = 0; j < 32; ++j) {
                const f32x4 av = *(const f32x4*)(xr + 16 * j);
                const f32x4 b0 = *(const f32x4*)(rwp + (size_t)j * 4 * 128), b1 = *(const f32x4*)(rwp + (size_t)j * 4 * 128 + 64);
                ssp += av[0] * av[0] + av[1] * av[1] + av[2] * av[2] + av[3] * av[3];
#pragma unroll
                for (int i = 0; i < 4; ++i) { acc0 = __builtin_amdgcn_mfma_f32_16x16x4f32(av[i], b0[i], acc0, 0, 0, 0); acc1 = __builtin_amdgcn_mfma_f32_16x16x4f32(av[i], b1[i], acc1, 0, 0, 0); }
            }
            ssp += __shfl_xor(ssp, 16); ssp += __shfl_xor(ssp, 32);
            if (kq == 0) ssq[wid * 16 + r16] = ssp;
#pragma unroll
            for (int i = 0; i < 4; ++i) { part[wid * 512 + (4 * kq + i) * 32 + r16] = acc0[i]; part[wid * 512 + (4 * kq + i) * 32 + 16 + r16] = acc1[i]; }
            __syncthreads();
#pragma unroll
            for (int rep = 0; rep < 2; ++rep) {
                const int idx = tid + 512 * rep, ts = idx >> 9, rr = (idx >> 5) & 15, e = idx & 31, grow = (2 * tp + ts) * 16 + rr;
                float lg = 0.f, ss = 0.f;
#pragma unroll
                for (int w = 0; w < 4; ++w) { lg += part[(4 * ts + w) * 512 + rr * 32 + e]; ss += ssq[(4 * ts + w) * 16 + rr]; }
                const float rstd = rsqrtf(ss * (1.0f / D) + NORM_EPS);
                const float mine = lg * rstd + br[e];
                int rank = 0;
#pragma unroll
                for (int k = 0; k < NE; ++k) { const float o = __shfl(mine, (lane & 32) + k); rank += (o > mine || (o == mine && k < e)) ? 1 : 0; }
                const bool sel = rank < 4;
                float mx = sel ? mine : -INFINITY;
#pragma unroll
                for (int o = 16; o > 0; o >>= 1) mx = fmaxf(mx, __shfl_xor(mx, o));
                const float ex = sel ? __expf(mine - mx) : 0.f;
                float den = ex;
#pragma unroll
                for (int o = 16; o > 0; o >>= 1) den += __shfl_xor(den, o);
                if (sel) { const int slot = atomicAdd((int*)&lcnt[e], 1); const int o = grow * 4 + rank; TOPE[o] = e; TOPG[o] = ex / den; SLOT[o] = slot; }
                if (e == 0) rsl[ts * 16 + rr] = rstd;
            }
            __syncthreads();
            if (tid < 32) { BCNT[tp * 32 + tid] = lcnt[tid]; lcnt[tid] = 0; }
            { const f32x4 wv = *(const f32x4*)(nwp + 4 * tid);
#pragma unroll 1
              for (int half = 0; half < 4; ++half) {
                f32x4 vv[8];
#pragma unroll
                for (int it = 0; it < 8; ++it) vv[it] = *(const f32x4*)(X2 + (size_t)(tp * 32 + half * 8 + it) * D + 4 * tid);
#pragma unroll
                for (int it = 0; it < 8; ++it) { const float rs = rsl[half * 8 + it]; const f32x4 v = vv[it];
                    *(uint2*)(XN + (size_t)(tp * 32 + half * 8 + it) * D + 4 * tid) = make_uint2(pack2(v[0] * rs * wv[0], v[1] * rs * wv[1]), pack2(v[2] * rs * wv[2], v[3] * rs * wv[3])); }
              } }
            __syncthreads();
        }
        SEAM(PH_ROUTER);
    }

    if (IN(PH_SCATTER)) {
        LAS int* red = (LAS int*)lds;
        for (int cb = bid; cb < 64; cb += G) {
            const int tp0 = 4 * cb, e = tid & 31, c = tid >> 5;
            int sb = 0, stt = 0;
#pragma unroll 4
            for (int q = 0; q < 16; ++q) { const int tpq = 16 * c + q; const int v = BCNT[tpq * 32 + e]; stt += v; sb += (tpq < tp0) ? v : 0; }
            red[c * 32 + e] = sb; red[512 + c * 32 + e] = stt;
            __syncthreads();
            if (tid < 32) { int b0 = 0, tt_ = 0;
#pragma unroll
                for (int q = 0; q < 16; ++q) { b0 += red[q * 32 + tid]; tt_ += red[512 + q * 32 + tid]; }
                red[1024 + tid] = b0; red[1056 + tid] = tt_; if (cb == 0) COUNT[tid] = (unsigned)tt_; }
            __syncthreads();
            { const int i = cb * 512 + tid, ei = TOPE[i], tp = i >> 7;
              int base = red[1024 + ei];
              for (int q = tp0; q < tp; ++q) base += BCNT[q * 32 + ei];
              int off = 0;
              for (int k = 0; k < ei; ++k) off += (red[1056 + k] + 255) >> 8;
              const int pos = off * 256 + base + SLOT[i];
              ROWTOK[pos] = i >> 2; POS[i] = pos; }
            __syncthreads();
        }
        SEAM(PH_SCATTER);
    }

    if (IN(PH_GATEUP)) {
        const int ntiles = moe_tile_table(lds, COUNT);
        { PatchProv<MkGateUp> P; P.mk = MkGateUp{ws, a.in[18], a.in[19], (const LAS int*)(lds + TT_OFF)}; P.init(ntiles, 16, G, vbid); gemm_stream<true>(lds, P, D); }
        SEAM(PH_GATEUP);
    }
    if (IN(PH_DOWN)) {
        const int ntiles = moe_tile_table(lds, COUNT);
        { PatchProv<MkDown> P; P.mk = MkDown{ws, a.in[20], a.in[21], (const LAS int*)(lds + TT_OFF)}; P.init(ntiles, 8, G, vbid); gemm_stream<false>(lds, P, DFF); }
        SEAM(PH_DOWN);
    }

    if (IN(PH_FINAL)) {
        const float* fw = a.in[22];
        for (int row = gwave; row < T; row += gwaves) {
            const float4* xr = (const float4*)(X2 + (size_t)row * D);
            float4 v[8], wg[8]; float gks[4]; int ps[4];
#pragma unroll
            for (int k = 0; k < 4; ++k) { gks[k] = TOPG[row * 4 + k]; ps[k] = POS[row * 4 + k]; }
#pragma unroll
            for (int i = 0; i < 8; ++i) { v[i] = xr[lane + 64 * i]; wg[i] = ((const float4*)fw)[lane + 64 * i]; }
#pragma unroll
            for (int k = 0; k < 4; ++k) { const float gk = gks[k]; const bf16_t* yr = YB + (size_t)ps[k] * D;
#pragma unroll
                for (int i = 0; i < 8; ++i) { const uint2 y = *(const uint2*)(yr + 4 * (lane + 64 * i));
                    v[i].x += gk * bf2f((bf16_t)(y.x & 0xffffu)); v[i].y += gk * bf2f((bf16_t)(y.x >> 16)); v[i].z += gk * bf2f((bf16_t)(y.y & 0xffffu)); v[i].w += gk * bf2f((bf16_t)(y.y >> 16)); } }
            float ss = 0.f;
#pragma unroll
            for (int i = 0; i < 8; ++i) ss += v[i].x * v[i].x + v[i].y * v[i].y + v[i].z * v[i].z + v[i].w * v[i].w;
            ss = wave_sum(ss);
            float rstd = rsqrtf(ss * (1.0f / D) + NORM_EPS);
#pragma unroll
            for (int i = 0; i < 8; ++i) { const float4 wv = wg[i];
                ((float4*)(a.out + (size_t)row * D))[lane + 64 * i] = make_float4(v[i].x * rstd * wv.x, v[i].y * rstd * wv.y, v[i].z * rstd * wv.z, v[i].w * rstd * wv.w); }
        }
    }
#undef IN
#undef SEAM
}

extern "C" void kernel_launch(void* const* d_in, const int* in_sizes, int n_in, void* d_out, int out_size, void* d_ws, size_t ws_size, hipStream_t stream) {
    static int grid = 0;
    if (grid == 0) {
        if (n_in != 23 || out_size != T * D || ws_size < WS_END) { fprintf(stderr, "kernel_launch: unexpected shapes (n_in %d, out %d, ws %zu < %zu)\n", n_in, out_size, ws_size, (size_t)WS_END); grid = -1; return; }
        int dev = 0, cus = 0, per_cu = 0;
        if (hipGetDevice(&dev) != hipSuccess || hipDeviceGetAttribute(&cus, hipDeviceAttributeMultiprocessorCount, dev) != hipSuccess) { grid = -1; return; }
        if (hipFuncSetAttribute((const void*)fwd, hipFuncAttributeMaxDynamicSharedMemorySize, LDS_BYTES) != hipSuccess) { fprintf(stderr, "kernel_launch: hipFuncSetAttribute failed\n"); grid = -1; return; }
        if (hipOccupancyMaxActiveBlocksPerMultiprocessor(&per_cu, (const void*)fwd, 512, LDS_BYTES) != hipSuccess || per_cu < 1) { fprintf(stderr, "kernel_launch: occupancy query says %d\n", per_cu); per_cu = 1; }
        (void)hipGetLastError();
        grid = cus;
    }
    if (grid < 0) return;
    (void)hipMemsetAsync((char*)d_ws + WS_CTL, 0, CTL_BYTES, stream);
    Args a{};
    for (int i = 0; i < 23; ++i) a.in[i] = (const float*)d_in[i];
    a.out = (float*)d_out; a.ws = (unsigned char*)d_ws;
#if N_LAUNCH_MODE == 1
    a.ph_lo = 0; a.ph_hi = N_PHASES;
    hipLaunchKernelGGL(fwd, dim3(grid), dim3(512), LDS_BYTES, stream, a);
#else
    for (int ph = 0; ph < N_PHASES; ++ph) { a.ph_lo = ph; a.ph_hi = ph + 1; hipLaunchKernelGGL(fwd, dim3(grid), dim3(512), LDS_BYTES, stream, a); }
#endif
}
```
